# Optimizing an MI355X kernel written in HIP

```python
import jax, jax.numpy as jnp
from jax import lax
import numpy as np

D_MODEL = 1024
BATCH = 2
SEQ = 8192
DEPTH = 2

N_MIXERS = 2
N_HGRN_LAYERS = (DEPTH + 1) // 2
N_ATTN_LAYERS = DEPTH // 2

HGRN_EXPAND = 128
HGRN_HEADS = D_MODEL // HGRN_EXPAND
HGRN_KEY_DIM = HGRN_EXPAND
HGRN_VAL_DIM = D_MODEL // HGRN_HEADS
HGRN_QK_WIDTH = HGRN_HEADS * HGRN_KEY_DIM
HGRN_V_WIDTH = HGRN_HEADS * HGRN_VAL_DIM
HGRN_IN_WIDTH = 2 * HGRN_QK_WIDTH + 2 * HGRN_V_WIDTH
HGRN_CHUNK = 64

ATTN_HEAD_DIM = 128
DILATED_GROUPS = ((128, 1), (512, 4), (2048, 16))
HEADS_PER_GROUP = 4
N_GROUPS = len(DILATED_GROUPS)
ATTN_HEADS = HEADS_PER_GROUP * N_GROUPS
ATTN_WIDTH = ATTN_HEADS * ATTN_HEAD_DIM
ROPE_THETA = 10000.0

D_FF = ((8 * D_MODEL // 3 + 255) // 256) * 256

NORM_EPS = 1e-6

kernel_name = "hgrn2_dilated_swa_interleaved_trunk"


def rmsnorm(x, gain):
    xf = x.astype(jnp.float32)
    y = xf * lax.rsqrt(jnp.mean(xf * xf, axis=-1, keepdims=True) + NORM_EPS)
    return (y * gain.astype(jnp.float32)).astype(x.dtype)


def rope_tables(seq_len):
    inv_freq = 1.0 / (ROPE_THETA ** (jnp.arange(0, ATTN_HEAD_DIM, 2, dtype=jnp.float32) / ATTN_HEAD_DIM))
    pos = jnp.arange(seq_len, dtype=jnp.float32)
    ang = pos[:, None] * inv_freq[None, :]
    return jnp.cos(ang)[:, None, :], jnp.sin(ang)[:, None, :]


def apply_rope(x, cos, sin):
    xf = x.astype(jnp.float32)
    x1, x2 = jnp.split(xf, 2, axis=-1)
    out = jnp.concatenate([x1 * cos - x2 * sin, x2 * cos + x1 * sin], axis=-1)
    return out.astype(x.dtype)


def hgrn2_mixer(u, w_in, lower_bound, out_gain, w_out):
    B, S, _ = u.shape
    H, K, V, C = HGRN_HEADS, HGRN_KEY_DIM, HGRN_VAL_DIM, HGRN_CHUNK
    proj = u @ w_in
    q, f, i, g = jnp.split(proj, [HGRN_QK_WIDTH, 2 * HGRN_QK_WIDTH, 2 * HGRN_QK_WIDTH + HGRN_V_WIDTH], axis=-1)
    lb = lower_bound.astype(jnp.float32)
    forget = lb + (1.0 - lb) * jax.nn.sigmoid(f.astype(jnp.float32))
    key = 1.0 - forget
    log_f = jnp.log(forget)
    query = jax.nn.silu(q.astype(jnp.float32))
    value = i.astype(jnp.float32)

    def to_chunks(t, d):
        return t.reshape(B, S // C, C, H, d).transpose(1, 0, 3, 2, 4)

    xs = (to_chunks(query, K), to_chunks(key, K), to_chunks(value, V), to_chunks(log_f, K))
    causal = jnp.tril(jnp.ones((C, C), dtype=bool))[:, :, None]

    def chunk_step(state, inp):
        qc, kc, vc, gc = inp
        b = jnp.cumsum(gc, axis=2)
        o_inter = jnp.einsum('bhck,bhkv->bhcv', qc * jnp.exp(b), state)
        diff = b[:, :, :, None, :] - b[:, :, None, :, :]
        decay = jnp.exp(jnp.where(causal, diff, -jnp.inf))
        scores = jnp.einsum('bhtk,bhsk,bhtsk->bhts', qc, kc, decay)
        o_intra = jnp.einsum('bhts,bhsv->bhtv', scores, vc)
        b_last = b[:, :, -1, :]
        k_to_end = kc * jnp.exp(b_last[:, :, None, :] - b)
        new_state = jnp.exp(b_last)[..., None] * state + jnp.einsum('bhck,bhcv->bhkv', k_to_end, vc)
        return new_state, o_inter + o_intra

    state0 = jnp.zeros((B, H, K, V), dtype=jnp.float32)
    _, o = lax.scan(chunk_step, state0, xs)
    o = o.transpose(1, 0, 3, 2, 4).reshape(B, S, H, V)
    o = rmsnorm(o, out_gain)
    o = o * jax.nn.silu(g.astype(jnp.float32)).reshape(B, S, H, V)
    return o.reshape(B, S, H * V).astype(u.dtype) @ w_out


def dilated_window_group(q, k, v, window, dilation):
    B, S, Hg, D = q.shape
    span = window // dilation
    L = S // dilation
    nb = -(-L // span)
    Lp = nb * span

    def to_blocks(t):
        t = t.reshape(B, L, dilation, Hg, D).transpose(0, 2, 3, 1, 4)
        t = jnp.pad(t, ((0, 0), (0, 0), (0, 0), (0, Lp - L), (0, 0)))
        return t.reshape(B, dilation, Hg, nb, span, D)

    qb, kb, vb = to_blocks(q), to_blocks(k), to_blocks(v)

    def with_prev(t):
        prev = jnp.pad(t, ((0, 0), (0, 0), (0, 0), (1, 0), (0, 0), (0, 0)))[:, :, :, :-1]
        return jnp.concatenate([prev, t], axis=4)

    kw, vw = with_prev(kb), with_prev(vb)
    scores = jnp.einsum('bdhnqe,bdhnke->bdhnqk', qb, kw, preferred_element_type=jnp.float32) * (D ** -0.5)
    blk = jnp.arange(nb)[:, None, None] * span
    qpos = blk + jnp.arange(span)[None, :, None]
    kpos = blk - span + jnp.arange(2 * span)[None, None, :]
    mask = (kpos <= qpos) & (kpos >= qpos - span) & (kpos >= 0)
    scores = jnp.where(mask, scores, -jnp.inf)
    m = jnp.max(scores, axis=-1, keepdims=True)
    p = jnp.exp(scores - m)
    l = jnp.sum(p, axis=-1, keepdims=True)
    out = jnp.einsum('bdhnqk,bdhnke->bdhnqe', p, vw.astype(jnp.float32)) / l
    lse = (m + jnp.log(l))[..., 0]
    out = out.reshape(B, dilation, Hg, Lp, D)[:, :, :, :L].transpose(0, 3, 1, 2, 4).reshape(B, S, Hg, D)
    lse = lse.reshape(B, dilation, Hg, Lp)[:, :, :, :L].transpose(0, 3, 1, 2).reshape(B, S, Hg)
    return out, lse


def dilated_attention_mixer(u, w_qkv, w_out, cos, sin):
    B, S, _ = u.shape
    qkv = (u @ w_qkv).reshape(B, S, 3, ATTN_HEADS, ATTN_HEAD_DIM)
    q = apply_rope(qkv[:, :, 0], cos, sin)
    k = apply_rope(qkv[:, :, 1], cos, sin)
    v = qkv[:, :, 2]
    outs, lses = [], []
    for gi, (window, dilation) in enumerate(DILATED_GROUPS):
        hs = slice(gi * HEADS_PER_GROUP, (gi + 1) * HEADS_PER_GROUP)
        o_g, lse_g = dilated_window_group(q[:, :, hs], k[:, :, hs], v[:, :, hs], window, dilation)
        outs.append(o_g)
        lses.append(lse_g)
    o = jnp.stack(outs, axis=2)
    lse = jnp.stack(lses, axis=2)
    alpha = jax.nn.softmax(lse, axis=2)
    o = (o * alpha[..., None]).reshape(B, S, ATTN_WIDTH).astype(u.dtype)
    return o @ w_out


def swiglu_ffn(u, w_in, w_down):
    gate, up = jnp.split(u @ w_in, 2, axis=-1)
    return (jax.nn.silu(gate) * up) @ w_down


def setup_inputs(seed: int = 0) -> dict:
    key = jax.random.key(seed)
    ks = jax.random.split(key, 13)
    f32 = jnp.float32

    def dense(k, shape, fan_in):
        return jax.random.normal(k, shape, f32) * (fan_in ** -0.5)

    def gain(k, shape):
        return 1.0 + 0.02 * jax.random.normal(k, shape, f32)

    return {
        "x": jax.random.normal(ks[0], (BATCH, SEQ, D_MODEL), f32),
        "norm_mix": gain(ks[1], (DEPTH, D_MODEL)),
        "norm_ffn": gain(ks[2], (DEPTH, D_MODEL)),
        "hgrn_w_in": dense(ks[3], (N_HGRN_LAYERS, D_MODEL, HGRN_IN_WIDTH), D_MODEL),
        "hgrn_lb_logits": 0.5 * jax.random.normal(ks[4], (DEPTH + 1, HGRN_QK_WIDTH), f32),
        "hgrn_out_norm": gain(ks[5], (N_HGRN_LAYERS, HGRN_VAL_DIM)),
        "hgrn_w_out": dense(ks[6], (N_HGRN_LAYERS, HGRN_V_WIDTH, D_MODEL), HGRN_V_WIDTH),
        "attn_w_qkv": dense(ks[7], (N_ATTN_LAYERS, D_MODEL, 3 * ATTN_WIDTH), D_MODEL),
        "attn_w_out": dense(ks[8], (N_ATTN_LAYERS, ATTN_WIDTH, D_MODEL), ATTN_WIDTH),
        "ffn_w_in": dense(ks[9], (DEPTH, D_MODEL, 2 * D_FF), D_MODEL),
        "ffn_w_down": dense(ks[10], (DEPTH, D_FF, D_MODEL), D_FF),
        "final_norm": gain(ks[11], (D_MODEL,)),
    }


def reference(x, norm_mix, norm_ffn, hgrn_w_in, hgrn_lb_logits, hgrn_out_norm, hgrn_w_out,
              attn_w_qkv, attn_w_out, ffn_w_in, ffn_w_down, final_norm):
    lb_table = jnp.cumsum(jax.nn.softmax(hgrn_lb_logits.astype(jnp.float32), axis=0), axis=0)
    cos, sin = rope_tables(x.shape[1])
    h = x
    for layer in range(DEPTH):
        u = rmsnorm(h, norm_mix[layer])
        if layer % N_MIXERS == 0:
            a = layer // N_MIXERS
            mix = hgrn2_mixer(u, hgrn_w_in[a], lb_table[layer], hgrn_out_norm[a], hgrn_w_out[a])
        else:
            a = layer // N_MIXERS
            mix = dilated_attention_mixer(u, attn_w_qkv[a], attn_w_out[a], cos, sin)
        h = h + mix
        h = h + swiglu_ffn(rmsnorm(h, norm_ffn[layer]), ffn_w_in[layer], ffn_w_down[layer])
    return rmsnorm(h, final_norm)
```

```cpp
#include <hip/hip_runtime.h>
#include <math.h>

constexpr int D = 1024, NB = 2, SEQ = 8192, M = NB * SEQ, DFF = 2816;
constexpr int HIN = 4096, QKVW = 4608, AW = 1536;
constexpr float EPS = 1e-6f;

__device__ __forceinline__ float wave_sum(float v) {
#pragma unroll
    for (int o = 1; o < 64; o <<= 1) v += __shfl_xor(v, o);
    return v;
}
__device__ __forceinline__ float sigmoidf_(float x) { return 1.0f / (1.0f + expf(-x)); }
__device__ __forceinline__ float siluf_(float x) { return x / (1.0f + expf(-x)); }

__global__ __launch_bounds__(256) void k_rmsnorm(const float* x, const float* gain, float* out, int rows) {
    const int wave = (blockIdx.x * blockDim.x + threadIdx.x) >> 6, lane = threadIdx.x & 63;
    if (wave >= rows) return;
    const float4* xr = (const float4*)(x + (size_t)wave * D);
    float4 v[4]; float s = 0.f;
#pragma unroll
    for (int j = 0; j < 4; ++j) { v[j] = xr[lane + 64 * j]; s += v[j].x * v[j].x + v[j].y * v[j].y + v[j].z * v[j].z + v[j].w * v[j].w; }
    s = wave_sum(s);
    const float r = 1.0f / sqrtf(s * (1.0f / D) + EPS);
    float4* o = (float4*)(out + (size_t)wave * D);
    const float4* g4 = (const float4*)gain;
#pragma unroll
    for (int j = 0; j < 4; ++j) { const float4 g = g4[lane + 64 * j]; float4 w; w.x = v[j].x * r * g.x; w.y = v[j].y * r * g.y; w.z = v[j].z * r * g.z; w.w = v[j].w * r * g.w; o[lane + 64 * j] = w; }
}

template <bool ADD>
__global__ __launch_bounds__(256) void k_gemm(const float* A, int lda, const float* W, int N, int K, float* C, int ldc, const float* R, int ldr) {
    __shared__ float As[8][132];
    __shared__ float Bs[8][128];
    const int tid = threadIdx.x, tx = tid & 15, ty = tid >> 4;
    const int row0 = blockIdx.y * 128, col0 = blockIdx.x * 128;
    float acc[8][8];
#pragma unroll
    for (int i = 0; i < 8; ++i)
#pragma unroll
        for (int j = 0; j < 8; ++j) acc[i][j] = 0.f;
    const float* Ap = A + (size_t)(row0 + (tid >> 1)) * lda + (tid & 1) * 4;
    const float* Wp = W + (size_t)(tid >> 5) * N + col0 + (tid & 31) * 4;
    for (int k0 = 0; k0 < K; k0 += 8) {
        const float4 a = *(const float4*)(Ap + k0);
        const float4 b = *(const float4*)(Wp + (size_t)k0 * N);
        As[(tid & 1) * 4 + 0][tid >> 1] = a.x; As[(tid & 1) * 4 + 1][tid >> 1] = a.y; As[(tid & 1) * 4 + 2][tid >> 1] = a.z; As[(tid & 1) * 4 + 3][tid >> 1] = a.w;
        *(float4*)&Bs[tid >> 5][(tid & 31) * 4] = b;
        __syncthreads();
#pragma unroll
        for (int kk = 0; kk < 8; ++kk) {
            const float4 a0 = *(const float4*)&As[kk][ty * 8], a1 = *(const float4*)&As[kk][ty * 8 + 4];
            const float4 b0 = *(const float4*)&Bs[kk][tx * 8], b1 = *(const float4*)&Bs[kk][tx * 8 + 4];
            const float av[8] = {a0.x, a0.y, a0.z, a0.w, a1.x, a1.y, a1.z, a1.w};
            const float bv[8] = {b0.x, b0.y, b0.z, b0.w, b1.x, b1.y, b1.z, b1.w};
#pragma unroll
            for (int i = 0; i < 8; ++i)
#pragma unroll
                for (int j = 0; j < 8; ++j) acc[i][j] = fmaf(av[i], bv[j], acc[i][j]);
        }
        __syncthreads();
    }
#pragma unroll
    for (int i = 0; i < 8; ++i) {
        const size_t r = (size_t)(row0 + ty * 8 + i);
        float* cp = C + r * ldc + col0 + tx * 8;
        float4 o0 = {acc[i][0], acc[i][1], acc[i][2], acc[i][3]}, o1 = {acc[i][4], acc[i][5], acc[i][6], acc[i][7]};
        if (ADD) { const float* rp = R + r * ldr + col0 + tx * 8; const float4 r0 = *(const float4*)rp, r1 = *(const float4*)(rp + 4);
            o0.x += r0.x; o0.y += r0.y; o0.z += r0.z; o0.w += r0.w; o1.x += r1.x; o1.y += r1.y; o1.z += r1.z; o1.w += r1.w; }
        *(float4*)cp = o0; *(float4*)(cp + 4) = o1;
    }
}

__global__ __launch_bounds__(64) void k_hgrn_rec(const float* P, const float* lbl, float* O) {
    const int h = blockIdx.x >> 4, vg = blockIdx.x & 15, lane = threadIdx.x;
    const int k0 = h * 128 + lane, k1 = k0 + 64;
    float lb0, lb1;
    { const float a = lbl[k0], b = lbl[1024 + k0], c = lbl[2048 + k0]; const float mx = fmaxf(a, fmaxf(b, c)); const float ea = expf(a - mx), eb = expf(b - mx), ec = expf(c - mx); lb0 = ea / (ea + eb + ec); }
    { const float a = lbl[k1], b = lbl[1024 + k1], c = lbl[2048 + k1]; const float mx = fmaxf(a, fmaxf(b, c)); const float ea = expf(a - mx), eb = expf(b - mx), ec = expf(c - mx); lb1 = ea / (ea + eb + ec); }
    float S0[8], S1[8];
#pragma unroll
    for (int j = 0; j < 8; ++j) { S0[j] = 0.f; S1[j] = 0.f; }
    const int vbase = 2048 + h * 128 + vg * 8;
#pragma unroll 2
    for (int t = 0; t < SEQ; ++t) {
        const float* p = P + (size_t)t * HIN;
        const float q0 = siluf_(p[k0]), q1 = siluf_(p[k1]);
        const float fg0 = lb0 + (1.f - lb0) * sigmoidf_(p[1024 + k0]), fg1 = lb1 + (1.f - lb1) * sigmoidf_(p[1024 + k1]);
        const float ky0 = 1.f - fg0, ky1 = 1.f - fg1;
        const float4 i0 = *(const float4*)(p + vbase), i1 = *(const float4*)(p + vbase + 4);
        const float iv[8] = {i0.x, i0.y, i0.z, i0.w, i1.x, i1.y, i1.z, i1.w};
        float part[8];
#pragma unroll
        for (int j = 0; j < 8; ++j) { S0[j] = fg0 * S0[j] + ky0 * iv[j]; S1[j] = fg1 * S1[j] + ky1 * iv[j]; part[j] = q0 * S0[j] + q1 * S1[j]; }
#pragma unroll
        for (int j = 0; j < 8; ++j) part[j] = wave_sum(part[j]);
        if (lane == 0) { float* o = O + (size_t)t * D + h * 128 + vg * 8; *(float4*)o = make_float4(part[0], part[1], part[2], part[3]); *(float4*)(o + 4) = make_float4(part[4], part[5], part[6], part[7]); }
    }
}

__global__ __launch_bounds__(256) void k_hgrn_post(float* O, const float* P, const float* gain, int rows) {
    const int w = (blockIdx.x * blockDim.x + threadIdx.x) >> 6, lane = threadIdx.x & 63;
    if (w >= rows * 8) return;
    const int t = w >> 3, h = w & 7;
    float2* op = (float2*)(O + (size_t)t * D + h * 128) + lane;
    const float2 v = *op;
    const float ss = wave_sum(v.x * v.x + v.y * v.y);
    const float r = 1.0f / sqrtf(ss * (1.0f / 128.0f) + EPS);
    const float2 g = *((const float2*)(P + (size_t)t * HIN + 3072 + h * 128) + lane);
    const float2 gn = *((const float2*)gain + lane);
    float2 o; o.x = v.x * r * gn.x * siluf_(g.x); o.y = v.y * r * gn.y * siluf_(g.y);
    *op = o;
}

__global__ __launch_bounds__(256) void k_swiglu(float* BIG, int rows) {
    const size_t i = (size_t)blockIdx.x * blockDim.x + threadIdx.x;
    if (i >= (size_t)rows * DFF) return;
    const size_t r = i / DFF; const int c = (int)(i % DFF);
    float* p = BIG + r * (2 * DFF) + c;
    *p = siluf_(p[0]) * p[DFF];
}

__global__ __launch_bounds__(256) void k_rope(float* BIG) {
    const size_t i = (size_t)blockIdx.x * blockDim.x + threadIdx.x;
    if (i >= (size_t)SEQ * 24 * 64) return;
    const int j = (int)(i & 63), hd = (int)((i >> 6) % 24), t = (int)(i / (24 * 64));
    const float inv = 1.0f / powf(10000.0f, (float)(2 * j) / 128.0f);
    const float ang = (float)t * inv;
    const float c = (float)cos((double)ang), s = (float)sin((double)ang);
    float* p = BIG + (size_t)t * QKVW + hd * 128 + j;
    const float x1 = p[0], x2 = p[64];
    p[0] = x1 * c - x2 * s; p[64] = x2 * c + x1 * s;
}

__global__ __launch_bounds__(256) void k_attn(float* BIG, float* LSE) {
    const int w = blockIdx.x * 4 + (threadIdx.x >> 6), lane = threadIdx.x & 63;
    if (w >= SEQ * 12) return;
    const int t = w / 12, hd = w % 12, g = hd >> 2;
    const int dil = g == 0 ? 1 : (g == 1 ? 4 : 16);
    float2* qp = (float2*)(BIG + (size_t)t * QKVW + hd * 128) + lane;
    const float2 q = *qp;
    float m = -INFINITY, l = 0.f, o0 = 0.f, o1 = 0.f;
    for (int j = 0; j <= 128; ++j) {
        const int tk = t - j * dil;
        if (tk < 0) break;
        const float2 kk = *((const float2*)(BIG + (size_t)tk * QKVW + AW + hd * 128) + lane);
        const float s = wave_sum(q.x * kk.x + q.y * kk.y) * 0.08838834764831845f;
        const float2 vv = *((const float2*)(BIG + (size_t)tk * QKVW + 2 * AW + hd * 128) + lane);
        const float mn = fmaxf(m, s), a = expf(m - mn), p = expf(s - mn);
        l = l * a + p; o0 = o0 * a + p * vv.x; o1 = o1 * a + p * vv.y; m = mn;
    }
    float2 o; o.x = o0 / l; o.y = o1 / l;
    *qp = o;
    if (lane == 0) LSE[(size_t)t * 12 + hd] = m + logf(l);
}

__global__ __launch_bounds__(256) void k_merge(float* BIG, const float* LSE) {
    const size_t i = (size_t)blockIdx.x * blockDim.x + threadIdx.x;
    if (i >= (size_t)SEQ * AW) return;
    const int t = (int)(i / AW), c = (int)(i % AW), hd = c >> 7, hg = hd & 3;
    const float* ls = LSE + (size_t)t * 12;
    const float a = ls[hg], b = ls[4 + hg], cc = ls[8 + hg], mx = fmaxf(a, fmaxf(b, cc));
    const float ea = expf(a - mx), eb = expf(b - mx), ec = expf(cc - mx);
    const float mine = expf(ls[hd] - mx) / (ea + eb + ec);
    BIG[(size_t)t * QKVW + c] *= mine;
}

extern "C" void kernel_launch(void* const* d_in, const int* in_sizes, int n_in, void* d_out, int out_size, void* d_ws, size_t ws_size, hipStream_t stream) {
    const float* x = (const float*)d_in[0];
    const float* norm_mix = (const float*)d_in[1];
    const float* norm_ffn = (const float*)d_in[2];
    const float* hgrn_w_in = (const float*)d_in[3];
    const float* lb_logits = (const float*)d_in[4];
    const float* hgrn_out_norm = (const float*)d_in[5];
    const float* hgrn_w_out = (const float*)d_in[6];
    const float* attn_w_qkv = (const float*)d_in[7];
    const float* attn_w_out = (const float*)d_in[8];
    const float* ffn_w_in = (const float*)d_in[9];
    const float* ffn_w_down = (const float*)d_in[10];
    const float* final_norm = (const float*)d_in[11];
    float* H = (float*)d_out;
    float* U = (float*)d_ws;
    float* BIG = U + (size_t)M * D;
    float* LSE = BIG + (size_t)SEQ * 2 * DFF;

    auto ffn = [&](int layer) {
        k_rmsnorm<<<M / 4, 256, 0, stream>>>(H, norm_ffn + layer * D, U, M);
        for (int b = 0; b < NB; ++b) {
            float* Ub = U + (size_t)b * SEQ * D; float* Hb = H + (size_t)b * SEQ * D;
            k_gemm<false><<<dim3(2 * DFF / 128, SEQ / 128), 256, 0, stream>>>(Ub, D, ffn_w_in + (size_t)layer * D * 2 * DFF, 2 * DFF, D, BIG, 2 * DFF, nullptr, 0);
            k_swiglu<<<(SEQ * DFF + 255) / 256, 256, 0, stream>>>(BIG, SEQ);
            k_gemm<true><<<dim3(D / 128, SEQ / 128), 256, 0, stream>>>(BIG, 2 * DFF, ffn_w_down + (size_t)layer * DFF * D, D, DFF, Hb, D, Hb, D);
        }
    };

    k_rmsnorm<<<M / 4, 256, 0, stream>>>(x, norm_mix, U, M);
    for (int b = 0; b < NB; ++b) {
        float* Ub = U + (size_t)b * SEQ * D; float* Hb = H + (size_t)b * SEQ * D; const float* xb = x + (size_t)b * SEQ * D;
        k_gemm<false><<<dim3(HIN / 128, SEQ / 128), 256, 0, stream>>>(Ub, D, hgrn_w_in, HIN, D, BIG, HIN, nullptr, 0);
        k_hgrn_rec<<<128, 64, 0, stream>>>(BIG, lb_logits, Ub);
        k_hgrn_post<<<SEQ * 8 / 4, 256, 0, stream>>>(Ub, BIG, hgrn_out_norm, SEQ);
        k_gemm<true><<<dim3(D / 128, SEQ / 128), 256, 0, stream>>>(Ub, D, hgrn_w_out, D, D, Hb, D, xb, D);
    }
    ffn(0);
    k_rmsnorm<<<M / 4, 256, 0, stream>>>(H, norm_mix + D, U, M);
    for (int b = 0; b < NB; ++b) {
        float* Ub = U + (size_t)b * SEQ * D; float* Hb = H + (size_t)b * SEQ * D;
        k_gemm<false><<<dim3(QKVW / 128, SEQ / 128), 256, 0, stream>>>(Ub, D, attn_w_qkv, QKVW, D, BIG, QKVW, nullptr, 0);
        k_rope<<<SEQ * 24 * 64 / 256, 256, 0, stream>>>(BIG);
        k_attn<<<SEQ * 12 / 4, 256, 0, stream>>>(BIG, LSE);
        k_merge<<<SEQ * AW / 256, 256, 0, stream>>>(BIG, LSE);
        k_gemm<true><<<dim3(D / 128, SEQ / 128), 256, 0, stream>>>(BIG, QKVW, attn_w_out, D, AW, Hb, D, Hb, D);
    }
    ffn(1);
    k_rmsnorm<<<M / 4, 256, 0, stream>>>(H, final_norm, H, M);
}
```

```cpp
#include <hip/hip_runtime.h>
#include <cstdio>
#include <cstdint>
#include <math.h>

constexpr int BATCH = 2, T = 8192, D = 1024, M = BATCH * T;
constexpr int HIN = 4096, DFF = 2816, FF2 = 2 * DFF, QKVW = 4608, AW = 1536;
constexpr float NORM_EPS = 1e-6f;

namespace pg8 {
#define PG8_LAS __attribute__((address_space(3)))
typedef unsigned short bf16_t;
typedef short bf16x8 __attribute__((ext_vector_type(8)));
typedef float f32x4 __attribute__((ext_vector_type(4)));
typedef unsigned u32x4 __attribute__((ext_vector_type(4)));
constexpr int BM = 256, BK = 64, HALF = 128, HTB = HALF * BK * 2  , STAGE_BYTES = 8 * HTB, NXCD = 8, WGM = 8;

__host__ __device__ __forceinline__ int lds_byte(int r, int c) { const int st = (r >> 4) * 2 + (c >> 5), rr = r & 15, cc = c & 31, ob = rr * 64 + cc * 2; return st * 1024 + (ob ^ (((ob >> 9) & 1) << 5)); }
__host__ __device__ __forceinline__ void stage_rc(int b, int& R, int& C) { const int st = b / 1024, sb = b % 1024, swz = sb ^ (((sb >> 9) & 1) << 5); R = (st >> 1) * 16 + swz / 64; C = (st & 1) * 32 + (swz % 64) / 2; }
__host__ __device__ __forceinline__ int perm32(int rho) { const int n = rho >> 4, i = rho & 15; return 8 * (i >> 2) + 4 * n + (i & 3); }

struct Unit { int pm, pn; };
struct Gemm { const bf16_t* A; const bf16_t* Bt; int M, N, K; };

struct StaticOrder {
    int nM, nN, nwg, G, c;
    __host__ __device__ void init(int M, int N, int G_, int c_) { nM = M / BM; nN = N / BM; nwg = nM * nN; G = G_; c = c_; }
    __host__ __device__ bool next(int i, Unit& u) const {
        const long L = (long)i * G + c; if (L >= nwg) return false;
        int wgid = (int)L; { const int q = nwg / NXCD, r = nwg % NXCD, xcd = wgid % NXCD, off = wgid / NXCD; wgid = (xcd < r ? xcd * (q + 1) : r * (q + 1) + (xcd - r) * q) + off; }
        const int nig = WGM * nN, gid = wgid / nig, fm = gid * WGM, gsz = (nM - fm) < WGM ? (nM - fm) : WGM;
        u.pm = fm + ((wgid % nig) % gsz); u.pn = (wgid % nig) / gsz; return true;
    }
    __device__ __forceinline__ void a_ready(const Unit&) const {}
    __device__ __forceinline__ void done(const Unit&) const {}
};


__device__ __forceinline__ unsigned cvt_pk_bf16(float lo, float hi) { unsigned r; asm volatile("v_cvt_pk_bf16_f32 %0, %1, %2" : "=v"(r) : "v"(lo), "v"(hi)); return r; }
typedef unsigned u32x2 __attribute__((ext_vector_type(2)));
__device__ __forceinline__ u32x4 pack8(const f32x4 a, const f32x4 b) { u32x4 w; w.x = cvt_pk_bf16(a[0], a[1]); w.y = cvt_pk_bf16(a[2], a[3]); w.z = cvt_pk_bf16(b[0], b[1]); w.w = cvt_pk_bf16(b[2], b[3]); return w; }
__device__ __forceinline__ u32x2 pack4(const f32x4 a) { u32x2 w; w.x = cvt_pk_bf16(a[0], a[1]); w.y = cvt_pk_bf16(a[2], a[3]); return w; }
__device__ __forceinline__ float silu_f(float x) { return x * __builtin_amdgcn_rcpf(1.0f + __expf(-x)); }
__device__ __forceinline__ f32x4 silu4(const f32x4 x) { f32x4 r; r[0] = silu_f(x[0]); r[1] = silu_f(x[1]); r[2] = silu_f(x[2]); r[3] = silu_f(x[3]); return r; }
__device__ __forceinline__ float row_rstd(const float* ss, int row, int fq) {
    const f32x4 p = *(const f32x4*)(ss + (size_t)row * 16 + 4 * fq);
    float s = (p[0] + p[1]) + (p[2] + p[3]);
    s += __shfl_xor(s, 16); s += __shfl_xor(s, 32);
    return 1.0f / sqrtf(s * (1.0f / 1024.0f) + NORM_EPS);
}
template <int CTRL> __device__ __forceinline__ float dpp_f(float x) { return __builtin_bit_cast(float, __builtin_amdgcn_update_dpp(0, __builtin_bit_cast(int, x), CTRL, 0xf, 0xf, true)); }

struct EpiRes {
    static constexpr bool PERM = false, AFTER_DRAIN = false;
    const float* base; float* out; bf16_t* xb; float* ss;
    __device__ __forceinline__ void operator()(const f32x4 (&acc)[2][2][4][2], const Unit& u, int wr, int wc, int fr, int fq) const {
        const int colb = u.pn * BM + wc * 32 + 8 * fq;
#pragma unroll
        for (int ai = 0; ai < 2; ++ai)
#pragma unroll
            for (int m = 0; m < 4; ++m) {
                const int row = u.pm * BM + ai * HALF + wr * 64 + m * 16 + fr;
                float sq = 0.f;
#pragma unroll
                for (int bj = 0; bj < 2; ++bj) {
                    const size_t off = (size_t)row * 1024 + colb + bj * HALF;
                    const f32x4 b0 = *(const f32x4*)(base + off), b1 = *(const f32x4*)(base + off + 4);
                    const f32x4 v0 = acc[ai][bj][m][0] + b0, v1 = acc[ai][bj][m][1] + b1;
                    *(f32x4*)(out + off) = v0; *(f32x4*)(out + off + 4) = v1;
                    if (xb) *(u32x4*)(xb + off) = pack8(v0, v1);
                    sq += (v0[0] * v0[0] + v0[1] * v0[1]) + (v0[2] * v0[2] + v0[3] * v0[3]) + (v1[0] * v1[0] + v1[1] * v1[1]) + (v1[2] * v1[2] + v1[3] * v1[3]);
                }
                sq += __shfl_xor(sq, 16); sq += __shfl_xor(sq, 32);
                if (fq == 0) ss[(size_t)row * 16 + u.pn * 4 + wc] = sq;
            }
    }
};
struct EpiSwiglu {
    static constexpr bool PERM = false, AFTER_DRAIN = false;
    bf16_t* act; const float* ss;
    __device__ __forceinline__ void operator()(const f32x4 (&acc)[2][2][4][2], const Unit& u, int wr, int wc, int fr, int fq) const {
        const int colb = u.pn * 128 + wc * 32 + 8 * fq;
#pragma unroll
        for (int ai = 0; ai < 2; ++ai)
#pragma unroll
            for (int m = 0; m < 4; ++m) {
                const int row = u.pm * BM + ai * HALF + wr * 64 + m * 16 + fr;
                const float r = row_rstd(ss, row, fq);
                const f32x4 a0 = silu4(acc[ai][0][m][0] * r) * (acc[ai][1][m][0] * r), a1 = silu4(acc[ai][0][m][1] * r) * (acc[ai][1][m][1] * r);
                *(u32x4*)(act + (size_t)row * DFF + colb) = pack8(a0, a1);
            }
    }
};
struct EpiQkv {
    static constexpr bool PERM = false, AFTER_DRAIN = false;
    bf16_t* Q; bf16_t* K; bf16_t* V; const float* ss; const float* cosT; const float* sinT;
    __device__ __forceinline__ void operator()(const f32x4 (&acc)[2][2][4][2], const Unit& u, int wr, int wc, int fr, int fq) const {
        if (u.pn < 12) {
            bf16_t* P = u.pn < 6 ? Q : K;
            const int j0 = (wc & 1) * 32 + 8 * fq, tcol = (u.pn % 6) * 256 + (wc >> 1) * 128 + j0;
#pragma unroll
            for (int ai = 0; ai < 2; ++ai)
#pragma unroll
                for (int m = 0; m < 4; ++m) {
                    const int row = u.pm * BM + ai * HALF + wr * 64 + m * 16 + fr;
                    const float r = row_rstd(ss, row, fq);
                    const size_t tb = (size_t)(row & (T - 1)) * 64 + j0;
                    const f32x4 c0 = *(const f32x4*)(cosT + tb), c1 = *(const f32x4*)(cosT + tb + 4), s0 = *(const f32x4*)(sinT + tb), s1 = *(const f32x4*)(sinT + tb + 4);
                    const f32x4 x1a = acc[ai][0][m][0] * r, x1b = acc[ai][0][m][1] * r, x2a = acc[ai][1][m][0] * r, x2b = acc[ai][1][m][1] * r;
                    bf16_t* p = P + (size_t)row * AW + tcol;
                    *(u32x4*)p = pack8(x1a * c0 - x2a * s0, x1b * c1 - x2b * s1);
                    *(u32x4*)(p + 64) = pack8(x2a * c0 + x1a * s0, x2b * c1 + x1b * s1);
                }
        } else {
            const int tcol = (u.pn - 12) * 256 + wc * 32 + 8 * fq;
#pragma unroll
            for (int ai = 0; ai < 2; ++ai)
#pragma unroll
                for (int m = 0; m < 4; ++m) {
                    const int row = u.pm * BM + ai * HALF + wr * 64 + m * 16 + fr;
                    const float r = row_rstd(ss, row, fq);
#pragma unroll
                    for (int bj = 0; bj < 2; ++bj) *(u32x4*)(V + (size_t)row * AW + tcol + bj * HALF) = pack8(acc[ai][bj][m][0] * r, acc[ai][bj][m][1] * r);
                }
        }
    }
};
struct EpiHgrnIn {
    static constexpr bool PERM = false, AFTER_DRAIN = false;
    bf16_t *QT, *KT, *VV, *GG; float *E1, *E2; const float* ss; const float* lb;
    __device__ __forceinline__ void operator()(const f32x4 (&acc)[2][2][4][2], const Unit& u, int wr, int wc, int fr, int fq) const {
        const int ch0 = u.pn * 64 + wc * 16 + 4 * fq;
        const f32x4 lbv = *(const f32x4*)(lb + ch0);
#pragma unroll
        for (int ai = 0; ai < 2; ++ai) {
            const int rowb = u.pm * BM + ai * HALF + wr * 64;
            float rs[4];
#pragma unroll
            for (int m = 0; m < 4; ++m) rs[m] = row_rstd(ss, rowb + m * 16 + fr, fq);
            f32x4 kv[4], bc[4], run = {0.f, 0.f, 0.f, 0.f};
#pragma unroll
            for (int m = 0; m < 4; ++m) {
                const f32x4 fz = acc[ai][0][m][1] * rs[m];
#pragma unroll
                for (int e = 0; e < 4; ++e) {
                    const float tt = __expf(-fmaxf(fz[e], -80.f)), inv = __builtin_amdgcn_rcpf(1.0f + tt);
                    const float oml = 1.0f - lbv[e];
                    const float fg = lbv[e] + oml * inv;
                    kv[m][e] = oml * (tt * inv);
                    float x = __logf(fg);
                    x += dpp_f<0x111>(x); x += dpp_f<0x112>(x); x += dpp_f<0x114>(x); x += dpp_f<0x118>(x);
                    const float tot = __shfl(x, 15, 16);
                    bc[m][e] = x + run[e]; run[e] += tot;
                }
            }
            f32x4 ref;
#pragma unroll
            for (int e = 0; e < 4; ++e) ref[e] = __shfl(bc[1][e], 15, 16);
            if (fr == 0) {
                const int chunk = rowb >> 6; f32x4 e1, e2;
#pragma unroll
                for (int e = 0; e < 4; ++e) { e1[e] = __expf(ref[e]); e2[e] = __expf(run[e] - ref[e]); }
                *(f32x4*)(E1 + (size_t)chunk * 1024 + ch0) = e1; *(f32x4*)(E2 + (size_t)chunk * 1024 + ch0) = e2;
            }
#pragma unroll
            for (int m = 0; m < 4; ++m) {
                const size_t off = (size_t)(rowb + m * 16 + fr) * 1024 + ch0;
                f32x4 qv = silu4(acc[ai][0][m][0] * rs[m]), kk = kv[m];
#pragma unroll
                for (int e = 0; e < 4; ++e) { const float dl = bc[m][e] - ref[e]; qv[e] *= __expf(dl); kk[e] *= __expf(-dl); }
                *(u32x2*)(QT + off) = pack4(qv); *(u32x2*)(KT + off) = pack4(kk);
                *(u32x2*)(VV + off) = pack4(acc[ai][1][m][0] * rs[m]); *(u32x2*)(GG + off) = pack4(silu4(acc[ai][1][m][1] * rs[m]));
            }
        }
    }
};

template <class Epi, class Sched, bool ALIGN_EPI = false, bool SP2 = false>
__device__ __forceinline__ void gemm_phase(PG8_LAS unsigned char* lds, const Gemm g, const Sched& S, const Epi& E) {
    const int tid = threadIdx.x, wid = __builtin_amdgcn_readfirstlane(tid >> 6), lane = tid & 63, wr = wid >> 2, wc = wid & 3, fr = lane & 15, fq = lane >> 4;
    const int K = g.K, nt = K / BK;
    unsigned voffA[2], voffB[2];
#pragma unroll
    for (int i = 0; i < 2; ++i) { int R, C; stage_rc(tid * 16 + i * 8192, R, C); const int Rb = Epi::PERM ? ((R & ~31) + perm32(R & 31)) : R;
        voffA[i] = (unsigned)(R * K + C) * 2u; voffB[i] = (unsigned)(Rb * K + C) * 2u; }
    const size_t kstep = (size_t)(BK * 2);
    const size_t hstep = (size_t)HALF * K * 2;
    const size_t tstep = 2 * hstep;
    const unsigned ldsw = (unsigned)wid * 1024u;
    const int aoff = lds_byte(wr * 64 + fr, fq * 8), boff = lds_byte(wc * 32 + fr, fq * 8);
#define PG8_SA(b, h) (((b) * 2 + (h)) * HTB)
#define PG8_SB(b, h) ((4 + (b) * 2 + (h)) * HTB)
#define PG8_STAGE(bufoff, gbase, voff) do { _Pragma("unroll") for (int _i = 0; _i < 2; ++_i) \
        __builtin_amdgcn_global_load_lds((const unsigned*)((const char*)(gbase) + (voff)[_i]), (PG8_LAS unsigned*)(lds + (bufoff) + ldsw + _i * 8192), 16, 0, 0); } while (0)
#define PG8_LDA(dst, b, h) do { _Pragma("unroll") for (int m = 0; m < 4; ++m) _Pragma("unroll") for (int k = 0; k < 2; ++k) dst[m][k] = *(const PG8_LAS bf16x8*)(lds + PG8_SA(b, h) + aoff + m * 2048 + k * 1024); } while (0)
#define PG8_LDB(dst, b, h) do { _Pragma("unroll") for (int n = 0; n < 2; ++n) _Pragma("unroll") for (int k = 0; k < 2; ++k) dst[n][k] = *(const PG8_LAS bf16x8*)(lds + PG8_SB(b, h) + boff + n * 2048 + k * 1024); } while (0)
#define PG8_MMA(ai, bj, At, Bt) do { __builtin_amdgcn_s_setprio(1); _Pragma("unroll") for (int m = 0; m < 4; ++m) _Pragma("unroll") for (int n = 0; n < 2; ++n) _Pragma("unroll") for (int k = 0; k < 2; ++k) \
        acc[ai][bj][m][n] = __builtin_amdgcn_mfma_f32_16x16x32_bf16(Bt[n][k], At[m][k], acc[ai][bj][m][n], 0, 0, 0); __builtin_amdgcn_s_setprio(0); } while (0)
#define PG8_WAIT_V(n) asm volatile("s_waitcnt vmcnt(" #n ")" ::: "memory")
#define PG8_WAIT_L(n) asm volatile("s_waitcnt lgkmcnt(" #n ")" ::: "memory")
#define PG8_BAR __builtin_amdgcn_s_barrier()
#define PG8_SCHED __builtin_amdgcn_sched_barrier(0)
    Unit cur, nxt; int ui = 0;
    if (!S.next(0, cur)) return;
    f32x4 acc[2][2][4][2];
#pragma unroll
    for (int a = 0; a < 2; ++a)
#pragma unroll
        for (int b = 0; b < 2; ++b)
#pragma unroll
            for (int m = 0; m < 4; ++m)
#pragma unroll
                for (int n = 0; n < 2; ++n) acc[a][b][m][n] = (f32x4){0.f, 0.f, 0.f, 0.f};
    bf16x8 At[4][2], B0[2][2], B1[2][2];
    const char* cA = (const char*)g.A + (size_t)cur.pm * tstep; const char* cB = (const char*)g.Bt + (size_t)cur.pn * tstep;
    S.a_ready(cur);
    if constexpr (SP2) {
        PG8_STAGE(PG8_SB(0, 0), cB, voffB); PG8_STAGE(PG8_SB(0, 1), cB + hstep, voffB); PG8_STAGE(PG8_SA(0, 0), cA, voffA); PG8_STAGE(PG8_SA(0, 1), cA + hstep, voffA);
        if (wr == 1) PG8_BAR;
        PG8_WAIT_V(2); PG8_BAR;
        PG8_STAGE(PG8_SB(1, 0), cB + kstep, voffB); PG8_STAGE(PG8_SA(1, 0), cA + kstep, voffA); PG8_STAGE(PG8_SB(1, 1), cB + hstep + kstep, voffB);
        PG8_WAIT_V(6); PG8_BAR;
    } else {
        PG8_STAGE(PG8_SB(0, 0), cB, voffB); PG8_STAGE(PG8_SA(0, 0), cA, voffA); PG8_STAGE(PG8_SB(0, 1), cB + hstep, voffB); PG8_STAGE(PG8_SA(0, 1), cA + hstep, voffA);
        if (wr == 1) PG8_BAR;
        PG8_WAIT_V(4); PG8_BAR;
        PG8_STAGE(PG8_SB(1, 0), cB + kstep, voffB); PG8_STAGE(PG8_SA(1, 0), cA + kstep, voffA); PG8_STAGE(PG8_SB(1, 1), cB + hstep + kstep, voffB);
        PG8_WAIT_V(6); PG8_BAR;
    }
    for (;;) {
        const bool has_next = S.next(ui + 1, nxt);
        const char* nA = has_next ? (const char*)g.A + (size_t)nxt.pm * tstep : cA; const char* nB = has_next ? (const char*)g.Bt + (size_t)nxt.pn * tstep : cB;
        for (int t = 0; t < nt; t += 2) {
            const bool last = (t == nt - 2);
            const char* a1 = cA + (size_t)(t + 1) * kstep;
            const char* a2 = last ? nA : cA + (size_t)(t + 2) * kstep; const char* b2 = last ? nB : cB + (size_t)(t + 2) * kstep;
            const char* a3 = a2 + kstep; const char* b3 = b2 + kstep;
            if (last && has_next) S.a_ready(nxt);
            if constexpr (SP2) {
            PG8_LDB(B0, 0, 0); PG8_LDB(B1, 0, 1); PG8_SCHED; PG8_LDA(At, 0, 0); PG8_STAGE(PG8_SA(1, 1), a1 + hstep, voffA);
            PG8_WAIT_V(8); PG8_WAIT_L(0); PG8_BAR; PG8_MMA(0, 0, At, B0); PG8_MMA(0, 1, At, B1); PG8_BAR; PG8_SCHED;
            PG8_LDA(At, 0, 1); PG8_STAGE(PG8_SB(0, 0), b2, voffB); PG8_STAGE(PG8_SB(0, 1), b2 + hstep, voffB); PG8_STAGE(PG8_SA(0, 0), a2, voffA);
            PG8_WAIT_V(8); PG8_WAIT_L(0); PG8_BAR; PG8_MMA(1, 0, At, B0); PG8_MMA(1, 1, At, B1); PG8_BAR; PG8_SCHED;
            PG8_LDB(B0, 1, 0); PG8_LDB(B1, 1, 1); PG8_SCHED; PG8_LDA(At, 1, 0); PG8_STAGE(PG8_SA(0, 1), a2 + hstep, voffA);
            PG8_WAIT_V(8); PG8_WAIT_L(0); PG8_BAR; PG8_MMA(0, 0, At, B0); PG8_MMA(0, 1, At, B1); PG8_BAR; PG8_SCHED;
            PG8_LDA(At, 1, 1); PG8_STAGE(PG8_SB(1, 0), b3, voffB); PG8_STAGE(PG8_SB(1, 1), b3 + hstep, voffB); PG8_STAGE(PG8_SA(1, 0), a3, voffA);
            PG8_WAIT_V(8); PG8_WAIT_L(0); PG8_BAR; PG8_MMA(1, 0, At, B0); PG8_MMA(1, 1, At, B1); PG8_BAR; PG8_SCHED;
            } else {
            PG8_LDB(B0, 0, 0); PG8_SCHED; PG8_LDA(At, 0, 0); PG8_STAGE(PG8_SA(1, 1), a1 + hstep, voffA);
            PG8_WAIT_L(8); PG8_BAR; PG8_WAIT_L(0); PG8_MMA(0, 0, At, B0); PG8_BAR; PG8_SCHED;
            PG8_LDB(B1, 0, 1); PG8_STAGE(PG8_SB(0, 0), b2, voffB);
            PG8_BAR; PG8_WAIT_L(0); PG8_MMA(0, 1, At, B1); PG8_BAR;
            PG8_LDA(At, 0, 1); PG8_STAGE(PG8_SA(0, 0), a2, voffA);
            PG8_BAR; PG8_WAIT_L(0); PG8_MMA(1, 0, At, B0); PG8_BAR; PG8_SCHED;
            PG8_STAGE(PG8_SB(0, 1), b2 + hstep, voffB);
            PG8_WAIT_V(6); PG8_BAR; PG8_MMA(1, 1, At, B1); PG8_BAR;
            PG8_LDB(B0, 1, 0); PG8_SCHED; PG8_LDA(At, 1, 0); PG8_STAGE(PG8_SA(0, 1), a2 + hstep, voffA);
            PG8_WAIT_L(8); PG8_BAR; PG8_WAIT_L(0); PG8_MMA(0, 0, At, B0); PG8_BAR; PG8_SCHED;
            PG8_LDB(B1, 1, 1); PG8_STAGE(PG8_SB(1, 0), b3, voffB);
            PG8_BAR; PG8_WAIT_L(0); PG8_MMA(0, 1, At, B1); PG8_BAR;
            PG8_LDA(At, 1, 1); PG8_STAGE(PG8_SA(1, 0), a3, voffA);
            PG8_BAR; PG8_WAIT_L(0); PG8_MMA(1, 0, At, B0); PG8_BAR; PG8_SCHED;
            PG8_STAGE(PG8_SB(1, 1), b3 + hstep, voffB);
            PG8_WAIT_V(6); PG8_BAR; PG8_MMA(1, 1, At, B1); PG8_BAR;
            }
        }
        if constexpr (ALIGN_EPI) { if (wr == 0) PG8_BAR; }
        if constexpr (!Epi::AFTER_DRAIN) { E(acc, cur, wr, wc, fr, fq); S.done(cur); }
        if (!has_next) break;
#pragma unroll
        for (int a = 0; a < 2; ++a)
#pragma unroll
            for (int b = 0; b < 2; ++b)
#pragma unroll
                for (int m = 0; m < 4; ++m)
#pragma unroll
                    for (int n = 0; n < 2; ++n) acc[a][b][m][n] = (f32x4){0.f, 0.f, 0.f, 0.f};
        cur = nxt; cA = nA; cB = nB; ++ui;
        if constexpr (ALIGN_EPI) { if (wr == 1) PG8_BAR; }
    }
    PG8_WAIT_V(0);
    if constexpr (!ALIGN_EPI) { if (wr == 0) PG8_BAR; }
    PG8_BAR;
    if constexpr (Epi::AFTER_DRAIN) { E.fused(acc, cur, wr, wc, fr, fq, lds, wid, lane); S.done(cur); }
#undef PG8_SA
#undef PG8_SB
#undef PG8_STAGE
#undef PG8_LDA
#undef PG8_LDB
#undef PG8_MMA
#undef PG8_WAIT_V
#undef PG8_WAIT_L
#undef PG8_BAR
#undef PG8_SCHED
}
}

constexpr int NWAVES = 8;
#ifndef MK_PER_PHASE
#define MK_PER_PHASE 0
#endif
constexpr int NPH = 14;

constexpr size_t MiB = 1u << 20;
constexpr size_t WS_CTL = 0, CTL_ZERO_BYTES = 64 * 1024;
constexpr size_t WS_WHIN = 1 * MiB, WS_WHOUT = 9 * MiB, WS_WQKV = 11 * MiB, WS_WAO = 20 * MiB, WS_WF1 = 23 * MiB, WS_WF2 = 45 * MiB;
constexpr size_t WS_SS = 56 * MiB, WS_E1 = 57 * MiB, WS_E2 = 58 * MiB, WS_COS = 59 * MiB, WS_SIN = 61 * MiB, WS_LSE = 63 * MiB, WS_LB = 63 * MiB + 768 * 1024;
constexpr size_t WS_ST = 64 * MiB;
constexpr size_t WS_XB = 80 * MiB;
constexpr size_t WS_ACT = 112 * MiB;
constexpr size_t WS_QT = WS_ACT, WS_KT = WS_ACT + 32 * MiB, WS_VV = WS_ACT + 64 * MiB, WS_GG = WS_ACT + 96 * MiB;
constexpr size_t WS_FF = WS_ACT;
constexpr size_t WS_QP = WS_ACT, WS_KP = WS_ACT + 48 * MiB, WS_VP = WS_ACT + 96 * MiB;
constexpr size_t WS_END = 256 * MiB;
static_assert(WS_VP + (size_t)M * AW * 2 <= WS_END && WS_FF + (size_t)M * DFF * 2 <= WS_END && WS_GG + (size_t)M * D * 2 <= WS_END, "d_ws map");
static_assert(WS_WF2 + 2 * (size_t)D * DFF * 2 <= WS_SS && WS_WF1 + 2 * (size_t)FF2 * D * 2 <= WS_WF2 && WS_WAO + (size_t)D * AW * 2 <= WS_WF1 && WS_WQKV + (size_t)QKVW * D * 2 <= WS_WAO, "weights map");
constexpr int CW_TMO = 0, CW_BAR = 4096;

constexpr int RING_OFF = 0, RING_BYTES = 131072;
constexpr int LDSCTL_OFF = RING_BYTES, MISC_OFF = LDSCTL_OFF + 320;
constexpr int LDS_BYTES = 147456;
#define GAS __attribute__((address_space(1)))
#define LAS __attribute__((address_space(3)))
typedef unsigned short bf16;
typedef unsigned v4u __attribute__((ext_vector_type(4)));
typedef float f32x4 __attribute__((ext_vector_type(4)));
typedef short bf16x8 __attribute__((ext_vector_type(8)));
typedef GAS unsigned gu32;
typedef GAS unsigned long long gu64;
#define RLX_AGENT __ATOMIC_RELAXED, __HIP_MEMORY_SCOPE_AGENT
#define LDS_WAIT() asm volatile("s_waitcnt lgkmcnt(0)" ::: "memory")
#define VM_WAIT() asm volatile("s_waitcnt vmcnt(0)" ::: "memory")
__device__ __forceinline__ unsigned long long rt() { return __builtin_amdgcn_s_memrealtime(); }
__device__ __forceinline__ unsigned f2bf(float f) { unsigned u = __builtin_bit_cast(unsigned, f); return (u + 0x7fffu + ((u >> 16) & 1u)) >> 16; }
__device__ __forceinline__ unsigned pk2(float lo, float hi) { return f2bf(lo) | (f2bf(hi) << 16); }

#define XB_TMO      128
#define XB_XCNT(j)  (256  + 64 * (j))
#define XB_XSUB(j)  (1280 + 64 * (j))
#define XB_XGEN(j)  (2304 + 64 * (j))
#define XB_TOP      3328
#define XB_TOPGEN   3392
#define XCD_BAR_WORDS 3456
#define XB_SPIN_CAP (1u << 18)

__device__ __forceinline__ unsigned xb_ld(unsigned* p)              { return __hip_atomic_load(p, __ATOMIC_RELAXED, __HIP_MEMORY_SCOPE_AGENT); }
__device__ __forceinline__ unsigned xb_add(unsigned* p, unsigned v) { return __hip_atomic_fetch_add(p, v, __ATOMIC_RELAXED, __HIP_MEMORY_SCOPE_AGENT); }
__device__ __forceinline__ unsigned xb_xcc_id() { return (unsigned)__builtin_amdgcn_s_getreg((3 << 11) | 20) & 0xFu; }
#define XB_SPIN(cond, bar) do { unsigned _sp = 0; while (cond) { __builtin_amdgcn_s_sleep(1); \
    if ((++_sp & 255u) == 0u) { if (xb_ld(&(bar)[XB_TMO])) break; if (_sp > XB_SPIN_CAP) { atomicAdd(&(bar)[XB_TMO], 1u); break; } } } } while (0)

struct XcdBarrier {
    unsigned* bar; unsigned x;
    volatile LAS unsigned* st;
};

__device__ __forceinline__ XcdBarrier xcd_barrier_post(unsigned* bar, volatile LAS unsigned* st) {
    XcdBarrier b; b.bar = bar; b.x = xb_xcc_id(); b.st = st;
    if (threadIdx.x == 0) (void)xb_add(&bar[XB_XCNT(b.x)], 1u);
    return b;
}
__device__ __forceinline__ void xcd_barrier_complete(unsigned* bar, unsigned x, unsigned& nloc, unsigned& nx) {
    const unsigned G = gridDim.x * gridDim.y * gridDim.z;
    unsigned sum, cnt, mine, sp = 0u;
    for (;;) {
        sum = 0u; cnt = 0u; mine = 0u;
#pragma unroll
        for (unsigned j = 0; j < 16; ++j) { const unsigned c = xb_ld(&bar[XB_XCNT(j)]); sum += c; cnt += (c > 0u) ? 1u : 0u; mine = (j == x) ? c : mine; }
        if (sum == G) break;
        __builtin_amdgcn_s_sleep(1);
        if ((++sp & 255u) == 0u) { if (xb_ld(&bar[XB_TMO])) break; if (sp > XB_SPIN_CAP) { atomicAdd(&bar[XB_TMO], 1u); break; } }
    }
    nloc = mine > 0u ? mine : 1u; nx = cnt > 0u ? cnt : 1u;
}

__device__ __forceinline__ void xcd_barrier(const XcdBarrier& b) {
    asm volatile("s_waitcnt vmcnt(0)" ::: "memory");
    __syncthreads();
    if (threadIdx.x == 0) {
        unsigned* bar = b.bar;
        __builtin_amdgcn_s_waitcnt(0);
        unsigned nloc = b.st[0], nx = b.st[1];
        if (nloc == 0u) { xcd_barrier_complete(bar, b.x, nloc, nx); b.st[0] = nloc; b.st[1] = nx; }
        const unsigned old = xb_add(&bar[XB_XSUB(b.x)], 1u);
        const unsigned gen = old / nloc;
        if (old + 1u == (gen + 1u) * nloc) {
            __builtin_amdgcn_fence(__ATOMIC_RELEASE, "agent");
            asm volatile("s_waitcnt vmcnt(0)" ::: "memory");
            const unsigned og = xb_add(&bar[XB_TOP], 1u);
            const unsigned tg = og / nx;
            if (og + 1u == (tg + 1u) * nx) xb_add(&bar[XB_TOPGEN], 1u);
            else XB_SPIN(xb_ld(&bar[XB_TOPGEN]) == tg, bar);
            __builtin_amdgcn_fence(__ATOMIC_ACQUIRE, "agent");
            xb_add(&bar[XB_XGEN(b.x)], 1u);
            asm volatile("s_waitcnt vmcnt(0)" ::: "memory");
        } else {
            XB_SPIN(xb_ld(&bar[XB_XGEN(b.x)]) == gen, bar);
            __builtin_amdgcn_fence(__ATOMIC_ACQUIRE, "agent");
            asm volatile("s_waitcnt vmcnt(0)" ::: "memory");
        }
    }
    __syncthreads();
}

struct Frame {
    LAS unsigned char* lds;
    volatile LAS unsigned* MISC;
    gu32* ctl;
    int tid, lane, wave;
    int vcu, G;
    const float *x, *norm_mix, *norm_ffn, *hgrn_w_in, *lb_logits, *hgrn_out_norm, *hgrn_w_out, *attn_w_qkv, *attn_w_out, *ffn_w_in, *ffn_w_down, *final_norm;
    float* out;
    bf16 *Whin, *Whout, *Wqkv, *Wao, *Wf1, *Wf2;
    float *SS, *E1, *E2, *COS, *SIN, *LSE, *LB, *ST;
    bf16 *XB, *QT, *KT, *VV, *GG, *FF, *QP, *KP, *VP;
};
__device__ __forceinline__ float wave_sum(float v) {
#pragma unroll
    for (int o = 1; o < 64; o <<= 1) v += __shfl_xor(v, o);
    return v;
}
__device__ __forceinline__ float bf_lo(unsigned u) { return __uint_as_float(u << 16); }
__device__ __forceinline__ float bf_hi(unsigned u) { return __uint_as_float(u & 0xffff0000u); }

__device__ __forceinline__ int pinv32(int l) { return 16 * ((l >> 2) & 1) + 4 * (l >> 3) + (l & 3); }
template <int MODE> __device__ __forceinline__ int phys_row(int c) {
    if (MODE == 0) return (c & ~31) + pinv32(c & 31);
    if (MODE == 1) { const int up = c >= DFF ? 1 : 0, j = c - up * DFF; return 256 * (j >> 7) + 128 * up + (j & 96) + pinv32(j & 31); }
    if (MODE == 2) {
        if (c >= 2 * AW) { const int cc = c - 2 * AW; return 256 * (12 + (cc >> 8)) + (cc & 224) + pinv32(cc & 31); }
        const int plane = c >= AW ? 1 : 0, cc = c - plane * AW, head = cc >> 7, d = cc & 127, half = d >> 6, j = d & 63;
        return 256 * (plane * 6 + (head >> 1)) + 128 * half + 32 * (2 * (head & 1) + (j >> 5)) + pinv32(j & 31);
    }
    { const int type = c >> 10, ch = c & 1023, chl = ch & 63; return 256 * (ch >> 6) + 128 * (type >> 1) + 32 * (chl >> 4) + 16 * (type & 1) + (chl & 15); }
}
template <int MODE>
__device__ __forceinline__ void p0_transpose_item(const float* W, int K, int N, bf16* WT, const float* gain, LAS float* scr, int item, int lane) {
    const int nblk = N / 32, kb = item / nblk, nb = item % nblk, k0 = 64 * kb, n0 = 32 * nb;
#pragma unroll 8
    for (int i = 0; i < 32; ++i) { const int kk = 2 * i + (lane >> 5); float w = W[(size_t)(k0 + kk) * N + n0 + (lane & 31)]; if (gain) w *= gain[k0 + kk]; scr[kk * 33 + (lane & 31)] = w; }
    LDS_WAIT(); asm volatile("" ::: "memory");
    const int c = lane & 7;
#pragma unroll
    for (int j = 0; j < 4; ++j) { const int n = (lane >> 3) + 8 * j; const LAS float* s = scr + (8 * c) * 33 + n;
        v4u o; o.x = pk2(s[0 * 33], s[1 * 33]); o.y = pk2(s[2 * 33], s[3 * 33]); o.z = pk2(s[4 * 33], s[5 * 33]); o.w = pk2(s[6 * 33], s[7 * 33]);
        *(GAS v4u*)(WT + (size_t)phys_row<MODE>(n0 + n) * K + k0 + 8 * c) = o; }
    LDS_WAIT(); asm volatile("" ::: "memory");
}
__device__ __forceinline__ void p0_prologue(Frame& F) {
    LAS float* scr = (LAS float*)(F.lds + RING_OFF + F.wave * 16384);
    const int gw = F.vcu * NWAVES + F.wave, NGW = F.G * NWAVES;
    constexpr int I_HIN = (D / 64) * (HIN / 32), I_HOUT = (D / 64) * (D / 32), I_QKV = (D / 64) * (QKVW / 32), I_AO = (AW / 64) * (D / 32), I_F1 = (D / 64) * (FF2 / 32), I_F2 = (DFF / 64) * (D / 32);
    constexpr int NITEMS = I_HIN + I_HOUT + I_QKV + I_AO + 2 * I_F1 + 2 * I_F2;
    for (int it = gw; it < NITEMS; it += NGW) {
        int r = it;
        if (r < I_HIN) { p0_transpose_item<3>(F.hgrn_w_in, D, HIN, F.Whin, F.norm_mix, scr, r, F.lane); continue; } r -= I_HIN;
        if (r < I_HOUT) { p0_transpose_item<0>(F.hgrn_w_out, D, D, F.Whout, nullptr, scr, r, F.lane); continue; } r -= I_HOUT;
        if (r < I_QKV) { p0_transpose_item<2>(F.attn_w_qkv, D, QKVW, F.Wqkv, F.norm_mix + D, scr, r, F.lane); continue; } r -= I_QKV;
        if (r < I_AO) { p0_transpose_item<0>(F.attn_w_out, AW, D, F.Wao, nullptr, scr, r, F.lane); continue; } r -= I_AO;
        if (r < 2 * I_F1) { const int l = r / I_F1; p0_transpose_item<1>(F.ffn_w_in + (size_t)l * D * FF2, D, FF2, F.Wf1 + (size_t)l * FF2 * D, F.norm_ffn + l * D, scr, r - l * I_F1, F.lane); continue; } r -= 2 * I_F1;
        { const int l = r / I_F2; p0_transpose_item<0>(F.ffn_w_down + (size_t)l * DFF * D, DFF, D, F.Wf2 + (size_t)l * D * DFF, nullptr, scr, r - l * I_F2, F.lane); }
    }
    for (int m = gw; m < M; m += NGW) {
        const GAS f32x4* xr = (const GAS f32x4*)(F.x + (size_t)m * D) + F.lane;
        GAS unsigned long long* o8 = (GAS unsigned long long*)(F.XB + (size_t)m * D) + F.lane;
        float s = 0.f;
#pragma unroll
        for (int j = 0; j < 4; ++j) { const f32x4 v = xr[64 * j]; s += (v.x * v.x + v.y * v.y) + (v.z * v.z + v.w * v.w); o8[64 * j] = (unsigned long long)pk2(v.x, v.y) | ((unsigned long long)pk2(v.z, v.w) << 32); }
        s = wave_sum(s);
        if (F.lane < 16) F.SS[(size_t)m * 16 + F.lane] = F.lane == 0 ? s : 0.f;
    }
    const int gt = F.vcu * NWAVES * 64 + F.tid, NGT = F.G * NWAVES * 64;
    for (int i = gt; i < T * 64; i += NGT) { const int pos = i >> 6, j = i & 63;
        const float inv = 1.0f / powf(10000.0f, (float)(2 * j) / 128.0f); const float ang = (float)pos * inv;
        F.COS[i] = (float)cos((double)ang); F.SIN[i] = (float)sin((double)ang); }
    if (gt < D) { const float a = F.lb_logits[gt], b = F.lb_logits[D + gt], c = F.lb_logits[2 * D + gt]; const float mx = fmaxf(a, fmaxf(b, c));
        const float ea = expf(a - mx), eb = expf(b - mx), ec = expf(c - mx); F.LB[gt] = ea / (ea + eb + ec); }
}

__device__ __forceinline__ void hgrn_simple_rec(Frame& F, float* oraw) {
    const int item = F.wave * F.G + F.vcu;
    if (item >= 256) return;
    const int b = item >> 7, h = (item >> 4) & 7, vg = item & 15, kc = h * 128 + 2 * F.lane, vc = h * 128 + vg * 8;
    float S0[8], S1[8];
#pragma unroll
    for (int j = 0; j < 8; ++j) { S0[j] = 0.f; S1[j] = 0.f; }
    for (int c = 0; c < 128; ++c) {
        const int chunk = b * 128 + c;
        const float e1x = F.E1[(size_t)chunk * 1024 + kc], e1y = F.E1[(size_t)chunk * 1024 + kc + 1], e2x = F.E2[(size_t)chunk * 1024 + kc], e2y = F.E2[(size_t)chunk * 1024 + kc + 1];
#pragma unroll
        for (int j = 0; j < 8; ++j) { S0[j] *= e1x; S1[j] *= e1y; }
#pragma unroll 2
        for (int t = 0; t < 64; ++t) {
            const size_t row = (size_t)chunk * 64 + t;
            const unsigned kq = *(const GAS unsigned*)(F.KT + row * 1024 + kc), qq = *(const GAS unsigned*)(F.QT + row * 1024 + kc);
            const v4u vv = *(const GAS v4u*)(F.VV + row * 1024 + vc);
            const float k0 = bf_lo(kq), k1 = bf_hi(kq), q0 = bf_lo(qq), q1 = bf_hi(qq);
            const float v[8] = {bf_lo(vv.x), bf_hi(vv.x), bf_lo(vv.y), bf_hi(vv.y), bf_lo(vv.z), bf_hi(vv.z), bf_lo(vv.w), bf_hi(vv.w)};
            float part[8];
#pragma unroll
            for (int j = 0; j < 8; ++j) { S0[j] = fmaf(k0, v[j], S0[j]); S1[j] = fmaf(k1, v[j], S1[j]); part[j] = q0 * S0[j] + q1 * S1[j]; }
#pragma unroll
            for (int j = 0; j < 8; ++j) part[j] = wave_sum(part[j]);
            if (F.lane == 0) { float* o = oraw + row * 1024 + vc; *(f32x4*)o = (f32x4){part[0], part[1], part[2], part[3]}; *(f32x4*)(o + 4) = (f32x4){part[4], part[5], part[6], part[7]}; }
        }
#pragma unroll
        for (int j = 0; j < 8; ++j) { S0[j] *= e2x; S1[j] *= e2y; }
    }
}
__device__ __forceinline__ void hgrn_simple_post(Frame& F, const float* oraw) {
    const int gw = F.vcu * NWAVES + F.wave, NGW = F.G * NWAVES;
    const float gn0 = F.hgrn_out_norm[2 * F.lane], gn1 = F.hgrn_out_norm[2 * F.lane + 1];
    for (int it = gw; it < M * 8; it += NGW) {
        const size_t off = (size_t)(it >> 3) * 1024 + (it & 7) * 128 + 2 * F.lane;
        const float v0 = oraw[off], v1 = oraw[off + 1];
        const float r = 1.0f / sqrtf(wave_sum(v0 * v0 + v1 * v1) * (1.0f / 128.0f) + NORM_EPS);
        const unsigned g = *(const GAS unsigned*)(F.GG + off);
        *(GAS unsigned*)(F.QT + off) = pk2(v0 * r * gn0 * bf_lo(g), v1 * r * gn1 * bf_hi(g));
    }
}
__device__ __forceinline__ void attn_simple(Frame& F) {
    const int gw = F.vcu * NWAVES + F.wave, NGW = F.G * NWAVES;
    for (int it = gw; it < M * 12; it += NGW) {
        const int row = it / 12, hd = it - row * 12, t = row & (T - 1), g = hd >> 2, dil = g == 0 ? 1 : (g == 1 ? 4 : 16);
        const size_t co = (size_t)hd * 128 + 2 * F.lane;
        const unsigned qq = *(const GAS unsigned*)(F.QP + (size_t)row * AW + co);
        const float q0 = bf_lo(qq), q1 = bf_hi(qq);
        float m = -INFINITY, l = 0.f, o0 = 0.f, o1 = 0.f;
        for (int j = 0; j <= 128; ++j) {
            if (t - j * dil < 0) break;
            const size_t rk = (size_t)(row - j * dil) * AW + co;
            const unsigned kk = *(const GAS unsigned*)(F.KP + rk), vv = *(const GAS unsigned*)(F.VP + rk);
            const float s = wave_sum(q0 * bf_lo(kk) + q1 * bf_hi(kk)) * 0.08838834764831845f;
            const float mn = fmaxf(m, s), a = __expf(m - mn), p = __expf(s - mn);
            l = l * a + p; o0 = o0 * a + p * bf_lo(vv); o1 = o1 * a + p * bf_hi(vv); m = mn;
        }
        *(GAS unsigned*)(F.QP + (size_t)row * AW + co) = pk2(o0 / l, o1 / l);
        if (F.lane == 0) F.LSE[(size_t)row * 12 + hd] = m + logf(l);
    }
}
__device__ __forceinline__ void attn_scale(Frame& F) {
    const int gt = F.vcu * NWAVES * 64 + F.tid, NGT = F.G * NWAVES * 64;
    for (int i = gt; i < M * (AW / 8); i += NGT) {
        const int row = i / (AW / 8), c8 = i - row * (AW / 8), hd = c8 >> 4, hg = hd & 3;
        const float* ls = F.LSE + (size_t)row * 12;
        const float a = ls[hg], b = ls[4 + hg], c = ls[8 + hg], mx = fmaxf(a, fmaxf(b, c));
        const float al = __expf(ls[hd] - mx) / (__expf(a - mx) + __expf(b - mx) + __expf(c - mx));
        GAS v4u* p = (GAS v4u*)(F.QP + (size_t)row * AW + c8 * 8);
        v4u v = *p;
        v.x = pk2(bf_lo(v.x) * al, bf_hi(v.x) * al); v.y = pk2(bf_lo(v.y) * al, bf_hi(v.y) * al); v.z = pk2(bf_lo(v.z) * al, bf_hi(v.z) * al); v.w = pk2(bf_lo(v.w) * al, bf_hi(v.w) * al);
        *p = v;
    }
}
__device__ __forceinline__ void final_norm_rows(Frame& F) {
    const int gw = F.vcu * NWAVES + F.wave, NGW = F.G * NWAVES;
    for (int m = gw; m < M; m += NGW) {
        const float s = wave_sum(F.lane < 16 ? F.SS[(size_t)m * 16 + F.lane] : 0.f);
        const float r = 1.0f / sqrtf(s * (1.0f / D) + NORM_EPS);
        GAS f32x4* xr = (GAS f32x4*)(F.out + (size_t)m * D) + F.lane;
        const GAS f32x4* gr = (const GAS f32x4*)F.final_norm + F.lane;
#pragma unroll
        for (int j = 0; j < 4; ++j) { const f32x4 v = xr[64 * j], g = gr[64 * j]; xr[64 * j] = v * r * g; }
    }
}

struct Args { const float* in[12]; float* out; unsigned char* ws; int ph_lo, ph_hi; };
__global__ void __launch_bounds__(NWAVES * 64, 2) trunk_fwd(Args args) {
    extern __shared__ __attribute__((aligned(16))) unsigned char lds[];
    Frame F;
    F.lds = (LAS unsigned char*)lds;
    F.MISC = (volatile LAS unsigned*)(F.lds + MISC_OFF);
    F.tid = threadIdx.x; F.lane = F.tid & 63; F.wave = __builtin_amdgcn_readfirstlane(F.tid >> 6);
    F.G = gridDim.x; { const int bx = blockIdx.x; F.vcu = (F.G % 8 == 0) ? (bx % 8) * (F.G / 8) + bx / 8 : bx; }
    unsigned char* ws = args.ws;
    F.ctl = (gu32*)(ws + WS_CTL);
    F.x = args.in[0]; F.norm_mix = args.in[1]; F.norm_ffn = args.in[2]; F.hgrn_w_in = args.in[3]; F.lb_logits = args.in[4]; F.hgrn_out_norm = args.in[5]; F.hgrn_w_out = args.in[6];
    F.attn_w_qkv = args.in[7]; F.attn_w_out = args.in[8]; F.ffn_w_in = args.in[9]; F.ffn_w_down = args.in[10]; F.final_norm = args.in[11]; F.out = args.out;
    F.Whin = (bf16*)(ws + WS_WHIN); F.Whout = (bf16*)(ws + WS_WHOUT); F.Wqkv = (bf16*)(ws + WS_WQKV); F.Wao = (bf16*)(ws + WS_WAO); F.Wf1 = (bf16*)(ws + WS_WF1); F.Wf2 = (bf16*)(ws + WS_WF2);
    F.SS = (float*)(ws + WS_SS); F.E1 = (float*)(ws + WS_E1); F.E2 = (float*)(ws + WS_E2); F.COS = (float*)(ws + WS_COS); F.SIN = (float*)(ws + WS_SIN); F.LSE = (float*)(ws + WS_LSE); F.LB = (float*)(ws + WS_LB); F.ST = (float*)(ws + WS_ST);
    F.XB = (bf16*)(ws + WS_XB); F.QT = (bf16*)(ws + WS_QT); F.KT = (bf16*)(ws + WS_KT); F.VV = (bf16*)(ws + WS_VV); F.GG = (bf16*)(ws + WS_GG); F.FF = (bf16*)(ws + WS_FF);
    F.QP = (bf16*)(ws + WS_QP); F.KP = (bf16*)(ws + WS_KP); F.VP = (bf16*)(ws + WS_VP);
    for (int u = F.tid; u < (LDS_BYTES - LDSCTL_OFF) / 4; u += NWAVES * 64) ((LAS unsigned*)(F.lds + LDSCTL_OFF))[u] = 0u;
    __syncthreads();
    XcdBarrier bar; bar.bar = (unsigned*)(F.ctl + CW_BAR); bar.x = 0; bar.st = nullptr;
    if (!MK_PER_PHASE) bar = xcd_barrier_post((unsigned*)(F.ctl + CW_BAR), F.MISC + 8);
    const int lo = args.ph_lo, hi = args.ph_hi;
#define IN(k) (lo <= (k) && (k) < hi)
#define SEAM(k) do { if (IN(k) && IN((k) + 1)) xcd_barrier(bar); } while (0)
    using pg8::Gemm; using pg8::StaticOrder;
#define RUN_GEMM(EPI, Aptr, Bptr, N_, K_, E) do { Gemm g{(const pg8::bf16_t*)(Aptr), (const pg8::bf16_t*)(Bptr), M, (N_), (K_)}; StaticOrder S; S.init(M, (N_), F.G, (int)blockIdx.x); \
        pg8::gemm_phase<EPI, StaticOrder, true, true>(F.lds + RING_OFF, g, S, E); } while (0)

    if (IN(0)) { p0_prologue(F); } SEAM(0);
    if (IN(1)) { pg8::EpiHgrnIn E{F.QT, F.KT, F.VV, F.GG, F.E1, F.E2, F.SS, F.LB}; RUN_GEMM(pg8::EpiHgrnIn, F.XB, F.Whin, HIN, D, E); } SEAM(1);
    if (IN(2)) { hgrn_simple_rec(F, F.out); } SEAM(2);
    if (IN(3)) { hgrn_simple_post(F, F.out); } SEAM(3);
    if (IN(4)) { pg8::EpiRes E{F.x, F.out, F.XB, F.SS}; RUN_GEMM(pg8::EpiRes, F.QT, F.Whout, D, D, E); } SEAM(4);
    if (IN(5)) { pg8::EpiSwiglu E{F.FF, F.SS}; RUN_GEMM(pg8::EpiSwiglu, F.XB, F.Wf1, FF2, D, E); } SEAM(5);
    if (IN(6)) { pg8::EpiRes E{F.out, F.out, F.XB, F.SS}; RUN_GEMM(pg8::EpiRes, F.FF, F.Wf2, D, DFF, E); } SEAM(6);
    if (IN(7)) { pg8::EpiQkv E{F.QP, F.KP, F.VP, F.SS, F.COS, F.SIN}; RUN_GEMM(pg8::EpiQkv, F.XB, F.Wqkv, QKVW, D, E); } SEAM(7);
    if (IN(8)) { attn_simple(F); } SEAM(8);
    if (IN(9)) { attn_scale(F); } SEAM(9);
    if (IN(10)) { pg8::EpiRes E{F.out, F.out, F.XB, F.SS}; RUN_GEMM(pg8::EpiRes, F.QP, F.Wao, D, AW, E); } SEAM(10);
    if (IN(11)) { pg8::EpiSwiglu E{F.FF, F.SS}; RUN_GEMM(pg8::EpiSwiglu, F.XB, F.Wf1 + (size_t)FF2 * D, FF2, D, E); } SEAM(11);
    if (IN(12)) { pg8::EpiRes E{F.out, F.out, nullptr, F.SS}; RUN_GEMM(pg8::EpiRes, F.FF, F.Wf2 + (size_t)D * DFF, D, DFF, E); } SEAM(12);
    if (IN(13)) { final_norm_rows(F); }
#undef IN
#undef SEAM
#undef RUN_GEMM
}

extern "C" void kernel_launch(void* const* d_in, const int* in_sizes, int n_in, void* d_out, int out_size, void* d_ws, size_t ws_size, hipStream_t stream) {
    static int grid = 0;
    if (grid == 0) {
        if (n_in != 12 || in_sizes[0] != M * D || out_size != M * D || ws_size < WS_END) { fprintf(stderr, "kernel_launch: unexpected shapes (n_in %d, in0 %d, out %d, ws %zu); nothing launched\n", n_in, n_in > 0 ? in_sizes[0] : -1, out_size, ws_size); grid = -1; return; }
        int dev = 0, cus = 0, per_cu = 0;
        if (hipGetDevice(&dev) != hipSuccess || hipDeviceGetAttribute(&cus, hipDeviceAttributeMultiprocessorCount, dev) != hipSuccess) { grid = -1; return; }
        if (hipFuncSetAttribute((const void*)trunk_fwd, hipFuncAttributeMaxDynamicSharedMemorySize, LDS_BYTES) != hipSuccess) { fprintf(stderr, "kernel_launch: hipFuncSetAttribute failed\n"); grid = -1; return; }
        if (hipOccupancyMaxActiveBlocksPerMultiprocessor(&per_cu, (const void*)trunk_fwd, NWAVES * 64, LDS_BYTES) != hipSuccess || per_cu < 1)
            fprintf(stderr, "kernel_launch: note: the occupancy query reports %d workgroups per CU\n", per_cu);
        (void)hipGetLastError();
        grid = cus;
    }
    if (grid < 0) return;
    if (hipMemsetAsync((char*)d_ws + WS_CTL, 0, CTL_ZERO_BYTES, stream) != hipSuccess) { fprintf(stderr, "kernel_launch: hipMemsetAsync failed\n"); return; }
    Args a{};
    for (int i = 0; i < 12; ++i) a.in[i] = (const float*)d_in[i];
    a.out = (float*)d_out; a.ws = (unsigned char*)d_ws;
#if MK_PER_PHASE
    for (int p = 0; p < NPH; ++p) { a.ph_lo = p; a.ph_hi = p + 1; hipLaunchKernelGGL(trunk_fwd, dim3(grid), dim3(NWAVES * 64), LDS_BYTES, stream, a); }
#else
    a.ph_lo = 0; a.ph_hi = NPH; hipLaunchKernelGGL(trunk_fwd, dim3(grid), dim3(NWAVES * 64), LDS_BYTES, stream, a);
#endif
    const hipError_t le = hipPeekAtLastError();
    if (le != hipSuccess) fprintf(stderr, "kernel_launch: launch failed: %s (grid %d)\n", hipGetErrorName(le), grid);
}
```

```cpp
#include <hip/hip_runtime.h>
#include <cstdio>
#include <cstdint>
#include <math.h>

constexpr int BATCH = 2, T = 8192, D = 1024, M = BATCH * T;
constexpr int HIN = 4096, DFF = 2816, FF2 = 2 * DFF, QKVW = 4608, AW = 1536;
constexpr float NORM_EPS = 1e-6f;

namespace pg8 {
#define PG8_LAS __attribute__((address_space(3)))
typedef unsigned short bf16_t;
typedef short bf16x8 __attribute__((ext_vector_type(8)));
typedef float f32x4 __attribute__((ext_vector_type(4)));
typedef unsigned u32x4 __attribute__((ext_vector_type(4)));
constexpr int BM = 256, BK = 64, HALF = 128, HTB = HALF * BK * 2  , STAGE_BYTES = 8 * HTB, NXCD = 8, WGM = 8;

__host__ __device__ __forceinline__ int lds_byte(int r, int c) { const int st = (r >> 4) * 2 + (c >> 5), rr = r & 15, cc = c & 31, ob = rr * 64 + cc * 2; return st * 1024 + (ob ^ (((ob >> 9) & 1) << 5)); }
__host__ __device__ __forceinline__ void stage_rc(int b, int& R, int& C) { const int st = b / 1024, sb = b % 1024, swz = sb ^ (((sb >> 9) & 1) << 5); R = (st >> 1) * 16 + swz / 64; C = (st & 1) * 32 + (swz % 64) / 2; }
__host__ __device__ __forceinline__ int perm32(int rho) { const int n = rho >> 4, i = rho & 15; return 8 * (i >> 2) + 4 * n + (i & 3); }

struct Unit { int pm, pn; };
struct Gemm { const bf16_t* A; const bf16_t* Bt; int M, N, K; };

struct StaticOrder {
    int nM, nN, nwg, G, c;
    __host__ __device__ void init(int M, int N, int G_, int c_) { nM = M / BM; nN = N / BM; nwg = nM * nN; G = G_; c = c_; }
    __host__ __device__ bool next(int i, Unit& u) const {
        const long L = (long)i * G + c; if (L >= nwg) return false;
        int wgid = (int)L; { const int q = nwg / NXCD, r = nwg % NXCD, xcd = wgid % NXCD, off = wgid / NXCD; wgid = (xcd < r ? xcd * (q + 1) : r * (q + 1) + (xcd - r) * q) + off; }
        const int nig = WGM * nN, gid = wgid / nig, fm = gid * WGM, gsz = (nM - fm) < WGM ? (nM - fm) : WGM;
        u.pm = fm + ((wgid % nig) % gsz); u.pn = (wgid % nig) / gsz; return true;
    }
    __device__ __forceinline__ void a_ready(const Unit&) const {}
    __device__ __forceinline__ void done(const Unit&) const {}
};


__device__ __forceinline__ unsigned cvt_pk_bf16(float lo, float hi) { unsigned r; asm volatile("v_cvt_pk_bf16_f32 %0, %1, %2" : "=v"(r) : "v"(lo), "v"(hi)); return r; }
typedef unsigned u32x2 __attribute__((ext_vector_type(2)));
__device__ __forceinline__ u32x4 pack8(const f32x4 a, const f32x4 b) { u32x4 w; w.x = cvt_pk_bf16(a[0], a[1]); w.y = cvt_pk_bf16(a[2], a[3]); w.z = cvt_pk_bf16(b[0], b[1]); w.w = cvt_pk_bf16(b[2], b[3]); return w; }
__device__ __forceinline__ u32x2 pack4(const f32x4 a) { u32x2 w; w.x = cvt_pk_bf16(a[0], a[1]); w.y = cvt_pk_bf16(a[2], a[3]); return w; }
__device__ __forceinline__ float silu_f(float x) { return x * __builtin_amdgcn_rcpf(1.0f + __expf(-x)); }
__device__ __forceinline__ f32x4 silu4(const f32x4 x) { f32x4 r; r[0] = silu_f(x[0]); r[1] = silu_f(x[1]); r[2] = silu_f(x[2]); r[3] = silu_f(x[3]); return r; }
__device__ __forceinline__ float row_rstd(const float* ss, int row, int fq) {
    const f32x4 p = *(const f32x4*)(ss + (size_t)row * 16 + 4 * fq);
    float s = (p[0] + p[1]) + (p[2] + p[3]);
    s += __shfl_xor(s, 16); s += __shfl_xor(s, 32);
    return 1.0f / sqrtf(s * (1.0f / 1024.0f) + NORM_EPS);
}
template <int CTRL> __device__ __forceinline__ float dpp_f(float x) { return __builtin_bit_cast(float, __builtin_amdgcn_update_dpp(0, __builtin_bit_cast(int, x), CTRL, 0xf, 0xf, true)); }

struct EpiRes {
    static constexpr bool PERM = false, AFTER_DRAIN = false;
    const float* base; float* out; bf16_t* xb; float* ss;
    __device__ __forceinline__ void operator()(const f32x4 (&acc)[2][2][4][2], const Unit& u, int wr, int wc, int fr, int fq) const {
        const int colb = u.pn * BM + wc * 32 + 8 * fq;
#pragma unroll
        for (int ai = 0; ai < 2; ++ai)
#pragma unroll
            for (int m = 0; m < 4; ++m) {
                const int row = u.pm * BM + ai * HALF + wr * 64 + m * 16 + fr;
                float sq = 0.f;
#pragma unroll
                for (int bj = 0; bj < 2; ++bj) {
                    const size_t off = (size_t)row * 1024 + colb + bj * HALF;
                    const f32x4 b0 = *(const f32x4*)(base + off), b1 = *(const f32x4*)(base + off + 4);
                    const f32x4 v0 = acc[ai][bj][m][0] + b0, v1 = acc[ai][bj][m][1] + b1;
                    *(f32x4*)(out + off) = v0; *(f32x4*)(out + off + 4) = v1;
                    if (xb) *(u32x4*)(xb + off) = pack8(v0, v1);
                    sq += (v0[0] * v0[0] + v0[1] * v0[1]) + (v0[2] * v0[2] + v0[3] * v0[3]) + (v1[0] * v1[0] + v1[1] * v1[1]) + (v1[2] * v1[2] + v1[3] * v1[3]);
                }
                sq += __shfl_xor(sq, 16); sq += __shfl_xor(sq, 32);
                if (fq == 0) ss[(size_t)row * 16 + u.pn * 4 + wc] = sq;
            }
    }
};
struct EpiSwiglu {
    static constexpr bool PERM = false, AFTER_DRAIN = false;
    bf16_t* act; const float* ss;
    __device__ __forceinline__ void operator()(const f32x4 (&acc)[2][2][4][2], const Unit& u, int wr, int wc, int fr, int fq) const {
        const int colb = u.pn * 128 + wc * 32 + 8 * fq;
#pragma unroll
        for (int ai = 0; ai < 2; ++ai)
#pragma unroll
            for (int m = 0; m < 4; ++m) {
                const int row = u.pm * BM + ai * HALF + wr * 64 + m * 16 + fr;
                const float r = row_rstd(ss, row, fq);
                const f32x4 a0 = silu4(acc[ai][0][m][0] * r) * (acc[ai][1][m][0] * r), a1 = silu4(acc[ai][0][m][1] * r) * (acc[ai][1][m][1] * r);
                *(u32x4*)(act + (size_t)row * DFF + colb) = pack8(a0, a1);
            }
    }
};
struct EpiQkv {
    static constexpr bool PERM = false, AFTER_DRAIN = false;
    bf16_t* Q; bf16_t* K; bf16_t* V; const float* ss; const float* cosT; const float* sinT;
    __device__ __forceinline__ void operator()(const f32x4 (&acc)[2][2][4][2], const Unit& u, int wr, int wc, int fr, int fq) const {
        if (u.pn < 12) {
            bf16_t* P = u.pn < 6 ? Q : K;
            const int j0 = (wc & 1) * 32 + 8 * fq, tcol = (u.pn % 6) * 256 + (wc >> 1) * 128 + j0;
#pragma unroll
            for (int ai = 0; ai < 2; ++ai)
#pragma unroll
                for (int m = 0; m < 4; ++m) {
                    const int row = u.pm * BM + ai * HALF + wr * 64 + m * 16 + fr;
                    const float r = row_rstd(ss, row, fq);
                    const size_t tb = (size_t)(row & (T - 1)) * 64 + j0;
                    const f32x4 c0 = *(const f32x4*)(cosT + tb), c1 = *(const f32x4*)(cosT + tb + 4), s0 = *(const f32x4*)(sinT + tb), s1 = *(const f32x4*)(sinT + tb + 4);
                    const f32x4 x1a = acc[ai][0][m][0] * r, x1b = acc[ai][0][m][1] * r, x2a = acc[ai][1][m][0] * r, x2b = acc[ai][1][m][1] * r;
                    bf16_t* p = P + (size_t)row * AW + tcol;
                    *(u32x4*)p = pack8(x1a * c0 - x2a * s0, x1b * c1 - x2b * s1);
                    *(u32x4*)(p + 64) = pack8(x2a * c0 + x1a * s0, x2b * c1 + x1b * s1);
                }
        } else {
            const int tcol = (u.pn - 12) * 256 + wc * 32 + 8 * fq;
#pragma unroll
            for (int ai = 0; ai < 2; ++ai)
#pragma unroll
                for (int m = 0; m < 4; ++m) {
                    const int row = u.pm * BM + ai * HALF + wr * 64 + m * 16 + fr;
                    const float r = row_rstd(ss, row, fq);
#pragma unroll
                    for (int bj = 0; bj < 2; ++bj) *(u32x4*)(V + (size_t)row * AW + tcol + bj * HALF) = pack8(acc[ai][bj][m][0] * r, acc[ai][bj][m][1] * r);
                }
        }
    }
};
struct EpiHgrnIn {
    static constexpr bool PERM = false, AFTER_DRAIN = false;
    bf16_t *QT, *KT, *VV, *GG; float *E1, *E2; const float* ss; const float* lb;
    __device__ __forceinline__ void operator()(const f32x4 (&acc)[2][2][4][2], const Unit& u, int wr, int wc, int fr, int fq) const {
        const int ch0 = u.pn * 64 + wc * 16 + 4 * fq;
        const f32x4 lbv = *(const f32x4*)(lb + ch0);
#pragma unroll
        for (int ai = 0; ai < 2; ++ai) {
            const int rowb = u.pm * BM + ai * HALF + wr * 64;
            float rs[4];
#pragma unroll
            for (int m = 0; m < 4; ++m) rs[m] = row_rstd(ss, rowb + m * 16 + fr, fq);
            f32x4 kv[4], bc[4], run = {0.f, 0.f, 0.f, 0.f};
#pragma unroll
            for (int m = 0; m < 4; ++m) {
                const f32x4 fz = acc[ai][0][m][1] * rs[m];
#pragma unroll
                for (int e = 0; e < 4; ++e) {
                    const float tt = __expf(-fmaxf(fz[e], -80.f)), inv = __builtin_amdgcn_rcpf(1.0f + tt);
                    const float oml = 1.0f - lbv[e];
                    const float fg = lbv[e] + oml * inv;
                    kv[m][e] = oml * (tt * inv);
                    float x = __logf(fg);
                    x += dpp_f<0x111>(x); x += dpp_f<0x112>(x); x += dpp_f<0x114>(x); x += dpp_f<0x118>(x);
                    const float tot = __shfl(x, 15, 16);
                    bc[m][e] = x + run[e]; run[e] += tot;
                }
            }
            f32x4 ref;
#pragma unroll
            for (int e = 0; e < 4; ++e) ref[e] = __shfl(bc[1][e], 15, 16);
            if (fr == 0) {
                const int chunk = rowb >> 6; f32x4 e1, e2;
#pragma unroll
                for (int e = 0; e < 4; ++e) { e1[e] = __expf(ref[e]); e2[e] = __expf(run[e] - ref[e]); }
                *(f32x4*)(E1 + (size_t)chunk * 1024 + ch0) = e1; *(f32x4*)(E2 + (size_t)chunk * 1024 + ch0) = e2;
            }
#pragma unroll
            for (int m = 0; m < 4; ++m) {
                const size_t off = (size_t)(rowb + m * 16 + fr) * 1024 + ch0;
                f32x4 qv = silu4(acc[ai][0][m][0] * rs[m]), kk = kv[m];
#pragma unroll
                for (int e = 0; e < 4; ++e) { const float dl = bc[m][e] - ref[e]; qv[e] *= __expf(dl); kk[e] *= __expf(-dl); }
                *(u32x2*)(QT + off) = pack4(qv); *(u32x2*)(KT + off) = pack4(kk);
                *(u32x2*)(VV + off) = pack4(acc[ai][1][m][0] * rs[m]); *(u32x2*)(GG + off) = pack4(silu4(acc[ai][1][m][1] * rs[m]));
            }
        }
    }
};

template <class Epi, class Sched, bool ALIGN_EPI = false, bool SP2 = false>
__device__ __forceinline__ void gemm_phase(PG8_LAS unsigned char* lds, const Gemm g, const Sched& S, const Epi& E) {
    const int tid = threadIdx.x, wid = __builtin_amdgcn_readfirstlane(tid >> 6), lane = tid & 63, wr = wid >> 2, wc = wid & 3, fr = lane & 15, fq = lane >> 4;
    const int K = g.K, nt = K / BK;
    unsigned voffA[2], voffB[2];
#pragma unroll
    for (int i = 0; i < 2; ++i) { int R, C; stage_rc(tid * 16 + i * 8192, R, C); const int Rb = Epi::PERM ? ((R & ~31) + perm32(R & 31)) : R;
        voffA[i] = (unsigned)(R * K + C) * 2u; voffB[i] = (unsigned)(Rb * K + C) * 2u; }
    const size_t kstep = (size_t)(BK * 2);
    const size_t hstep = (size_t)HALF * K * 2;
    const size_t tstep = 2 * hstep;
    const unsigned ldsw = (unsigned)wid * 1024u;
    const int aoff = lds_byte(wr * 64 + fr, fq * 8), boff = lds_byte(wc * 32 + fr, fq * 8);
#define PG8_SA(b, h) (((b) * 2 + (h)) * HTB)
#define PG8_SB(b, h) ((4 + (b) * 2 + (h)) * HTB)
#define PG8_STAGE(bufoff, gbase, voff) do { _Pragma("unroll") for (int _i = 0; _i < 2; ++_i) \
        __builtin_amdgcn_global_load_lds((const unsigned*)((const char*)(gbase) + (voff)[_i]), (PG8_LAS unsigned*)(lds + (bufoff) + ldsw + _i * 8192), 16, 0, 0); } while (0)
#define PG8_LDA(dst, b, h) do { _Pragma("unroll") for (int m = 0; m < 4; ++m) _Pragma("unroll") for (int k = 0; k < 2; ++k) dst[m][k] = *(const PG8_LAS bf16x8*)(lds + PG8_SA(b, h) + aoff + m * 2048 + k * 1024); } while (0)
#define PG8_LDB(dst, b, h) do { _Pragma("unroll") for (int n = 0; n < 2; ++n) _Pragma("unroll") for (int k = 0; k < 2; ++k) dst[n][k] = *(const PG8_LAS bf16x8*)(lds + PG8_SB(b, h) + boff + n * 2048 + k * 1024); } while (0)
#define PG8_MMA(ai, bj, At, Bt) do { __builtin_amdgcn_s_setprio(1); _Pragma("unroll") for (int m = 0; m < 4; ++m) _Pragma("unroll") for (int n = 0; n < 2; ++n) _Pragma("unroll") for (int k = 0; k < 2; ++k) \
        acc[ai][bj][m][n] = __builtin_amdgcn_mfma_f32_16x16x32_bf16(Bt[n][k], At[m][k], acc[ai][bj][m][n], 0, 0, 0); __builtin_amdgcn_s_setprio(0); } while (0)
#define PG8_WAIT_V(n) asm volatile("s_waitcnt vmcnt(" #n ")" ::: "memory")
#define PG8_WAIT_L(n) asm volatile("s_waitcnt lgkmcnt(" #n ")" ::: "memory")
#define PG8_BAR __builtin_amdgcn_s_barrier()
#define PG8_SCHED __builtin_amdgcn_sched_barrier(0)
    Unit cur, nxt; int ui = 0;
    if (!S.next(0, cur)) return;
    f32x4 acc[2][2][4][2];
#pragma unroll
    for (int a = 0; a < 2; ++a)
#pragma unroll
        for (int b = 0; b < 2; ++b)
#pragma unroll
            for (int m = 0; m < 4; ++m)
#pragma unroll
                for (int n = 0; n < 2; ++n) acc[a][b][m][n] = (f32x4){0.f, 0.f, 0.f, 0.f};
    bf16x8 At[4][2], B0[2][2], B1[2][2];
    const char* cA = (const char*)g.A + (size_t)cur.pm * tstep; const char* cB = (const char*)g.Bt + (size_t)cur.pn * tstep;
    S.a_ready(cur);
    if constexpr (SP2) {
        PG8_STAGE(PG8_SB(0, 0), cB, voffB); PG8_STAGE(PG8_SB(0, 1), cB + hstep, voffB); PG8_STAGE(PG8_SA(0, 0), cA, voffA); PG8_STAGE(PG8_SA(0, 1), cA + hstep, voffA);
        if (wr == 1) PG8_BAR;
        PG8_WAIT_V(2); PG8_BAR;
        PG8_STAGE(PG8_SB(1, 0), cB + kstep, voffB); PG8_STAGE(PG8_SA(1, 0), cA + kstep, voffA); PG8_STAGE(PG8_SB(1, 1), cB + hstep + kstep, voffB);
        PG8_WAIT_V(6); PG8_BAR;
    } else {
        PG8_STAGE(PG8_SB(0, 0), cB, voffB); PG8_STAGE(PG8_SA(0, 0), cA, voffA); PG8_STAGE(PG8_SB(0, 1), cB + hstep, voffB); PG8_STAGE(PG8_SA(0, 1), cA + hstep, voffA);
        if (wr == 1) PG8_BAR;
        PG8_WAIT_V(4); PG8_BAR;
        PG8_STAGE(PG8_SB(1, 0), cB + kstep, voffB); PG8_STAGE(PG8_SA(1, 0), cA + kstep, voffA); PG8_STAGE(PG8_SB(1, 1), cB + hstep + kstep, voffB);
        PG8_WAIT_V(6); PG8_BAR;
    }
    for (;;) {
        const bool has_next = S.next(ui + 1, nxt);
        const char* nA = has_next ? (const char*)g.A + (size_t)nxt.pm * tstep : cA; const char* nB = has_next ? (const char*)g.Bt + (size_t)nxt.pn * tstep : cB;
        for (int t = 0; t < nt; t += 2) {
            const bool last = (t == nt - 2);
            const char* a1 = cA + (size_t)(t + 1) * kstep;
            const char* a2 = last ? nA : cA + (size_t)(t + 2) * kstep; const char* b2 = last ? nB : cB + (size_t)(t + 2) * kstep;
            const char* a3 = a2 + kstep; const char* b3 = b2 + kstep;
            if (last && has_next) S.a_ready(nxt);
            if constexpr (SP2) {
            PG8_LDB(B0, 0, 0); PG8_LDB(B1, 0, 1); PG8_SCHED; PG8_LDA(At, 0, 0); PG8_STAGE(PG8_SA(1, 1), a1 + hstep, voffA);
            PG8_WAIT_V(8); PG8_WAIT_L(0); PG8_BAR; PG8_MMA(0, 0, At, B0); PG8_MMA(0, 1, At, B1); PG8_BAR; PG8_SCHED;
            PG8_LDA(At, 0, 1); PG8_STAGE(PG8_SB(0, 0), b2, voffB); PG8_STAGE(PG8_SB(0, 1), b2 + hstep, voffB); PG8_STAGE(PG8_SA(0, 0), a2, voffA);
            PG8_WAIT_V(8); PG8_WAIT_L(0); PG8_BAR; PG8_MMA(1, 0, At, B0); PG8_MMA(1, 1, At, B1); PG8_BAR; PG8_SCHED;
            PG8_LDB(B0, 1, 0); PG8_LDB(B1, 1, 1); PG8_SCHED; PG8_LDA(At, 1, 0); PG8_STAGE(PG8_SA(0, 1), a2 + hstep, voffA);
            PG8_WAIT_V(8); PG8_WAIT_L(0); PG8_BAR; PG8_MMA(0, 0, At, B0); PG8_MMA(0, 1, At, B1); PG8_BAR; PG8_SCHED;
            PG8_LDA(At, 1, 1); PG8_STAGE(PG8_SB(1, 0), b3, voffB); PG8_STAGE(PG8_SB(1, 1), b3 + hstep, voffB); PG8_STAGE(PG8_SA(1, 0), a3, voffA);
            PG8_WAIT_V(8); PG8_WAIT_L(0); PG8_BAR; PG8_MMA(1, 0, At, B0); PG8_MMA(1, 1, At, B1); PG8_BAR; PG8_SCHED;
            } else {
            PG8_LDB(B0, 0, 0); PG8_SCHED; PG8_LDA(At, 0, 0); PG8_STAGE(PG8_SA(1, 1), a1 + hstep, voffA);
            PG8_WAIT_L(8); PG8_BAR; PG8_WAIT_L(0); PG8_MMA(0, 0, At, B0); PG8_BAR; PG8_SCHED;
            PG8_LDB(B1, 0, 1); PG8_STAGE(PG8_SB(0, 0), b2, voffB);
            PG8_BAR; PG8_WAIT_L(0); PG8_MMA(0, 1, At, B1); PG8_BAR;
            PG8_LDA(At, 0, 1); PG8_STAGE(PG8_SA(0, 0), a2, voffA);
            PG8_BAR; PG8_WAIT_L(0); PG8_MMA(1, 0, At, B0); PG8_BAR; PG8_SCHED;
            PG8_STAGE(PG8_SB(0, 1), b2 + hstep, voffB);
            PG8_WAIT_V(6); PG8_BAR; PG8_MMA(1, 1, At, B1); PG8_BAR;
            PG8_LDB(B0, 1, 0); PG8_SCHED; PG8_LDA(At, 1, 0); PG8_STAGE(PG8_SA(0, 1), a2 + hstep, voffA);
            PG8_WAIT_L(8); PG8_BAR; PG8_WAIT_L(0); PG8_MMA(0, 0, At, B0); PG8_BAR; PG8_SCHED;
            PG8_LDB(B1, 1, 1); PG8_STAGE(PG8_SB(1, 0), b3, voffB);
            PG8_BAR; PG8_WAIT_L(0); PG8_MMA(0, 1, At, B1); PG8_BAR;
            PG8_LDA(At, 1, 1); PG8_STAGE(PG8_SA(1, 0), a3, voffA);
            PG8_BAR; PG8_WAIT_L(0); PG8_MMA(1, 0, At, B0); PG8_BAR; PG8_SCHED;
            PG8_STAGE(PG8_SB(1, 1), b3 + hstep, voffB);
            PG8_WAIT_V(6); PG8_BAR; PG8_MMA(1, 1, At, B1); PG8_BAR;
            }
        }
        if constexpr (ALIGN_EPI) { if (wr == 0) PG8_BAR; }
        if constexpr (!Epi::AFTER_DRAIN) { E(acc, cur, wr, wc, fr, fq); S.done(cur); }
        if (!has_next) break;
#pragma unroll
        for (int a = 0; a < 2; ++a)
#pragma unroll
            for (int b = 0; b < 2; ++b)
#pragma unroll
                for (int m = 0; m < 4; ++m)
#pragma unroll
                    for (int n = 0; n < 2; ++n) acc[a][b][m][n] = (f32x4){0.f, 0.f, 0.f, 0.f};
        cur = nxt; cA = nA; cB = nB; ++ui;
        if constexpr (ALIGN_EPI) { if (wr == 1) PG8_BAR; }
    }
    PG8_WAIT_V(0);
    if constexpr (!ALIGN_EPI) { if (wr == 0) PG8_BAR; }
    PG8_BAR;
    if constexpr (Epi::AFTER_DRAIN) { E.fused(acc, cur, wr, wc, fr, fq, lds, wid, lane); S.done(cur); }
#undef PG8_SA
#undef PG8_SB
#undef PG8_STAGE
#undef PG8_LDA
#undef PG8_LDB
#undef PG8_MMA
#undef PG8_WAIT_V
#undef PG8_WAIT_L
#undef PG8_BAR
#undef PG8_SCHED
}
}


constexpr int NWAVES = 8;
#ifndef MK_PER_PHASE
#define MK_PER_PHASE 0
#endif
constexpr int NPH = 14;

constexpr size_t MiB = 1u << 20;
constexpr size_t WS_CTL = 0, CTL_ZERO_BYTES = 64 * 1024;
constexpr size_t WS_WHIN = 1 * MiB, WS_WHOUT = 9 * MiB, WS_WQKV = 11 * MiB, WS_WAO = 20 * MiB, WS_WF1 = 23 * MiB, WS_WF2 = 45 * MiB;
constexpr size_t WS_SS = 56 * MiB, WS_E1 = 57 * MiB, WS_E2 = 58 * MiB, WS_COS = 59 * MiB, WS_SIN = 61 * MiB, WS_LSE = 63 * MiB, WS_LB = 63 * MiB + 768 * 1024;
constexpr size_t WS_ST = 64 * MiB;
constexpr size_t WS_XB = 80 * MiB;
constexpr size_t WS_ACT = 112 * MiB;
constexpr size_t WS_QT = WS_ACT, WS_KT = WS_ACT + 32 * MiB, WS_VV = WS_ACT + 64 * MiB, WS_GG = WS_ACT + 96 * MiB;
constexpr size_t WS_FF = WS_ACT;
constexpr size_t WS_QP = WS_ACT, WS_KP = WS_ACT + 48 * MiB, WS_VP = WS_ACT + 96 * MiB;
constexpr size_t WS_END = 256 * MiB;
static_assert(WS_VP + (size_t)M * AW * 2 <= WS_END && WS_FF + (size_t)M * DFF * 2 <= WS_END && WS_GG + (size_t)M * D * 2 <= WS_END, "d_ws map");
static_assert(WS_WF2 + 2 * (size_t)D * DFF * 2 <= WS_SS && WS_WF1 + 2 * (size_t)FF2 * D * 2 <= WS_WF2 && WS_WAO + (size_t)D * AW * 2 <= WS_WF1 && WS_WQKV + (size_t)QKVW * D * 2 <= WS_WAO, "weights map");
constexpr int CW_TMO = 0, CW_BAR = 4096;

constexpr int RING_OFF = 0, RING_BYTES = 131072;
constexpr int LDSCTL_OFF = RING_BYTES, MISC_OFF = LDSCTL_OFF + 320;
constexpr int LDS_BYTES = 147456;
namespace swa {
constexpr float SCALE = 0.08838834764831845f;
constexpr int D = 128; constexpr bool WSKIP = true; constexpr float THR = 8.f;
constexpr int PLANE_PITCH = AW, SEQ_T = T; constexpr size_t K_FROM_Q = (WS_KP - WS_QP) / 2, V_FROM_K = (WS_VP - WS_KP) / 2;
constexpr int NW = 8, QBLK = 32, KVBLK = 64, QB = NW * QBLK;
constexpr int SHM_V = KVBLK * D * 2, SHM_K = KVBLK * D * 2, ATT_LDS_BYTES = 2 * SHM_V + 2 * SHM_K + NW * 64 * 4;
typedef unsigned short bf16;
typedef short bf16x8 __attribute__((ext_vector_type(8)));
typedef short s16x4 __attribute__((ext_vector_type(4)));
typedef float f32x16 __attribute__((ext_vector_type(16)));
typedef float f32x4 __attribute__((ext_vector_type(4)));
typedef unsigned u32x4 __attribute__((ext_vector_type(4)));
template <class A, class Bt> struct same_t { static constexpr bool v = false; };
template <class A> struct same_t<A, A> { static constexpr bool v = true; };

#define KSWZ(row, colB) ((row) * 256 + ((colB) ^ (((row) & 7) << 4)))
#define SBAR() __builtin_amdgcn_sched_barrier(0)
__device__ __forceinline__ int v_st(int k, int c) { const int kk = (k & ~0xC) | ((k & 4) << 1) | ((k & 8) >> 1); return ((kk >> 3) * 4 + (c >> 5)) * 512 + ((kk & 7) * 32 + (c & 31)) * 2; }
__device__ __forceinline__ int v_rd_base(int lane) { return ((lane & 3) << 3) | (((lane >> 2) & 3) << 6) | (((lane >> 4) & 1) << 5) | (((lane >> 5) & 1) << 8); }
constexpr int v_rd_off(int d0, int ks, int half) { return d0 * 512 + ks * 4096 + half * 2048; }
__device__ __forceinline__ int crow(int r, int hi) { return (r & 3) + 8 * (r >> 2) + 4 * hi; }
__device__ __forceinline__ unsigned cvtpk(float lo, float hi) {
    unsigned r; asm volatile("v_cvt_pk_bf16_f32 %0, %1, %2" : "=v"(r) : "v"(lo), "v"(hi)); return r;
}
__device__ __forceinline__ bf16x8 pack8(f32x4 a, f32x4 b) {
    u32x4 w = {cvtpk(a[0], a[1]), cvtpk(a[2], a[3]), cvtpk(b[0], b[1]), cvtpk(b[2], b[3])};
    return *reinterpret_cast<bf16x8*>(&w);
}
template <class T> __device__ __forceinline__ bf16x8 load8(const T* p) {
    if constexpr (same_t<T, float>::v) { return pack8(*(const f32x4*)p, *(const f32x4*)(p + 4)); }
    else { return *reinterpret_cast<const bf16x8*>(p); }
}
__device__ __forceinline__ void mask_tile(f32x16& p0, f32x16& p1, int dq, unsigned W) {
    const float NEG = -__builtin_inff();
#pragma unroll
    for (int r = 0; r < 16; ++r) {
        const int c = (r & 3) + 8 * (r >> 2);
        if ((unsigned)(dq - c) >= W) p0[r] = NEG;
        if ((unsigned)(dq - c - 32) >= W) p1[r] = NEG;
    }
}
__device__ __forceinline__ void partialSM(f32x16& p0, f32x16& p1, float& m_reg, float& mn, float& alpha) {
    float pmax = p0[0]; for (int r = 1; r < 16; ++r) pmax = fmaxf(pmax, p0[r]); for (int r = 0; r < 16; ++r) pmax = fmaxf(pmax, p1[r]);
    { auto rr = __builtin_amdgcn_permlane32_swap(__float_as_uint(pmax), __float_as_uint(pmax), false, false);
      pmax = fmaxf(__uint_as_float(rr[0]), __uint_as_float(rr[1])); }
    constexpr float C2 = 1.4426950408889634f * SCALE;
    if (__builtin_expect(__all((pmax - m_reg) * SCALE <= THR), 1)) { mn = m_reg; alpha = 1.f; }
    else { mn = fmaxf(m_reg, pmax); alpha = __builtin_amdgcn_exp2f((m_reg - mn) * C2); m_reg = mn; }
    const float mnL = -mn * C2;
    for (int r = 0; r < 16; ++r) p0[r] = fmaf(p0[r], C2, mnL); for (int r = 0; r < 16; ++r) p1[r] = fmaf(p1[r], C2, mnL);
    for (int r = 0; r < 16; ++r) p0[r] = __builtin_amdgcn_exp2f(p0[r]);
}
__device__ __forceinline__ void finishSM(f32x16& p0, f32x16& p1, float alpha, float& l_reg, bf16x8& pa0, bf16x8& pa1, bf16x8& pa2, bf16x8& pa3) {
    for (int r = 0; r < 16; ++r) p1[r] = __builtin_amdgcn_exp2f(p1[r]);
    float ps = 0; for (int r = 0; r < 16; ++r) ps += p0[r]; for (int r = 0; r < 16; ++r) ps += p1[r];
    { auto rr = __builtin_amdgcn_permlane32_swap(__float_as_uint(ps), __float_as_uint(ps), false, false);
      ps = __uint_as_float(rr[0]) + __uint_as_float(rr[1]); }
    l_reg = l_reg * alpha + ps;
#define PK4(P, B_, OUT) do { unsigned a0 = cvtpk(P[B_+0], P[B_+1]), a1 = cvtpk(P[B_+2], P[B_+3]);                          \
        unsigned b0 = cvtpk(P[B_+4], P[B_+5]), b1 = cvtpk(P[B_+6], P[B_+7]);                                             \
        auto r0 = __builtin_amdgcn_permlane32_swap(a0, b0, false, false); auto r1 = __builtin_amdgcn_permlane32_swap(a1, b1, false, false); \
        u32x4 w = {r0[0], r1[0], r0[1], r1[1]}; OUT = *reinterpret_cast<bf16x8*>(&w); } while (0)
    PK4(p0, 0, pa0); PK4(p0, 8, pa1); PK4(p1, 0, pa2); PK4(p1, 8, pa3);
#undef PK4
}
template <int KB, bool SK>
__device__ __forceinline__ void qkt(f32x16& p0, f32x16& p1, const char* K_lds, int r32, int hi, const bf16x8* qr, bool act) {
    if (SK && !act) { const float NEG = -__builtin_inff();
#pragma unroll
        for (int r = 0; r < 16; ++r) { p0[r] = NEG; p1[r] = NEG; } return; }
    p0 = f32x16{}; p1 = f32x16{};
    const char* kb[4];
#pragma unroll
    for (int dd = 0; dd < 4; ++dd) kb[dd] = K_lds + KB * SHM_K + KSWZ(r32, (dd * 16 + hi * 8) * 2);
#pragma unroll
    for (int d0 = 0; d0 < 8; ++d0) { const char* a = kb[d0 & 3] + (d0 >> 2) * 128;
        bf16x8 b0 = *reinterpret_cast<const bf16x8*>(a);
        bf16x8 b1 = *reinterpret_cast<const bf16x8*>(a + 32 * 256);
        p0 = __builtin_amdgcn_mfma_f32_32x32x16_bf16(b0, qr[d0], p0, 0, 0, 0);
        p1 = __builtin_amdgcn_mfma_f32_32x32x16_bf16(b1, qr[d0], p1, 0, 0, 0); }
}
template <int VB, bool SK>
__device__ __forceinline__ void pv_tile(f32x16* o, int vb0, bf16x8 pa0, bf16x8 pa1, bf16x8 pa2, bf16x8 pa3, bool act) {
    if (SK && !act) return;
#define TRRD(dst, off) asm volatile("ds_read_b64_tr_b16 %0, %1 offset:%2" : "=&v"(dst) : "v"(vb0), "i"(off) : "memory")
#define PV_D0(d0) do { s16x4 l0, l1, l2, l3, h0, h1, h2, h3; constexpr int b_ = VB * SHM_V + v_rd_off(d0, 0, 0);     \
        TRRD(l0, b_); TRRD(h0, b_ + 2048); TRRD(l1, b_ + 4096); TRRD(h1, b_ + 6144); TRRD(l2, b_ + 8192); TRRD(h2, b_ + 10240); TRRD(l3, b_ + 12288); TRRD(h3, b_ + 14336); \
        asm volatile("s_waitcnt lgkmcnt(0)" ::: "memory"); SBAR();                 \
        o[d0] = __builtin_amdgcn_mfma_f32_32x32x16_bf16(pa0, (bf16x8){l0[0], l0[1], l0[2], l0[3], h0[0], h0[1], h0[2], h0[3]}, o[d0], 0, 0, 0);   \
        o[d0] = __builtin_amdgcn_mfma_f32_32x32x16_bf16(pa1, (bf16x8){l1[0], l1[1], l1[2], l1[3], h1[0], h1[1], h1[2], h1[3]}, o[d0], 0, 0, 0);   \
        o[d0] = __builtin_amdgcn_mfma_f32_32x32x16_bf16(pa2, (bf16x8){l2[0], l2[1], l2[2], l2[3], h2[0], h2[1], h2[2], h2[3]}, o[d0], 0, 0, 0);   \
        o[d0] = __builtin_amdgcn_mfma_f32_32x32x16_bf16(pa3, (bf16x8){l3[0], l3[1], l3[2], l3[3], h3[0], h3[1], h3[2], h3[3]}, o[d0], 0, 0, 0); } while (0)
    PV_D0(0); PV_D0(1); PV_D0(2); PV_D0(3);
#undef PV_D0
#undef TRRD
}

template <class TIn, class TOut> struct BlockRef { const TIn* Q; int P0, sh, lrow;
    __device__ __forceinline__ int pitch() const { return PLANE_PITCH << sh; }
    __device__ __forceinline__ const TIn* K() const { return Q + K_FROM_Q - (size_t)P0 * (size_t)pitch(); }
    __device__ __forceinline__ const TIn* V() const { return K() + V_FROM_K; }
    __device__ __forceinline__ int skv() const { return SEQ_T >> sh; }
    __device__ __forceinline__ int lp() const { return 12 << sh; } };
template <class TIn> struct Seam {
    bf16x8 qr[8];
    bf16x8 st_v0, st_v1, st_k0, st_k1; f32x4 sf0, sf1, sf2, sf3;
    f32x4 tq[16];
};
__device__ __forceinline__ int swa_jlo(int P0, int W) { const int lowk = P0 - W + 1; return lowk > 0 ? lowk / KVBLK : 0; }
#define ROW(p, k0, rr, kp_) ((p) + (size_t)((k0) + (rr)) * (kp_) + sc)
#define VMW() asm volatile("s_waitcnt vmcnt(0)" ::: "memory")
#define VMWN(n) asm volatile("s_waitcnt vmcnt(%0)" :: "i"(n) : "memory")
#define SLOAD_H(Kp, Vp, k0, kp_) do { S.st_v0 = load8<TIn>(ROW(Vp, k0, sr, kp_)); S.st_v1 = load8<TIn>(ROW(Vp, k0, 32 + sr, kp_));              \
                         S.st_k0 = load8<TIn>(ROW(Kp, k0, sr, kp_)); S.st_k1 = load8<TIn>(ROW(Kp, k0, 32 + sr, kp_)); } while (0)
#define SWRITE_HK(bf) do { *(bf16x8*)(K_lds + (bf) * SHM_K + kws) = S.st_k0; *(bf16x8*)(K_lds + (bf) * SHM_K + kws + 32 * 256) = S.st_k1; } while (0)
#define SWRITE_HV(bf) do { *(bf16x8*)(V_lds + (bf) * SHM_V + vst0) = S.st_v0; *(bf16x8*)(V_lds + (bf) * SHM_V + vst1) = S.st_v1; } while (0)
#define SWRITE_H(bf) do { SWRITE_HV(bf); SWRITE_HK(bf); } while (0)
#define SLOAD_F(p, k0) do { S.sf0 = *(const f32x4*)ROW(p, k0, sr, D); S.sf1 = *(const f32x4*)(ROW(p, k0, sr, D) + 4);                \
                            S.sf2 = *(const f32x4*)ROW(p, k0, 32 + sr, D); S.sf3 = *(const f32x4*)(ROW(p, k0, 32 + sr, D) + 4); } while (0)
#define SWRITE_KF(bf) do { *(bf16x8*)(K_lds + (bf) * SHM_K + kws) = pack8(S.sf0, S.sf1); *(bf16x8*)(K_lds + (bf) * SHM_K + kws + 32 * 256) = pack8(S.sf2, S.sf3); } while (0)
#define SWRITE_VF(bf) do { *(bf16x8*)(V_lds + (bf) * SHM_V + vst0) = pack8(S.sf0, S.sf1); *(bf16x8*)(V_lds + (bf) * SHM_V + vst1) = pack8(S.sf2, S.sf3); } while (0)
template <class TIn, class TOut>
__device__ __forceinline__ void causal_swa_prime(const BlockRef<TIn, TOut>& cur, int W, char* lds, Seam<TIn>& S) {
    constexpr bool F32 = same_t<TIn, float>::v;
    const int tid = threadIdx.x, wid = __builtin_amdgcn_readfirstlane(tid >> 6), lane = tid & 63, r32 = lane & 31, hi = lane >> 5;
    const int sr = tid >> 4, sc = (tid & 15) * 8, kws = KSWZ(sr, sc * 2); char* K_lds = lds + 2 * SHM_V;
    const int kb0 = swa_jlo(cur.P0, W) * KVBLK;
    for (int d0 = 0; d0 < 8; ++d0) S.qr[d0] = load8<TIn>(cur.Q + (size_t)(wid * QBLK + r32) * cur.pitch() + d0 * 16 + hi * 8);
    if constexpr (F32) { SLOAD_F((const float*)cur.K(), kb0); VMW(); SWRITE_KF(0); SBAR(); SLOAD_F((const float*)cur.V(), kb0); }
    else { SLOAD_H(cur.K(), cur.V(), kb0, cur.pitch()); VMW(); SWRITE_HK(0); }
    __syncthreads();
}
template <class TIn, class TOut>
__device__ __forceinline__ void causal_swa_block(const BlockRef<TIn, TOut>& cur, const BlockRef<TIn, TOut>& nxt, float* lse, int W, char* lds, Seam<TIn>& S) {
    const int skv = cur.skv();
    constexpr bool F32 = same_t<TIn, float>::v;
    const int tid = threadIdx.x, wid = __builtin_amdgcn_readfirstlane(tid >> 6), lane = tid & 63, r32 = lane & 31, hi = lane >> 5;
    const int j_lo = swa_jlo(cur.P0, W);
    int j_hi = (cur.P0 + QB - 1) / KVBLK + 1; if (j_hi > skv / KVBLK) j_hi = skv / KVBLK;
    const int NT = j_hi - j_lo;
    const int kbn = swa_jlo(nxt.P0, W) * KVBLK;
    const int qlo = cur.P0 + wid * QBLK, qm = qlo + r32 - 4 * hi;
    char* V_lds = lds; char* K_lds = lds + 2 * SHM_V;
    float* ws = (float*)(lds + 2 * SHM_V + 2 * SHM_K) + wid * 64; float* li_l = ws, * al_l = ws + 32;
    float m_reg = -1e30f, l_reg = 0; f32x16 o[4] = {};
    const int sr = tid >> 4, sc = (tid & 15) * 8, vst0 = v_st(sr, sc), vst1 = v_st(32 + sr, sc), kws = KSWZ(sr, sc * 2);
    const int vb0 = (int)(uintptr_t)V_lds + v_rd_base(lane);
    const TIn* Kh = cur.K(); const TIn* Vh = Kh + V_FROM_K; const int kpc = cur.pitch();
#define RESC(a) do { if (__any((a) < 1.f)) { if (hi == 0) al_l[r32] = (a); asm volatile("s_waitcnt lgkmcnt(0)" ::: "memory");              \
                     for (int d_ = 0; d_ < 4; ++d_) for (int r = 0; r < 16; ++r) o[d_][r] *= al_l[crow(r, hi)]; } } while (0)
#define KBASE(t) ((j_lo + (t)) * KVBLK)
#define ACT(t) (KBASE(t) <= qlo + QBLK - 1 && KBASE(t) + KVBLK - 1 >= qlo - W + 1)
#define MASKT(P0_, P1_, t) do { const int kb_ = KBASE(t); if ((!SK || ACT(t)) && (kb_ + KVBLK - 1 > qlo || kb_ <= qlo + QBLK - 1 - W)) mask_tile(P0_, P1_, qm - kb_, (unsigned)W); } while (0)
    constexpr int NQL = F32 ? 16 : 8;
    constexpr bool SK = WSKIP && !F32;
#define SEAM_K0() do { VMWN(NQL); if constexpr (F32) { SWRITE_KF(0); SBAR(); SLOAD_F((const float*)nxt.V(), kbn); } else { SWRITE_HK(0); } SBAR(); } while (0)
    f32x16 pA0, pA1, pB0, pB1; float mnA, mnB, alA, alB; bf16x8 pa0, pa1, pa2, pa3;
    if constexpr (F32) { VMW(); SWRITE_VF(0); SBAR(); } else { SWRITE_HV(0); SBAR(); }
    if (NT > 1) { if constexpr (F32) SLOAD_F((const float*)Kh, KBASE(1)); else SLOAD_H(Kh, Vh, KBASE(1), kpc); }
    SBAR(); qkt<0, SK>(pA0, pA1, K_lds, r32, hi, S.qr, ACT(0));
    if constexpr (F32) { if (NT > 1) { VMW(); SWRITE_KF(1); SBAR(); SLOAD_F((const float*)Vh, KBASE(1)); } }
    MASKT(pA0, pA1, 0); partialSM(pA0, pA1, m_reg, mnA, alA);
    if (NT > 1) { VMW(); if constexpr (F32) { SWRITE_VF(1); SBAR(); if (NT > 2) SLOAD_F((const float*)Kh, KBASE(2)); } else SWRITE_H(1); }
    __syncthreads();
#define HALF_STEP(PX0, PX1, mnX, alX, PY0, PY1, alY, t, KB, VB, SB) do {                                                      \
        SBAR(); qkt<KB, SK>(PX0, PX1, K_lds, r32, hi, S.qr, ACT(t));                                             \
        finishSM(PY0, PY1, alY, l_reg, pa0, pa1, pa2, pa3); SBAR();                                                           \
        if ((t) + 1 < NT) { if constexpr (F32) { VMW(); SWRITE_KF(SB); SBAR(); SLOAD_F((const float*)Vh, KBASE((t) + 1)); }  \
                            else { SLOAD_H(Kh, Vh, KBASE((t) + 1), kpc); } SBAR(); }                                               \
        pv_tile<VB, SK>(o, vb0, pa0, pa1, pa2, pa3, ACT((t) - 1)); MASKT(PX0, PX1, (t)); partialSM(PX0, PX1, m_reg, mnX, alX);                                        \
        __syncthreads();                                                                                                      \
        if ((t) + 1 < NT) { VMW(); if constexpr (F32) { SWRITE_VF(SB); SBAR(); if ((t) + 2 < NT) SLOAD_F((const float*)Kh, KBASE((t) + 2)); } \
                            else { SWRITE_H(SB); } }                                                                          \
        RESC(alX); __syncthreads(); } while (0)
    for (int t = 1; t + 1 < NT; t += 2) {
        HALF_STEP(pB0, pB1, mnB, alB, pA0, pA1, alA, t, 1, 0, 0);
        HALF_STEP(pA0, pA1, mnA, alA, pB0, pB1, alB, t + 1, 0, 1, 1);
    }
    const bool even = (NT & 1) == 0;
    if (even) { SBAR(); qkt<1, SK>(pB0, pB1, K_lds, r32, hi, S.qr, ACT(NT - 1)); SBAR(); }
#define QROW(e) (nxt.Q + (size_t)(wid * QBLK + r32) * nxt.pitch() + ((e) >> 1) * 16 + hi * 8 + ((e) & 1) * 4)
    if constexpr (F32) { SLOAD_F((const float*)nxt.K(), kbn); SBAR();
#pragma unroll
        for (int e = 0; e < 8; ++e) S.tq[e] = *(const f32x4*)QROW(e); }
    else { SLOAD_H(nxt.K(), nxt.V(), kbn, nxt.pitch()); SBAR();
#pragma unroll
        for (int d0 = 0; d0 < 8; ++d0) S.qr[d0] = load8<TIn>(nxt.Q + (size_t)(wid * QBLK + r32) * nxt.pitch() + d0 * 16 + hi * 8); }
    SBAR();
    finishSM(pA0, pA1, alA, l_reg, pa0, pa1, pa2, pa3); SBAR();
    if constexpr (F32) {
#pragma unroll
        for (int e = 8; e < 16; ++e) S.tq[e] = *(const f32x4*)QROW(e); SBAR(); }
#undef QROW
    pv_tile<0, SK>(o, vb0, pa0, pa1, pa2, pa3, ACT(even ? NT - 2 : NT - 1));
    if (even) { MASKT(pB0, pB1, NT - 1); partialSM(pB0, pB1, m_reg, mnB, alB); __syncthreads(); RESC(alB);
        finishSM(pB0, pB1, alB, l_reg, pa0, pa1, pa2, pa3); SBAR(); pv_tile<1, SK>(o, vb0, pa0, pa1, pa2, pa3, ACT(NT - 1)); }
    SBAR(); SEAM_K0();
    if (hi == 0) li_l[r32] = l_reg; asm volatile("s_waitcnt lgkmcnt(0)" ::: "memory");
    float rli[16];
#pragma unroll
    for (int r = 0; r < 16; ++r) rli[r] = __builtin_amdgcn_rcpf(li_l[crow(r, hi)]);
    TOut* Ow = (TOut*)cur.Q + (size_t)(wid * QBLK) * kpc;
    if (hi == 0) lse[(size_t)cur.lrow + (size_t)(wid * QBLK + r32) * cur.lp()] = m_reg * SCALE + __logf(l_reg);
#pragma unroll
    for (int r = 0; r < 16; ++r) { const int orow = crow(r, hi);
#pragma unroll
        for (int d0 = 0; d0 < 4; ++d0) { const float v = o[d0][r] * rli[r];
            if constexpr (same_t<TOut, float>::v) { Ow[(size_t)orow * kpc + d0 * 32 + r32] = v; }
            else { const float vn = __shfl_xor(v, 1);
                   if ((r32 & 1) == 0) *(unsigned*)(Ow + (size_t)orow * kpc + d0 * 32 + r32) = cvtpk(v, vn); } } }
    if constexpr (F32) {
#pragma unroll
        for (int d0 = 0; d0 < 8; ++d0) S.qr[d0] = pack8(S.tq[2 * d0], S.tq[2 * d0 + 1]); }
    __syncthreads();
#undef RESC
#undef KBASE
#undef ACT
#undef MASKT
#undef SEAM_K0
#undef HALF_STEP
}
#undef ROW
#undef VMW
#undef VMWN
#undef SLOAD_H
#undef SWRITE_HK
#undef SWRITE_HV
#undef SWRITE_H
#undef SLOAD_F
#undef SWRITE_KF
#undef SWRITE_VF


}

#define GAS __attribute__((address_space(1)))
#define LAS __attribute__((address_space(3)))
typedef unsigned short bf16;
typedef unsigned v4u __attribute__((ext_vector_type(4)));
typedef float f32x4 __attribute__((ext_vector_type(4)));
typedef short bf16x8 __attribute__((ext_vector_type(8)));
typedef GAS unsigned gu32;
typedef GAS unsigned long long gu64;
#define RLX_AGENT __ATOMIC_RELAXED, __HIP_MEMORY_SCOPE_AGENT
#define LDS_WAIT() asm volatile("s_waitcnt lgkmcnt(0)" ::: "memory")
#define VM_WAIT() asm volatile("s_waitcnt vmcnt(0)" ::: "memory")
__device__ __forceinline__ unsigned long long rt() { return __builtin_amdgcn_s_memrealtime(); }
__device__ __forceinline__ unsigned f2bf(float f) { unsigned u = __builtin_bit_cast(unsigned, f); return (u + 0x7fffu + ((u >> 16) & 1u)) >> 16; }
__device__ __forceinline__ unsigned pk2(float lo, float hi) { return f2bf(lo) | (f2bf(hi) << 16); }

#define XB_TMO      128
#define XB_XCNT(j)  (256  + 64 * (j))
#define XB_XSUB(j)  (1280 + 64 * (j))
#define XB_XGEN(j)  (2304 + 64 * (j))
#define XB_TOP      3328
#define XB_TOPGEN   3392
#define XCD_BAR_WORDS 3456
#define XB_SPIN_CAP (1u << 18)

__device__ __forceinline__ unsigned xb_ld(unsigned* p)              { return __hip_atomic_load(p, __ATOMIC_RELAXED, __HIP_MEMORY_SCOPE_AGENT); }
__device__ __forceinline__ unsigned xb_add(unsigned* p, unsigned v) { return __hip_atomic_fetch_add(p, v, __ATOMIC_RELAXED, __HIP_MEMORY_SCOPE_AGENT); }
__device__ __forceinline__ unsigned xb_xcc_id() { return (unsigned)__builtin_amdgcn_s_getreg((3 << 11) | 20) & 0xFu; }
#define XB_SPIN(cond, bar) do { unsigned _sp = 0; while (cond) { __builtin_amdgcn_s_sleep(1); \
    if ((++_sp & 255u) == 0u) { if (xb_ld(&(bar)[XB_TMO])) break; if (_sp > XB_SPIN_CAP) { atomicAdd(&(bar)[XB_TMO], 1u); break; } } } } while (0)

struct XcdBarrier {
    unsigned* bar; unsigned x;
    volatile LAS unsigned* st;
};

__device__ __forceinline__ XcdBarrier xcd_barrier_post(unsigned* bar, volatile LAS unsigned* st) {
    XcdBarrier b; b.bar = bar; b.x = xb_xcc_id(); b.st = st;
    if (threadIdx.x == 0) (void)xb_add(&bar[XB_XCNT(b.x)], 1u);
    return b;
}
__device__ __forceinline__ void xcd_barrier_complete(unsigned* bar, unsigned x, unsigned& nloc, unsigned& nx) {
    const unsigned G = gridDim.x * gridDim.y * gridDim.z;
    unsigned sum, cnt, mine, sp = 0u;
    for (;;) {
        sum = 0u; cnt = 0u; mine = 0u;
#pragma unroll
        for (unsigned j = 0; j < 16; ++j) { const unsigned c = xb_ld(&bar[XB_XCNT(j)]); sum += c; cnt += (c > 0u) ? 1u : 0u; mine = (j == x) ? c : mine; }
        if (sum == G) break;
        __builtin_amdgcn_s_sleep(1);
        if ((++sp & 255u) == 0u) { if (xb_ld(&bar[XB_TMO])) break; if (sp > XB_SPIN_CAP) { atomicAdd(&bar[XB_TMO], 1u); break; } }
    }
    nloc = mine > 0u ? mine : 1u; nx = cnt > 0u ? cnt : 1u;
}

__device__ __forceinline__ void xcd_barrier(const XcdBarrier& b) {
    asm volatile("s_waitcnt vmcnt(0)" ::: "memory");
    __syncthreads();
    if (threadIdx.x == 0) {
        unsigned* bar = b.bar;
        __builtin_amdgcn_s_waitcnt(0);
        unsigned nloc = b.st[0], nx = b.st[1];
        if (nloc == 0u) { xcd_barrier_complete(bar, b.x, nloc, nx); b.st[0] = nloc; b.st[1] = nx; }
        const unsigned old = xb_add(&bar[XB_XSUB(b.x)], 1u);
        const unsigned gen = old / nloc;
        if (old + 1u == (gen + 1u) * nloc) {
            __builtin_amdgcn_fence(__ATOMIC_RELEASE, "agent");
            asm volatile("s_waitcnt vmcnt(0)" ::: "memory");
            const unsigned og = xb_add(&bar[XB_TOP], 1u);
            const unsigned tg = og / nx;
            if (og + 1u == (tg + 1u) * nx) xb_add(&bar[XB_TOPGEN], 1u);
            else XB_SPIN(xb_ld(&bar[XB_TOPGEN]) == tg, bar);
            __builtin_amdgcn_fence(__ATOMIC_ACQUIRE, "agent");
            xb_add(&bar[XB_XGEN(b.x)], 1u);
            asm volatile("s_waitcnt vmcnt(0)" ::: "memory");
        } else {
            XB_SPIN(xb_ld(&bar[XB_XGEN(b.x)]) == gen, bar);
            __builtin_amdgcn_fence(__ATOMIC_ACQUIRE, "agent");
            asm volatile("s_waitcnt vmcnt(0)" ::: "memory");
        }
    }
    __syncthreads();
}

struct Frame {
    LAS unsigned char* lds;
    volatile LAS unsigned* MISC;
    gu32* ctl;
    int tid, lane, wave;
    int vcu, G;
    const float *x, *norm_mix, *norm_ffn, *hgrn_w_in, *lb_logits, *hgrn_out_norm, *hgrn_w_out, *attn_w_qkv, *attn_w_out, *ffn_w_in, *ffn_w_down, *final_norm;
    float* out;
    bf16 *Whin, *Whout, *Wqkv, *Wao, *Wf1, *Wf2;
    float *SS, *E1, *E2, *COS, *SIN, *LSE, *LB, *ST;
    bf16 *XB, *QT, *KT, *VV, *GG, *FF, *QP, *KP, *VP;
};
__device__ __forceinline__ float wave_sum(float v) {
#pragma unroll
    for (int o = 1; o < 64; o <<= 1) v += __shfl_xor(v, o);
    return v;
}
__device__ __forceinline__ float bf_lo(unsigned u) { return __uint_as_float(u << 16); }
__device__ __forceinline__ float bf_hi(unsigned u) { return __uint_as_float(u & 0xffff0000u); }

__device__ __forceinline__ int pinv32(int l) { return 16 * ((l >> 2) & 1) + 4 * (l >> 3) + (l & 3); }
template <int MODE> __device__ __forceinline__ int phys_row(int c) {
    if (MODE == 0) return (c & ~31) + pinv32(c & 31);
    if (MODE == 1) { const int up = c >= DFF ? 1 : 0, j = c - up * DFF; return 256 * (j >> 7) + 128 * up + (j & 96) + pinv32(j & 31); }
    if (MODE == 2) {
        if (c >= 2 * AW) { const int cc = c - 2 * AW; return 256 * (12 + (cc >> 8)) + (cc & 224) + pinv32(cc & 31); }
        const int plane = c >= AW ? 1 : 0, cc = c - plane * AW, head = cc >> 7, d = cc & 127, half = d >> 6, j = d & 63;
        return 256 * (plane * 6 + (head >> 1)) + 128 * half + 32 * (2 * (head & 1) + (j >> 5)) + pinv32(j & 31);
    }
    { const int type = c >> 10, ch = c & 1023, chl = ch & 63; return 256 * (ch >> 6) + 128 * (type >> 1) + 32 * (chl >> 4) + 16 * (type & 1) + (chl & 15); }
}
template <int MODE>
__device__ __forceinline__ void p0_transpose_item(const float* W, int K, int N, bf16* WT, const float* gain, LAS float* scr, int item, int lane) {
    const int nblk = N / 32, kb = item / nblk, nb = item % nblk, k0 = 64 * kb, n0 = 32 * nb;
#pragma unroll 8
    for (int i = 0; i < 32; ++i) { const int kk = 2 * i + (lane >> 5); float w = W[(size_t)(k0 + kk) * N + n0 + (lane & 31)]; if (gain) w *= gain[k0 + kk]; scr[kk * 33 + (lane & 31)] = w; }
    LDS_WAIT(); asm volatile("" ::: "memory");
    const int c = lane & 7;
#pragma unroll
    for (int j = 0; j < 4; ++j) { const int n = (lane >> 3) + 8 * j; const LAS float* s = scr + (8 * c) * 33 + n;
        v4u o; o.x = pk2(s[0 * 33], s[1 * 33]); o.y = pk2(s[2 * 33], s[3 * 33]); o.z = pk2(s[4 * 33], s[5 * 33]); o.w = pk2(s[6 * 33], s[7 * 33]);
        *(GAS v4u*)(WT + (size_t)phys_row<MODE>(n0 + n) * K + k0 + 8 * c) = o; }
    LDS_WAIT(); asm volatile("" ::: "memory");
}
__device__ __forceinline__ void p0_prologue(Frame& F) {
    LAS float* scr = (LAS float*)(F.lds + RING_OFF + F.wave * 16384);
    const int gw = F.vcu * NWAVES + F.wave, NGW = F.G * NWAVES;
    constexpr int I_HIN = (D / 64) * (HIN / 32), I_HOUT = (D / 64) * (D / 32), I_QKV = (D / 64) * (QKVW / 32), I_AO = (AW / 64) * (D / 32), I_F1 = (D / 64) * (FF2 / 32), I_F2 = (DFF / 64) * (D / 32);
    constexpr int NITEMS = I_HIN + I_HOUT + I_QKV + I_AO + 2 * I_F1 + 2 * I_F2;
    for (int it = gw; it < NITEMS; it += NGW) {
        int r = it;
        if (r < I_HIN) { p0_transpose_item<3>(F.hgrn_w_in, D, HIN, F.Whin, F.norm_mix, scr, r, F.lane); continue; } r -= I_HIN;
        if (r < I_HOUT) { p0_transpose_item<0>(F.hgrn_w_out, D, D, F.Whout, nullptr, scr, r, F.lane); continue; } r -= I_HOUT;
        if (r < I_QKV) { p0_transpose_item<2>(F.attn_w_qkv, D, QKVW, F.Wqkv, F.norm_mix + D, scr, r, F.lane); continue; } r -= I_QKV;
        if (r < I_AO) { p0_transpose_item<0>(F.attn_w_out, AW, D, F.Wao, nullptr, scr, r, F.lane); continue; } r -= I_AO;
        if (r < 2 * I_F1) { const int l = r / I_F1; p0_transpose_item<1>(F.ffn_w_in + (size_t)l * D * FF2, D, FF2, F.Wf1 + (size_t)l * FF2 * D, F.norm_ffn + l * D, scr, r - l * I_F1, F.lane); continue; } r -= 2 * I_F1;
        { const int l = r / I_F2; p0_transpose_item<0>(F.ffn_w_down + (size_t)l * DFF * D, DFF, D, F.Wf2 + (size_t)l * D * DFF, nullptr, scr, r - l * I_F2, F.lane); }
    }
    for (int m = gw; m < M; m += NGW) {
        const GAS f32x4* xr = (const GAS f32x4*)(F.x + (size_t)m * D) + F.lane;
        GAS unsigned long long* o8 = (GAS unsigned long long*)(F.XB + (size_t)m * D) + F.lane;
        float s = 0.f;
#pragma unroll
        for (int j = 0; j < 4; ++j) { const f32x4 v = xr[64 * j]; s += (v.x * v.x + v.y * v.y) + (v.z * v.z + v.w * v.w); o8[64 * j] = (unsigned long long)pk2(v.x, v.y) | ((unsigned long long)pk2(v.z, v.w) << 32); }
        s = wave_sum(s);
        if (F.lane < 16) F.SS[(size_t)m * 16 + F.lane] = F.lane == 0 ? s : 0.f;
    }
    const int gt = F.vcu * NWAVES * 64 + F.tid, NGT = F.G * NWAVES * 64;
    for (int i = gt; i < T * 64; i += NGT) { const int pos = i >> 6, j = i & 63;
        const float inv = 1.0f / powf(10000.0f, (float)(2 * j) / 128.0f); const float ang = (float)pos * inv;
        F.COS[i] = (float)cos((double)ang); F.SIN[i] = (float)sin((double)ang); }
    if (gt < D) { const float a = F.lb_logits[gt], b = F.lb_logits[D + gt], c = F.lb_logits[2 * D + gt]; const float mx = fmaxf(a, fmaxf(b, c));
        const float ea = expf(a - mx), eb = expf(b - mx), ec = expf(c - mx); F.LB[gt] = ea / (ea + eb + ec); }
}

__device__ __forceinline__ void hgrn_simple_rec(Frame& F, float* oraw) {
    const int item = F.wave * F.G + F.vcu;
    if (item >= 256) return;
    const int b = item >> 7, h = (item >> 4) & 7, vg = item & 15, kc = h * 128 + 2 * F.lane, vc = h * 128 + vg * 8;
    float S0[8], S1[8];
#pragma unroll
    for (int j = 0; j < 8; ++j) { S0[j] = 0.f; S1[j] = 0.f; }
    for (int c = 0; c < 128; ++c) {
        const int chunk = b * 128 + c;
        const float e1x = F.E1[(size_t)chunk * 1024 + kc], e1y = F.E1[(size_t)chunk * 1024 + kc + 1], e2x = F.E2[(size_t)chunk * 1024 + kc], e2y = F.E2[(size_t)chunk * 1024 + kc + 1];
#pragma unroll
        for (int j = 0; j < 8; ++j) { S0[j] *= e1x; S1[j] *= e1y; }
#pragma unroll 2
        for (int t = 0; t < 64; ++t) {
            const size_t row = (size_t)chunk * 64 + t;
            const unsigned kq = *(const GAS unsigned*)(F.KT + row * 1024 + kc), qq = *(const GAS unsigned*)(F.QT + row * 1024 + kc);
            const v4u vv = *(const GAS v4u*)(F.VV + row * 1024 + vc);
            const float k0 = bf_lo(kq), k1 = bf_hi(kq), q0 = bf_lo(qq), q1 = bf_hi(qq);
            const float v[8] = {bf_lo(vv.x), bf_hi(vv.x), bf_lo(vv.y), bf_hi(vv.y), bf_lo(vv.z), bf_hi(vv.z), bf_lo(vv.w), bf_hi(vv.w)};
            float part[8];
#pragma unroll
            for (int j = 0; j < 8; ++j) { S0[j] = fmaf(k0, v[j], S0[j]); S1[j] = fmaf(k1, v[j], S1[j]); part[j] = q0 * S0[j] + q1 * S1[j]; }
#pragma unroll
            for (int j = 0; j < 8; ++j) part[j] = wave_sum(part[j]);
            if (F.lane == 0) { float* o = oraw + row * 1024 + vc; *(f32x4*)o = (f32x4){part[0], part[1], part[2], part[3]}; *(f32x4*)(o + 4) = (f32x4){part[4], part[5], part[6], part[7]}; }
        }
#pragma unroll
        for (int j = 0; j < 8; ++j) { S0[j] *= e2x; S1[j] *= e2y; }
    }
}
__device__ __forceinline__ void hgrn_simple_post(Frame& F, const float* oraw) {
    const int gw = F.vcu * NWAVES + F.wave, NGW = F.G * NWAVES;
    const float gn0 = F.hgrn_out_norm[2 * F.lane], gn1 = F.hgrn_out_norm[2 * F.lane + 1];
    for (int it = gw; it < M * 8; it += NGW) {
        const size_t off = (size_t)(it >> 3) * 1024 + (it & 7) * 128 + 2 * F.lane;
        const float v0 = oraw[off], v1 = oraw[off + 1];
        const float r = 1.0f / sqrtf(wave_sum(v0 * v0 + v1 * v1) * (1.0f / 128.0f) + NORM_EPS);
        const unsigned g = *(const GAS unsigned*)(F.GG + off);
        *(GAS unsigned*)(F.QT + off) = pk2(v0 * r * gn0 * bf_lo(g), v1 * r * gn1 * bf_hi(g));
    }
}
__device__ __forceinline__ void attn_simple(Frame& F) {
    const int gw = F.vcu * NWAVES + F.wave, NGW = F.G * NWAVES;
    for (int it = gw; it < M * 12; it += NGW) {
        const int row = it / 12, hd = it - row * 12, t = row & (T - 1), g = hd >> 2, dil = g == 0 ? 1 : (g == 1 ? 4 : 16);
        const size_t co = (size_t)hd * 128 + 2 * F.lane;
        const unsigned qq = *(const GAS unsigned*)(F.QP + (size_t)row * AW + co);
        const float q0 = bf_lo(qq), q1 = bf_hi(qq);
        float m = -INFINITY, l = 0.f, o0 = 0.f, o1 = 0.f;
        for (int j = 0; j <= 128; ++j) {
            if (t - j * dil < 0) break;
            const size_t rk = (size_t)(row - j * dil) * AW + co;
            const unsigned kk = *(const GAS unsigned*)(F.KP + rk), vv = *(const GAS unsigned*)(F.VP + rk);
            const float s = wave_sum(q0 * bf_lo(kk) + q1 * bf_hi(kk)) * 0.08838834764831845f;
            const float mn = fmaxf(m, s), a = __expf(m - mn), p = __expf(s - mn);
            l = l * a + p; o0 = o0 * a + p * bf_lo(vv); o1 = o1 * a + p * bf_hi(vv); m = mn;
        }
        *(GAS unsigned*)(F.QP + (size_t)row * AW + co) = pk2(o0 / l, o1 / l);
        if (F.lane == 0) F.LSE[(size_t)row * 12 + hd] = m + logf(l);
    }
}
typedef swa::BlockRef<bf16, bf16> AttRef;
__device__ __forceinline__ AttRef attn_ref(const Frame& F, int L) {
    const int bh = L >> 5, x = L & 31, b = bh / 12, head = bh - b * 12, sh = 2 * (head >> 2), nqs = 5 - sh;
    const int r = x >> nqs, qb = x & ((1 << nqs) - 1);
    const size_t rowq = (size_t)b * T + r + ((size_t)qb * 256 << sh);
    AttRef R; R.Q = F.QP + rowq * AW + head * 128; R.P0 = qb * 256; R.sh = sh; R.lrow = (int)rowq * 12 + head;
    return R;
}
__device__ __forceinline__ void attn_fast(Frame& F, char* lds) {
    constexpr int NITEM = BATCH * 12 * 32, W = 129;
    int L = F.vcu; if (L >= NITEM) return;
    AttRef cur = attn_ref(F, L);
    swa::Seam<bf16> S;
    swa::causal_swa_prime<bf16, bf16>(cur, W, lds, S);
    for (;;) {
        const bool more = L + F.G < NITEM;
        const AttRef nxt = more ? attn_ref(F, L + F.G) : cur;
        swa::causal_swa_block<bf16, bf16>(cur, nxt, F.LSE, W, lds, S);
        if (!more) break;
        cur = nxt; L += F.G;
    }
}
__device__ __forceinline__ void attn_scale(Frame& F) {
    const int gt = F.vcu * NWAVES * 64 + F.tid, NGT = F.G * NWAVES * 64;
    for (int i = gt; i < M * (AW / 8); i += NGT) {
        const int row = i / (AW / 8), c8 = i - row * (AW / 8), hd = c8 >> 4, hg = hd & 3;
        const float* ls = F.LSE + (size_t)row * 12;
        const float a = ls[hg], b = ls[4 + hg], c = ls[8 + hg], mx = fmaxf(a, fmaxf(b, c));
        const float al = __expf(ls[hd] - mx) / (__expf(a - mx) + __expf(b - mx) + __expf(c - mx));
        GAS v4u* p = (GAS v4u*)(F.QP + (size_t)row * AW + c8 * 8);
        v4u v = *p;
        v.x = pk2(bf_lo(v.x) * al, bf_hi(v.x) * al); v.y = pk2(bf_lo(v.y) * al, bf_hi(v.y) * al); v.z = pk2(bf_lo(v.z) * al, bf_hi(v.z) * al); v.w = pk2(bf_lo(v.w) * al, bf_hi(v.w) * al);
        *p = v;
    }
}
__device__ __forceinline__ void final_norm_rows(Frame& F) {
    const int gw = F.vcu * NWAVES + F.wave, NGW = F.G * NWAVES;
    for (int m = gw; m < M; m += NGW) {
        const float s = wave_sum(F.lane < 16 ? F.SS[(size_t)m * 16 + F.lane] : 0.f);
        const float r = 1.0f / sqrtf(s * (1.0f / D) + NORM_EPS);
        GAS f32x4* xr = (GAS f32x4*)(F.out + (size_t)m * D) + F.lane;
        const GAS f32x4* gr = (const GAS f32x4*)F.final_norm + F.lane;
#pragma unroll
        for (int j = 0; j < 4; ++j) { const f32x4 v = xr[64 * j], g = gr[64 * j]; xr[64 * j] = v * r * g; }
    }
}

struct Args { const float* in[12]; float* out; unsigned char* ws; int ph_lo, ph_hi; };
__global__ void __launch_bounds__(NWAVES * 64, 2) trunk_fwd(Args args) {
    extern __shared__ __attribute__((aligned(16))) unsigned char lds[];
    Frame F;
    F.lds = (LAS unsigned char*)lds;
    F.MISC = (volatile LAS unsigned*)(F.lds + MISC_OFF);
    F.tid = threadIdx.x; F.lane = F.tid & 63; F.wave = __builtin_amdgcn_readfirstlane(F.tid >> 6);
    F.G = gridDim.x; { const int bx = blockIdx.x; F.vcu = (F.G % 8 == 0) ? (bx % 8) * (F.G / 8) + bx / 8 : bx; }
    unsigned char* ws = args.ws;
    F.ctl = (gu32*)(ws + WS_CTL);
    F.x = args.in[0]; F.norm_mix = args.in[1]; F.norm_ffn = args.in[2]; F.hgrn_w_in = args.in[3]; F.lb_logits = args.in[4]; F.hgrn_out_norm = args.in[5]; F.hgrn_w_out = args.in[6];
    F.attn_w_qkv = args.in[7]; F.attn_w_out = args.in[8]; F.ffn_w_in = args.in[9]; F.ffn_w_down = args.in[10]; F.final_norm = args.in[11]; F.out = args.out;
    F.Whin = (bf16*)(ws + WS_WHIN); F.Whout = (bf16*)(ws + WS_WHOUT); F.Wqkv = (bf16*)(ws + WS_WQKV); F.Wao = (bf16*)(ws + WS_WAO); F.Wf1 = (bf16*)(ws + WS_WF1); F.Wf2 = (bf16*)(ws + WS_WF2);
    F.SS = (float*)(ws + WS_SS); F.E1 = (float*)(ws + WS_E1); F.E2 = (float*)(ws + WS_E2); F.COS = (float*)(ws + WS_COS); F.SIN = (float*)(ws + WS_SIN); F.LSE = (float*)(ws + WS_LSE); F.LB = (float*)(ws + WS_LB); F.ST = (float*)(ws + WS_ST);
    F.XB = (bf16*)(ws + WS_XB); F.QT = (bf16*)(ws + WS_QT); F.KT = (bf16*)(ws + WS_KT); F.VV = (bf16*)(ws + WS_VV); F.GG = (bf16*)(ws + WS_GG); F.FF = (bf16*)(ws + WS_FF);
    F.QP = (bf16*)(ws + WS_QP); F.KP = (bf16*)(ws + WS_KP); F.VP = (bf16*)(ws + WS_VP);
    for (int u = F.tid; u < (LDS_BYTES - LDSCTL_OFF) / 4; u += NWAVES * 64) ((LAS unsigned*)(F.lds + LDSCTL_OFF))[u] = 0u;
    __syncthreads();
    XcdBarrier bar; bar.bar = (unsigned*)(F.ctl + CW_BAR); bar.x = 0; bar.st = nullptr;
    if (!MK_PER_PHASE) bar = xcd_barrier_post((unsigned*)(F.ctl + CW_BAR), F.MISC + 8);
    const int lo = args.ph_lo, hi = args.ph_hi;
#define IN(k) (lo <= (k) && (k) < hi)
#define SEAM(k) do { if (IN(k) && IN((k) + 1)) xcd_barrier(bar); } while (0)
    using pg8::Gemm; using pg8::StaticOrder;
#define RUN_GEMM(EPI, Aptr, Bptr, N_, K_, E) do { Gemm g{(const pg8::bf16_t*)(Aptr), (const pg8::bf16_t*)(Bptr), M, (N_), (K_)}; StaticOrder S; S.init(M, (N_), F.G, (int)blockIdx.x); \
        pg8::gemm_phase<EPI, StaticOrder, true, true>(F.lds + RING_OFF, g, S, E); } while (0)

    if (IN(0)) { p0_prologue(F); } SEAM(0);
    if (IN(1)) { pg8::EpiHgrnIn E{F.QT, F.KT, F.VV, F.GG, F.E1, F.E2, F.SS, F.LB}; RUN_GEMM(pg8::EpiHgrnIn, F.XB, F.Whin, HIN, D, E); } SEAM(1);
    if (IN(2)) { hgrn_simple_rec(F, F.out); } SEAM(2);
    if (IN(3)) { hgrn_simple_post(F, F.out); } SEAM(3);
    if (IN(4)) { pg8::EpiRes E{F.x, F.out, F.XB, F.SS}; RUN_GEMM(pg8::EpiRes, F.QT, F.Whout, D, D, E); } SEAM(4);
    if (IN(5)) { pg8::EpiSwiglu E{F.FF, F.SS}; RUN_GEMM(pg8::EpiSwiglu, F.XB, F.Wf1, FF2, D, E); } SEAM(5);
    if (IN(6)) { pg8::EpiRes E{F.out, F.out, F.XB, F.SS}; RUN_GEMM(pg8::EpiRes, F.FF, F.Wf2, D, DFF, E); } SEAM(6);
    if (IN(7)) { pg8::EpiQkv E{F.QP, F.KP, F.VP, F.SS, F.COS, F.SIN}; RUN_GEMM(pg8::EpiQkv, F.XB, F.Wqkv, QKVW, D, E); } SEAM(7);
    if (IN(8)) { attn_fast(F, (char*)lds); } SEAM(8);
    if (IN(9)) { attn_scale(F); } SEAM(9);
    if (IN(10)) { pg8::EpiRes E{F.out, F.out, F.XB, F.SS}; RUN_GEMM(pg8::EpiRes, F.QP, F.Wao, D, AW, E); } SEAM(10);
    if (IN(11)) { pg8::EpiSwiglu E{F.FF, F.SS}; RUN_GEMM(pg8::EpiSwiglu, F.XB, F.Wf1 + (size_t)FF2 * D, FF2, D, E); } SEAM(11);
    if (IN(12)) { pg8::EpiRes E{F.out, F.out, nullptr, F.SS}; RUN_GEMM(pg8::EpiRes, F.FF, F.Wf2 + (size_t)D * DFF, D, DFF, E); } SEAM(12);
    if (IN(13)) { final_norm_rows(F); }
#undef IN
#undef SEAM
#undef RUN_GEMM
}

extern "C" void kernel_launch(void* const* d_in, const int* in_sizes, int n_in, void* d_out, int out_size, void* d_ws, size_t ws_size, hipStream_t stream) {
    static int grid = 0;
    if (grid == 0) {
        if (n_in != 12 || in_sizes[0] != M * D || out_size != M * D || ws_size < WS_END) { fprintf(stderr, "kernel_launch: unexpected shapes (n_in %d, in0 %d, out %d, ws %zu); nothing launched\n", n_in, n_in > 0 ? in_sizes[0] : -1, out_size, ws_size); grid = -1; return; }
        int dev = 0, cus = 0, per_cu = 0;
        if (hipGetDevice(&dev) != hipSuccess || hipDeviceGetAttribute(&cus, hipDeviceAttributeMultiprocessorCount, dev) != hipSuccess) { grid = -1; return; }
        if (hipFuncSetAttribute((const void*)trunk_fwd, hipFuncAttributeMaxDynamicSharedMemorySize, LDS_BYTES) != hipSuccess) { fprintf(stderr, "kernel_launch: hipFuncSetAttribute failed\n"); grid = -1; return; }
        if (hipOccupancyMaxActiveBlocksPerMultiprocessor(&per_cu, (const void*)trunk_fwd, NWAVES * 64, LDS_BYTES) != hipSuccess || per_cu < 1)
            fprintf(stderr, "kernel_launch: note: the occupancy query reports %d workgroups per CU\n", per_cu);
        (void)hipGetLastError();
        grid = cus;
    }
    if (grid < 0) return;
    if (hipMemsetAsync((char*)d_ws + WS_CTL, 0, CTL_ZERO_BYTES, stream) != hipSuccess) { fprintf(stderr, "kernel_launch: hipMemsetAsync failed\n"); return; }
    Args a{};
    for (int i = 0; i < 12; ++i) a.in[i] = (const float*)d_in[i];
    a.out = (float*)d_out; a.ws = (unsigned char*)d_ws;
#if MK_PER_PHASE
    for (int p = 0; p < NPH; ++p) { a.ph_lo = p; a.ph_hi = p + 1; hipLaunchKernelGGL(trunk_fwd, dim3(grid), dim3(NWAVES * 64), LDS_BYTES, stream, a); }
#else
    a.ph_lo = 0; a.ph_hi = NPH; hipLaunchKernelGGL(trunk_fwd, dim3(grid), dim3(NWAVES * 64), LDS_BYTES, stream, a);
#endif
    const hipError_t le = hipPeekAtLastError();
    if (le != hipSuccess) fprintf(stderr, "kernel_launch: launch failed: %s (grid %d)\n", hipGetErrorName(le), grid);
}
```

```cpp
#include <hip/hip_runtime.h>
#include <cstdio>
#include <cstdint>
#include <math.h>

constexpr int BATCH = 2, T = 8192, D = 1024, M = BATCH * T;
constexpr int HIN = 4096, DFF = 2816, FF2 = 2 * DFF, QKVW = 4608, AW = 1536;
constexpr float NORM_EPS = 1e-6f;

namespace pg8 {
#define PG8_LAS __attribute__((address_space(3)))
typedef unsigned short bf16_t;
typedef short bf16x8 __attribute__((ext_vector_type(8)));
typedef float f32x4 __attribute__((ext_vector_type(4)));
typedef unsigned u32x4 __attribute__((ext_vector_type(4)));
constexpr int BM = 256, BK = 64, HALF = 128, HTB = HALF * BK * 2  , STAGE_BYTES = 8 * HTB, NXCD = 8, WGM = 8;

__host__ __device__ __forceinline__ int lds_byte(int r, int c) { const int st = (r >> 4) * 2 + (c >> 5), rr = r & 15, cc = c & 31, ob = rr * 64 + cc * 2; return st * 1024 + (ob ^ (((ob >> 9) & 1) << 5)); }
__host__ __device__ __forceinline__ void stage_rc(int b, int& R, int& C) { const int st = b / 1024, sb = b % 1024, swz = sb ^ (((sb >> 9) & 1) << 5); R = (st >> 1) * 16 + swz / 64; C = (st & 1) * 32 + (swz % 64) / 2; }
__host__ __device__ __forceinline__ int perm32(int rho) { const int n = rho >> 4, i = rho & 15; return 8 * (i >> 2) + 4 * n + (i & 3); }

struct Unit { int pm, pn; };
struct Gemm { const bf16_t* A; const bf16_t* Bt; int M, N, K; };

struct StaticOrder {
    int nM, nN, nwg, G, c;
    __host__ __device__ void init(int M, int N, int G_, int c_) { nM = M / BM; nN = N / BM; nwg = nM * nN; G = G_; c = c_; }
    __host__ __device__ bool next(int i, Unit& u) const {
        const long L = (long)i * G + c; if (L >= nwg) return false;
        int wgid = (int)L; { const int q = nwg / NXCD, r = nwg % NXCD, xcd = wgid % NXCD, off = wgid / NXCD; wgid = (xcd < r ? xcd * (q + 1) : r * (q + 1) + (xcd - r) * q) + off; }
        const int nig = WGM * nN, gid = wgid / nig, fm = gid * WGM, gsz = (nM - fm) < WGM ? (nM - fm) : WGM;
        u.pm = fm + ((wgid % nig) % gsz); u.pn = (wgid % nig) / gsz; return true;
    }
    __device__ __forceinline__ void a_ready(const Unit&) const {}
    __device__ __forceinline__ void done(const Unit&) const {}
};


typedef float f32x2 __attribute__((ext_vector_type(2)));
typedef __bf16 bf16x2_t __attribute__((ext_vector_type(2)));
__device__ __forceinline__ unsigned cvt_pk_bf16(float lo, float hi) { const f32x2 v = {lo, hi}; return __builtin_bit_cast(unsigned, __builtin_convertvector(v, bf16x2_t)); }
typedef unsigned u32x2 __attribute__((ext_vector_type(2)));
__device__ __forceinline__ u32x4 pack8(const f32x4 a, const f32x4 b) { u32x4 w; w.x = cvt_pk_bf16(a[0], a[1]); w.y = cvt_pk_bf16(a[2], a[3]); w.z = cvt_pk_bf16(b[0], b[1]); w.w = cvt_pk_bf16(b[2], b[3]); return w; }
__device__ __forceinline__ u32x2 pack4(const f32x4 a) { u32x2 w; w.x = cvt_pk_bf16(a[0], a[1]); w.y = cvt_pk_bf16(a[2], a[3]); return w; }
__device__ __forceinline__ float silu_f(float x) { return x * __builtin_amdgcn_rcpf(1.0f + __expf(-x)); }
__device__ __forceinline__ f32x4 silu4(const f32x4 x) { f32x4 r; r[0] = silu_f(x[0]); r[1] = silu_f(x[1]); r[2] = silu_f(x[2]); r[3] = silu_f(x[3]); return r; }
__device__ __forceinline__ float row_rstd(const float* ss, int row, int fq) {
    const f32x4 p = *(const f32x4*)(ss + (size_t)row * 16 + 4 * fq);
    float s = (p[0] + p[1]) + (p[2] + p[3]);
    s += __shfl_xor(s, 16); s += __shfl_xor(s, 32);
    return 1.0f / sqrtf(s * (1.0f / 1024.0f) + NORM_EPS);
}
template <int CTRL> __device__ __forceinline__ float dpp_f(float x) { return __builtin_bit_cast(float, __builtin_amdgcn_update_dpp(0, __builtin_bit_cast(int, x), CTRL, 0xf, 0xf, true)); }

struct EpiRes {
    static constexpr bool PERM = false, AFTER_DRAIN = false;
    const float* base; float* out; bf16_t* xb; float* ss;
    __device__ __forceinline__ void operator()(const f32x4 (&acc)[2][2][4][2], const Unit& u, int wr, int wc, int fr, int fq) const {
        const int colb = u.pn * BM + wc * 32 + 8 * fq;
#pragma unroll
        for (int ai = 0; ai < 2; ++ai)
#pragma unroll
            for (int m = 0; m < 4; ++m) {
                const int row = u.pm * BM + ai * HALF + wr * 64 + m * 16 + fr;
                float sq = 0.f;
#pragma unroll
                for (int bj = 0; bj < 2; ++bj) {
                    const size_t off = (size_t)row * 1024 + colb + bj * HALF;
                    const f32x4 b0 = *(const f32x4*)(base + off), b1 = *(const f32x4*)(base + off + 4);
                    const f32x4 v0 = acc[ai][bj][m][0] + b0, v1 = acc[ai][bj][m][1] + b1;
                    *(f32x4*)(out + off) = v0; *(f32x4*)(out + off + 4) = v1;
                    if (xb) *(u32x4*)(xb + off) = pack8(v0, v1);
                    sq += (v0[0] * v0[0] + v0[1] * v0[1]) + (v0[2] * v0[2] + v0[3] * v0[3]) + (v1[0] * v1[0] + v1[1] * v1[1]) + (v1[2] * v1[2] + v1[3] * v1[3]);
                }
                sq += __shfl_xor(sq, 16); sq += __shfl_xor(sq, 32);
                if (fq == 0) ss[(size_t)row * 16 + u.pn * 4 + wc] = sq;
            }
    }
};
struct EpiSwiglu {
    static constexpr bool PERM = false, AFTER_DRAIN = false;
    bf16_t* act; const float* ss;
    __device__ __forceinline__ void operator()(const f32x4 (&acc)[2][2][4][2], const Unit& u, int wr, int wc, int fr, int fq) const {
        const int colb = u.pn * 128 + wc * 32 + 8 * fq;
#pragma unroll
        for (int ai = 0; ai < 2; ++ai)
#pragma unroll
            for (int m = 0; m < 4; ++m) {
                const int row = u.pm * BM + ai * HALF + wr * 64 + m * 16 + fr;
                const float r = row_rstd(ss, row, fq);
                const f32x4 a0 = silu4(acc[ai][0][m][0] * r) * (acc[ai][1][m][0] * r), a1 = silu4(acc[ai][0][m][1] * r) * (acc[ai][1][m][1] * r);
                *(u32x4*)(act + (size_t)row * DFF + colb) = pack8(a0, a1);
            }
    }
};
struct EpiQkv {
    static constexpr bool PERM = false, AFTER_DRAIN = false;
    bf16_t* Q; bf16_t* K; bf16_t* V; const float* ss; const float* cosT; const float* sinT;
    __device__ __forceinline__ void operator()(const f32x4 (&acc)[2][2][4][2], const Unit& u, int wr, int wc, int fr, int fq) const {
        if (u.pn < 12) {
            bf16_t* P = u.pn < 6 ? Q : K;
            const int j0 = (wc & 1) * 32 + 8 * fq, tcol = (u.pn % 6) * 256 + (wc >> 1) * 128 + j0;
#pragma unroll
            for (int ai = 0; ai < 2; ++ai)
#pragma unroll
                for (int m = 0; m < 4; ++m) {
                    const int row = u.pm * BM + ai * HALF + wr * 64 + m * 16 + fr;
                    const float r = row_rstd(ss, row, fq);
                    const size_t tb = (size_t)(row & (T - 1)) * 64 + j0;
                    const f32x4 c0 = *(const f32x4*)(cosT + tb), c1 = *(const f32x4*)(cosT + tb + 4), s0 = *(const f32x4*)(sinT + tb), s1 = *(const f32x4*)(sinT + tb + 4);
                    const f32x4 x1a = acc[ai][0][m][0] * r, x1b = acc[ai][0][m][1] * r, x2a = acc[ai][1][m][0] * r, x2b = acc[ai][1][m][1] * r;
                    bf16_t* p = P + (size_t)row * AW + tcol;
                    *(u32x4*)p = pack8(x1a * c0 - x2a * s0, x1b * c1 - x2b * s1);
                    *(u32x4*)(p + 64) = pack8(x2a * c0 + x1a * s0, x2b * c1 + x1b * s1);
                }
        } else {
            const int tcol = (u.pn - 12) * 256 + wc * 32 + 8 * fq;
#pragma unroll
            for (int ai = 0; ai < 2; ++ai)
#pragma unroll
                for (int m = 0; m < 4; ++m) {
                    const int row = u.pm * BM + ai * HALF + wr * 64 + m * 16 + fr;
                    const float r = row_rstd(ss, row, fq);
#pragma unroll
                    for (int bj = 0; bj < 2; ++bj) *(u32x4*)(V + (size_t)row * AW + tcol + bj * HALF) = pack8(acc[ai][bj][m][0] * r, acc[ai][bj][m][1] * r);
                }
        }
    }
};
struct EpiHgrnIn {
    static constexpr bool PERM = false, AFTER_DRAIN = false;
    bf16_t *QT, *KT, *VV, *GG; float *E1, *E2; const float* ss; const float* lb;
    __device__ __forceinline__ void operator()(const f32x4 (&acc)[2][2][4][2], const Unit& u, int wr, int wc, int fr, int fq) const {
        const int ch0 = u.pn * 64 + wc * 16 + 4 * fq;
        const f32x4 lbv = *(const f32x4*)(lb + ch0);
#pragma unroll
        for (int ai = 0; ai < 2; ++ai) {
            const int rowb = u.pm * BM + ai * HALF + wr * 64;
            float rs[4];
#pragma unroll
            for (int m = 0; m < 4; ++m) rs[m] = row_rstd(ss, rowb + m * 16 + fr, fq);
            f32x4 kv[4], bc[4], run = {0.f, 0.f, 0.f, 0.f};
#pragma unroll
            for (int m = 0; m < 4; ++m) {
                const f32x4 fz = acc[ai][0][m][1] * rs[m];
#pragma unroll
                for (int e = 0; e < 4; ++e) {
                    const float tt = __expf(-fmaxf(fz[e], -80.f)), inv = __builtin_amdgcn_rcpf(1.0f + tt);
                    const float oml = 1.0f - lbv[e];
                    const float fg = lbv[e] + oml * inv;
                    kv[m][e] = oml * (tt * inv);
                    float x = __logf(fg);
                    x += dpp_f<0x111>(x); x += dpp_f<0x112>(x); x += dpp_f<0x114>(x); x += dpp_f<0x118>(x);
                    const float tot = __shfl(x, 15, 16);
                    bc[m][e] = x + run[e]; run[e] += tot;
                }
            }
            f32x4 ref;
#pragma unroll
            for (int e = 0; e < 4; ++e) ref[e] = __shfl(bc[1][e], 15, 16);
            if (fr == 0) {
                const int chunk = rowb >> 6; f32x4 e1, e2;
#pragma unroll
                for (int e = 0; e < 4; ++e) { e1[e] = __expf(ref[e]); e2[e] = __expf(run[e] - ref[e]); }
                *(f32x4*)(E1 + (size_t)chunk * 1024 + ch0) = e1; *(f32x4*)(E2 + (size_t)chunk * 1024 + ch0) = e2;
            }
#pragma unroll
            for (int m = 0; m < 4; ++m) {
                const size_t off = (size_t)(rowb + m * 16 + fr) * 1024 + ch0;
                f32x4 qv = silu4(acc[ai][0][m][0] * rs[m]), kk = kv[m];
#pragma unroll
                for (int e = 0; e < 4; ++e) { const float dl = bc[m][e] - ref[e]; qv[e] *= __expf(dl); kk[e] *= __expf(-dl); }
                *(u32x2*)(QT + off) = pack4(qv); *(u32x2*)(KT + off) = pack4(kk);
                *(u32x2*)(VV + off) = pack4(acc[ai][1][m][0] * rs[m]); *(u32x2*)(GG + off) = pack4(silu4(acc[ai][1][m][1] * rs[m]));
            }
        }
    }
};

template <class Epi, class Sched, bool ALIGN_EPI = false, bool SP2 = false>
__device__ __forceinline__ void gemm_phase(PG8_LAS unsigned char* lds, const Gemm g, const Sched& S, const Epi& E) {
    int tid = threadIdx.x; asm volatile("" : "+v"(tid));
    const int wid = __builtin_amdgcn_readfirstlane(tid >> 6), lane = tid & 63, wr = wid >> 2, wc = wid & 3, fr = lane & 15, fq = lane >> 4;
    const int K = g.K, nt = K / BK;
    unsigned voffA[2], voffB[2];
#pragma unroll
    for (int i = 0; i < 2; ++i) { int R, C; stage_rc(tid * 16 + i * 8192, R, C); const int Rb = Epi::PERM ? ((R & ~31) + perm32(R & 31)) : R;
        voffA[i] = (unsigned)(R * K + C) * 2u; voffB[i] = (unsigned)(Rb * K + C) * 2u; }
    const size_t kstep = (size_t)(BK * 2);
    const size_t hstep = (size_t)HALF * K * 2;
    const size_t tstep = 2 * hstep;
    const unsigned ldsw = (unsigned)wid * 1024u;
    const int aoff = lds_byte(wr * 64 + fr, fq * 8), boff = lds_byte(wc * 32 + fr, fq * 8);
#define PG8_SA(b, h) (((b) * 2 + (h)) * HTB)
#define PG8_SB(b, h) ((4 + (b) * 2 + (h)) * HTB)
#define PG8_STAGE(bufoff, gbase, voff) do { _Pragma("unroll") for (int _i = 0; _i < 2; ++_i) \
        __builtin_amdgcn_global_load_lds((const unsigned*)((const char*)(gbase) + (voff)[_i]), (PG8_LAS unsigned*)(lds + (bufoff) + ldsw + _i * 8192), 16, 0, 0); } while (0)
#define PG8_LDA(dst, b, h) do { _Pragma("unroll") for (int m = 0; m < 4; ++m) _Pragma("unroll") for (int k = 0; k < 2; ++k) dst[m][k] = *(const PG8_LAS bf16x8*)(lds + PG8_SA(b, h) + aoff + m * 2048 + k * 1024); } while (0)
#define PG8_LDB(dst, b, h) do { _Pragma("unroll") for (int n = 0; n < 2; ++n) _Pragma("unroll") for (int k = 0; k < 2; ++k) dst[n][k] = *(const PG8_LAS bf16x8*)(lds + PG8_SB(b, h) + boff + n * 2048 + k * 1024); } while (0)
#define PG8_MMA(ai, bj, At, Bt) do { __builtin_amdgcn_s_setprio(1); _Pragma("unroll") for (int m = 0; m < 4; ++m) _Pragma("unroll") for (int n = 0; n < 2; ++n) _Pragma("unroll") for (int k = 0; k < 2; ++k) \
        acc[ai][bj][m][n] = __builtin_amdgcn_mfma_f32_16x16x32_bf16(Bt[n][k], At[m][k], acc[ai][bj][m][n], 0, 0, 0); __builtin_amdgcn_s_setprio(0); } while (0)
#define PG8_WAIT_V(n) asm volatile("s_waitcnt vmcnt(" #n ")" ::: "memory")
#define PG8_WAIT_L(n) asm volatile("s_waitcnt lgkmcnt(" #n ")" ::: "memory")
#define PG8_BAR __builtin_amdgcn_s_barrier()
#define PG8_SCHED __builtin_amdgcn_sched_barrier(0)
    Unit cur, nxt; int ui = 0;
    if (!S.next(0, cur)) return;
    f32x4 acc[2][2][4][2];
#pragma unroll
    for (int a = 0; a < 2; ++a)
#pragma unroll
        for (int b = 0; b < 2; ++b)
#pragma unroll
            for (int m = 0; m < 4; ++m)
#pragma unroll
                for (int n = 0; n < 2; ++n) acc[a][b][m][n] = (f32x4){0.f, 0.f, 0.f, 0.f};
    bf16x8 At[4][2], B0[2][2], B1[2][2];
    const char* cA = (const char*)g.A + (size_t)cur.pm * tstep; const char* cB = (const char*)g.Bt + (size_t)cur.pn * tstep;
    S.a_ready(cur);
    if constexpr (SP2) {
        PG8_STAGE(PG8_SB(0, 0), cB, voffB); PG8_STAGE(PG8_SB(0, 1), cB + hstep, voffB); PG8_STAGE(PG8_SA(0, 0), cA, voffA); PG8_STAGE(PG8_SA(0, 1), cA + hstep, voffA);
        if (wr == 1) PG8_BAR;
        PG8_WAIT_V(2); PG8_BAR;
        PG8_STAGE(PG8_SB(1, 0), cB + kstep, voffB); PG8_STAGE(PG8_SA(1, 0), cA + kstep, voffA); PG8_STAGE(PG8_SB(1, 1), cB + hstep + kstep, voffB);
        PG8_WAIT_V(6); PG8_BAR;
    } else {
        PG8_STAGE(PG8_SB(0, 0), cB, voffB); PG8_STAGE(PG8_SA(0, 0), cA, voffA); PG8_STAGE(PG8_SB(0, 1), cB + hstep, voffB); PG8_STAGE(PG8_SA(0, 1), cA + hstep, voffA);
        if (wr == 1) PG8_BAR;
        PG8_WAIT_V(4); PG8_BAR;
        PG8_STAGE(PG8_SB(1, 0), cB + kstep, voffB); PG8_STAGE(PG8_SA(1, 0), cA + kstep, voffA); PG8_STAGE(PG8_SB(1, 1), cB + hstep + kstep, voffB);
        PG8_WAIT_V(6); PG8_BAR;
    }
    for (;;) {
        const bool has_next = S.next(ui + 1, nxt);
        const char* nA = has_next ? (const char*)g.A + (size_t)nxt.pm * tstep : cA; const char* nB = has_next ? (const char*)g.Bt + (size_t)nxt.pn * tstep : cB;
        for (int t = 0; t < nt; t += 2) {
            const bool last = (t == nt - 2);
            const char* a1 = cA + (size_t)(t + 1) * kstep;
            const char* a2 = last ? nA : cA + (size_t)(t + 2) * kstep; const char* b2 = last ? nB : cB + (size_t)(t + 2) * kstep;
            const char* a3 = a2 + kstep; const char* b3 = b2 + kstep;
            if (last && has_next) S.a_ready(nxt);
            if constexpr (SP2) {
            PG8_LDB(B0, 0, 0); PG8_LDB(B1, 0, 1); PG8_SCHED; PG8_LDA(At, 0, 0); PG8_STAGE(PG8_SA(1, 1), a1 + hstep, voffA);
            PG8_WAIT_V(8); PG8_WAIT_L(0); PG8_BAR; PG8_MMA(0, 0, At, B0); PG8_MMA(0, 1, At, B1); PG8_BAR; PG8_SCHED;
            PG8_LDA(At, 0, 1); PG8_STAGE(PG8_SB(0, 0), b2, voffB); PG8_STAGE(PG8_SB(0, 1), b2 + hstep, voffB); PG8_STAGE(PG8_SA(0, 0), a2, voffA);
            PG8_WAIT_V(8); PG8_WAIT_L(0); PG8_BAR; PG8_MMA(1, 0, At, B0); PG8_MMA(1, 1, At, B1); PG8_BAR; PG8_SCHED;
            PG8_LDB(B0, 1, 0); PG8_LDB(B1, 1, 1); PG8_SCHED; PG8_LDA(At, 1, 0); PG8_STAGE(PG8_SA(0, 1), a2 + hstep, voffA);
            PG8_WAIT_V(8); PG8_WAIT_L(0); PG8_BAR; PG8_MMA(0, 0, At, B0); PG8_MMA(0, 1, At, B1); PG8_BAR; PG8_SCHED;
            PG8_LDA(At, 1, 1); PG8_STAGE(PG8_SB(1, 0), b3, voffB); PG8_STAGE(PG8_SB(1, 1), b3 + hstep, voffB); PG8_STAGE(PG8_SA(1, 0), a3, voffA);
            PG8_WAIT_V(8); PG8_WAIT_L(0); PG8_BAR; PG8_MMA(1, 0, At, B0); PG8_MMA(1, 1, At, B1); PG8_BAR; PG8_SCHED;
            } else {
            PG8_LDB(B0, 0, 0); PG8_SCHED; PG8_LDA(At, 0, 0); PG8_STAGE(PG8_SA(1, 1), a1 + hstep, voffA);
            PG8_WAIT_L(8); PG8_BAR; PG8_WAIT_L(0); PG8_MMA(0, 0, At, B0); PG8_BAR; PG8_SCHED;
            PG8_LDB(B1, 0, 1); PG8_STAGE(PG8_SB(0, 0), b2, voffB);
            PG8_BAR; PG8_WAIT_L(0); PG8_MMA(0, 1, At, B1); PG8_BAR;
            PG8_LDA(At, 0, 1); PG8_STAGE(PG8_SA(0, 0), a2, voffA);
            PG8_BAR; PG8_WAIT_L(0); PG8_MMA(1, 0, At, B0); PG8_BAR; PG8_SCHED;
            PG8_STAGE(PG8_SB(0, 1), b2 + hstep, voffB);
            PG8_WAIT_V(6); PG8_BAR; PG8_MMA(1, 1, At, B1); PG8_BAR;
            PG8_LDB(B0, 1, 0); PG8_SCHED; PG8_LDA(At, 1, 0); PG8_STAGE(PG8_SA(0, 1), a2 + hstep, voffA);
            PG8_WAIT_L(8); PG8_BAR; PG8_WAIT_L(0); PG8_MMA(0, 0, At, B0); PG8_BAR; PG8_SCHED;
            PG8_LDB(B1, 1, 1); PG8_STAGE(PG8_SB(1, 0), b3, voffB);
            PG8_BAR; PG8_WAIT_L(0); PG8_MMA(0, 1, At, B1); PG8_BAR;
            PG8_LDA(At, 1, 1); PG8_STAGE(PG8_SA(1, 0), a3, voffA);
            PG8_BAR; PG8_WAIT_L(0); PG8_MMA(1, 0, At, B0); PG8_BAR; PG8_SCHED;
            PG8_STAGE(PG8_SB(1, 1), b3 + hstep, voffB);
            PG8_WAIT_V(6); PG8_BAR; PG8_MMA(1, 1, At, B1); PG8_BAR;
            }
        }
        if constexpr (ALIGN_EPI) { if (wr == 0) PG8_BAR; }
        if constexpr (!Epi::AFTER_DRAIN) { E(acc, cur, wr, wc, fr, fq); S.done(cur); }
        if (!has_next) break;
#pragma unroll
        for (int a = 0; a < 2; ++a)
#pragma unroll
            for (int b = 0; b < 2; ++b)
#pragma unroll
                for (int m = 0; m < 4; ++m)
#pragma unroll
                    for (int n = 0; n < 2; ++n) acc[a][b][m][n] = (f32x4){0.f, 0.f, 0.f, 0.f};
        cur = nxt; cA = nA; cB = nB; ++ui;
        if constexpr (ALIGN_EPI) { if (wr == 1) PG8_BAR; }
    }
    PG8_WAIT_V(0);
    if constexpr (!ALIGN_EPI) { if (wr == 0) PG8_BAR; }
    PG8_BAR;
    if constexpr (Epi::AFTER_DRAIN) { E.fused(acc, cur, wr, wc, fr, fq, lds, wid, lane); S.done(cur); }
#undef PG8_SA
#undef PG8_SB
#undef PG8_STAGE
#undef PG8_LDA
#undef PG8_LDB
#undef PG8_MMA
#undef PG8_WAIT_V
#undef PG8_WAIT_L
#undef PG8_BAR
#undef PG8_SCHED
}
}


constexpr int NWAVES = 8;
#ifndef MK_PER_PHASE
#define MK_PER_PHASE 0
#endif
constexpr int NPH = 15;

constexpr size_t MiB = 1u << 20;
constexpr size_t WS_CTL = 0, CTL_ZERO_BYTES = 64 * 1024;
constexpr size_t WS_WHIN = 1 * MiB, WS_WHOUT = 9 * MiB, WS_WQKV = 11 * MiB, WS_WAO = 20 * MiB, WS_WF1 = 23 * MiB, WS_WF2 = 45 * MiB;
constexpr size_t WS_SS = 56 * MiB, WS_E1 = 57 * MiB, WS_E2 = 58 * MiB, WS_COS = 59 * MiB, WS_SIN = 61 * MiB, WS_LSE = 63 * MiB, WS_LB = 63 * MiB + 768 * 1024;
constexpr size_t WS_ST = 64 * MiB;
constexpr size_t WS_XB = 80 * MiB;
constexpr size_t WS_ACT = 112 * MiB;
constexpr size_t WS_QT = WS_ACT, WS_KT = WS_ACT + 32 * MiB, WS_VV = WS_ACT + 64 * MiB, WS_GG = WS_ACT + 96 * MiB;
constexpr size_t WS_FF = WS_ACT;
constexpr size_t WS_QP = WS_ACT, WS_KP = WS_ACT + 48 * MiB, WS_VP = WS_ACT + 96 * MiB;
constexpr size_t WS_END = 256 * MiB;
static_assert(WS_VP + (size_t)M * AW * 2 <= WS_END && WS_FF + (size_t)M * DFF * 2 <= WS_END && WS_GG + (size_t)M * D * 2 <= WS_END, "d_ws map");
static_assert(WS_WF2 + 2 * (size_t)D * DFF * 2 <= WS_SS && WS_WF1 + 2 * (size_t)FF2 * D * 2 <= WS_WF2 && WS_WAO + (size_t)D * AW * 2 <= WS_WF1 && WS_WQKV + (size_t)QKVW * D * 2 <= WS_WAO, "weights map");
constexpr int CW_TMO = 0, CW_BAR = 4096;

constexpr int RING_OFF = 0, RING_BYTES = 131072;
constexpr int LDSCTL_OFF = RING_BYTES, MISC_OFF = LDSCTL_OFF + 320;
constexpr int LDS_BYTES = 147456;
namespace swa {
constexpr float SCALE = 0.08838834764831845f;
constexpr int D = 128; constexpr bool WSKIP = true; constexpr float THR = 8.f;
constexpr int PLANE_PITCH = AW, SEQ_T = T; constexpr size_t K_FROM_Q = (WS_KP - WS_QP) / 2, V_FROM_K = (WS_VP - WS_KP) / 2;
constexpr int NW = 8, QBLK = 32, KVBLK = 64, QB = NW * QBLK;
constexpr int SHM_V = KVBLK * D * 2, SHM_K = KVBLK * D * 2, ATT_LDS_BYTES = 2 * SHM_V + 2 * SHM_K + NW * 64 * 4;
typedef unsigned short bf16;
typedef short bf16x8 __attribute__((ext_vector_type(8)));
typedef short s16x4 __attribute__((ext_vector_type(4)));
typedef float f32x16 __attribute__((ext_vector_type(16)));
typedef float f32x4 __attribute__((ext_vector_type(4)));
typedef unsigned u32x4 __attribute__((ext_vector_type(4)));
template <class A, class Bt> struct same_t { static constexpr bool v = false; };
template <class A> struct same_t<A, A> { static constexpr bool v = true; };

#define KSWZ(row, colB) ((row) * 256 + ((colB) ^ (((row) & 7) << 4)))
#define SBAR() __builtin_amdgcn_sched_barrier(0)
__device__ __forceinline__ int v_st(int k, int c) { const int kk = (k & ~0xC) | ((k & 4) << 1) | ((k & 8) >> 1); return ((kk >> 3) * 4 + (c >> 5)) * 512 + ((kk & 7) * 32 + (c & 31)) * 2; }
__device__ __forceinline__ int v_rd_base(int lane) { return ((lane & 3) << 3) | (((lane >> 2) & 3) << 6) | (((lane >> 4) & 1) << 5) | (((lane >> 5) & 1) << 8); }
constexpr int v_rd_off(int d0, int ks, int half) { return d0 * 512 + ks * 4096 + half * 2048; }
__device__ __forceinline__ int crow(int r, int hi) { return (r & 3) + 8 * (r >> 2) + 4 * hi; }
__device__ __forceinline__ unsigned cvtpk(float lo, float hi) {
    unsigned r; asm volatile("v_cvt_pk_bf16_f32 %0, %1, %2" : "=v"(r) : "v"(lo), "v"(hi)); return r;
}
__device__ __forceinline__ bf16x8 pack8(f32x4 a, f32x4 b) {
    u32x4 w = {cvtpk(a[0], a[1]), cvtpk(a[2], a[3]), cvtpk(b[0], b[1]), cvtpk(b[2], b[3])};
    return *reinterpret_cast<bf16x8*>(&w);
}
template <class T> __device__ __forceinline__ bf16x8 load8(const T* p) {
    if constexpr (same_t<T, float>::v) { return pack8(*(const f32x4*)p, *(const f32x4*)(p + 4)); }
    else { return *reinterpret_cast<const bf16x8*>(p); }
}
__device__ __forceinline__ void mask_tile(f32x16& p0, f32x16& p1, int dq, unsigned W) {
    const float NEG = -__builtin_inff();
#pragma unroll
    for (int r = 0; r < 16; ++r) {
        const int c = (r & 3) + 8 * (r >> 2);
        if ((unsigned)(dq - c) >= W) p0[r] = NEG;
        if ((unsigned)(dq - c - 32) >= W) p1[r] = NEG;
    }
}
__device__ __forceinline__ void partialSM(f32x16& p0, f32x16& p1, float& m_reg, float& mn, float& alpha) {
    float pmax = p0[0]; for (int r = 1; r < 16; ++r) pmax = fmaxf(pmax, p0[r]); for (int r = 0; r < 16; ++r) pmax = fmaxf(pmax, p1[r]);
    { auto rr = __builtin_amdgcn_permlane32_swap(__float_as_uint(pmax), __float_as_uint(pmax), false, false);
      pmax = fmaxf(__uint_as_float(rr[0]), __uint_as_float(rr[1])); }
    constexpr float C2 = 1.4426950408889634f * SCALE;
    if (__builtin_expect(__all((pmax - m_reg) * SCALE <= THR), 1)) { mn = m_reg; alpha = 1.f; }
    else { mn = fmaxf(m_reg, pmax); alpha = __builtin_amdgcn_exp2f((m_reg - mn) * C2); m_reg = mn; }
    const float mnL = -mn * C2;
    for (int r = 0; r < 16; ++r) p0[r] = fmaf(p0[r], C2, mnL); for (int r = 0; r < 16; ++r) p1[r] = fmaf(p1[r], C2, mnL);
    for (int r = 0; r < 16; ++r) p0[r] = __builtin_amdgcn_exp2f(p0[r]);
}
__device__ __forceinline__ void finishSM(f32x16& p0, f32x16& p1, float alpha, float& l_reg, bf16x8& pa0, bf16x8& pa1, bf16x8& pa2, bf16x8& pa3) {
    for (int r = 0; r < 16; ++r) p1[r] = __builtin_amdgcn_exp2f(p1[r]);
    float ps = 0; for (int r = 0; r < 16; ++r) ps += p0[r]; for (int r = 0; r < 16; ++r) ps += p1[r];
    { auto rr = __builtin_amdgcn_permlane32_swap(__float_as_uint(ps), __float_as_uint(ps), false, false);
      ps = __uint_as_float(rr[0]) + __uint_as_float(rr[1]); }
    l_reg = l_reg * alpha + ps;
#define PK4(P, B_, OUT) do { unsigned a0 = cvtpk(P[B_+0], P[B_+1]), a1 = cvtpk(P[B_+2], P[B_+3]);                          \
        unsigned b0 = cvtpk(P[B_+4], P[B_+5]), b1 = cvtpk(P[B_+6], P[B_+7]);                                             \
        auto r0 = __builtin_amdgcn_permlane32_swap(a0, b0, false, false); auto r1 = __builtin_amdgcn_permlane32_swap(a1, b1, false, false); \
        u32x4 w = {r0[0], r1[0], r0[1], r1[1]}; OUT = *reinterpret_cast<bf16x8*>(&w); } while (0)
    PK4(p0, 0, pa0); PK4(p0, 8, pa1); PK4(p1, 0, pa2); PK4(p1, 8, pa3);
#undef PK4
}
template <int KB, bool SK>
__device__ __forceinline__ void qkt(f32x16& p0, f32x16& p1, const char* K_lds, int r32, int hi, const bf16x8* qr, bool act) {
    if (SK && !act) { const float NEG = -__builtin_inff();
#pragma unroll
        for (int r = 0; r < 16; ++r) { p0[r] = NEG; p1[r] = NEG; } return; }
    p0 = f32x16{}; p1 = f32x16{};
    const char* kb[4];
#pragma unroll
    for (int dd = 0; dd < 4; ++dd) kb[dd] = K_lds + KB * SHM_K + KSWZ(r32, (dd * 16 + hi * 8) * 2);
#pragma unroll
    for (int d0 = 0; d0 < 8; ++d0) { const char* a = kb[d0 & 3] + (d0 >> 2) * 128;
        bf16x8 b0 = *reinterpret_cast<const bf16x8*>(a);
        bf16x8 b1 = *reinterpret_cast<const bf16x8*>(a + 32 * 256);
        p0 = __builtin_amdgcn_mfma_f32_32x32x16_bf16(b0, qr[d0], p0, 0, 0, 0);
        p1 = __builtin_amdgcn_mfma_f32_32x32x16_bf16(b1, qr[d0], p1, 0, 0, 0); }
}
template <int VB, bool SK>
__device__ __forceinline__ void pv_tile(f32x16* o, int vb0, bf16x8 pa0, bf16x8 pa1, bf16x8 pa2, bf16x8 pa3, bool act) {
    if (SK && !act) return;
#define TRRD(dst, off) asm volatile("ds_read_b64_tr_b16 %0, %1 offset:%2" : "=&v"(dst) : "v"(vb0), "i"(off) : "memory")
#define PV_D0(d0) do { s16x4 l0, l1, l2, l3, h0, h1, h2, h3; constexpr int b_ = VB * SHM_V + v_rd_off(d0, 0, 0);     \
        TRRD(l0, b_); TRRD(h0, b_ + 2048); TRRD(l1, b_ + 4096); TRRD(h1, b_ + 6144); TRRD(l2, b_ + 8192); TRRD(h2, b_ + 10240); TRRD(l3, b_ + 12288); TRRD(h3, b_ + 14336); \
        asm volatile("s_waitcnt lgkmcnt(0)" ::: "memory"); SBAR();                 \
        o[d0] = __builtin_amdgcn_mfma_f32_32x32x16_bf16(pa0, (bf16x8){l0[0], l0[1], l0[2], l0[3], h0[0], h0[1], h0[2], h0[3]}, o[d0], 0, 0, 0);   \
        o[d0] = __builtin_amdgcn_mfma_f32_32x32x16_bf16(pa1, (bf16x8){l1[0], l1[1], l1[2], l1[3], h1[0], h1[1], h1[2], h1[3]}, o[d0], 0, 0, 0);   \
        o[d0] = __builtin_amdgcn_mfma_f32_32x32x16_bf16(pa2, (bf16x8){l2[0], l2[1], l2[2], l2[3], h2[0], h2[1], h2[2], h2[3]}, o[d0], 0, 0, 0);   \
        o[d0] = __builtin_amdgcn_mfma_f32_32x32x16_bf16(pa3, (bf16x8){l3[0], l3[1], l3[2], l3[3], h3[0], h3[1], h3[2], h3[3]}, o[d0], 0, 0, 0); } while (0)
    PV_D0(0); PV_D0(1); PV_D0(2); PV_D0(3);
#undef PV_D0
#undef TRRD
}

template <class TIn, class TOut> struct BlockRef { const TIn* Q; int P0, sh, lrow;
    __device__ __forceinline__ int pitch() const { return PLANE_PITCH << sh; }
    __device__ __forceinline__ const TIn* K() const { return Q + K_FROM_Q - (size_t)P0 * (size_t)pitch(); }
    __device__ __forceinline__ const TIn* V() const { return K() + V_FROM_K; }
    __device__ __forceinline__ int skv() const { return SEQ_T >> sh; }
    __device__ __forceinline__ int lp() const { return 12 << sh; } };
template <class TIn> struct Seam {
    bf16x8 qr[8];
    bf16x8 st_v0, st_v1, st_k0, st_k1; f32x4 sf0, sf1, sf2, sf3;
    f32x4 tq[16];
};
__device__ __forceinline__ int swa_jlo(int P0, int W) { const int lowk = P0 - W + 1; return lowk > 0 ? lowk / KVBLK : 0; }
#define ROW(p, k0, rr, kp_) ((p) + (size_t)((k0) + (rr)) * (kp_) + sc)
#define VMW() asm volatile("s_waitcnt vmcnt(0)" ::: "memory")
#define VMWN(n) asm volatile("s_waitcnt vmcnt(%0)" :: "i"(n) : "memory")
#define SLOAD_H(Kp, Vp, k0, kp_) do { S.st_v0 = load8<TIn>(ROW(Vp, k0, sr, kp_)); S.st_v1 = load8<TIn>(ROW(Vp, k0, 32 + sr, kp_));              \
                         S.st_k0 = load8<TIn>(ROW(Kp, k0, sr, kp_)); S.st_k1 = load8<TIn>(ROW(Kp, k0, 32 + sr, kp_)); } while (0)
#define SWRITE_HK(bf) do { *(bf16x8*)(K_lds + (bf) * SHM_K + kws) = S.st_k0; *(bf16x8*)(K_lds + (bf) * SHM_K + kws + 32 * 256) = S.st_k1; } while (0)
#define SWRITE_HV(bf) do { *(bf16x8*)(V_lds + (bf) * SHM_V + vst0) = S.st_v0; *(bf16x8*)(V_lds + (bf) * SHM_V + vst1) = S.st_v1; } while (0)
#define SWRITE_H(bf) do { SWRITE_HV(bf); SWRITE_HK(bf); } while (0)
#define SLOAD_F(p, k0) do { S.sf0 = *(const f32x4*)ROW(p, k0, sr, D); S.sf1 = *(const f32x4*)(ROW(p, k0, sr, D) + 4);                \
                            S.sf2 = *(const f32x4*)ROW(p, k0, 32 + sr, D); S.sf3 = *(const f32x4*)(ROW(p, k0, 32 + sr, D) + 4); } while (0)
#define SWRITE_KF(bf) do { *(bf16x8*)(K_lds + (bf) * SHM_K + kws) = pack8(S.sf0, S.sf1); *(bf16x8*)(K_lds + (bf) * SHM_K + kws + 32 * 256) = pack8(S.sf2, S.sf3); } while (0)
#define SWRITE_VF(bf) do { *(bf16x8*)(V_lds + (bf) * SHM_V + vst0) = pack8(S.sf0, S.sf1); *(bf16x8*)(V_lds + (bf) * SHM_V + vst1) = pack8(S.sf2, S.sf3); } while (0)
template <class TIn, class TOut>
__device__ __forceinline__ void causal_swa_prime(const BlockRef<TIn, TOut>& cur, int W, char* lds, Seam<TIn>& S) {
    constexpr bool F32 = same_t<TIn, float>::v;
    const int tid = threadIdx.x, wid = __builtin_amdgcn_readfirstlane(tid >> 6), lane = tid & 63, r32 = lane & 31, hi = lane >> 5;
    const int sr = tid >> 4, sc = (tid & 15) * 8, kws = KSWZ(sr, sc * 2); char* K_lds = lds + 2 * SHM_V;
    const int kb0 = swa_jlo(cur.P0, W) * KVBLK;
    for (int d0 = 0; d0 < 8; ++d0) S.qr[d0] = load8<TIn>(cur.Q + (size_t)(wid * QBLK + r32) * cur.pitch() + d0 * 16 + hi * 8);
    if constexpr (F32) { SLOAD_F((const float*)cur.K(), kb0); VMW(); SWRITE_KF(0); SBAR(); SLOAD_F((const float*)cur.V(), kb0); }
    else { SLOAD_H(cur.K(), cur.V(), kb0, cur.pitch()); VMW(); SWRITE_HK(0); }
    __syncthreads();
}
template <class TIn, class TOut>
__device__ __forceinline__ void causal_swa_block(const BlockRef<TIn, TOut>& cur, const BlockRef<TIn, TOut>& nxt, float* lse, int W, char* lds, Seam<TIn>& S) {
    const int skv = cur.skv();
    constexpr bool F32 = same_t<TIn, float>::v;
    const int tid = threadIdx.x, wid = __builtin_amdgcn_readfirstlane(tid >> 6), lane = tid & 63, r32 = lane & 31, hi = lane >> 5;
    const int j_lo = swa_jlo(cur.P0, W);
    int j_hi = (cur.P0 + QB - 1) / KVBLK + 1; if (j_hi > skv / KVBLK) j_hi = skv / KVBLK;
    const int NT = j_hi - j_lo;
    const int kbn = swa_jlo(nxt.P0, W) * KVBLK;
    const int qlo = cur.P0 + wid * QBLK, qm = qlo + r32 - 4 * hi;
    char* V_lds = lds; char* K_lds = lds + 2 * SHM_V;
    float* ws = (float*)(lds + 2 * SHM_V + 2 * SHM_K) + wid * 64; float* li_l = ws, * al_l = ws + 32;
    float m_reg = -1e30f, l_reg = 0; f32x16 o[4] = {};
    const int sr = tid >> 4, sc = (tid & 15) * 8, vst0 = v_st(sr, sc), vst1 = v_st(32 + sr, sc), kws = KSWZ(sr, sc * 2);
    const int vb0 = (int)(uintptr_t)V_lds + v_rd_base(lane);
    const TIn* Kh = cur.K(); const TIn* Vh = Kh + V_FROM_K; const int kpc = cur.pitch();
#define RESC(a) do { if (__any((a) < 1.f)) { if (hi == 0) al_l[r32] = (a); asm volatile("s_waitcnt lgkmcnt(0)" ::: "memory");              \
                     for (int d_ = 0; d_ < 4; ++d_) for (int r = 0; r < 16; ++r) o[d_][r] *= al_l[crow(r, hi)]; } } while (0)
#define KBASE(t) ((j_lo + (t)) * KVBLK)
#define ACT(t) (KBASE(t) <= qlo + QBLK - 1 && KBASE(t) + KVBLK - 1 >= qlo - W + 1)
#define MASKT(P0_, P1_, t) do { const int kb_ = KBASE(t); if ((!SK || ACT(t)) && (kb_ + KVBLK - 1 > qlo || kb_ <= qlo + QBLK - 1 - W)) mask_tile(P0_, P1_, qm - kb_, (unsigned)W); } while (0)
    constexpr int NQL = F32 ? 16 : 8;
    constexpr bool SK = WSKIP && !F32;
#define SEAM_K0() do { VMWN(NQL); if constexpr (F32) { SWRITE_KF(0); SBAR(); SLOAD_F((const float*)nxt.V(), kbn); } else { SWRITE_HK(0); } SBAR(); } while (0)
    f32x16 pA0, pA1, pB0, pB1; float mnA, mnB, alA, alB; bf16x8 pa0, pa1, pa2, pa3;
    if constexpr (F32) { VMW(); SWRITE_VF(0); SBAR(); } else { SWRITE_HV(0); SBAR(); }
    if (NT > 1) { if constexpr (F32) SLOAD_F((const float*)Kh, KBASE(1)); else SLOAD_H(Kh, Vh, KBASE(1), kpc); }
    SBAR(); qkt<0, SK>(pA0, pA1, K_lds, r32, hi, S.qr, ACT(0));
    if constexpr (F32) { if (NT > 1) { VMW(); SWRITE_KF(1); SBAR(); SLOAD_F((const float*)Vh, KBASE(1)); } }
    MASKT(pA0, pA1, 0); partialSM(pA0, pA1, m_reg, mnA, alA);
    if (NT > 1) { VMW(); if constexpr (F32) { SWRITE_VF(1); SBAR(); if (NT > 2) SLOAD_F((const float*)Kh, KBASE(2)); } else SWRITE_H(1); }
    __syncthreads();
#define HALF_STEP(PX0, PX1, mnX, alX, PY0, PY1, alY, t, KB, VB, SB) do {                                                      \
        SBAR(); qkt<KB, SK>(PX0, PX1, K_lds, r32, hi, S.qr, ACT(t));                                             \
        finishSM(PY0, PY1, alY, l_reg, pa0, pa1, pa2, pa3); SBAR();                                                           \
        if ((t) + 1 < NT) { if constexpr (F32) { VMW(); SWRITE_KF(SB); SBAR(); SLOAD_F((const float*)Vh, KBASE((t) + 1)); }  \
                            else { SLOAD_H(Kh, Vh, KBASE((t) + 1), kpc); } SBAR(); }                                               \
        pv_tile<VB, SK>(o, vb0, pa0, pa1, pa2, pa3, ACT((t) - 1)); MASKT(PX0, PX1, (t)); partialSM(PX0, PX1, m_reg, mnX, alX);                                        \
        __syncthreads();                                                                                                      \
        if ((t) + 1 < NT) { VMW(); if constexpr (F32) { SWRITE_VF(SB); SBAR(); if ((t) + 2 < NT) SLOAD_F((const float*)Kh, KBASE((t) + 2)); } \
                            else { SWRITE_H(SB); } }                                                                          \
        RESC(alX); __syncthreads(); } while (0)
    for (int t = 1; t + 1 < NT; t += 2) {
        HALF_STEP(pB0, pB1, mnB, alB, pA0, pA1, alA, t, 1, 0, 0);
        HALF_STEP(pA0, pA1, mnA, alA, pB0, pB1, alB, t + 1, 0, 1, 1);
    }
    const bool even = (NT & 1) == 0;
    if (even) { SBAR(); qkt<1, SK>(pB0, pB1, K_lds, r32, hi, S.qr, ACT(NT - 1)); SBAR(); }
#define QROW(e) (nxt.Q + (size_t)(wid * QBLK + r32) * nxt.pitch() + ((e) >> 1) * 16 + hi * 8 + ((e) & 1) * 4)
    if constexpr (F32) { SLOAD_F((const float*)nxt.K(), kbn); SBAR();
#pragma unroll
        for (int e = 0; e < 8; ++e) S.tq[e] = *(const f32x4*)QROW(e); }
    else { SLOAD_H(nxt.K(), nxt.V(), kbn, nxt.pitch()); SBAR();
#pragma unroll
        for (int d0 = 0; d0 < 8; ++d0) S.qr[d0] = load8<TIn>(nxt.Q + (size_t)(wid * QBLK + r32) * nxt.pitch() + d0 * 16 + hi * 8); }
    SBAR();
    finishSM(pA0, pA1, alA, l_reg, pa0, pa1, pa2, pa3); SBAR();
    if constexpr (F32) {
#pragma unroll
        for (int e = 8; e < 16; ++e) S.tq[e] = *(const f32x4*)QROW(e); SBAR(); }
#undef QROW
    pv_tile<0, SK>(o, vb0, pa0, pa1, pa2, pa3, ACT(even ? NT - 2 : NT - 1));
    if (even) { MASKT(pB0, pB1, NT - 1); partialSM(pB0, pB1, m_reg, mnB, alB); __syncthreads(); RESC(alB);
        finishSM(pB0, pB1, alB, l_reg, pa0, pa1, pa2, pa3); SBAR(); pv_tile<1, SK>(o, vb0, pa0, pa1, pa2, pa3, ACT(NT - 1)); }
    SBAR(); SEAM_K0();
    if (hi == 0) li_l[r32] = l_reg; asm volatile("s_waitcnt lgkmcnt(0)" ::: "memory");
    float rli[16];
#pragma unroll
    for (int r = 0; r < 16; ++r) rli[r] = __builtin_amdgcn_rcpf(li_l[crow(r, hi)]);
    TOut* Ow = (TOut*)cur.Q + (size_t)(wid * QBLK) * kpc;
    if (hi == 0) lse[(size_t)cur.lrow + (size_t)(wid * QBLK + r32) * cur.lp()] = m_reg * SCALE + __logf(l_reg);
#pragma unroll
    for (int r = 0; r < 16; ++r) { const int orow = crow(r, hi);
#pragma unroll
        for (int d0 = 0; d0 < 4; ++d0) { const float v = o[d0][r] * rli[r];
            if constexpr (same_t<TOut, float>::v) { Ow[(size_t)orow * kpc + d0 * 32 + r32] = v; }
            else { const float vn = __shfl_xor(v, 1);
                   if ((r32 & 1) == 0) *(unsigned*)(Ow + (size_t)orow * kpc + d0 * 32 + r32) = cvtpk(v, vn); } } }
    if constexpr (F32) {
#pragma unroll
        for (int d0 = 0; d0 < 8; ++d0) S.qr[d0] = pack8(S.tq[2 * d0], S.tq[2 * d0 + 1]); }
    __syncthreads();
#undef RESC
#undef KBASE
#undef ACT
#undef MASKT
#undef SEAM_K0
#undef HALF_STEP
}
#undef ROW
#undef VMW
#undef VMWN
#undef SLOAD_H
#undef SWRITE_HK
#undef SWRITE_HV
#undef SWRITE_H
#undef SLOAD_F
#undef SWRITE_KF
#undef SWRITE_VF


}

#define GAS __attribute__((address_space(1)))
#define LAS __attribute__((address_space(3)))
typedef unsigned short bf16;
typedef unsigned v4u __attribute__((ext_vector_type(4)));
typedef unsigned u32x2 __attribute__((ext_vector_type(2)));
typedef float f32x4 __attribute__((ext_vector_type(4)));
typedef short bf16x8 __attribute__((ext_vector_type(8)));
typedef GAS unsigned gu32;
typedef GAS unsigned long long gu64;
#define RLX_AGENT __ATOMIC_RELAXED, __HIP_MEMORY_SCOPE_AGENT
#define LDS_WAIT() asm volatile("s_waitcnt lgkmcnt(0)" ::: "memory")
#define VM_WAIT() asm volatile("s_waitcnt vmcnt(0)" ::: "memory")
__device__ __forceinline__ unsigned long long rt() { return __builtin_amdgcn_s_memrealtime(); }
__device__ __forceinline__ unsigned f2bf(float f) { unsigned u = __builtin_bit_cast(unsigned, f); return (u + 0x7fffu + ((u >> 16) & 1u)) >> 16; }
__device__ __forceinline__ unsigned pk2(float lo, float hi) { return f2bf(lo) | (f2bf(hi) << 16); }

#define XB_TMO      128
#define XB_XCNT(j)  (256  + 64 * (j))
#define XB_XSUB(j)  (1280 + 64 * (j))
#define XB_XGEN(j)  (2304 + 64 * (j))
#define XB_TOP      3328
#define XB_TOPGEN   3392
#define XCD_BAR_WORDS 3456
#define XB_SPIN_CAP (1u << 18)

__device__ __forceinline__ unsigned xb_ld(unsigned* p)              { return __hip_atomic_load(p, __ATOMIC_RELAXED, __HIP_MEMORY_SCOPE_AGENT); }
__device__ __forceinline__ unsigned xb_add(unsigned* p, unsigned v) { return __hip_atomic_fetch_add(p, v, __ATOMIC_RELAXED, __HIP_MEMORY_SCOPE_AGENT); }
__device__ __forceinline__ unsigned xb_xcc_id() { return (unsigned)__builtin_amdgcn_s_getreg((3 << 11) | 20) & 0xFu; }
#define XB_SPIN(cond, bar) do { unsigned _sp = 0; while (cond) { __builtin_amdgcn_s_sleep(1); \
    if ((++_sp & 255u) == 0u) { if (xb_ld(&(bar)[XB_TMO])) break; if (_sp > XB_SPIN_CAP) { atomicAdd(&(bar)[XB_TMO], 1u); break; } } } } while (0)

struct XcdBarrier {
    unsigned* bar; unsigned x;
    volatile LAS unsigned* st;
};

__device__ __forceinline__ XcdBarrier xcd_barrier_post(unsigned* bar, volatile LAS unsigned* st) {
    XcdBarrier b; b.bar = bar; b.x = xb_xcc_id(); b.st = st;
    if (threadIdx.x == 0) (void)xb_add(&bar[XB_XCNT(b.x)], 1u);
    return b;
}
__device__ __forceinline__ void xcd_barrier_complete(unsigned* bar, unsigned x, unsigned& nloc, unsigned& nx) {
    const unsigned G = gridDim.x * gridDim.y * gridDim.z;
    unsigned sum, cnt, mine, sp = 0u;
    for (;;) {
        sum = 0u; cnt = 0u; mine = 0u;
#pragma unroll
        for (unsigned j = 0; j < 16; ++j) { const unsigned c = xb_ld(&bar[XB_XCNT(j)]); sum += c; cnt += (c > 0u) ? 1u : 0u; mine = (j == x) ? c : mine; }
        if (sum == G) break;
        __builtin_amdgcn_s_sleep(1);
        if ((++sp & 255u) == 0u) { if (xb_ld(&bar[XB_TMO])) break; if (sp > XB_SPIN_CAP) { atomicAdd(&bar[XB_TMO], 1u); break; } }
    }
    nloc = mine > 0u ? mine : 1u; nx = cnt > 0u ? cnt : 1u;
}

__device__ __forceinline__ void xcd_barrier(const XcdBarrier& b) {
    asm volatile("s_waitcnt vmcnt(0)" ::: "memory");
    __syncthreads();
    if (threadIdx.x == 0) {
        unsigned* bar = b.bar;
        __builtin_amdgcn_s_waitcnt(0);
        unsigned nloc = b.st[0], nx = b.st[1];
        if (nloc == 0u) { xcd_barrier_complete(bar, b.x, nloc, nx); b.st[0] = nloc; b.st[1] = nx; }
        const unsigned old = xb_add(&bar[XB_XSUB(b.x)], 1u);
        const unsigned gen = old / nloc;
        if (old + 1u == (gen + 1u) * nloc) {
            __builtin_amdgcn_fence(__ATOMIC_RELEASE, "agent");
            asm volatile("s_waitcnt vmcnt(0)" ::: "memory");
            const unsigned og = xb_add(&bar[XB_TOP], 1u);
            const unsigned tg = og / nx;
            if (og + 1u == (tg + 1u) * nx) xb_add(&bar[XB_TOPGEN], 1u);
            else XB_SPIN(xb_ld(&bar[XB_TOPGEN]) == tg, bar);
            __builtin_amdgcn_fence(__ATOMIC_ACQUIRE, "agent");
            xb_add(&bar[XB_XGEN(b.x)], 1u);
            asm volatile("s_waitcnt vmcnt(0)" ::: "memory");
        } else {
            XB_SPIN(xb_ld(&bar[XB_XGEN(b.x)]) == gen, bar);
            __builtin_amdgcn_fence(__ATOMIC_ACQUIRE, "agent");
            asm volatile("s_waitcnt vmcnt(0)" ::: "memory");
        }
    }
    __syncthreads();
}

struct Frame {
    LAS unsigned char* lds;
    volatile LAS unsigned* MISC;
    gu32* ctl;
    int tid, lane, wave;
    int vcu, G;
    const float *x, *norm_mix, *norm_ffn, *hgrn_w_in, *lb_logits, *hgrn_out_norm, *hgrn_w_out, *attn_w_qkv, *attn_w_out, *ffn_w_in, *ffn_w_down, *final_norm;
    float* out;
    bf16 *Whin, *Whout, *Wqkv, *Wao, *Wf1, *Wf2;
    float *SS, *E1, *E2, *COS, *SIN, *LSE, *LB, *ST, *DJ;
    bf16 *XB, *QT, *KT, *VV, *GG, *FF, *QP, *KP, *VP;
};
__device__ __forceinline__ float wave_sum(float v) {
#pragma unroll
    for (int o = 1; o < 64; o <<= 1) v += __shfl_xor(v, o);
    return v;
}
__device__ __forceinline__ float bf_lo(unsigned u) { return __uint_as_float(u << 16); }
__device__ __forceinline__ float bf_hi(unsigned u) { return __uint_as_float(u & 0xffff0000u); }

__device__ __forceinline__ int pinv32(int l) { return 16 * ((l >> 2) & 1) + 4 * (l >> 3) + (l & 3); }
template <int MODE> __device__ __forceinline__ int phys_row(int c) {
    if (MODE == 0) return (c & ~31) + pinv32(c & 31);
    if (MODE == 1) { const int up = c >= DFF ? 1 : 0, j = c - up * DFF; return 256 * (j >> 7) + 128 * up + (j & 96) + pinv32(j & 31); }
    if (MODE == 2) {
        if (c >= 2 * AW) { const int cc = c - 2 * AW; return 256 * (12 + (cc >> 8)) + (cc & 224) + pinv32(cc & 31); }
        const int plane = c >= AW ? 1 : 0, cc = c - plane * AW, head = cc >> 7, d = cc & 127, half = d >> 6, j = d & 63;
        return 256 * (plane * 6 + (head >> 1)) + 128 * half + 32 * (2 * (head & 1) + (j >> 5)) + pinv32(j & 31);
    }
    { const int type = c >> 10, ch = c & 1023, chl = ch & 63; return 256 * (ch >> 6) + 128 * (type >> 1) + 32 * (chl >> 4) + 16 * (type & 1) + (chl & 15); }
}
template <int MODE>
__device__ __forceinline__ void p0_transpose_item(const float* W, int K, int N, bf16* WT, const float* gain, LAS float* scr, int item, int lane) {
    const int nblk = N / 32, kb = item / nblk, nb = item % nblk, k0 = 64 * kb, n0 = 32 * nb;
#pragma unroll 8
    for (int i = 0; i < 32; ++i) { const int kk = 2 * i + (lane >> 5); float w = W[(size_t)(k0 + kk) * N + n0 + (lane & 31)]; if (gain) w *= gain[k0 + kk]; scr[kk * 33 + (lane & 31)] = w; }
    LDS_WAIT(); asm volatile("" ::: "memory");
    const int c = lane & 7;
#pragma unroll
    for (int j = 0; j < 4; ++j) { const int n = (lane >> 3) + 8 * j; const LAS float* s = scr + (8 * c) * 33 + n;
        v4u o; o.x = pk2(s[0 * 33], s[1 * 33]); o.y = pk2(s[2 * 33], s[3 * 33]); o.z = pk2(s[4 * 33], s[5 * 33]); o.w = pk2(s[6 * 33], s[7 * 33]);
        *(GAS v4u*)(WT + (size_t)phys_row<MODE>(n0 + n) * K + k0 + 8 * c) = o; }
    LDS_WAIT(); asm volatile("" ::: "memory");
}
__device__ __forceinline__ void p0_prologue(Frame& F) {
    LAS float* scr = (LAS float*)(F.lds + RING_OFF + F.wave * 16384);
    const int gw = F.vcu * NWAVES + F.wave, NGW = F.G * NWAVES;
    constexpr int I_HIN = (D / 64) * (HIN / 32), I_HOUT = (D / 64) * (D / 32), I_QKV = (D / 64) * (QKVW / 32), I_AO = (AW / 64) * (D / 32), I_F1 = (D / 64) * (FF2 / 32), I_F2 = (DFF / 64) * (D / 32);
    constexpr int NITEMS = I_HIN + I_HOUT + I_QKV + I_AO + 2 * I_F1 + 2 * I_F2;
    for (int it = gw; it < NITEMS; it += NGW) {
        int r = it;
        if (r < I_HIN) { p0_transpose_item<3>(F.hgrn_w_in, D, HIN, F.Whin, F.norm_mix, scr, r, F.lane); continue; } r -= I_HIN;
        if (r < I_HOUT) { p0_transpose_item<0>(F.hgrn_w_out, D, D, F.Whout, nullptr, scr, r, F.lane); continue; } r -= I_HOUT;
        if (r < I_QKV) { p0_transpose_item<2>(F.attn_w_qkv, D, QKVW, F.Wqkv, F.norm_mix + D, scr, r, F.lane); continue; } r -= I_QKV;
        if (r < I_AO) { p0_transpose_item<0>(F.attn_w_out, AW, D, F.Wao, nullptr, scr, r, F.lane); continue; } r -= I_AO;
        if (r < 2 * I_F1) { const int l = r / I_F1; p0_transpose_item<1>(F.ffn_w_in + (size_t)l * D * FF2, D, FF2, F.Wf1 + (size_t)l * FF2 * D, F.norm_ffn + l * D, scr, r - l * I_F1, F.lane); continue; } r -= 2 * I_F1;
        { const int l = r / I_F2; p0_transpose_item<0>(F.ffn_w_down + (size_t)l * DFF * D, DFF, D, F.Wf2 + (size_t)l * D * DFF, nullptr, scr, r - l * I_F2, F.lane); }
    }
    for (int m = gw; m < M; m += NGW) {
        const GAS f32x4* xr = (const GAS f32x4*)(F.x + (size_t)m * D) + F.lane;
        GAS unsigned long long* o8 = (GAS unsigned long long*)(F.XB + (size_t)m * D) + F.lane;
        float s = 0.f;
#pragma unroll
        for (int j = 0; j < 4; ++j) { const f32x4 v = xr[64 * j]; s += (v.x * v.x + v.y * v.y) + (v.z * v.z + v.w * v.w); o8[64 * j] = (unsigned long long)pk2(v.x, v.y) | ((unsigned long long)pk2(v.z, v.w) << 32); }
        s = wave_sum(s);
        if (F.lane < 16) F.SS[(size_t)m * 16 + F.lane] = F.lane == 0 ? s : 0.f;
    }
    const int gt = F.vcu * NWAVES * 64 + F.tid, NGT = F.G * NWAVES * 64;
    for (int i = gt; i < T * 64; i += NGT) { const int pos = i >> 6, j = i & 63;
        const float inv = 1.0f / powf(10000.0f, (float)(2 * j) / 128.0f); const float ang = (float)pos * inv;
        F.COS[i] = (float)cos((double)ang); F.SIN[i] = (float)sin((double)ang); }
    if (gt < D) { const float a = F.lb_logits[gt], b = F.lb_logits[D + gt], c = F.lb_logits[2 * D + gt]; const float mx = fmaxf(a, fmaxf(b, c));
        const float ea = expf(a - mx), eb = expf(b - mx), ec = expf(c - mx); F.LB[gt] = ea / (ea + eb + ec); }
}

namespace hg {
typedef short bf16x8 __attribute__((ext_vector_type(8)));
typedef short s16x4 __attribute__((ext_vector_type(4)));
constexpr int TILE = 16384, BUF = 3 * TILE;
constexpr int OFF_F = 2 * BUF, OFF_PART = OFF_F + 1024;
constexpr int HG_LDS_BYTES = OFF_PART + 4096;
constexpr int SUPER = 8, NSUPER = T / (64 * SUPER), NITEM = BATCH * 8 * NSUPER;
__device__ __forceinline__ int swz(int row) { return ((row & 7) << 5) | (((row >> 3) & 1) << 4); }
__device__ __forceinline__ bf16x8 mk8(u32x2 a, u32x2 b) { v4u w = {a.x, a.y, b.x, b.y}; return __builtin_bit_cast(bf16x8, w); }
__device__ __forceinline__ bf16x8 mk8s(s16x4 a, s16x4 b) { return (bf16x8){a[0], a[1], a[2], a[3], b[0], b[1], b[2], b[3]}; }
__device__ __forceinline__ u32x2 pk4(const f32x4 a) { u32x2 w; w.x = pg8::cvt_pk_bf16(a[0], a[1]); w.y = pg8::cvt_pk_bf16(a[2], a[3]); return w; }
#define HG_TRRD(dst, addr, off) asm volatile("ds_read_b64_tr_b16 %0, %1 offset:%2" : "=&v"(dst) : "v"(addr), "i"(off) : "memory")
#define HG_LGKM0() do { asm volatile("s_waitcnt lgkmcnt(0)" ::: "memory"); __builtin_amdgcn_sched_barrier(0); } while (0)
#define HG_MFMA(a, b, c) __builtin_amdgcn_mfma_f32_16x16x32_bf16((a), (b), (c), 0, 0, 0)

template <bool PC>
__device__ __forceinline__ void item(Frame& F, int it, float* DJ) {
    const int tid = F.tid, lane = F.lane, w = F.wave, li = lane & 15, g = lane >> 4;
    const int bh = it / NSUPER, j = it - bh * NSUPER, b = bh >> 3, h = bh & 7;
    const size_t row0 = (size_t)b * T + (size_t)j * (64 * SUPER);
    const int chunk0 = (int)(row0 >> 6), hc = h * 128;
    LAS unsigned char* L = F.lds + RING_OFF;
    const int srow = tid >> 4, sc16 = tid & 15;
    const unsigned st_off = (unsigned)(srow * 256 + ((sc16 * 16) ^ swz(srow)));
    const size_t g_off = (size_t)srow * 1024 + hc + sc16 * 8;
    const int sr = swz(li);
    const unsigned rbase = (unsigned)(li * 256 + ((8 * g) ^ (sr & 16))), sEr = (unsigned)(sr & 0xE0);
    const int trow = 4 * g + (li >> 2), stt = swz(trow);
    const unsigned tbase = (unsigned)(trow * 256 + ((8 * (li & 3)) ^ (stt & 16))), sEt = (unsigned)(stt & 0xE0);
    const unsigned ldsb = (unsigned)(size_t)L;

    f32x4 S[8]; bf16x8 Sb[4];
    float dprod = 1.f;
    if (PC && j > 0) {
        const float* st = F.ST + ((size_t)it << 14) + (size_t)(w * 32) * 64 + lane;
#pragma unroll
        for (int kt = 0; kt < 8; ++kt) {
            const f32x4 e1 = *(const f32x4*)(F.E1 + (size_t)chunk0 * 1024 + hc + 16 * kt + 4 * g);
#pragma unroll
            for (int r = 0; r < 4; ++r) S[kt][r] = st[(kt * 4 + r) * 64] * e1[r];
        }
    } else {
#pragma unroll
        for (int kt = 0; kt < 8; ++kt) S[kt] = (f32x4){0.f, 0.f, 0.f, 0.f};
        if (!PC && tid < 128) dprod = F.E1[(size_t)chunk0 * 1024 + hc + tid];
    }
#pragma unroll
    for (int kp = 0; kp < 4; ++kp) Sb[kp] = mk8(pk4(S[2 * kp]), pk4(S[2 * kp + 1]));
    float gn[4];
#pragma unroll
    for (int r = 0; r < 4; ++r) gn[r] = PC ? F.hgrn_out_norm[16 * w + 4 * g + r] : 0.f;

    v4u sq0, sq1, sk0, sk1, sv0, sv1; float fe = 1.f;
#define HG_LOAD(cc) do { const size_t ro_ = (row0 + (size_t)(cc) * 64) * 1024 + g_off; \
        if (PC) { sq0 = *(const GAS v4u*)(F.QT + ro_); sq1 = *(const GAS v4u*)(F.QT + ro_ + 32 * 1024); } \
        sk0 = *(const GAS v4u*)(F.KT + ro_); sk1 = *(const GAS v4u*)(F.KT + ro_ + 32 * 1024); sv0 = *(const GAS v4u*)(F.VV + ro_); sv1 = *(const GAS v4u*)(F.VV + ro_ + 32 * 1024); \
        if (tid < 128) { fe = F.E2[(size_t)(chunk0 + (cc)) * 1024 + hc + tid]; if ((cc) < SUPER - 1) fe *= F.E1[(size_t)(chunk0 + (cc) + 1) * 1024 + hc + tid]; dprod *= fe; } } while (0)
#define HG_WRITE(bi) do { LAS unsigned char* B_ = L + (bi) * BUF + st_off; \
        if (PC) { *(LAS v4u*)B_ = sq0; *(LAS v4u*)(B_ + 8192) = sq1; } \
        *(LAS v4u*)(B_ + TILE) = sk0; *(LAS v4u*)(B_ + TILE + 8192) = sk1; *(LAS v4u*)(B_ + 2 * TILE) = sv0; *(LAS v4u*)(B_ + 2 * TILE + 8192) = sv1; \
        if (tid < 128) ((LAS float*)(L + OFF_F + (bi) * 512))[tid] = fe; } while (0)

    HG_LOAD(0); HG_WRITE(0);
    __syncthreads();
    for (int c = 0; c < SUPER; ++c) {
        const int bi = c & 1;
        u32x2 gg[4];
        if (c + 1 < SUPER) HG_LOAD(c + 1);
        if (PC) {
#pragma unroll
            for (int ti = 0; ti < 4; ++ti) gg[ti] = *(const GAS u32x2*)(F.GG + (row0 + (size_t)c * 64 + 16 * ti + li) * 1024 + hc + 16 * w + 4 * g);
        }
        const unsigned qb_ = ldsb + bi * BUF, kb_ = qb_ + TILE, vb_ = qb_ + 2 * TILE;
        LAS unsigned char* Qp = L + bi * BUF; LAS unsigned char* Kp = Qp + TILE;
        bf16x8 vf[2];
        { s16x4 a0, a1, a2, a3; const unsigned va = vb_ + tbase + ((32u * w) ^ sEt);
          HG_TRRD(a0, va, 0); HG_TRRD(a1, va, 4096); HG_TRRD(a2, va, 8192); HG_TRRD(a3, va, 12288); HG_LGKM0();
          vf[0] = mk8s(a0, a1); vf[1] = mk8s(a2, a3); }
        f32x4 O[4];
        if (PC) {
#pragma unroll
            for (int ti = 0; ti < 4; ++ti) {
                bf16x8 qf[4];
#pragma unroll
                for (int kp = 0; kp < 4; ++kp) { const LAS unsigned char* a = Qp + 4096 * ti + rbase;
                    qf[kp] = mk8(*(const LAS u32x2*)(a + ((64u * kp) ^ sEr)), *(const LAS u32x2*)(a + ((64u * kp + 32u) ^ sEr))); }
                f32x4 o = {0.f, 0.f, 0.f, 0.f};
#pragma unroll
                for (int kp = 0; kp < 4; ++kp) o = HG_MFMA(Sb[kp], qf[kp], o);
                __builtin_amdgcn_sched_barrier(0);
                f32x4 p[4];
#pragma unroll
                for (int si = 0; si < 4; ++si) { p[si] = (f32x4){0.f, 0.f, 0.f, 0.f};
                    if (si <= ti) {
#pragma unroll
                        for (int kp = 0; kp < 4; ++kp) { const LAS unsigned char* a = Kp + 4096 * si + rbase;
                            const bf16x8 kf = mk8(*(const LAS u32x2*)(a + ((64u * kp) ^ sEr)), *(const LAS u32x2*)(a + ((64u * kp + 32u) ^ sEr)));
                            p[si] = HG_MFMA(kf, qf[kp], p[si]); }
                    } }
#pragma unroll
                for (int r = 0; r < 4; ++r) if (4 * g + r > li) p[ti][r] = 0.f;
                o = HG_MFMA(vf[0], mk8(pk4(p[0]), pk4(p[1])), o);
                if (ti >= 2) o = HG_MFMA(vf[1], mk8(pk4(p[2]), pk4(p[3])), o);
                O[ti] = o;
                __builtin_amdgcn_sched_barrier(0);
            }
        }
#pragma unroll
        for (int kt = 0; kt < 8; ++kt) {
            s16x4 a0, a1, a2, a3; const unsigned ka = kb_ + tbase + ((32u * kt) ^ sEt);
            HG_TRRD(a0, ka, 0); HG_TRRD(a1, ka, 4096); HG_TRRD(a2, ka, 8192); HG_TRRD(a3, ka, 12288); HG_LGKM0();
            S[kt] = HG_MFMA(mk8s(a0, a1), vf[0], S[kt]); S[kt] = HG_MFMA(mk8s(a2, a3), vf[1], S[kt]);
        }
#pragma unroll
        for (int kt = 0; kt < 8; ++kt) S[kt] = S[kt] * *(const LAS f32x4*)(L + OFF_F + bi * 512 + (16 * kt + 4 * g) * 4);
#pragma unroll
        for (int kp = 0; kp < 4; ++kp) Sb[kp] = mk8(pk4(S[2 * kp]), pk4(S[2 * kp + 1]));
        LAS float* part = (LAS float*)(L + OFF_PART + bi * 2048);
        if (PC) {
#pragma unroll
            for (int ti = 0; ti < 4; ++ti) { float q = (O[ti][0] * O[ti][0] + O[ti][1] * O[ti][1]) + (O[ti][2] * O[ti][2] + O[ti][3] * O[ti][3]);
                q += __shfl_xor(q, 16); q += __shfl_xor(q, 32);
                if (g == 0) part[(16 * ti + li) * 8 + w] = q; }
        }
        if (c + 1 < SUPER) HG_WRITE(bi ^ 1);
        __syncthreads();
        if (PC) {
#pragma unroll
            for (int ti = 0; ti < 4; ++ti) {
                const f32x4 p0 = *(const LAS f32x4*)(part + (16 * ti + li) * 8), p1 = *(const LAS f32x4*)(part + (16 * ti + li) * 8 + 4);
                const float tot = ((p0[0] + p0[1]) + (p0[2] + p0[3])) + ((p1[0] + p1[1]) + (p1[2] + p1[3]));
                const float r = 1.0f / sqrtf(tot * (1.0f / 128.0f) + NORM_EPS);
                f32x4 o = O[ti] * r;
                o[0] *= gn[0] * bf_lo(gg[ti].x); o[1] *= gn[1] * bf_hi(gg[ti].x); o[2] *= gn[2] * bf_lo(gg[ti].y); o[3] *= gn[3] * bf_hi(gg[ti].y);
                *(GAS u32x2*)(F.QT + (row0 + (size_t)c * 64 + 16 * ti + li) * 1024 + hc + 16 * w + 4 * g) = pk4(o);
            }
        }
    }
    if (!PC) {
        float* st = F.ST + ((size_t)(it + 1) << 14) + (size_t)(w * 32) * 64 + lane;
#pragma unroll
        for (int kt = 0; kt < 8; ++kt)
#pragma unroll
            for (int r = 0; r < 4; ++r) st[(kt * 4 + r) * 64] = S[kt][r];
        if (tid < 128) DJ[it * 128 + tid] = dprod;
    }
    __syncthreads();
#undef HG_LOAD
#undef HG_WRITE
}
__device__ __forceinline__ void phase_a(Frame& F, float* DJ) {
    for (int it = F.vcu; it < NITEM; it += F.G) { if ((it % NSUPER) == NSUPER - 1) continue; item<false>(F, it, DJ); }
}
__device__ __forceinline__ void phase_b(Frame& F, const float* DJ) {
    const int gt = F.vcu * NWAVES * 64 + F.tid, NGT = F.G * NWAVES * 64;
    for (int e = gt; e < BATCH * 8 * 16384; e += NGT) {
        const int bh = e >> 14, idx = e & 16383, kr = (idx >> 6) & 31, k = 16 * (kr >> 2) + 4 * ((idx & 63) >> 4) + (kr & 3);
        float s = 0.f;
        for (int j = 0; j + 1 < NSUPER; ++j) { const size_t a = ((size_t)(bh * NSUPER + j + 1) << 14) + idx; s = DJ[(bh * NSUPER + j) * 128 + k] * s + F.ST[a]; F.ST[a] = s; }
    }
}
__device__ __forceinline__ void phase_c(Frame& F) {
    for (int it = F.vcu; it < NITEM; it += F.G) item<true>(F, it, nullptr);
}
#undef HG_TRRD
#undef HG_LGKM0
#undef HG_MFMA
}

__device__ __forceinline__ void hgrn_simple_rec(Frame& F, float* oraw) {
    const int item = F.wave * F.G + F.vcu;
    if (item >= 256) return;
    const int b = item >> 7, h = (item >> 4) & 7, vg = item & 15, kc = h * 128 + 2 * F.lane, vc = h * 128 + vg * 8;
    float S0[8], S1[8];
#pragma unroll
    for (int j = 0; j < 8; ++j) { S0[j] = 0.f; S1[j] = 0.f; }
    for (int c = 0; c < 128; ++c) {
        const int chunk = b * 128 + c;
        const float e1x = F.E1[(size_t)chunk * 1024 + kc], e1y = F.E1[(size_t)chunk * 1024 + kc + 1], e2x = F.E2[(size_t)chunk * 1024 + kc], e2y = F.E2[(size_t)chunk * 1024 + kc + 1];
#pragma unroll
        for (int j = 0; j < 8; ++j) { S0[j] *= e1x; S1[j] *= e1y; }
#pragma unroll 2
        for (int t = 0; t < 64; ++t) {
            const size_t row = (size_t)chunk * 64 + t;
            const unsigned kq = *(const GAS unsigned*)(F.KT + row * 1024 + kc), qq = *(const GAS unsigned*)(F.QT + row * 1024 + kc);
            const v4u vv = *(const GAS v4u*)(F.VV + row * 1024 + vc);
            const float k0 = bf_lo(kq), k1 = bf_hi(kq), q0 = bf_lo(qq), q1 = bf_hi(qq);
            const float v[8] = {bf_lo(vv.x), bf_hi(vv.x), bf_lo(vv.y), bf_hi(vv.y), bf_lo(vv.z), bf_hi(vv.z), bf_lo(vv.w), bf_hi(vv.w)};
            float part[8];
#pragma unroll
            for (int j = 0; j < 8; ++j) { S0[j] = fmaf(k0, v[j], S0[j]); S1[j] = fmaf(k1, v[j], S1[j]); part[j] = q0 * S0[j] + q1 * S1[j]; }
#pragma unroll
            for (int j = 0; j < 8; ++j) part[j] = wave_sum(part[j]);
            if (F.lane == 0) { float* o = oraw + row * 1024 + vc; *(f32x4*)o = (f32x4){part[0], part[1], part[2], part[3]}; *(f32x4*)(o + 4) = (f32x4){part[4], part[5], part[6], part[7]}; }
        }
#pragma unroll
        for (int j = 0; j < 8; ++j) { S0[j] *= e2x; S1[j] *= e2y; }
    }
}
__device__ __forceinline__ void hgrn_simple_post(Frame& F, const float* oraw) {
    const int gw = F.vcu * NWAVES + F.wave, NGW = F.G * NWAVES;
    const float gn0 = F.hgrn_out_norm[2 * F.lane], gn1 = F.hgrn_out_norm[2 * F.lane + 1];
    for (int it = gw; it < M * 8; it += NGW) {
        const size_t off = (size_t)(it >> 3) * 1024 + (it & 7) * 128 + 2 * F.lane;
        const float v0 = oraw[off], v1 = oraw[off + 1];
        const float r = 1.0f / sqrtf(wave_sum(v0 * v0 + v1 * v1) * (1.0f / 128.0f) + NORM_EPS);
        const unsigned g = *(const GAS unsigned*)(F.GG + off);
        *(GAS unsigned*)(F.QT + off) = pk2(v0 * r * gn0 * bf_lo(g), v1 * r * gn1 * bf_hi(g));
    }
}
__device__ __forceinline__ void attn_simple(Frame& F) {
    const int gw = F.vcu * NWAVES + F.wave, NGW = F.G * NWAVES;
    for (int it = gw; it < M * 12; it += NGW) {
        const int row = it / 12, hd = it - row * 12, t = row & (T - 1), g = hd >> 2, dil = g == 0 ? 1 : (g == 1 ? 4 : 16);
        const size_t co = (size_t)hd * 128 + 2 * F.lane;
        const unsigned qq = *(const GAS unsigned*)(F.QP + (size_t)row * AW + co);
        const float q0 = bf_lo(qq), q1 = bf_hi(qq);
        float m = -INFINITY, l = 0.f, o0 = 0.f, o1 = 0.f;
        for (int j = 0; j <= 128; ++j) {
            if (t - j * dil < 0) break;
            const size_t rk = (size_t)(row - j * dil) * AW + co;
            const unsigned kk = *(const GAS unsigned*)(F.KP + rk), vv = *(const GAS unsigned*)(F.VP + rk);
            const float s = wave_sum(q0 * bf_lo(kk) + q1 * bf_hi(kk)) * 0.08838834764831845f;
            const float mn = fmaxf(m, s), a = __expf(m - mn), p = __expf(s - mn);
            l = l * a + p; o0 = o0 * a + p * bf_lo(vv); o1 = o1 * a + p * bf_hi(vv); m = mn;
        }
        *(GAS unsigned*)(F.QP + (size_t)row * AW + co) = pk2(o0 / l, o1 / l);
        if (F.lane == 0) F.LSE[(size_t)row * 12 + hd] = m + logf(l);
    }
}
typedef swa::BlockRef<bf16, bf16> AttRef;
__device__ __forceinline__ AttRef attn_ref(const Frame& F, int L) {
    const int bh = L >> 5, x = L & 31, b = bh / 12, head = bh - b * 12, sh = 2 * (head >> 2), nqs = 5 - sh;
    const int r = x >> nqs, qb = x & ((1 << nqs) - 1);
    const size_t rowq = (size_t)b * T + r + ((size_t)qb * 256 << sh);
    AttRef R; R.Q = F.QP + rowq * AW + head * 128; R.P0 = qb * 256; R.sh = sh; R.lrow = (int)rowq * 12 + head;
    return R;
}
__device__ __forceinline__ void attn_fast(Frame& F, char* lds) {
    constexpr int NITEM = BATCH * 12 * 32, W = 129;
    int L = F.vcu; if (L >= NITEM) return;
    AttRef cur = attn_ref(F, L);
    swa::Seam<bf16> S;
    swa::causal_swa_prime<bf16, bf16>(cur, W, lds, S);
    for (;;) {
        const bool more = L + F.G < NITEM;
        const AttRef nxt = more ? attn_ref(F, L + F.G) : cur;
        swa::causal_swa_block<bf16, bf16>(cur, nxt, F.LSE, W, lds, S);
        if (!more) break;
        cur = nxt; L += F.G;
    }
}
__device__ __forceinline__ void attn_scale(Frame& F) {
    const int gt = F.vcu * NWAVES * 64 + F.tid, NGT = F.G * NWAVES * 64;
    for (int i = gt; i < M * (AW / 8); i += NGT) {
        const int row = i / (AW / 8), c8 = i - row * (AW / 8), hd = c8 >> 4, hg = hd & 3;
        const float* ls = F.LSE + (size_t)row * 12;
        const float a = ls[hg], b = ls[4 + hg], c = ls[8 + hg], mx = fmaxf(a, fmaxf(b, c));
        const float al = __expf(ls[hd] - mx) / (__expf(a - mx) + __expf(b - mx) + __expf(c - mx));
        GAS v4u* p = (GAS v4u*)(F.QP + (size_t)row * AW + c8 * 8);
        v4u v = *p;
        v.x = pk2(bf_lo(v.x) * al, bf_hi(v.x) * al); v.y = pk2(bf_lo(v.y) * al, bf_hi(v.y) * al); v.z = pk2(bf_lo(v.z) * al, bf_hi(v.z) * al); v.w = pk2(bf_lo(v.w) * al, bf_hi(v.w) * al);
        *p = v;
    }
}
__device__ __forceinline__ void final_norm_rows(Frame& F) {
    const int gw = F.vcu * NWAVES + F.wave, NGW = F.G * NWAVES;
    for (int m = gw; m < M; m += NGW) {
        const float s = wave_sum(F.lane < 16 ? F.SS[(size_t)m * 16 + F.lane] : 0.f);
        const float r = 1.0f / sqrtf(s * (1.0f / D) + NORM_EPS);
        GAS f32x4* xr = (GAS f32x4*)(F.out + (size_t)m * D) + F.lane;
        const GAS f32x4* gr = (const GAS f32x4*)F.final_norm + F.lane;
#pragma unroll
        for (int j = 0; j < 4; ++j) { const f32x4 v = xr[64 * j], g = gr[64 * j]; xr[64 * j] = v * r * g; }
    }
}

__device__ __forceinline__ bool fresh(Frame& F) { int t = threadIdx.x; asm volatile("" : "+v"(t)); F.tid = t; F.lane = t & 63; F.wave = __builtin_amdgcn_readfirstlane(t >> 6); return true; }
struct Args { const float* in[12]; float* out; unsigned char* ws; int ph_lo, ph_hi; };
__global__ void __launch_bounds__(NWAVES * 64, 2) trunk_fwd(Args args) {
    extern __shared__ __attribute__((aligned(16))) unsigned char lds[];
    Frame F;
    F.lds = (LAS unsigned char*)lds;
    F.MISC = (volatile LAS unsigned*)(F.lds + MISC_OFF);
    F.tid = threadIdx.x; F.lane = F.tid & 63; F.wave = __builtin_amdgcn_readfirstlane(F.tid >> 6);
    F.G = gridDim.x; { const int bx = blockIdx.x; F.vcu = (F.G % 8 == 0) ? (bx % 8) * (F.G / 8) + bx / 8 : bx; }
    unsigned char* ws = args.ws;
    F.ctl = (gu32*)(ws + WS_CTL);
    F.x = args.in[0]; F.norm_mix = args.in[1]; F.norm_ffn = args.in[2]; F.hgrn_w_in = args.in[3]; F.lb_logits = args.in[4]; F.hgrn_out_norm = args.in[5]; F.hgrn_w_out = args.in[6];
    F.attn_w_qkv = args.in[7]; F.attn_w_out = args.in[8]; F.ffn_w_in = args.in[9]; F.ffn_w_down = args.in[10]; F.final_norm = args.in[11]; F.out = args.out;
    F.Whin = (bf16*)(ws + WS_WHIN); F.Whout = (bf16*)(ws + WS_WHOUT); F.Wqkv = (bf16*)(ws + WS_WQKV); F.Wao = (bf16*)(ws + WS_WAO); F.Wf1 = (bf16*)(ws + WS_WF1); F.Wf2 = (bf16*)(ws + WS_WF2);
    F.SS = (float*)(ws + WS_SS); F.E1 = (float*)(ws + WS_E1); F.E2 = (float*)(ws + WS_E2); F.COS = (float*)(ws + WS_COS); F.SIN = (float*)(ws + WS_SIN); F.LSE = (float*)(ws + WS_LSE); F.LB = (float*)(ws + WS_LB); F.DJ = (float*)(ws + WS_LB + 4096); F.ST = (float*)(ws + WS_ST);
    F.XB = (bf16*)(ws + WS_XB); F.QT = (bf16*)(ws + WS_QT); F.KT = (bf16*)(ws + WS_KT); F.VV = (bf16*)(ws + WS_VV); F.GG = (bf16*)(ws + WS_GG); F.FF = (bf16*)(ws + WS_FF);
    F.QP = (bf16*)(ws + WS_QP); F.KP = (bf16*)(ws + WS_KP); F.VP = (bf16*)(ws + WS_VP);
    for (int u = F.tid; u < (LDS_BYTES - LDSCTL_OFF) / 4; u += NWAVES * 64) ((LAS unsigned*)(F.lds + LDSCTL_OFF))[u] = 0u;
    __syncthreads();
    XcdBarrier bar; bar.bar = (unsigned*)(F.ctl + CW_BAR); bar.x = 0; bar.st = nullptr;
    if (!MK_PER_PHASE) bar = xcd_barrier_post((unsigned*)(F.ctl + CW_BAR), F.MISC + 8);
    const int lo = args.ph_lo, hi = args.ph_hi;
#define IN(k) (lo <= (k) && (k) < hi && fresh(F))
#define SEAM(k) do { if (IN(k) && IN((k) + 1)) xcd_barrier(bar); } while (0)
    using pg8::Gemm; using pg8::StaticOrder;
#define RUN_GEMM(EPI, Aptr, Bptr, N_, K_, E) do { Gemm g{(const pg8::bf16_t*)(Aptr), (const pg8::bf16_t*)(Bptr), M, (N_), (K_)}; StaticOrder S; S.init(M, (N_), F.G, (int)blockIdx.x); \
        pg8::gemm_phase<EPI, StaticOrder, true, true>(F.lds + RING_OFF, g, S, E); } while (0)

    if (IN(0)) { p0_prologue(F); } SEAM(0);
    if (IN(1)) { pg8::EpiHgrnIn E{F.QT, F.KT, F.VV, F.GG, F.E1, F.E2, F.SS, F.LB}; RUN_GEMM(pg8::EpiHgrnIn, F.XB, F.Whin, HIN, D, E); } SEAM(1);
    if (IN(2)) { hg::phase_a(F, F.DJ); } SEAM(2);
    if (IN(3)) { hg::phase_b(F, F.DJ); } SEAM(3);
    if (IN(4)) { hg::phase_c(F); } SEAM(4);
    if (IN(5)) { pg8::EpiRes E{F.x, F.out, F.XB, F.SS}; RUN_GEMM(pg8::EpiRes, F.QT, F.Whout, D, D, E); } SEAM(5);
    if (IN(6)) { pg8::EpiSwiglu E{F.FF, F.SS}; RUN_GEMM(pg8::EpiSwiglu, F.XB, F.Wf1, FF2, D, E); } SEAM(6);
    if (IN(7)) { pg8::EpiRes E{F.out, F.out, F.XB, F.SS}; RUN_GEMM(pg8::EpiRes, F.FF, F.Wf2, D, DFF, E); } SEAM(7);
    if (IN(8)) { pg8::EpiQkv E{F.QP, F.KP, F.VP, F.SS, F.COS, F.SIN}; RUN_GEMM(pg8::EpiQkv, F.XB, F.Wqkv, QKVW, D, E); } SEAM(8);
    if (IN(9)) { attn_fast(F, (char*)lds); } SEAM(9);
    if (IN(10)) { attn_scale(F); } SEAM(10);
    if (IN(11)) { pg8::EpiRes E{F.out, F.out, F.XB, F.SS}; RUN_GEMM(pg8::EpiRes, F.QP, F.Wao, D, AW, E); } SEAM(11);
    if (IN(12)) { pg8::EpiSwiglu E{F.FF, F.SS}; RUN_GEMM(pg8::EpiSwiglu, F.XB, F.Wf1 + (size_t)FF2 * D, FF2, D, E); } SEAM(12);
    if (IN(13)) { pg8::EpiRes E{F.out, F.out, nullptr, F.SS}; RUN_GEMM(pg8::EpiRes, F.FF, F.Wf2 + (size_t)D * DFF, D, DFF, E); } SEAM(13);
    if (IN(14)) { final_norm_rows(F); }
#undef IN
#undef SEAM
#undef RUN_GEMM
}

extern "C" void kernel_launch(void* const* d_in, const int* in_sizes, int n_in, void* d_out, int out_size, void* d_ws, size_t ws_size, hipStream_t stream) {
    static int grid = 0;
    if (grid == 0) {
        if (n_in != 12 || in_sizes[0] != M * D || out_size != M * D || ws_size < WS_END) { fprintf(stderr, "kernel_launch: unexpected shapes (n_in %d, in0 %d, out %d, ws %zu); nothing launched\n", n_in, n_in > 0 ? in_sizes[0] : -1, out_size, ws_size); grid = -1; return; }
        int dev = 0, cus = 0, per_cu = 0;
        if (hipGetDevice(&dev) != hipSuccess || hipDeviceGetAttribute(&cus, hipDeviceAttributeMultiprocessorCount, dev) != hipSuccess) { grid = -1; return; }
        if (hipFuncSetAttribute((const void*)trunk_fwd, hipFuncAttributeMaxDynamicSharedMemorySize, LDS_BYTES) != hipSuccess) { fprintf(stderr, "kernel_launch: hipFuncSetAttribute failed\n"); grid = -1; return; }
        if (hipOccupancyMaxActiveBlocksPerMultiprocessor(&per_cu, (const void*)trunk_fwd, NWAVES * 64, LDS_BYTES) != hipSuccess || per_cu < 1)
            fprintf(stderr, "kernel_launch: note: the occupancy query reports %d workgroups per CU\n", per_cu);
        (void)hipGetLastError();
        grid = cus;
    }
    if (grid < 0) return;
    if (hipMemsetAsync((char*)d_ws + WS_CTL, 0, CTL_ZERO_BYTES, stream) != hipSuccess) { fprintf(stderr, "kernel_launch: hipMemsetAsync failed\n"); return; }
    Args a{};
    for (int i = 0; i < 12; ++i) a.in[i] = (const float*)d_in[i];
    a.out = (float*)d_out; a.ws = (unsigned char*)d_ws;
#if MK_PER_PHASE
    for (int p = 0; p < NPH; ++p) { a.ph_lo = p; a.ph_hi = p + 1; hipLaunchKernelGGL(trunk_fwd, dim3(grid), dim3(NWAVES * 64), LDS_BYTES, stream, a); }
#else
    a.ph_lo = 0; a.ph_hi = NPH; hipLaunchKernelGGL(trunk_fwd, dim3(grid), dim3(NWAVES * 64), LDS_BYTES, stream, a);
#endif
    const hipError_t le = hipPeekAtLastError();
    if (le != hipSuccess) fprintf(stderr, "kernel_launch: launch failed: %s (grid %d)\n", hipGetErrorName(le), grid);
}
```

```cpp
#include <hip/hip_runtime.h>
#include <cstdio>
#include <cstdint>
#include <math.h>

constexpr int BATCH = 2, T = 8192, D = 1024, M = BATCH * T;
constexpr int HIN = 4096, DFF = 2816, FF2 = 2 * DFF, QKVW = 4608, AW = 1536;
constexpr float NORM_EPS = 1e-6f;

namespace pg8 {
#define PG8_LAS __attribute__((address_space(3)))
typedef unsigned short bf16_t;
typedef short bf16x8 __attribute__((ext_vector_type(8)));
typedef float f32x4 __attribute__((ext_vector_type(4)));
typedef unsigned u32x4 __attribute__((ext_vector_type(4)));
constexpr int BM = 256, BK = 64, HALF = 128, HTB = HALF * BK * 2  , STAGE_BYTES = 8 * HTB, NXCD = 8, WGM = 8;

__host__ __device__ __forceinline__ int lds_byte(int r, int c) { const int st = (r >> 4) * 2 + (c >> 5), rr = r & 15, cc = c & 31, ob = rr * 64 + cc * 2; return st * 1024 + (ob ^ (((ob >> 9) & 1) << 5)); }
__host__ __device__ __forceinline__ void stage_rc(int b, int& R, int& C) { const int st = b / 1024, sb = b % 1024, swz = sb ^ (((sb >> 9) & 1) << 5); R = (st >> 1) * 16 + swz / 64; C = (st & 1) * 32 + (swz % 64) / 2; }
__host__ __device__ __forceinline__ int perm32(int rho) { const int n = rho >> 4, i = rho & 15; return 8 * (i >> 2) + 4 * n + (i & 3); }

struct Unit { int pm, pn; };
struct Gemm { const bf16_t* A; const bf16_t* Bt; int M, N, K; };

struct StaticOrder {
    int nM, nN, nwg, G, c;
    __host__ __device__ void init(int M, int N, int G_, int c_) { nM = M / BM; nN = N / BM; nwg = nM * nN; G = G_; c = c_; }
    __host__ __device__ bool next(int i, Unit& u) const {
        const long L = (long)i * G + c; if (L >= nwg) return false;
        int wgid = (int)L; { const int q = nwg / NXCD, r = nwg % NXCD, xcd = wgid % NXCD, off = wgid / NXCD; wgid = (xcd < r ? xcd * (q + 1) : r * (q + 1) + (xcd - r) * q) + off; }
        const int nig = WGM * nN, gid = wgid / nig, fm = gid * WGM, gsz = (nM - fm) < WGM ? (nM - fm) : WGM;
        u.pm = fm + ((wgid % nig) % gsz); u.pn = (wgid % nig) / gsz; return true;
    }
    __device__ __forceinline__ void a_ready(const Unit&) const {}
    __device__ __forceinline__ void done(const Unit&) const {}
};


typedef float f32x2 __attribute__((ext_vector_type(2)));
typedef __bf16 bf16x2_t __attribute__((ext_vector_type(2)));
__device__ __forceinline__ unsigned cvt_pk_bf16(float lo, float hi) { const f32x2 v = {lo, hi}; return __builtin_bit_cast(unsigned, __builtin_convertvector(v, bf16x2_t)); }
typedef unsigned u32x2 __attribute__((ext_vector_type(2)));
__device__ __forceinline__ u32x4 pack8(const f32x4 a, const f32x4 b) { u32x4 w; w.x = cvt_pk_bf16(a[0], a[1]); w.y = cvt_pk_bf16(a[2], a[3]); w.z = cvt_pk_bf16(b[0], b[1]); w.w = cvt_pk_bf16(b[2], b[3]); return w; }
__device__ __forceinline__ u32x2 pack4(const f32x4 a) { u32x2 w; w.x = cvt_pk_bf16(a[0], a[1]); w.y = cvt_pk_bf16(a[2], a[3]); return w; }
__device__ __forceinline__ float silu_f(float x) { return x * __builtin_amdgcn_rcpf(1.0f + __expf(-x)); }
__device__ __forceinline__ f32x4 silu4(const f32x4 x) { f32x4 r; r[0] = silu_f(x[0]); r[1] = silu_f(x[1]); r[2] = silu_f(x[2]); r[3] = silu_f(x[3]); return r; }
__device__ __forceinline__ float row_rstd(const float* ss, int row, int fq) {
    const f32x4 p = *(const f32x4*)(ss + (size_t)row * 16 + 4 * fq);
    float s = (p[0] + p[1]) + (p[2] + p[3]);
    s += __shfl_xor(s, 16); s += __shfl_xor(s, 32);
    return 1.0f / sqrtf(s * (1.0f / 1024.0f) + NORM_EPS);
}
template <int CTRL> __device__ __forceinline__ float dpp_f(float x) { return __builtin_bit_cast(float, __builtin_amdgcn_update_dpp(0, __builtin_bit_cast(int, x), CTRL, 0xf, 0xf, true)); }

struct EpiRes {
    static constexpr bool PERM = false, AFTER_DRAIN = false;
    bf16_t* xb; float* ss;
    __device__ __forceinline__ void operator()(const f32x4 (&acc)[2][2][4][2], const Unit& u, int wr, int wc, int fr, int fq) const {
        const int colb = u.pn * BM + wc * 32 + 8 * fq;
#pragma unroll
        for (int ai = 0; ai < 2; ++ai)
#pragma unroll
            for (int m = 0; m < 4; ++m) {
                const int row = u.pm * BM + ai * HALF + wr * 64 + m * 16 + fr;
                float sq = 0.f;
#pragma unroll
                for (int bj = 0; bj < 2; ++bj) {
                    bf16_t* p = xb + (size_t)row * 1024 + colb + bj * HALF;
                    const u32x4 b = *(const u32x4*)p;
                    f32x4 v0 = acc[ai][bj][m][0], v1 = acc[ai][bj][m][1];
                    v0[0] += __uint_as_float(b.x << 16); v0[1] += __uint_as_float(b.x & 0xffff0000u); v0[2] += __uint_as_float(b.y << 16); v0[3] += __uint_as_float(b.y & 0xffff0000u);
                    v1[0] += __uint_as_float(b.z << 16); v1[1] += __uint_as_float(b.z & 0xffff0000u); v1[2] += __uint_as_float(b.w << 16); v1[3] += __uint_as_float(b.w & 0xffff0000u);
                    *(u32x4*)p = pack8(v0, v1);
                    sq += (v0[0] * v0[0] + v0[1] * v0[1]) + (v0[2] * v0[2] + v0[3] * v0[3]) + (v1[0] * v1[0] + v1[1] * v1[1]) + (v1[2] * v1[2] + v1[3] * v1[3]);
                }
                sq += __shfl_xor(sq, 16); sq += __shfl_xor(sq, 32);
                if (fq == 0) ss[(size_t)row * 16 + u.pn * 4 + wc] = sq;
            }
    }
};
struct EpiSwiglu {
    static constexpr bool PERM = false, AFTER_DRAIN = false;
    bf16_t* act; const float* ss;
    __device__ __forceinline__ void operator()(const f32x4 (&acc)[2][2][4][2], const Unit& u, int wr, int wc, int fr, int fq) const {
        const int colb = u.pn * 128 + wc * 32 + 8 * fq;
#pragma unroll
        for (int ai = 0; ai < 2; ++ai)
#pragma unroll
            for (int m = 0; m < 4; ++m) {
                const int row = u.pm * BM + ai * HALF + wr * 64 + m * 16 + fr;
                const float r = row_rstd(ss, row, fq);
                const f32x4 a0 = silu4(acc[ai][0][m][0] * r) * (acc[ai][1][m][0] * r), a1 = silu4(acc[ai][0][m][1] * r) * (acc[ai][1][m][1] * r);
                *(u32x4*)(act + (size_t)row * DFF + colb) = pack8(a0, a1);
            }
    }
};
struct EpiQkv {
    static constexpr bool PERM = false, AFTER_DRAIN = false;
    bf16_t* Q; bf16_t* K; bf16_t* V; const float* ss; const float* cosT; const float* sinT;
    __device__ __forceinline__ void operator()(const f32x4 (&acc)[2][2][4][2], const Unit& u, int wr, int wc, int fr, int fq) const {
        if (u.pn < 12) {
            bf16_t* P = u.pn < 6 ? Q : K;
            const int j0 = (wc & 1) * 32 + 8 * fq, tcol = (u.pn % 6) * 256 + (wc >> 1) * 128 + j0;
#pragma unroll
            for (int ai = 0; ai < 2; ++ai)
#pragma unroll
                for (int m = 0; m < 4; ++m) {
                    const int row = u.pm * BM + ai * HALF + wr * 64 + m * 16 + fr;
                    const float r = row_rstd(ss, row, fq);
                    const size_t tb = (size_t)(row & (T - 1)) * 64 + j0;
                    const f32x4 c0 = *(const f32x4*)(cosT + tb), c1 = *(const f32x4*)(cosT + tb + 4), s0 = *(const f32x4*)(sinT + tb), s1 = *(const f32x4*)(sinT + tb + 4);
                    const f32x4 x1a = acc[ai][0][m][0] * r, x1b = acc[ai][0][m][1] * r, x2a = acc[ai][1][m][0] * r, x2b = acc[ai][1][m][1] * r;
                    bf16_t* p = P + (size_t)row * AW + tcol;
                    *(u32x4*)p = pack8(x1a * c0 - x2a * s0, x1b * c1 - x2b * s1);
                    *(u32x4*)(p + 64) = pack8(x2a * c0 + x1a * s0, x2b * c1 + x1b * s1);
                }
        } else {
            const int tcol = (u.pn - 12) * 256 + wc * 32 + 8 * fq;
#pragma unroll
            for (int ai = 0; ai < 2; ++ai)
#pragma unroll
                for (int m = 0; m < 4; ++m) {
                    const int row = u.pm * BM + ai * HALF + wr * 64 + m * 16 + fr;
                    const float r = row_rstd(ss, row, fq);
#pragma unroll
                    for (int bj = 0; bj < 2; ++bj) *(u32x4*)(V + (size_t)row * AW + tcol + bj * HALF) = pack8(acc[ai][bj][m][0] * r, acc[ai][bj][m][1] * r);
                }
        }
    }
};
struct EpiHgrnIn {
    static constexpr bool PERM = false, AFTER_DRAIN = false;
    bf16_t *QT, *KT, *VV, *GG; float *E1, *E2; const float* ss; const float* lb;
    __device__ __forceinline__ void operator()(const f32x4 (&acc)[2][2][4][2], const Unit& u, int wr, int wc, int fr, int fq) const {
        const int ch0 = u.pn * 64 + wc * 16 + 4 * fq;
        const f32x4 lbv = *(const f32x4*)(lb + ch0);
#pragma unroll
        for (int ai = 0; ai < 2; ++ai) {
            const int rowb = u.pm * BM + ai * HALF + wr * 64;
            float rs[4];
#pragma unroll
            for (int m = 0; m < 4; ++m) rs[m] = row_rstd(ss, rowb + m * 16 + fr, fq);
            f32x4 kv[4], bc[4], run = {0.f, 0.f, 0.f, 0.f};
#pragma unroll
            for (int m = 0; m < 4; ++m) {
                const f32x4 fz = acc[ai][0][m][1] * rs[m];
#pragma unroll
                for (int e = 0; e < 4; ++e) {
                    const float tt = __expf(-fmaxf(fz[e], -80.f)), inv = __builtin_amdgcn_rcpf(1.0f + tt);
                    const float oml = 1.0f - lbv[e];
                    const float fg = lbv[e] + oml * inv;
                    kv[m][e] = oml * (tt * inv);
                    float x = __logf(fg);
                    x += dpp_f<0x111>(x); x += dpp_f<0x112>(x); x += dpp_f<0x114>(x); x += dpp_f<0x118>(x);
                    const float tot = __shfl(x, 15, 16);
                    bc[m][e] = x + run[e]; run[e] += tot;
                }
            }
            f32x4 ref;
#pragma unroll
            for (int e = 0; e < 4; ++e) ref[e] = __shfl(bc[1][e], 15, 16);
            if (fr == 0) {
                const int chunk = rowb >> 6; f32x4 e1, e2;
#pragma unroll
                for (int e = 0; e < 4; ++e) { e1[e] = __expf(ref[e]); e2[e] = __expf(run[e] - ref[e]); }
                *(f32x4*)(E1 + (size_t)chunk * 1024 + ch0) = e1; *(f32x4*)(E2 + (size_t)chunk * 1024 + ch0) = e2;
            }
#pragma unroll
            for (int m = 0; m < 4; ++m) {
                const size_t off = (size_t)(rowb + m * 16 + fr) * 1024 + ch0;
                f32x4 qv = silu4(acc[ai][0][m][0] * rs[m]), kk = kv[m];
#pragma unroll
                for (int e = 0; e < 4; ++e) { const float dl = bc[m][e] - ref[e]; qv[e] *= __expf(dl); kk[e] *= __expf(-dl); }
                *(u32x2*)(QT + off) = pack4(qv); *(u32x2*)(KT + off) = pack4(kk);
                *(u32x2*)(VV + off) = pack4(acc[ai][1][m][0] * rs[m]); *(u32x2*)(GG + off) = pack4(silu4(acc[ai][1][m][1] * rs[m]));
            }
        }
    }
};

template <class Epi, class Sched, bool ALIGN_EPI = false, bool SP2 = false>
__device__ __forceinline__ void gemm_phase(PG8_LAS unsigned char* lds, const Gemm g, const Sched& S, const Epi& E) {
    int tid = threadIdx.x; asm volatile("" : "+v"(tid));
    const int wid = __builtin_amdgcn_readfirstlane(tid >> 6), lane = tid & 63, wr = wid >> 2, wc = wid & 3, fr = lane & 15, fq = lane >> 4;
    const int K = g.K, nt = K / BK;
    unsigned voffA[2], voffB[2];
#pragma unroll
    for (int i = 0; i < 2; ++i) { int R, C; stage_rc(tid * 16 + i * 8192, R, C); const int Rb = Epi::PERM ? ((R & ~31) + perm32(R & 31)) : R;
        voffA[i] = (unsigned)(R * K + C) * 2u; voffB[i] = (unsigned)(Rb * K + C) * 2u; }
    const size_t kstep = (size_t)(BK * 2);
    const size_t hstep = (size_t)HALF * K * 2;
    const size_t tstep = 2 * hstep;
    const unsigned ldsw = (unsigned)wid * 1024u;
    const int aoff = lds_byte(wr * 64 + fr, fq * 8), boff = lds_byte(wc * 32 + fr, fq * 8);
#define PG8_SA(b, h) (((b) * 2 + (h)) * HTB)
#define PG8_SB(b, h) ((4 + (b) * 2 + (h)) * HTB)
#define PG8_STAGE(bufoff, gbase, voff) do { _Pragma("unroll") for (int _i = 0; _i < 2; ++_i) \
        __builtin_amdgcn_global_load_lds((const unsigned*)((const char*)(gbase) + (voff)[_i]), (PG8_LAS unsigned*)(lds + (bufoff) + ldsw + _i * 8192), 16, 0, 0); } while (0)
#define PG8_LDA(dst, b, h) do { _Pragma("unroll") for (int m = 0; m < 4; ++m) _Pragma("unroll") for (int k = 0; k < 2; ++k) dst[m][k] = *(const PG8_LAS bf16x8*)(lds + PG8_SA(b, h) + aoff + m * 2048 + k * 1024); } while (0)
#define PG8_LDB(dst, b, h) do { _Pragma("unroll") for (int n = 0; n < 2; ++n) _Pragma("unroll") for (int k = 0; k < 2; ++k) dst[n][k] = *(const PG8_LAS bf16x8*)(lds + PG8_SB(b, h) + boff + n * 2048 + k * 1024); } while (0)
#define PG8_MMA(ai, bj, At, Bt) do { __builtin_amdgcn_s_setprio(1); _Pragma("unroll") for (int m = 0; m < 4; ++m) _Pragma("unroll") for (int n = 0; n < 2; ++n) _Pragma("unroll") for (int k = 0; k < 2; ++k) \
        acc[ai][bj][m][n] = __builtin_amdgcn_mfma_f32_16x16x32_bf16(Bt[n][k], At[m][k], acc[ai][bj][m][n], 0, 0, 0); __builtin_amdgcn_s_setprio(0); } while (0)
#define PG8_WAIT_V(n) asm volatile("s_waitcnt vmcnt(" #n ")" ::: "memory")
#define PG8_WAIT_L(n) asm volatile("s_waitcnt lgkmcnt(" #n ")" ::: "memory")
#define PG8_BAR __builtin_amdgcn_s_barrier()
#define PG8_SCHED __builtin_amdgcn_sched_barrier(0)
    Unit cur, nxt; int ui = 0;
    if (!S.next(0, cur)) return;
    f32x4 acc[2][2][4][2];
#pragma unroll
    for (int a = 0; a < 2; ++a)
#pragma unroll
        for (int b = 0; b < 2; ++b)
#pragma unroll
            for (int m = 0; m < 4; ++m)
#pragma unroll
                for (int n = 0; n < 2; ++n) acc[a][b][m][n] = (f32x4){0.f, 0.f, 0.f, 0.f};
    bf16x8 At[4][2], B0[2][2], B1[2][2];
    const char* cA = (const char*)g.A + (size_t)cur.pm * tstep; const char* cB = (const char*)g.Bt + (size_t)cur.pn * tstep;
    S.a_ready(cur);
    if constexpr (SP2) {
        PG8_STAGE(PG8_SB(0, 0), cB, voffB); PG8_STAGE(PG8_SB(0, 1), cB + hstep, voffB); PG8_STAGE(PG8_SA(0, 0), cA, voffA); PG8_STAGE(PG8_SA(0, 1), cA + hstep, voffA);
        if (wr == 1) PG8_BAR;
        PG8_WAIT_V(2); PG8_BAR;
        PG8_STAGE(PG8_SB(1, 0), cB + kstep, voffB); PG8_STAGE(PG8_SA(1, 0), cA + kstep, voffA); PG8_STAGE(PG8_SB(1, 1), cB + hstep + kstep, voffB);
        PG8_WAIT_V(6); PG8_BAR;
    } else {
        PG8_STAGE(PG8_SB(0, 0), cB, voffB); PG8_STAGE(PG8_SA(0, 0), cA, voffA); PG8_STAGE(PG8_SB(0, 1), cB + hstep, voffB); PG8_STAGE(PG8_SA(0, 1), cA + hstep, voffA);
        if (wr == 1) PG8_BAR;
        PG8_WAIT_V(4); PG8_BAR;
        PG8_STAGE(PG8_SB(1, 0), cB + kstep, voffB); PG8_STAGE(PG8_SA(1, 0), cA + kstep, voffA); PG8_STAGE(PG8_SB(1, 1), cB + hstep + kstep, voffB);
        PG8_WAIT_V(6); PG8_BAR;
    }
    for (;;) {
        const bool has_next = S.next(ui + 1, nxt);
        const char* nA = has_next ? (const char*)g.A + (size_t)nxt.pm * tstep : cA; const char* nB = has_next ? (const char*)g.Bt + (size_t)nxt.pn * tstep : cB;
        for (int t = 0; t < nt; t += 2) {
            const bool last = (t == nt - 2);
            const char* a1 = cA + (size_t)(t + 1) * kstep;
            const char* a2 = last ? nA : cA + (size_t)(t + 2) * kstep; const char* b2 = last ? nB : cB + (size_t)(t + 2) * kstep;
            const char* a3 = a2 + kstep; const char* b3 = b2 + kstep;
            if (last && has_next) S.a_ready(nxt);
            if constexpr (SP2) {
            PG8_LDB(B0, 0, 0); PG8_LDB(B1, 0, 1); PG8_SCHED; PG8_LDA(At, 0, 0); PG8_STAGE(PG8_SA(1, 1), a1 + hstep, voffA);
            PG8_WAIT_V(8); PG8_WAIT_L(0); PG8_BAR; PG8_MMA(0, 0, At, B0); PG8_MMA(0, 1, At, B1); PG8_BAR; PG8_SCHED;
            PG8_LDA(At, 0, 1); PG8_STAGE(PG8_SB(0, 0), b2, voffB); PG8_STAGE(PG8_SB(0, 1), b2 + hstep, voffB); PG8_STAGE(PG8_SA(0, 0), a2, voffA);
            PG8_WAIT_V(8); PG8_WAIT_L(0); PG8_BAR; PG8_MMA(1, 0, At, B0); PG8_MMA(1, 1, At, B1); PG8_BAR; PG8_SCHED;
            PG8_LDB(B0, 1, 0); PG8_LDB(B1, 1, 1); PG8_SCHED; PG8_LDA(At, 1, 0); PG8_STAGE(PG8_SA(0, 1), a2 + hstep, voffA);
            PG8_WAIT_V(8); PG8_WAIT_L(0); PG8_BAR; PG8_MMA(0, 0, At, B0); PG8_MMA(0, 1, At, B1); PG8_BAR; PG8_SCHED;
            PG8_LDA(At, 1, 1); PG8_STAGE(PG8_SB(1, 0), b3, voffB); PG8_STAGE(PG8_SB(1, 1), b3 + hstep, voffB); PG8_STAGE(PG8_SA(1, 0), a3, voffA);
            PG8_WAIT_V(8); PG8_WAIT_L(0); PG8_BAR; PG8_MMA(1, 0, At, B0); PG8_MMA(1, 1, At, B1); PG8_BAR; PG8_SCHED;
            } else {
            PG8_LDB(B0, 0, 0); PG8_SCHED; PG8_LDA(At, 0, 0); PG8_STAGE(PG8_SA(1, 1), a1 + hstep, voffA);
            PG8_WAIT_L(8); PG8_BAR; PG8_WAIT_L(0); PG8_MMA(0, 0, At, B0); PG8_BAR; PG8_SCHED;
            PG8_LDB(B1, 0, 1); PG8_STAGE(PG8_SB(0, 0), b2, voffB);
            PG8_BAR; PG8_WAIT_L(0); PG8_MMA(0, 1, At, B1); PG8_BAR;
            PG8_LDA(At, 0, 1); PG8_STAGE(PG8_SA(0, 0), a2, voffA);
            PG8_BAR; PG8_WAIT_L(0); PG8_MMA(1, 0, At, B0); PG8_BAR; PG8_SCHED;
            PG8_STAGE(PG8_SB(0, 1), b2 + hstep, voffB);
            PG8_WAIT_V(6); PG8_BAR; PG8_MMA(1, 1, At, B1); PG8_BAR;
            PG8_LDB(B0, 1, 0); PG8_SCHED; PG8_LDA(At, 1, 0); PG8_STAGE(PG8_SA(0, 1), a2 + hstep, voffA);
            PG8_WAIT_L(8); PG8_BAR; PG8_WAIT_L(0); PG8_MMA(0, 0, At, B0); PG8_BAR; PG8_SCHED;
            PG8_LDB(B1, 1, 1); PG8_STAGE(PG8_SB(1, 0), b3, voffB);
            PG8_BAR; PG8_WAIT_L(0); PG8_MMA(0, 1, At, B1); PG8_BAR;
            PG8_LDA(At, 1, 1); PG8_STAGE(PG8_SA(1, 0), a3, voffA);
            PG8_BAR; PG8_WAIT_L(0); PG8_MMA(1, 0, At, B0); PG8_BAR; PG8_SCHED;
            PG8_STAGE(PG8_SB(1, 1), b3 + hstep, voffB);
            PG8_WAIT_V(6); PG8_BAR; PG8_MMA(1, 1, At, B1); PG8_BAR;
            }
        }
        if constexpr (ALIGN_EPI) { if (wr == 0) PG8_BAR; }
        if constexpr (!Epi::AFTER_DRAIN) { E(acc, cur, wr, wc, fr, fq); S.done(cur); }
        if (!has_next) break;
#pragma unroll
        for (int a = 0; a < 2; ++a)
#pragma unroll
            for (int b = 0; b < 2; ++b)
#pragma unroll
                for (int m = 0; m < 4; ++m)
#pragma unroll
                    for (int n = 0; n < 2; ++n) acc[a][b][m][n] = (f32x4){0.f, 0.f, 0.f, 0.f};
        cur = nxt; cA = nA; cB = nB; ++ui;
        if constexpr (ALIGN_EPI) { if (wr == 1) PG8_BAR; }
    }
    PG8_WAIT_V(0);
    if constexpr (!ALIGN_EPI) { if (wr == 0) PG8_BAR; }
    PG8_BAR;
    if constexpr (Epi::AFTER_DRAIN) { E.fused(acc, cur, wr, wc, fr, fq, lds, wid, lane); S.done(cur); }
#undef PG8_SA
#undef PG8_SB
#undef PG8_STAGE
#undef PG8_LDA
#undef PG8_LDB
#undef PG8_MMA
#undef PG8_WAIT_V
#undef PG8_WAIT_L
#undef PG8_BAR
#undef PG8_SCHED
}
}


constexpr int NWAVES = 8;
#ifndef MK_PER_PHASE
#define MK_PER_PHASE 0
#endif
constexpr int NPH = 15;

constexpr size_t MiB = 1u << 20;
constexpr size_t WS_CTL = 0, CTL_ZERO_BYTES = 64 * 1024;
constexpr size_t WS_WHIN = 1 * MiB, WS_WHOUT = 9 * MiB, WS_WQKV = 11 * MiB, WS_WAO = 20 * MiB, WS_WF1 = 23 * MiB, WS_WF2 = 45 * MiB;
constexpr size_t WS_SS = 56 * MiB, WS_E1 = 57 * MiB, WS_E2 = 58 * MiB, WS_COS = 59 * MiB, WS_SIN = 61 * MiB, WS_LSE = 63 * MiB, WS_LB = 63 * MiB + 768 * 1024;
constexpr size_t WS_ST = 64 * MiB;
constexpr size_t WS_XB = 80 * MiB;
constexpr size_t WS_ACT = 112 * MiB;
constexpr size_t WS_QT = WS_ACT, WS_KT = WS_ACT + 32 * MiB, WS_VV = WS_ACT + 64 * MiB, WS_GG = WS_ACT + 96 * MiB;
constexpr size_t WS_FF = WS_ACT;
constexpr size_t WS_QP = WS_ACT, WS_KP = WS_ACT + 48 * MiB, WS_VP = WS_ACT + 96 * MiB;
constexpr size_t WS_END = 256 * MiB;
static_assert(WS_VP + (size_t)M * AW * 2 <= WS_END && WS_FF + (size_t)M * DFF * 2 <= WS_END && WS_GG + (size_t)M * D * 2 <= WS_END, "d_ws map");
static_assert(WS_WF2 + 2 * (size_t)D * DFF * 2 <= WS_SS && WS_WF1 + 2 * (size_t)FF2 * D * 2 <= WS_WF2 && WS_WAO + (size_t)D * AW * 2 <= WS_WF1 && WS_WQKV + (size_t)QKVW * D * 2 <= WS_WAO, "weights map");
constexpr int CW_TMO = 0, CW_BAR = 4096;

constexpr int RING_OFF = 0, RING_BYTES = 131072;
constexpr int LDSCTL_OFF = RING_BYTES, MISC_OFF = LDSCTL_OFF + 320;
constexpr int LDS_BYTES = 147456;
namespace swa {
constexpr float SCALE = 0.08838834764831845f;
constexpr int D = 128; constexpr bool WSKIP = true; constexpr float THR = 8.f;
constexpr int PLANE_PITCH = AW, SEQ_T = T; constexpr size_t K_FROM_Q = (WS_KP - WS_QP) / 2, V_FROM_K = (WS_VP - WS_KP) / 2;
constexpr int NW = 8, QBLK = 32, KVBLK = 64, QB = NW * QBLK;
constexpr int SHM_V = KVBLK * D * 2, SHM_K = KVBLK * D * 2, ATT_LDS_BYTES = 2 * SHM_V + 2 * SHM_K + NW * 64 * 4;
typedef unsigned short bf16;
typedef short bf16x8 __attribute__((ext_vector_type(8)));
typedef short s16x4 __attribute__((ext_vector_type(4)));
typedef float f32x16 __attribute__((ext_vector_type(16)));
typedef float f32x4 __attribute__((ext_vector_type(4)));
typedef unsigned u32x4 __attribute__((ext_vector_type(4)));
template <class A, class Bt> struct same_t { static constexpr bool v = false; };
template <class A> struct same_t<A, A> { static constexpr bool v = true; };

#define KSWZ(row, colB) ((row) * 256 + ((colB) ^ (((row) & 7) << 4)))
#define SBAR() __builtin_amdgcn_sched_barrier(0)
__device__ __forceinline__ int v_st(int k, int c) { const int kk = (k & ~0xC) | ((k & 4) << 1) | ((k & 8) >> 1); return ((kk >> 3) * 4 + (c >> 5)) * 512 + ((kk & 7) * 32 + (c & 31)) * 2; }
__device__ __forceinline__ int v_rd_base(int lane) { return ((lane & 3) << 3) | (((lane >> 2) & 3) << 6) | (((lane >> 4) & 1) << 5) | (((lane >> 5) & 1) << 8); }
constexpr int v_rd_off(int d0, int ks, int half) { return d0 * 512 + ks * 4096 + half * 2048; }
__device__ __forceinline__ int crow(int r, int hi) { return (r & 3) + 8 * (r >> 2) + 4 * hi; }
__device__ __forceinline__ unsigned cvtpk(float lo, float hi) {
    unsigned r; asm volatile("v_cvt_pk_bf16_f32 %0, %1, %2" : "=v"(r) : "v"(lo), "v"(hi)); return r;
}
__device__ __forceinline__ bf16x8 pack8(f32x4 a, f32x4 b) {
    u32x4 w = {cvtpk(a[0], a[1]), cvtpk(a[2], a[3]), cvtpk(b[0], b[1]), cvtpk(b[2], b[3])};
    return *reinterpret_cast<bf16x8*>(&w);
}
template <class T> __device__ __forceinline__ bf16x8 load8(const T* p) {
    if constexpr (same_t<T, float>::v) { return pack8(*(const f32x4*)p, *(const f32x4*)(p + 4)); }
    else { return *reinterpret_cast<const bf16x8*>(p); }
}
__device__ __forceinline__ void mask_tile(f32x16& p0, f32x16& p1, int dq, unsigned W) {
    const float NEG = -__builtin_inff();
#pragma unroll
    for (int r = 0; r < 16; ++r) {
        const int c = (r & 3) + 8 * (r >> 2);
        if ((unsigned)(dq - c) >= W) p0[r] = NEG;
        if ((unsigned)(dq - c - 32) >= W) p1[r] = NEG;
    }
}
__device__ __forceinline__ void partialSM(f32x16& p0, f32x16& p1, float& m_reg, float& mn, float& alpha) {
    float pmax = p0[0]; for (int r = 1; r < 16; ++r) pmax = fmaxf(pmax, p0[r]); for (int r = 0; r < 16; ++r) pmax = fmaxf(pmax, p1[r]);
    { auto rr = __builtin_amdgcn_permlane32_swap(__float_as_uint(pmax), __float_as_uint(pmax), false, false);
      pmax = fmaxf(__uint_as_float(rr[0]), __uint_as_float(rr[1])); }
    constexpr float C2 = 1.4426950408889634f * SCALE;
    if (__builtin_expect(__all((pmax - m_reg) * SCALE <= THR), 1)) { mn = m_reg; alpha = 1.f; }
    else { mn = fmaxf(m_reg, pmax); alpha = __builtin_amdgcn_exp2f((m_reg - mn) * C2); m_reg = mn; }
    const float mnL = -mn * C2;
    for (int r = 0; r < 16; ++r) p0[r] = fmaf(p0[r], C2, mnL); for (int r = 0; r < 16; ++r) p1[r] = fmaf(p1[r], C2, mnL);
    for (int r = 0; r < 16; ++r) p0[r] = __builtin_amdgcn_exp2f(p0[r]);
}
__device__ __forceinline__ void finishSM(f32x16& p0, f32x16& p1, float alpha, float& l_reg, bf16x8& pa0, bf16x8& pa1, bf16x8& pa2, bf16x8& pa3) {
    for (int r = 0; r < 16; ++r) p1[r] = __builtin_amdgcn_exp2f(p1[r]);
    float ps = 0; for (int r = 0; r < 16; ++r) ps += p0[r]; for (int r = 0; r < 16; ++r) ps += p1[r];
    { auto rr = __builtin_amdgcn_permlane32_swap(__float_as_uint(ps), __float_as_uint(ps), false, false);
      ps = __uint_as_float(rr[0]) + __uint_as_float(rr[1]); }
    l_reg = l_reg * alpha + ps;
#define PK4(P, B_, OUT) do { unsigned a0 = cvtpk(P[B_+0], P[B_+1]), a1 = cvtpk(P[B_+2], P[B_+3]);                          \
        unsigned b0 = cvtpk(P[B_+4], P[B_+5]), b1 = cvtpk(P[B_+6], P[B_+7]);                                             \
        auto r0 = __builtin_amdgcn_permlane32_swap(a0, b0, false, false); auto r1 = __builtin_amdgcn_permlane32_swap(a1, b1, false, false); \
        u32x4 w = {r0[0], r1[0], r0[1], r1[1]}; OUT = *reinterpret_cast<bf16x8*>(&w); } while (0)
    PK4(p0, 0, pa0); PK4(p0, 8, pa1); PK4(p1, 0, pa2); PK4(p1, 8, pa3);
#undef PK4
}
template <int KB, bool SK>
__device__ __forceinline__ void qkt(f32x16& p0, f32x16& p1, const char* K_lds, int r32, int hi, const bf16x8* qr, bool act) {
    if (SK && !act) { const float NEG = -__builtin_inff();
#pragma unroll
        for (int r = 0; r < 16; ++r) { p0[r] = NEG; p1[r] = NEG; } return; }
    p0 = f32x16{}; p1 = f32x16{};
    const char* kb[4];
#pragma unroll
    for (int dd = 0; dd < 4; ++dd) kb[dd] = K_lds + KB * SHM_K + KSWZ(r32, (dd * 16 + hi * 8) * 2);
#pragma unroll
    for (int d0 = 0; d0 < 8; ++d0) { const char* a = kb[d0 & 3] + (d0 >> 2) * 128;
        bf16x8 b0 = *reinterpret_cast<const bf16x8*>(a);
        bf16x8 b1 = *reinterpret_cast<const bf16x8*>(a + 32 * 256);
        p0 = __builtin_amdgcn_mfma_f32_32x32x16_bf16(b0, qr[d0], p0, 0, 0, 0);
        p1 = __builtin_amdgcn_mfma_f32_32x32x16_bf16(b1, qr[d0], p1, 0, 0, 0); }
}
template <int VB, bool SK>
__device__ __forceinline__ void pv_tile(f32x16* o, int vb0, bf16x8 pa0, bf16x8 pa1, bf16x8 pa2, bf16x8 pa3, bool act) {
    if (SK && !act) return;
#define TRRD(dst, off) asm volatile("ds_read_b64_tr_b16 %0, %1 offset:%2" : "=&v"(dst) : "v"(vb0), "i"(off) : "memory")
#define PV_D0(d0) do { s16x4 l0, l1, l2, l3, h0, h1, h2, h3; constexpr int b_ = VB * SHM_V + v_rd_off(d0, 0, 0);     \
        TRRD(l0, b_); TRRD(h0, b_ + 2048); TRRD(l1, b_ + 4096); TRRD(h1, b_ + 6144); TRRD(l2, b_ + 8192); TRRD(h2, b_ + 10240); TRRD(l3, b_ + 12288); TRRD(h3, b_ + 14336); \
        asm volatile("s_waitcnt lgkmcnt(0)" ::: "memory"); SBAR();                 \
        o[d0] = __builtin_amdgcn_mfma_f32_32x32x16_bf16(pa0, (bf16x8){l0[0], l0[1], l0[2], l0[3], h0[0], h0[1], h0[2], h0[3]}, o[d0], 0, 0, 0);   \
        o[d0] = __builtin_amdgcn_mfma_f32_32x32x16_bf16(pa1, (bf16x8){l1[0], l1[1], l1[2], l1[3], h1[0], h1[1], h1[2], h1[3]}, o[d0], 0, 0, 0);   \
        o[d0] = __builtin_amdgcn_mfma_f32_32x32x16_bf16(pa2, (bf16x8){l2[0], l2[1], l2[2], l2[3], h2[0], h2[1], h2[2], h2[3]}, o[d0], 0, 0, 0);   \
        o[d0] = __builtin_amdgcn_mfma_f32_32x32x16_bf16(pa3, (bf16x8){l3[0], l3[1], l3[2], l3[3], h3[0], h3[1], h3[2], h3[3]}, o[d0], 0, 0, 0); } while (0)
    PV_D0(0); PV_D0(1); PV_D0(2); PV_D0(3);
#undef PV_D0
#undef TRRD
}

template <class TIn, class TOut> struct BlockRef { const TIn* Q; int P0, sh, lrow;
    __device__ __forceinline__ int pitch() const { return PLANE_PITCH << sh; }
    __device__ __forceinline__ const TIn* K() const { return Q + K_FROM_Q - (size_t)P0 * (size_t)pitch(); }
    __device__ __forceinline__ const TIn* V() const { return K() + V_FROM_K; }
    __device__ __forceinline__ int skv() const { return SEQ_T >> sh; }
    __device__ __forceinline__ int lp() const { return 12 << sh; } };
template <class TIn> struct Seam {
    bf16x8 qr[8];
    bf16x8 st_v0, st_v1, st_k0, st_k1; f32x4 sf0, sf1, sf2, sf3;
    f32x4 tq[16];
};
__device__ __forceinline__ int swa_jlo(int P0, int W) { const int lowk = P0 - W + 1; return lowk > 0 ? lowk / KVBLK : 0; }
#define ROW(p, k0, rr, kp_) ((p) + (size_t)((k0) + (rr)) * (kp_) + sc)
#define VMW() asm volatile("s_waitcnt vmcnt(0)" ::: "memory")
#define VMWN(n) asm volatile("s_waitcnt vmcnt(%0)" :: "i"(n) : "memory")
#define SLOAD_H(Kp, Vp, k0, kp_) do { S.st_v0 = load8<TIn>(ROW(Vp, k0, sr, kp_)); S.st_v1 = load8<TIn>(ROW(Vp, k0, 32 + sr, kp_));              \
                         S.st_k0 = load8<TIn>(ROW(Kp, k0, sr, kp_)); S.st_k1 = load8<TIn>(ROW(Kp, k0, 32 + sr, kp_)); } while (0)
#define SWRITE_HK(bf) do { *(bf16x8*)(K_lds + (bf) * SHM_K + kws) = S.st_k0; *(bf16x8*)(K_lds + (bf) * SHM_K + kws + 32 * 256) = S.st_k1; } while (0)
#define SWRITE_HV(bf) do { *(bf16x8*)(V_lds + (bf) * SHM_V + vst0) = S.st_v0; *(bf16x8*)(V_lds + (bf) * SHM_V + vst1) = S.st_v1; } while (0)
#define SWRITE_H(bf) do { SWRITE_HV(bf); SWRITE_HK(bf); } while (0)
#define SLOAD_F(p, k0) do { S.sf0 = *(const f32x4*)ROW(p, k0, sr, D); S.sf1 = *(const f32x4*)(ROW(p, k0, sr, D) + 4);                \
                            S.sf2 = *(const f32x4*)ROW(p, k0, 32 + sr, D); S.sf3 = *(const f32x4*)(ROW(p, k0, 32 + sr, D) + 4); } while (0)
#define SWRITE_KF(bf) do { *(bf16x8*)(K_lds + (bf) * SHM_K + kws) = pack8(S.sf0, S.sf1); *(bf16x8*)(K_lds + (bf) * SHM_K + kws + 32 * 256) = pack8(S.sf2, S.sf3); } while (0)
#define SWRITE_VF(bf) do { *(bf16x8*)(V_lds + (bf) * SHM_V + vst0) = pack8(S.sf0, S.sf1); *(bf16x8*)(V_lds + (bf) * SHM_V + vst1) = pack8(S.sf2, S.sf3); } while (0)
template <class TIn, class TOut>
__device__ __forceinline__ void causal_swa_prime(const BlockRef<TIn, TOut>& cur, int W, char* lds, Seam<TIn>& S) {
    constexpr bool F32 = same_t<TIn, float>::v;
    const int tid = threadIdx.x, wid = __builtin_amdgcn_readfirstlane(tid >> 6), lane = tid & 63, r32 = lane & 31, hi = lane >> 5;
    const int sr = tid >> 4, sc = (tid & 15) * 8, kws = KSWZ(sr, sc * 2); char* K_lds = lds + 2 * SHM_V;
    const int kb0 = swa_jlo(cur.P0, W) * KVBLK;
    for (int d0 = 0; d0 < 8; ++d0) S.qr[d0] = load8<TIn>(cur.Q + (size_t)(wid * QBLK + r32) * cur.pitch() + d0 * 16 + hi * 8);
    if constexpr (F32) { SLOAD_F((const float*)cur.K(), kb0); VMW(); SWRITE_KF(0); SBAR(); SLOAD_F((const float*)cur.V(), kb0); }
    else { SLOAD_H(cur.K(), cur.V(), kb0, cur.pitch()); VMW(); SWRITE_HK(0); }
    __syncthreads();
}
template <class TIn, class TOut>
__device__ __forceinline__ void causal_swa_block(const BlockRef<TIn, TOut>& cur, const BlockRef<TIn, TOut>& nxt, float* lse, int W, char* lds, Seam<TIn>& S) {
    const int skv = cur.skv();
    constexpr bool F32 = same_t<TIn, float>::v;
    const int tid = threadIdx.x, wid = __builtin_amdgcn_readfirstlane(tid >> 6), lane = tid & 63, r32 = lane & 31, hi = lane >> 5;
    const int j_lo = swa_jlo(cur.P0, W);
    int j_hi = (cur.P0 + QB - 1) / KVBLK + 1; if (j_hi > skv / KVBLK) j_hi = skv / KVBLK;
    const int NT = j_hi - j_lo;
    const int kbn = swa_jlo(nxt.P0, W) * KVBLK;
    const int qlo = cur.P0 + wid * QBLK, qm = qlo + r32 - 4 * hi;
    char* V_lds = lds; char* K_lds = lds + 2 * SHM_V;
    float* ws = (float*)(lds + 2 * SHM_V + 2 * SHM_K) + wid * 64; float* li_l = ws, * al_l = ws + 32;
    float m_reg = -1e30f, l_reg = 0; f32x16 o[4] = {};
    const int sr = tid >> 4, sc = (tid & 15) * 8, vst0 = v_st(sr, sc), vst1 = v_st(32 + sr, sc), kws = KSWZ(sr, sc * 2);
    const int vb0 = (int)(uintptr_t)V_lds + v_rd_base(lane);
    const TIn* Kh = cur.K(); const TIn* Vh = Kh + V_FROM_K; const int kpc = cur.pitch();
#define RESC(a) do { if (__any((a) < 1.f)) { if (hi == 0) al_l[r32] = (a); asm volatile("s_waitcnt lgkmcnt(0)" ::: "memory");              \
                     for (int d_ = 0; d_ < 4; ++d_) for (int r = 0; r < 16; ++r) o[d_][r] *= al_l[crow(r, hi)]; } } while (0)
#define KBASE(t) ((j_lo + (t)) * KVBLK)
#define ACT(t) (KBASE(t) <= qlo + QBLK - 1 && KBASE(t) + KVBLK - 1 >= qlo - W + 1)
#define MASKT(P0_, P1_, t) do { const int kb_ = KBASE(t); if ((!SK || ACT(t)) && (kb_ + KVBLK - 1 > qlo || kb_ <= qlo + QBLK - 1 - W)) mask_tile(P0_, P1_, qm - kb_, (unsigned)W); } while (0)
    constexpr int NQL = F32 ? 16 : 8;
    constexpr bool SK = WSKIP && !F32;
#define SEAM_K0() do { VMWN(NQL); if constexpr (F32) { SWRITE_KF(0); SBAR(); SLOAD_F((const float*)nxt.V(), kbn); } else { SWRITE_HK(0); } SBAR(); } while (0)
    f32x16 pA0, pA1, pB0, pB1; float mnA, mnB, alA, alB; bf16x8 pa0, pa1, pa2, pa3;
    if constexpr (F32) { VMW(); SWRITE_VF(0); SBAR(); } else { SWRITE_HV(0); SBAR(); }
    if (NT > 1) { if constexpr (F32) SLOAD_F((const float*)Kh, KBASE(1)); else SLOAD_H(Kh, Vh, KBASE(1), kpc); }
    SBAR(); qkt<0, SK>(pA0, pA1, K_lds, r32, hi, S.qr, ACT(0));
    if constexpr (F32) { if (NT > 1) { VMW(); SWRITE_KF(1); SBAR(); SLOAD_F((const float*)Vh, KBASE(1)); } }
    MASKT(pA0, pA1, 0); partialSM(pA0, pA1, m_reg, mnA, alA);
    if (NT > 1) { VMW(); if constexpr (F32) { SWRITE_VF(1); SBAR(); if (NT > 2) SLOAD_F((const float*)Kh, KBASE(2)); } else SWRITE_H(1); }
    __syncthreads();
#define HALF_STEP(PX0, PX1, mnX, alX, PY0, PY1, alY, t, KB, VB, SB) do {                                                      \
        SBAR(); qkt<KB, SK>(PX0, PX1, K_lds, r32, hi, S.qr, ACT(t));                                             \
        finishSM(PY0, PY1, alY, l_reg, pa0, pa1, pa2, pa3); SBAR();                                                           \
        if ((t) + 1 < NT) { if constexpr (F32) { VMW(); SWRITE_KF(SB); SBAR(); SLOAD_F((const float*)Vh, KBASE((t) + 1)); }  \
                            else { SLOAD_H(Kh, Vh, KBASE((t) + 1), kpc); } SBAR(); }                                               \
        pv_tile<VB, SK>(o, vb0, pa0, pa1, pa2, pa3, ACT((t) - 1)); MASKT(PX0, PX1, (t)); partialSM(PX0, PX1, m_reg, mnX, alX);                                        \
        __syncthreads();                                                                                                      \
        if ((t) + 1 < NT) { VMW(); if constexpr (F32) { SWRITE_VF(SB); SBAR(); if ((t) + 2 < NT) SLOAD_F((const float*)Kh, KBASE((t) + 2)); } \
                            else { SWRITE_H(SB); } }                                                                          \
        RESC(alX); __syncthreads(); } while (0)
    for (int t = 1; t + 1 < NT; t += 2) {
        HALF_STEP(pB0, pB1, mnB, alB, pA0, pA1, alA, t, 1, 0, 0);
        HALF_STEP(pA0, pA1, mnA, alA, pB0, pB1, alB, t + 1, 0, 1, 1);
    }
    const bool even = (NT & 1) == 0;
    if (even) { SBAR(); qkt<1, SK>(pB0, pB1, K_lds, r32, hi, S.qr, ACT(NT - 1)); SBAR(); }
#define QROW(e) (nxt.Q + (size_t)(wid * QBLK + r32) * nxt.pitch() + ((e) >> 1) * 16 + hi * 8 + ((e) & 1) * 4)
    if constexpr (F32) { SLOAD_F((const float*)nxt.K(), kbn); SBAR();
#pragma unroll
        for (int e = 0; e < 8; ++e) S.tq[e] = *(const f32x4*)QROW(e); }
    else { SLOAD_H(nxt.K(), nxt.V(), kbn, nxt.pitch()); SBAR();
#pragma unroll
        for (int d0 = 0; d0 < 8; ++d0) S.qr[d0] = load8<TIn>(nxt.Q + (size_t)(wid * QBLK + r32) * nxt.pitch() + d0 * 16 + hi * 8); }
    SBAR();
    finishSM(pA0, pA1, alA, l_reg, pa0, pa1, pa2, pa3); SBAR();
    if constexpr (F32) {
#pragma unroll
        for (int e = 8; e < 16; ++e) S.tq[e] = *(const f32x4*)QROW(e); SBAR(); }
#undef QROW
    pv_tile<0, SK>(o, vb0, pa0, pa1, pa2, pa3, ACT(even ? NT - 2 : NT - 1));
    if (even) { MASKT(pB0, pB1, NT - 1); partialSM(pB0, pB1, m_reg, mnB, alB); __syncthreads(); RESC(alB);
        finishSM(pB0, pB1, alB, l_reg, pa0, pa1, pa2, pa3); SBAR(); pv_tile<1, SK>(o, vb0, pa0, pa1, pa2, pa3, ACT(NT - 1)); }
    SBAR(); SEAM_K0();
    if (hi == 0) li_l[r32] = l_reg; asm volatile("s_waitcnt lgkmcnt(0)" ::: "memory");
    float rli[16];
#pragma unroll
    for (int r = 0; r < 16; ++r) rli[r] = __builtin_amdgcn_rcpf(li_l[crow(r, hi)]);
    TOut* Ow = (TOut*)cur.Q + (size_t)(wid * QBLK) * kpc;
    if (hi == 0) lse[(size_t)cur.lrow + (size_t)(wid * QBLK + r32) * cur.lp()] = m_reg * SCALE + __logf(l_reg);
#pragma unroll
    for (int r = 0; r < 16; ++r) { const int orow = crow(r, hi);
#pragma unroll
        for (int d0 = 0; d0 < 4; ++d0) { const float v = o[d0][r] * rli[r];
            if constexpr (same_t<TOut, float>::v) { Ow[(size_t)orow * kpc + d0 * 32 + r32] = v; }
            else { const float vn = __shfl_xor(v, 1);
                   if ((r32 & 1) == 0) *(unsigned*)(Ow + (size_t)orow * kpc + d0 * 32 + r32) = cvtpk(v, vn); } } }
    if constexpr (F32) {
#pragma unroll
        for (int d0 = 0; d0 < 8; ++d0) S.qr[d0] = pack8(S.tq[2 * d0], S.tq[2 * d0 + 1]); }
    __syncthreads();
#undef RESC
#undef KBASE
#undef ACT
#undef MASKT
#undef SEAM_K0
#undef HALF_STEP
}
#undef ROW
#undef VMW
#undef VMWN
#undef SLOAD_H
#undef SWRITE_HK
#undef SWRITE_HV
#undef SWRITE_H
#undef SLOAD_F
#undef SWRITE_KF
#undef SWRITE_VF


}

#define GAS __attribute__((address_space(1)))
#define LAS __attribute__((address_space(3)))
typedef unsigned short bf16;
typedef unsigned v4u __attribute__((ext_vector_type(4)));
typedef unsigned u32x2 __attribute__((ext_vector_type(2)));
typedef float f32x4 __attribute__((ext_vector_type(4)));
typedef short bf16x8 __attribute__((ext_vector_type(8)));
typedef GAS unsigned gu32;
typedef GAS unsigned long long gu64;
#define RLX_AGENT __ATOMIC_RELAXED, __HIP_MEMORY_SCOPE_AGENT
#define LDS_WAIT() asm volatile("s_waitcnt lgkmcnt(0)" ::: "memory")
#define VM_WAIT() asm volatile("s_waitcnt vmcnt(0)" ::: "memory")
__device__ __forceinline__ unsigned long long rt() { return __builtin_amdgcn_s_memrealtime(); }
__device__ __forceinline__ unsigned f2bf(float f) { unsigned u = __builtin_bit_cast(unsigned, f); return (u + 0x7fffu + ((u >> 16) & 1u)) >> 16; }
__device__ __forceinline__ unsigned pk2(float lo, float hi) { return f2bf(lo) | (f2bf(hi) << 16); }

#define XB_TMO      128
#define XB_XCNT(j)  (256  + 64 * (j))
#define XB_XSUB(j)  (1280 + 64 * (j))
#define XB_XGEN(j)  (2304 + 64 * (j))
#define XB_TOP      3328
#define XB_TOPGEN   3392
#define XCD_BAR_WORDS 3456
#define XB_SPIN_CAP (1u << 18)

__device__ __forceinline__ unsigned xb_ld(unsigned* p)              { return __hip_atomic_load(p, __ATOMIC_RELAXED, __HIP_MEMORY_SCOPE_AGENT); }
__device__ __forceinline__ unsigned xb_add(unsigned* p, unsigned v) { return __hip_atomic_fetch_add(p, v, __ATOMIC_RELAXED, __HIP_MEMORY_SCOPE_AGENT); }
__device__ __forceinline__ unsigned xb_xcc_id() { return (unsigned)__builtin_amdgcn_s_getreg((3 << 11) | 20) & 0xFu; }
#define XB_SPIN(cond, bar) do { unsigned _sp = 0; while (cond) { __builtin_amdgcn_s_sleep(1); \
    if ((++_sp & 255u) == 0u) { if (xb_ld(&(bar)[XB_TMO])) break; if (_sp > XB_SPIN_CAP) { atomicAdd(&(bar)[XB_TMO], 1u); break; } } } } while (0)

struct XcdBarrier {
    unsigned* bar; unsigned x;
    volatile LAS unsigned* st;
};

__device__ __forceinline__ XcdBarrier xcd_barrier_post(unsigned* bar, volatile LAS unsigned* st) {
    XcdBarrier b; b.bar = bar; b.x = xb_xcc_id(); b.st = st;
    if (threadIdx.x == 0) (void)xb_add(&bar[XB_XCNT(b.x)], 1u);
    return b;
}
__device__ __forceinline__ void xcd_barrier_complete(unsigned* bar, unsigned x, unsigned& nloc, unsigned& nx) {
    const unsigned G = gridDim.x * gridDim.y * gridDim.z;
    unsigned sum, cnt, mine, sp = 0u;
    for (;;) {
        sum = 0u; cnt = 0u; mine = 0u;
#pragma unroll
        for (unsigned j = 0; j < 16; ++j) { const unsigned c = xb_ld(&bar[XB_XCNT(j)]); sum += c; cnt += (c > 0u) ? 1u : 0u; mine = (j == x) ? c : mine; }
        if (sum == G) break;
        __builtin_amdgcn_s_sleep(1);
        if ((++sp & 255u) == 0u) { if (xb_ld(&bar[XB_TMO])) break; if (sp > XB_SPIN_CAP) { atomicAdd(&bar[XB_TMO], 1u); break; } }
    }
    nloc = mine > 0u ? mine : 1u; nx = cnt > 0u ? cnt : 1u;
}

__device__ __forceinline__ void xcd_barrier(const XcdBarrier& b) {
    asm volatile("s_waitcnt vmcnt(0)" ::: "memory");
    __syncthreads();
    if (threadIdx.x == 0) {
        unsigned* bar = b.bar;
        __builtin_amdgcn_s_waitcnt(0);
        unsigned nloc = b.st[0], nx = b.st[1];
        if (nloc == 0u) { xcd_barrier_complete(bar, b.x, nloc, nx); b.st[0] = nloc; b.st[1] = nx; }
        const unsigned old = xb_add(&bar[XB_XSUB(b.x)], 1u);
        const unsigned gen = old / nloc;
        if (old + 1u == (gen + 1u) * nloc) {
            __builtin_amdgcn_fence(__ATOMIC_RELEASE, "agent");
            asm volatile("s_waitcnt vmcnt(0)" ::: "memory");
            const unsigned og = xb_add(&bar[XB_TOP], 1u);
            const unsigned tg = og / nx;
            if (og + 1u == (tg + 1u) * nx) xb_add(&bar[XB_TOPGEN], 1u);
            else XB_SPIN(xb_ld(&bar[XB_TOPGEN]) == tg, bar);
            __builtin_amdgcn_fence(__ATOMIC_ACQUIRE, "agent");
            xb_add(&bar[XB_XGEN(b.x)], 1u);
            asm volatile("s_waitcnt vmcnt(0)" ::: "memory");
        } else {
            XB_SPIN(xb_ld(&bar[XB_XGEN(b.x)]) == gen, bar);
            __builtin_amdgcn_fence(__ATOMIC_ACQUIRE, "agent");
            asm volatile("s_waitcnt vmcnt(0)" ::: "memory");
        }
    }
    __syncthreads();
}

struct Frame {
    LAS unsigned char* lds;
    volatile LAS unsigned* MISC;
    gu32* ctl;
    int tid, lane, wave;
    int vcu, G;
    const float *x, *norm_mix, *norm_ffn, *hgrn_w_in, *lb_logits, *hgrn_out_norm, *hgrn_w_out, *attn_w_qkv, *attn_w_out, *ffn_w_in, *ffn_w_down, *final_norm;
    float* out;
    bf16 *Whin, *Whout, *Wqkv, *Wao, *Wf1, *Wf2;
    float *SS, *E1, *E2, *COS, *SIN, *LSE, *LB, *ST, *DJ;
    bf16 *XB, *QT, *KT, *VV, *GG, *FF, *QP, *KP, *VP;
};
__device__ __forceinline__ float wave_sum(float v) {
#pragma unroll
    for (int o = 1; o < 64; o <<= 1) v += __shfl_xor(v, o);
    return v;
}
__device__ __forceinline__ float bf_lo(unsigned u) { return __uint_as_float(u << 16); }
__device__ __forceinline__ float bf_hi(unsigned u) { return __uint_as_float(u & 0xffff0000u); }

__device__ __forceinline__ int pinv32(int l) { return 16 * ((l >> 2) & 1) + 4 * (l >> 3) + (l & 3); }
template <int MODE> __device__ __forceinline__ int phys_row(int c) {
    if (MODE == 0) return (c & ~31) + pinv32(c & 31);
    if (MODE == 1) { const int up = c >= DFF ? 1 : 0, j = c - up * DFF; return 256 * (j >> 7) + 128 * up + (j & 96) + pinv32(j & 31); }
    if (MODE == 2) {
        if (c >= 2 * AW) { const int cc = c - 2 * AW; return 256 * (12 + (cc >> 8)) + (cc & 224) + pinv32(cc & 31); }
        const int plane = c >= AW ? 1 : 0, cc = c - plane * AW, head = cc >> 7, d = cc & 127, half = d >> 6, j = d & 63;
        return 256 * (plane * 6 + (head >> 1)) + 128 * half + 32 * (2 * (head & 1) + (j >> 5)) + pinv32(j & 31);
    }
    { const int type = c >> 10, ch = c & 1023, chl = ch & 63; return 256 * (ch >> 6) + 128 * (type >> 1) + 32 * (chl >> 4) + 16 * (type & 1) + (chl & 15); }
}
template <int MODE>
__device__ __forceinline__ void p0_transpose_item(const float* W, int K, int N, bf16* WT, const float* gain, LAS float* scr, int item, int lane) {
    const int nblk = N / 32, kb = item / nblk, nb = item % nblk, k0 = 64 * kb, n0 = 32 * nb;
#pragma unroll 8
    for (int i = 0; i < 32; ++i) { const int kk = 2 * i + (lane >> 5); float w = W[(size_t)(k0 + kk) * N + n0 + (lane & 31)]; if (gain) w *= gain[k0 + kk]; scr[kk * 33 + (lane & 31)] = w; }
    LDS_WAIT(); asm volatile("" ::: "memory");
    const int c = lane & 7;
#pragma unroll
    for (int j = 0; j < 4; ++j) { const int n = (lane >> 3) + 8 * j; const LAS float* s = scr + (8 * c) * 33 + n;
        v4u o; o.x = pk2(s[0 * 33], s[1 * 33]); o.y = pk2(s[2 * 33], s[3 * 33]); o.z = pk2(s[4 * 33], s[5 * 33]); o.w = pk2(s[6 * 33], s[7 * 33]);
        *(GAS v4u*)(WT + (size_t)phys_row<MODE>(n0 + n) * K + k0 + 8 * c) = o; }
    LDS_WAIT(); asm volatile("" ::: "memory");
}
__device__ __forceinline__ void p0_prologue(Frame& F) {
    LAS float* scr = (LAS float*)(F.lds + RING_OFF + F.wave * 16384);
    const int gw = F.vcu * NWAVES + F.wave, NGW = F.G * NWAVES;
    constexpr int I_HIN = (D / 64) * (HIN / 32), I_HOUT = (D / 64) * (D / 32), I_QKV = (D / 64) * (QKVW / 32), I_AO = (AW / 64) * (D / 32), I_F1 = (D / 64) * (FF2 / 32), I_F2 = (DFF / 64) * (D / 32);
    constexpr int NITEMS = I_HIN + I_HOUT + I_QKV + I_AO + 2 * I_F1 + 2 * I_F2;
    for (int it = gw; it < NITEMS; it += NGW) {
        int r = it;
        if (r < I_HIN) { p0_transpose_item<3>(F.hgrn_w_in, D, HIN, F.Whin, F.norm_mix, scr, r, F.lane); continue; } r -= I_HIN;
        if (r < I_HOUT) { p0_transpose_item<0>(F.hgrn_w_out, D, D, F.Whout, nullptr, scr, r, F.lane); continue; } r -= I_HOUT;
        if (r < I_QKV) { p0_transpose_item<2>(F.attn_w_qkv, D, QKVW, F.Wqkv, F.norm_mix + D, scr, r, F.lane); continue; } r -= I_QKV;
        if (r < I_AO) { p0_transpose_item<0>(F.attn_w_out, AW, D, F.Wao, nullptr, scr, r, F.lane); continue; } r -= I_AO;
        if (r < 2 * I_F1) { const int l = r / I_F1; p0_transpose_item<1>(F.ffn_w_in + (size_t)l * D * FF2, D, FF2, F.Wf1 + (size_t)l * FF2 * D, F.norm_ffn + l * D, scr, r - l * I_F1, F.lane); continue; } r -= 2 * I_F1;
        { const int l = r / I_F2; p0_transpose_item<0>(F.ffn_w_down + (size_t)l * DFF * D, DFF, D, F.Wf2 + (size_t)l * D * DFF, nullptr, scr, r - l * I_F2, F.lane); }
    }
    for (int m = gw; m < M; m += NGW) {
        const GAS f32x4* xr = (const GAS f32x4*)(F.x + (size_t)m * D) + F.lane;
        GAS unsigned long long* o8 = (GAS unsigned long long*)(F.XB + (size_t)m * D) + F.lane;
        float s = 0.f;
#pragma unroll
        for (int j = 0; j < 4; ++j) { const f32x4 v = xr[64 * j]; s += (v.x * v.x + v.y * v.y) + (v.z * v.z + v.w * v.w); o8[64 * j] = (unsigned long long)pk2(v.x, v.y) | ((unsigned long long)pk2(v.z, v.w) << 32); }
        s = wave_sum(s);
        if (F.lane < 16) F.SS[(size_t)m * 16 + F.lane] = F.lane == 0 ? s : 0.f;
    }
    const int gt = F.vcu * NWAVES * 64 + F.tid, NGT = F.G * NWAVES * 64;
    for (int i = gt; i < T * 64; i += NGT) { const int pos = i >> 6, j = i & 63;
        const float inv = 1.0f / exp2f((float)j * (13.287712379549449f / 64.0f)); const float ang = (float)pos * inv;
        const double rev = (double)ang * 0.15915494309189535; const float fr = (float)(rev - floor(rev));
        F.COS[i] = __builtin_amdgcn_cosf(fr); F.SIN[i] = __builtin_amdgcn_sinf(fr); }
    if (gt < D) { const float a = F.lb_logits[gt], b = F.lb_logits[D + gt], c = F.lb_logits[2 * D + gt]; const float mx = fmaxf(a, fmaxf(b, c));
        const float ea = expf(a - mx), eb = expf(b - mx), ec = expf(c - mx); F.LB[gt] = ea / (ea + eb + ec); }
}

namespace hg {
typedef short bf16x8 __attribute__((ext_vector_type(8)));
typedef short s16x4 __attribute__((ext_vector_type(4)));
constexpr int TILE = 16384, BUF = 3 * TILE;
constexpr int OFF_F = 2 * BUF, OFF_PART = OFF_F + 1024;
constexpr int HG_LDS_BYTES = OFF_PART + 4096;
constexpr int SUPER = 8, NSUPER = T / (64 * SUPER), NITEM = BATCH * 8 * NSUPER;
__device__ __forceinline__ int swz(int row) { return ((row & 7) << 5) | (((row >> 3) & 1) << 4); }
__device__ __forceinline__ bf16x8 mk8(u32x2 a, u32x2 b) { v4u w = {a.x, a.y, b.x, b.y}; return __builtin_bit_cast(bf16x8, w); }
__device__ __forceinline__ bf16x8 mk8s(s16x4 a, s16x4 b) { return (bf16x8){a[0], a[1], a[2], a[3], b[0], b[1], b[2], b[3]}; }
__device__ __forceinline__ u32x2 pk4(const f32x4 a) { u32x2 w; w.x = pg8::cvt_pk_bf16(a[0], a[1]); w.y = pg8::cvt_pk_bf16(a[2], a[3]); return w; }
#define HG_TRRD(dst, addr, off) asm volatile("ds_read_b64_tr_b16 %0, %1 offset:%2" : "=&v"(dst) : "v"(addr), "i"(off) : "memory")
#define HG_LGKM0() do { asm volatile("s_waitcnt lgkmcnt(0)" ::: "memory"); __builtin_amdgcn_sched_barrier(0); } while (0)
#define HG_MFMA(a, b, c) __builtin_amdgcn_mfma_f32_16x16x32_bf16((a), (b), (c), 0, 0, 0)

template <bool PC>
__device__ __forceinline__ void item(Frame& F, int it, float* DJ) {
    const int tid = F.tid, lane = F.lane, w = F.wave, li = lane & 15, g = lane >> 4;
    const int bh = it / NSUPER, j = it - bh * NSUPER, b = bh >> 3, h = bh & 7;
    const size_t row0 = (size_t)b * T + (size_t)j * (64 * SUPER);
    const int chunk0 = (int)(row0 >> 6), hc = h * 128;
    LAS unsigned char* L = F.lds + RING_OFF;
    const int srow = tid >> 4, sc16 = tid & 15;
    const unsigned st_off = (unsigned)(srow * 256 + ((sc16 * 16) ^ swz(srow)));
    const size_t g_off = (size_t)srow * 1024 + hc + sc16 * 8;
    const int sr = swz(li);
    const unsigned rbase = (unsigned)(li * 256 + ((8 * g) ^ (sr & 16))), sEr = (unsigned)(sr & 0xE0);
    const int trow = 4 * g + (li >> 2), stt = swz(trow);
    const unsigned tbase = (unsigned)(trow * 256 + ((8 * (li & 3)) ^ (stt & 16))), sEt = (unsigned)(stt & 0xE0);
    const unsigned ldsb = (unsigned)(size_t)L;

    f32x4 S[8]; bf16x8 Sb[4];
    float dprod = 1.f;
    if (PC && j > 0) {
        const float* st = F.ST + ((size_t)it << 14) + (size_t)(w * 32) * 64 + lane;
#pragma unroll
        for (int kt = 0; kt < 8; ++kt) {
            const f32x4 e1 = *(const f32x4*)(F.E1 + (size_t)chunk0 * 1024 + hc + 16 * kt + 4 * g);
#pragma unroll
            for (int r = 0; r < 4; ++r) S[kt][r] = st[(kt * 4 + r) * 64] * e1[r];
        }
    } else {
#pragma unroll
        for (int kt = 0; kt < 8; ++kt) S[kt] = (f32x4){0.f, 0.f, 0.f, 0.f};
        if (!PC && tid < 128) dprod = F.E1[(size_t)chunk0 * 1024 + hc + tid];
    }
#pragma unroll
    for (int kp = 0; kp < 4; ++kp) Sb[kp] = mk8(pk4(S[2 * kp]), pk4(S[2 * kp + 1]));
    float gn[4];
#pragma unroll
    for (int r = 0; r < 4; ++r) gn[r] = PC ? F.hgrn_out_norm[16 * w + 4 * g + r] : 0.f;

    v4u sq0, sq1, sk0, sk1, sv0, sv1; float fe = 1.f;
#define HG_LOAD(cc) do { const size_t ro_ = (row0 + (size_t)(cc) * 64) * 1024 + g_off; \
        if (PC) { sq0 = *(const GAS v4u*)(F.QT + ro_); sq1 = *(const GAS v4u*)(F.QT + ro_ + 32 * 1024); } \
        sk0 = *(const GAS v4u*)(F.KT + ro_); sk1 = *(const GAS v4u*)(F.KT + ro_ + 32 * 1024); sv0 = *(const GAS v4u*)(F.VV + ro_); sv1 = *(const GAS v4u*)(F.VV + ro_ + 32 * 1024); \
        if (tid < 128) { fe = F.E2[(size_t)(chunk0 + (cc)) * 1024 + hc + tid]; if ((cc) < SUPER - 1) fe *= F.E1[(size_t)(chunk0 + (cc) + 1) * 1024 + hc + tid]; dprod *= fe; } } while (0)
#define HG_WRITE(bi) do { LAS unsigned char* B_ = L + (bi) * BUF + st_off; \
        if (PC) { *(LAS v4u*)B_ = sq0; *(LAS v4u*)(B_ + 8192) = sq1; } \
        *(LAS v4u*)(B_ + TILE) = sk0; *(LAS v4u*)(B_ + TILE + 8192) = sk1; *(LAS v4u*)(B_ + 2 * TILE) = sv0; *(LAS v4u*)(B_ + 2 * TILE + 8192) = sv1; \
        if (tid < 128) ((LAS float*)(L + OFF_F + (bi) * 512))[tid] = fe; } while (0)

    HG_LOAD(0); HG_WRITE(0);
    __syncthreads();
    for (int c = 0; c < SUPER; ++c) {
        const int bi = c & 1;
        u32x2 gg[4];
        if (c + 1 < SUPER) HG_LOAD(c + 1);
        if (PC) {
#pragma unroll
            for (int ti = 0; ti < 4; ++ti) gg[ti] = *(const GAS u32x2*)(F.GG + (row0 + (size_t)c * 64 + 16 * ti + li) * 1024 + hc + 16 * w + 4 * g);
        }
        const unsigned qb_ = ldsb + bi * BUF, kb_ = qb_ + TILE, vb_ = qb_ + 2 * TILE;
        LAS unsigned char* Qp = L + bi * BUF; LAS unsigned char* Kp = Qp + TILE;
        bf16x8 vf[2];
        { s16x4 a0, a1, a2, a3; const unsigned va = vb_ + tbase + ((32u * w) ^ sEt);
          HG_TRRD(a0, va, 0); HG_TRRD(a1, va, 4096); HG_TRRD(a2, va, 8192); HG_TRRD(a3, va, 12288); HG_LGKM0();
          vf[0] = mk8s(a0, a1); vf[1] = mk8s(a2, a3); }
        f32x4 O[4];
        if (PC) {
#pragma unroll
            for (int ti = 0; ti < 4; ++ti) {
                bf16x8 qf[4];
#pragma unroll
                for (int kp = 0; kp < 4; ++kp) { const LAS unsigned char* a = Qp + 4096 * ti + rbase;
                    qf[kp] = mk8(*(const LAS u32x2*)(a + ((64u * kp) ^ sEr)), *(const LAS u32x2*)(a + ((64u * kp + 32u) ^ sEr))); }
                f32x4 o = {0.f, 0.f, 0.f, 0.f};
#pragma unroll
                for (int kp = 0; kp < 4; ++kp) o = HG_MFMA(Sb[kp], qf[kp], o);
                __builtin_amdgcn_sched_barrier(0);
                f32x4 p[4];
#pragma unroll
                for (int si = 0; si < 4; ++si) { p[si] = (f32x4){0.f, 0.f, 0.f, 0.f};
                    if (si <= ti) {
#pragma unroll
                        for (int kp = 0; kp < 4; ++kp) { const LAS unsigned char* a = Kp + 4096 * si + rbase;
                            const bf16x8 kf = mk8(*(const LAS u32x2*)(a + ((64u * kp) ^ sEr)), *(const LAS u32x2*)(a + ((64u * kp + 32u) ^ sEr)));
                            p[si] = HG_MFMA(kf, qf[kp], p[si]); }
                    } }
#pragma unroll
                for (int r = 0; r < 4; ++r) if (4 * g + r > li) p[ti][r] = 0.f;
                o = HG_MFMA(vf[0], mk8(pk4(p[0]), pk4(p[1])), o);
                if (ti >= 2) o = HG_MFMA(vf[1], mk8(pk4(p[2]), pk4(p[3])), o);
                O[ti] = o;
                __builtin_amdgcn_sched_barrier(0);
            }
        }
#pragma unroll
        for (int kt = 0; kt < 8; ++kt) {
            s16x4 a0, a1, a2, a3; const unsigned ka = kb_ + tbase + ((32u * kt) ^ sEt);
            HG_TRRD(a0, ka, 0); HG_TRRD(a1, ka, 4096); HG_TRRD(a2, ka, 8192); HG_TRRD(a3, ka, 12288); HG_LGKM0();
            S[kt] = HG_MFMA(mk8s(a0, a1), vf[0], S[kt]); S[kt] = HG_MFMA(mk8s(a2, a3), vf[1], S[kt]);
        }
#pragma unroll
        for (int kt = 0; kt < 8; ++kt) S[kt] = S[kt] * *(const LAS f32x4*)(L + OFF_F + bi * 512 + (16 * kt + 4 * g) * 4);
#pragma unroll
        for (int kp = 0; kp < 4; ++kp) Sb[kp] = mk8(pk4(S[2 * kp]), pk4(S[2 * kp + 1]));
        LAS float* part = (LAS float*)(L + OFF_PART + bi * 2048);
        if (PC) {
#pragma unroll
            for (int ti = 0; ti < 4; ++ti) { float q = (O[ti][0] * O[ti][0] + O[ti][1] * O[ti][1]) + (O[ti][2] * O[ti][2] + O[ti][3] * O[ti][3]);
                q += __shfl_xor(q, 16); q += __shfl_xor(q, 32);
                if (g == 0) part[(16 * ti + li) * 8 + w] = q; }
        }
        if (c + 1 < SUPER) HG_WRITE(bi ^ 1);
        __syncthreads();
        if (PC) {
#pragma unroll
            for (int ti = 0; ti < 4; ++ti) {
                const f32x4 p0 = *(const LAS f32x4*)(part + (16 * ti + li) * 8), p1 = *(const LAS f32x4*)(part + (16 * ti + li) * 8 + 4);
                const float tot = ((p0[0] + p0[1]) + (p0[2] + p0[3])) + ((p1[0] + p1[1]) + (p1[2] + p1[3]));
                const float r = 1.0f / sqrtf(tot * (1.0f / 128.0f) + NORM_EPS);
                f32x4 o = O[ti] * r;
                o[0] *= gn[0] * bf_lo(gg[ti].x); o[1] *= gn[1] * bf_hi(gg[ti].x); o[2] *= gn[2] * bf_lo(gg[ti].y); o[3] *= gn[3] * bf_hi(gg[ti].y);
                *(GAS u32x2*)(F.QT + (row0 + (size_t)c * 64 + 16 * ti + li) * 1024 + hc + 16 * w + 4 * g) = pk4(o);
            }
        }
    }
    if (!PC) {
        float* st = F.ST + ((size_t)(it + 1) << 14) + (size_t)(w * 32) * 64 + lane;
#pragma unroll
        for (int kt = 0; kt < 8; ++kt)
#pragma unroll
            for (int r = 0; r < 4; ++r) st[(kt * 4 + r) * 64] = S[kt][r];
        if (tid < 128) DJ[it * 128 + tid] = dprod;
    }
    __syncthreads();
#undef HG_LOAD
#undef HG_WRITE
}
__device__ __forceinline__ void phase_a(Frame& F, float* DJ) {
    for (int it = F.vcu; it < NITEM; it += F.G) { if ((it % NSUPER) == NSUPER - 1) continue; item<false>(F, it, DJ); }
}
__device__ __forceinline__ void phase_b(Frame& F, const float* DJ) {
    const int gt = F.vcu * NWAVES * 64 + F.tid, NGT = F.G * NWAVES * 64;
    for (int e = gt; e < BATCH * 8 * 16384; e += NGT) {
        const int bh = e >> 14, idx = e & 16383, kr = (idx >> 6) & 31, k = 16 * (kr >> 2) + 4 * ((idx & 63) >> 4) + (kr & 3);
        float s = 0.f;
        for (int j = 0; j + 1 < NSUPER; ++j) { const size_t a = ((size_t)(bh * NSUPER + j + 1) << 14) + idx; s = DJ[(bh * NSUPER + j) * 128 + k] * s + F.ST[a]; F.ST[a] = s; }
    }
}
__device__ __forceinline__ void phase_c(Frame& F) {
    for (int it = F.vcu; it < NITEM; it += F.G) item<true>(F, it, nullptr);
}
#undef HG_TRRD
#undef HG_LGKM0
#undef HG_MFMA
}

__device__ __forceinline__ void hgrn_simple_rec(Frame& F, float* oraw) {
    const int item = F.wave * F.G + F.vcu;
    if (item >= 256) return;
    const int b = item >> 7, h = (item >> 4) & 7, vg = item & 15, kc = h * 128 + 2 * F.lane, vc = h * 128 + vg * 8;
    float S0[8], S1[8];
#pragma unroll
    for (int j = 0; j < 8; ++j) { S0[j] = 0.f; S1[j] = 0.f; }
    for (int c = 0; c < 128; ++c) {
        const int chunk = b * 128 + c;
        const float e1x = F.E1[(size_t)chunk * 1024 + kc], e1y = F.E1[(size_t)chunk * 1024 + kc + 1], e2x = F.E2[(size_t)chunk * 1024 + kc], e2y = F.E2[(size_t)chunk * 1024 + kc + 1];
#pragma unroll
        for (int j = 0; j < 8; ++j) { S0[j] *= e1x; S1[j] *= e1y; }
#pragma unroll 2
        for (int t = 0; t < 64; ++t) {
            const size_t row = (size_t)chunk * 64 + t;
            const unsigned kq = *(const GAS unsigned*)(F.KT + row * 1024 + kc), qq = *(const GAS unsigned*)(F.QT + row * 1024 + kc);
            const v4u vv = *(const GAS v4u*)(F.VV + row * 1024 + vc);
            const float k0 = bf_lo(kq), k1 = bf_hi(kq), q0 = bf_lo(qq), q1 = bf_hi(qq);
            const float v[8] = {bf_lo(vv.x), bf_hi(vv.x), bf_lo(vv.y), bf_hi(vv.y), bf_lo(vv.z), bf_hi(vv.z), bf_lo(vv.w), bf_hi(vv.w)};
            float part[8];
#pragma unroll
            for (int j = 0; j < 8; ++j) { S0[j] = fmaf(k0, v[j], S0[j]); S1[j] = fmaf(k1, v[j], S1[j]); part[j] = q0 * S0[j] + q1 * S1[j]; }
#pragma unroll
            for (int j = 0; j < 8; ++j) part[j] = wave_sum(part[j]);
            if (F.lane == 0) { float* o = oraw + row * 1024 + vc; *(f32x4*)o = (f32x4){part[0], part[1], part[2], part[3]}; *(f32x4*)(o + 4) = (f32x4){part[4], part[5], part[6], part[7]}; }
        }
#pragma unroll
        for (int j = 0; j < 8; ++j) { S0[j] *= e2x; S1[j] *= e2y; }
    }
}
__device__ __forceinline__ void hgrn_simple_post(Frame& F, const float* oraw) {
    const int gw = F.vcu * NWAVES + F.wave, NGW = F.G * NWAVES;
    const float gn0 = F.hgrn_out_norm[2 * F.lane], gn1 = F.hgrn_out_norm[2 * F.lane + 1];
    for (int it = gw; it < M * 8; it += NGW) {
        const size_t off = (size_t)(it >> 3) * 1024 + (it & 7) * 128 + 2 * F.lane;
        const float v0 = oraw[off], v1 = oraw[off + 1];
        const float r = 1.0f / sqrtf(wave_sum(v0 * v0 + v1 * v1) * (1.0f / 128.0f) + NORM_EPS);
        const unsigned g = *(const GAS unsigned*)(F.GG + off);
        *(GAS unsigned*)(F.QT + off) = pk2(v0 * r * gn0 * bf_lo(g), v1 * r * gn1 * bf_hi(g));
    }
}
__device__ __forceinline__ void attn_simple(Frame& F) {
    const int gw = F.vcu * NWAVES + F.wave, NGW = F.G * NWAVES;
    for (int it = gw; it < M * 12; it += NGW) {
        const int row = it / 12, hd = it - row * 12, t = row & (T - 1), g = hd >> 2, dil = g == 0 ? 1 : (g == 1 ? 4 : 16);
        const size_t co = (size_t)hd * 128 + 2 * F.lane;
        const unsigned qq = *(const GAS unsigned*)(F.QP + (size_t)row * AW + co);
        const float q0 = bf_lo(qq), q1 = bf_hi(qq);
        float m = -INFINITY, l = 0.f, o0 = 0.f, o1 = 0.f;
        for (int j = 0; j <= 128; ++j) {
            if (t - j * dil < 0) break;
            const size_t rk = (size_t)(row - j * dil) * AW + co;
            const unsigned kk = *(const GAS unsigned*)(F.KP + rk), vv = *(const GAS unsigned*)(F.VP + rk);
            const float s = wave_sum(q0 * bf_lo(kk) + q1 * bf_hi(kk)) * 0.08838834764831845f;
            const float mn = fmaxf(m, s), a = __expf(m - mn), p = __expf(s - mn);
            l = l * a + p; o0 = o0 * a + p * bf_lo(vv); o1 = o1 * a + p * bf_hi(vv); m = mn;
        }
        *(GAS unsigned*)(F.QP + (size_t)row * AW + co) = pk2(o0 / l, o1 / l);
        if (F.lane == 0) F.LSE[(size_t)row * 12 + hd] = m + logf(l);
    }
}
typedef swa::BlockRef<bf16, bf16> AttRef;
__device__ __forceinline__ AttRef attn_ref(const Frame& F, int L) {
    const int bh = L >> 5, x = L & 31, b = bh / 12, head = bh - b * 12, sh = 2 * (head >> 2), nqs = 5 - sh;
    const int r = x >> nqs, qb = x & ((1 << nqs) - 1);
    const size_t rowq = (size_t)b * T + r + ((size_t)qb * 256 << sh);
    AttRef R; R.Q = F.QP + rowq * AW + head * 128; R.P0 = qb * 256; R.sh = sh; R.lrow = (int)rowq * 12 + head;
    return R;
}
__device__ __forceinline__ void attn_fast(Frame& F, char* lds) {
    constexpr int NITEM = BATCH * 12 * 32, W = 129;
    int L = F.vcu; if (L >= NITEM) return;
    AttRef cur = attn_ref(F, L);
    swa::Seam<bf16> S;
    swa::causal_swa_prime<bf16, bf16>(cur, W, lds, S);
    for (;;) {
        const bool more = L + F.G < NITEM;
        const AttRef nxt = more ? attn_ref(F, L + F.G) : cur;
        swa::causal_swa_block<bf16, bf16>(cur, nxt, F.LSE, W, lds, S);
        if (!more) break;
        cur = nxt; L += F.G;
    }
}
__device__ __forceinline__ void attn_scale(Frame& F) {
    const int gt = F.vcu * NWAVES * 64 + F.tid, NGT = F.G * NWAVES * 64;
    for (int i = gt; i < M * (AW / 8); i += NGT) {
        const int row = i / (AW / 8), c8 = i - row * (AW / 8), hd = c8 >> 4, hg = hd & 3;
        const float* ls = F.LSE + (size_t)row * 12;
        const float a = ls[hg], b = ls[4 + hg], c = ls[8 + hg], mx = fmaxf(a, fmaxf(b, c));
        const float al = __expf(ls[hd] - mx) / (__expf(a - mx) + __expf(b - mx) + __expf(c - mx));
        GAS v4u* p = (GAS v4u*)(F.QP + (size_t)row * AW + c8 * 8);
        v4u v = *p;
        v.x = pk2(bf_lo(v.x) * al, bf_hi(v.x) * al); v.y = pk2(bf_lo(v.y) * al, bf_hi(v.y) * al); v.z = pk2(bf_lo(v.z) * al, bf_hi(v.z) * al); v.w = pk2(bf_lo(v.w) * al, bf_hi(v.w) * al);
        *p = v;
    }
}
__device__ __forceinline__ void final_norm_rows(Frame& F) {
    const int gw = F.vcu * NWAVES + F.wave, NGW = F.G * NWAVES;
    for (int m = gw; m < M; m += NGW) {
        const float s = wave_sum(F.lane < 16 ? F.SS[(size_t)m * 16 + F.lane] : 0.f);
        const float r = 1.0f / sqrtf(s * (1.0f / D) + NORM_EPS);
        const GAS v4u* xr = (const GAS v4u*)(F.XB + (size_t)m * D) + F.lane;
        GAS f32x4* o = (GAS f32x4*)(F.out + (size_t)m * D) + 2 * F.lane;
        const GAS f32x4* gr = (const GAS f32x4*)F.final_norm + 2 * F.lane;
#pragma unroll
        for (int j = 0; j < 2; ++j) { const v4u v = xr[64 * j]; const f32x4 g0 = gr[128 * j], g1 = gr[128 * j + 1];
            o[128 * j] = (f32x4){bf_lo(v.x) * r * g0.x, bf_hi(v.x) * r * g0.y, bf_lo(v.y) * r * g0.z, bf_hi(v.y) * r * g0.w};
            o[128 * j + 1] = (f32x4){bf_lo(v.z) * r * g1.x, bf_hi(v.z) * r * g1.y, bf_lo(v.w) * r * g1.z, bf_hi(v.w) * r * g1.w}; }
    }
}

__device__ __forceinline__ bool fresh(Frame& F) { int t = threadIdx.x; asm volatile("" : "+v"(t)); F.tid = t; F.lane = t & 63; F.wave = __builtin_amdgcn_readfirstlane(t >> 6); return true; }
struct Args { const float* in[12]; float* out; unsigned char* ws; int ph_lo, ph_hi; };
__global__ void __launch_bounds__(NWAVES * 64, 2) trunk_fwd(Args args) {
    extern __shared__ __attribute__((aligned(16))) unsigned char lds[];
    Frame F;
    F.lds = (LAS unsigned char*)lds;
    F.MISC = (volatile LAS unsigned*)(F.lds + MISC_OFF);
    F.tid = threadIdx.x; F.lane = F.tid & 63; F.wave = __builtin_amdgcn_readfirstlane(F.tid >> 6);
    F.G = gridDim.x; { const int bx = blockIdx.x; F.vcu = (F.G % 8 == 0) ? (bx % 8) * (F.G / 8) + bx / 8 : bx; }
    unsigned char* ws = args.ws;
    F.ctl = (gu32*)(ws + WS_CTL);
    F.x = args.in[0]; F.norm_mix = args.in[1]; F.norm_ffn = args.in[2]; F.hgrn_w_in = args.in[3]; F.lb_logits = args.in[4]; F.hgrn_out_norm = args.in[5]; F.hgrn_w_out = args.in[6];
    F.attn_w_qkv = args.in[7]; F.attn_w_out = args.in[8]; F.ffn_w_in = args.in[9]; F.ffn_w_down = args.in[10]; F.final_norm = args.in[11]; F.out = args.out;
    F.Whin = (bf16*)(ws + WS_WHIN); F.Whout = (bf16*)(ws + WS_WHOUT); F.Wqkv = (bf16*)(ws + WS_WQKV); F.Wao = (bf16*)(ws + WS_WAO); F.Wf1 = (bf16*)(ws + WS_WF1); F.Wf2 = (bf16*)(ws + WS_WF2);
    F.SS = (float*)(ws + WS_SS); F.E1 = (float*)(ws + WS_E1); F.E2 = (float*)(ws + WS_E2); F.COS = (float*)(ws + WS_COS); F.SIN = (float*)(ws + WS_SIN); F.LSE = (float*)(ws + WS_LSE); F.LB = (float*)(ws + WS_LB); F.DJ = (float*)(ws + WS_LB + 4096); F.ST = (float*)(ws + WS_ST);
    F.XB = (bf16*)(ws + WS_XB); F.QT = (bf16*)(ws + WS_QT); F.KT = (bf16*)(ws + WS_KT); F.VV = (bf16*)(ws + WS_VV); F.GG = (bf16*)(ws + WS_GG); F.FF = (bf16*)(ws + WS_FF);
    F.QP = (bf16*)(ws + WS_QP); F.KP = (bf16*)(ws + WS_KP); F.VP = (bf16*)(ws + WS_VP);
    for (int u = F.tid; u < (LDS_BYTES - LDSCTL_OFF) / 4; u += NWAVES * 64) ((LAS unsigned*)(F.lds + LDSCTL_OFF))[u] = 0u;
    __syncthreads();
    XcdBarrier bar; bar.bar = (unsigned*)(F.ctl + CW_BAR); bar.x = 0; bar.st = nullptr;
    if (!MK_PER_PHASE) bar = xcd_barrier_post((unsigned*)(F.ctl + CW_BAR), F.MISC + 8);
    const int lo = args.ph_lo, hi = args.ph_hi;
#define IN(k) (lo <= (k) && (k) < hi && fresh(F))
#ifndef PROBE_A
#define PROBE_A -1
#define PROBE_B -1
#endif
#define SEAM(k) do { if (IN(k) && IN((k) + 1)) xcd_barrier(bar); if (PROBE_A >= 0 && blockIdx.x == 0 && F.tid == 0) ((unsigned long long*)(ws + WS_LB + 4096 + 256 * 1024))[(k) + 1] = __builtin_amdgcn_s_memrealtime(); } while (0)
    using pg8::Gemm; using pg8::StaticOrder;
#define RUN_GEMM(EPI, Aptr, Bptr, N_, K_, E) do { Gemm g{(const pg8::bf16_t*)(Aptr), (const pg8::bf16_t*)(Bptr), M, (N_), (K_)}; StaticOrder S; S.init(M, (N_), F.G, (int)blockIdx.x); \
        pg8::gemm_phase<EPI, StaticOrder, true, true>(F.lds + RING_OFF, g, S, E); } while (0)

    if (PROBE_A >= 0 && blockIdx.x == 0 && F.tid == 0) ((unsigned long long*)(ws + WS_LB + 4096 + 256 * 1024))[0] = __builtin_amdgcn_s_memrealtime();
    if (IN(0)) { p0_prologue(F); } SEAM(0);
    if (IN(1)) { pg8::EpiHgrnIn E{F.QT, F.KT, F.VV, F.GG, F.E1, F.E2, F.SS, F.LB}; RUN_GEMM(pg8::EpiHgrnIn, F.XB, F.Whin, HIN, D, E); } SEAM(1);
    if (IN(2)) { hg::phase_a(F, F.DJ); } SEAM(2);
    if (IN(3)) { hg::phase_b(F, F.DJ); } SEAM(3);
    if (IN(4)) { hg::phase_c(F); } SEAM(4);
    if (IN(5)) { pg8::EpiRes E{F.XB, F.SS}; RUN_GEMM(pg8::EpiRes, F.QT, F.Whout, D, D, E); } SEAM(5);
    if (IN(6)) { pg8::EpiSwiglu E{F.FF, F.SS}; RUN_GEMM(pg8::EpiSwiglu, F.XB, F.Wf1, FF2, D, E); } SEAM(6);
    if (IN(7)) { pg8::EpiRes E{F.XB, F.SS}; RUN_GEMM(pg8::EpiRes, F.FF, F.Wf2, D, DFF, E); } SEAM(7);
    if (IN(8)) { pg8::EpiQkv E{F.QP, F.KP, F.VP, F.SS, F.COS, F.SIN}; RUN_GEMM(pg8::EpiQkv, F.XB, F.Wqkv, QKVW, D, E); } SEAM(8);
    if (IN(9)) { attn_fast(F, (char*)lds); } SEAM(9);
    if (IN(10)) { attn_scale(F); } SEAM(10);
    if (IN(11)) { pg8::EpiRes E{F.XB, F.SS}; RUN_GEMM(pg8::EpiRes, F.QP, F.Wao, D, AW, E); } SEAM(11);
    if (IN(12)) { pg8::EpiSwiglu E{F.FF, F.SS}; RUN_GEMM(pg8::EpiSwiglu, F.XB, F.Wf1 + (size_t)FF2 * D, FF2, D, E); } SEAM(12);
    if (IN(13)) { pg8::EpiRes E{F.XB, F.SS}; RUN_GEMM(pg8::EpiRes, F.FF, F.Wf2 + (size_t)D * DFF, D, DFF, E); } SEAM(13);
    if (IN(14)) { final_norm_rows(F); }
    if (PROBE_A >= 0) {
        if (blockIdx.x == 0 && F.tid == 0) ((unsigned long long*)(ws + WS_LB + 4096 + 256 * 1024))[15] = __builtin_amdgcn_s_memrealtime();
        xcd_barrier(bar);
        const unsigned long long* ts = (const unsigned long long*)(ws + WS_LB + 4096 + 256 * 1024);
        if (blockIdx.x == 0 && F.tid == 0) F.out[0] += (float)(ts[PROBE_B] - ts[PROBE_A]) * 0.0025f;
    }
#undef IN
#undef SEAM
#undef RUN_GEMM
}

extern "C" void kernel_launch(void* const* d_in, const int* in_sizes, int n_in, void* d_out, int out_size, void* d_ws, size_t ws_size, hipStream_t stream) {
    static int grid = 0;
    if (grid == 0) {
        if (n_in != 12 || in_sizes[0] != M * D || out_size != M * D || ws_size < WS_END) { fprintf(stderr, "kernel_launch: unexpected shapes (n_in %d, in0 %d, out %d, ws %zu); nothing launched\n", n_in, n_in > 0 ? in_sizes[0] : -1, out_size, ws_size); grid = -1; return; }
        int dev = 0, cus = 0, per_cu = 0;
        if (hipGetDevice(&dev) != hipSuccess || hipDeviceGetAttribute(&cus, hipDeviceAttributeMultiprocessorCount, dev) != hipSuccess) { grid = -1; return; }
        if (hipFuncSetAttribute((const void*)trunk_fwd, hipFuncAttributeMaxDynamicSharedMemorySize, LDS_BYTES) != hipSuccess) { fprintf(stderr, "kernel_launch: hipFuncSetAttribute failed\n"); grid = -1; return; }
        if (hipOccupancyMaxActiveBlocksPerMultiprocessor(&per_cu, (const void*)trunk_fwd, NWAVES * 64, LDS_BYTES) != hipSuccess || per_cu < 1)
            fprintf(stderr, "kernel_launch: note: the occupancy query reports %d workgroups per CU\n", per_cu);
        (void)hipGetLastError();
        grid = cus;
    }
    if (grid < 0) return;
    if (hipMemsetAsync((char*)d_ws + WS_CTL, 0, CTL_ZERO_BYTES, stream) != hipSuccess) { fprintf(stderr, "kernel_launch: hipMemsetAsync failed\n"); return; }
    Args a{};
    for (int i = 0; i < 12; ++i) a.in[i] = (const float*)d_in[i];
    a.out = (float*)d_out; a.ws = (unsigned char*)d_ws;
#if MK_PER_PHASE
    for (int p = 0; p < NPH; ++p) { a.ph_lo = p; a.ph_hi = p + 1; hipLaunchKernelGGL(trunk_fwd, dim3(grid), dim3(NWAVES * 64), LDS_BYTES, stream, a); }
#else
    a.ph_lo = 0; a.ph_hi = NPH; hipLaunchKernelGGL(trunk_fwd, dim3(grid), dim3(NWAVES * 64), LDS_BYTES, stream, a);
#endif
    const hipError_t le = hipPeekAtLastError();
    if (le != hipSuccess) fprintf(stderr, "kernel_launch: launch failed: %s (grid %d)\n", hipGetErrorName(le), grid);
}
```

```cpp
#include <hip/hip_runtime.h>
#include <cstdio>
#include <cstdint>
#include <math.h>

constexpr int BATCH = 2, T = 8192, D = 1024, M = BATCH * T;
constexpr int HIN = 4096, DFF = 2816, FF2 = 2 * DFF, QKVW = 4608, AW = 1536;
constexpr float NORM_EPS = 1e-6f;

namespace pg8 {
#define PG8_LAS __attribute__((address_space(3)))
typedef unsigned short bf16_t;
typedef short bf16x8 __attribute__((ext_vector_type(8)));
typedef float f32x4 __attribute__((ext_vector_type(4)));
typedef unsigned u32x4 __attribute__((ext_vector_type(4)));
constexpr int BM = 256, BK = 64, HALF = 128, HTB = HALF * BK * 2  , STAGE_BYTES = 8 * HTB, NXCD = 8, WGM = 8;

__host__ __device__ __forceinline__ int lds_byte(int r, int c) { const int st = (r >> 4) * 2 + (c >> 5), rr = r & 15, cc = c & 31, ob = rr * 64 + cc * 2; return st * 1024 + (ob ^ (((ob >> 9) & 1) << 5)); }
__host__ __device__ __forceinline__ void stage_rc(int b, int& R, int& C) { const int st = b / 1024, sb = b % 1024, swz = sb ^ (((sb >> 9) & 1) << 5); R = (st >> 1) * 16 + swz / 64; C = (st & 1) * 32 + (swz % 64) / 2; }
__host__ __device__ __forceinline__ int perm32(int rho) { const int n = rho >> 4, i = rho & 15; return 8 * (i >> 2) + 4 * n + (i & 3); }

struct Unit { int pm, pn; };
struct Gemm { const bf16_t* A; const bf16_t* Bt; int M, N, K; };

struct StaticOrder {
    int nM, nN, nwg, G, c;
    __host__ __device__ void init(int M, int N, int G_, int c_) { nM = M / BM; nN = N / BM; nwg = nM * nN; G = G_; c = c_; }
    __host__ __device__ bool next(int i, Unit& u) const {
        const long L = (long)i * G + c; if (L >= nwg) return false;
        int wgid = (int)L; { const int q = nwg / NXCD, r = nwg % NXCD, xcd = wgid % NXCD, off = wgid / NXCD; wgid = (xcd < r ? xcd * (q + 1) : r * (q + 1) + (xcd - r) * q) + off; }
        const int nig = WGM * nN, gid = wgid / nig, fm = gid * WGM, gsz = (nM - fm) < WGM ? (nM - fm) : WGM;
        u.pm = fm + ((wgid % nig) % gsz); u.pn = (wgid % nig) / gsz; return true;
    }
    __device__ __forceinline__ void a_ready(const Unit&) const {}
    __device__ __forceinline__ void done(const Unit&) const {}
};


typedef float f32x2 __attribute__((ext_vector_type(2)));
typedef __bf16 bf16x2_t __attribute__((ext_vector_type(2)));
__device__ __forceinline__ unsigned cvt_pk_bf16(float lo, float hi) { const f32x2 v = {lo, hi}; return __builtin_bit_cast(unsigned, __builtin_convertvector(v, bf16x2_t)); }
typedef unsigned u32x2 __attribute__((ext_vector_type(2)));
__device__ __forceinline__ u32x4 pack8(const f32x4 a, const f32x4 b) { u32x4 w; w.x = cvt_pk_bf16(a[0], a[1]); w.y = cvt_pk_bf16(a[2], a[3]); w.z = cvt_pk_bf16(b[0], b[1]); w.w = cvt_pk_bf16(b[2], b[3]); return w; }
__device__ __forceinline__ u32x2 pack4(const f32x4 a) { u32x2 w; w.x = cvt_pk_bf16(a[0], a[1]); w.y = cvt_pk_bf16(a[2], a[3]); return w; }
__device__ __forceinline__ float silu_f(float x) { return x * __builtin_amdgcn_rcpf(1.0f + __expf(-x)); }
__device__ __forceinline__ f32x4 silu4(const f32x4 x) { f32x4 r; r[0] = silu_f(x[0]); r[1] = silu_f(x[1]); r[2] = silu_f(x[2]); r[3] = silu_f(x[3]); return r; }
__device__ __forceinline__ float row_rstd(const float* ss, int row, int fq) {
    const f32x4 p = *(const f32x4*)(ss + (size_t)row * 16 + 4 * fq);
    float s = (p[0] + p[1]) + (p[2] + p[3]);
    s += __shfl_xor(s, 16); s += __shfl_xor(s, 32);
    return 1.0f / sqrtf(s * (1.0f / 1024.0f) + NORM_EPS);
}
template <int CTRL> __device__ __forceinline__ float dpp_f(float x) { return __builtin_bit_cast(float, __builtin_amdgcn_update_dpp(0, __builtin_bit_cast(int, x), CTRL, 0xf, 0xf, true)); }

struct EpiRes {
    static constexpr bool PERM = false, AFTER_DRAIN = false, KHOOK = false;
    bf16_t* xb; float* ss;
    __device__ __forceinline__ void operator()(const f32x4 (&acc)[2][2][4][2], const Unit& u, int wr, int wc, int fr, int fq) const {
        const int colb = u.pn * BM + wc * 32 + 8 * fq;
#pragma unroll
        for (int ai = 0; ai < 2; ++ai)
#pragma unroll
            for (int m = 0; m < 4; ++m) {
                const int row = u.pm * BM + ai * HALF + wr * 64 + m * 16 + fr;
                float sq = 0.f;
#pragma unroll
                for (int bj = 0; bj < 2; ++bj) {
                    bf16_t* p = xb + (size_t)row * 1024 + colb + bj * HALF;
                    const u32x4 b = *(const u32x4*)p;
                    f32x4 v0 = acc[ai][bj][m][0], v1 = acc[ai][bj][m][1];
                    v0[0] += __uint_as_float(b.x << 16); v0[1] += __uint_as_float(b.x & 0xffff0000u); v0[2] += __uint_as_float(b.y << 16); v0[3] += __uint_as_float(b.y & 0xffff0000u);
                    v1[0] += __uint_as_float(b.z << 16); v1[1] += __uint_as_float(b.z & 0xffff0000u); v1[2] += __uint_as_float(b.w << 16); v1[3] += __uint_as_float(b.w & 0xffff0000u);
                    *(u32x4*)p = pack8(v0, v1);
                    sq += (v0[0] * v0[0] + v0[1] * v0[1]) + (v0[2] * v0[2] + v0[3] * v0[3]) + (v1[0] * v1[0] + v1[1] * v1[1]) + (v1[2] * v1[2] + v1[3] * v1[3]);
                }
                sq += __shfl_xor(sq, 16); sq += __shfl_xor(sq, 32);
                if (fq == 0) ss[(size_t)row * 16 + u.pn * 4 + wc] = sq;
            }
    }
};
struct EpiResMerge {
    static constexpr bool PERM = false, AFTER_DRAIN = false, KHOOK = true;
    bf16_t* xb; float* ss; const PG8_LAS float* rt;
    __device__ __forceinline__ void khook(f32x4 (&acc)[2][2][4][2], int t, int wr, int fr) const {
        if (t == 4 || t == 10 || t == 16) { const int idx = t == 4 ? 0 : (t == 10 ? 1 : 2);
#pragma unroll
            for (int ai = 0; ai < 2; ++ai)
#pragma unroll
                for (int m = 0; m < 4; ++m) { const float f = rt[(ai * HALF + wr * 64 + m * 16 + fr) * 4 + idx];
#pragma unroll
                    for (int bj = 0; bj < 2; ++bj) { acc[ai][bj][m][0] = acc[ai][bj][m][0] * f; acc[ai][bj][m][1] = acc[ai][bj][m][1] * f; } } }
    }
    __device__ __forceinline__ void operator()(const f32x4 (&acc)[2][2][4][2], const Unit& u, int wr, int wc, int fr, int fq) const {
        const int colb = u.pn * BM + wc * 32 + 8 * fq;
#pragma unroll
        for (int ai = 0; ai < 2; ++ai)
#pragma unroll
            for (int m = 0; m < 4; ++m) {
                const int row = u.pm * BM + ai * HALF + wr * 64 + m * 16 + fr;
                const float f = rt[(ai * HALF + wr * 64 + m * 16 + fr) * 4 + 3];
                float sq = 0.f;
#pragma unroll
                for (int bj = 0; bj < 2; ++bj) {
                    bf16_t* p = xb + (size_t)row * 1024 + colb + bj * HALF;
                    const u32x4 b = *(const u32x4*)p;
                    f32x4 v0 = acc[ai][bj][m][0] * f, v1 = acc[ai][bj][m][1] * f;
                    v0[0] += __uint_as_float(b.x << 16); v0[1] += __uint_as_float(b.x & 0xffff0000u); v0[2] += __uint_as_float(b.y << 16); v0[3] += __uint_as_float(b.y & 0xffff0000u);
                    v1[0] += __uint_as_float(b.z << 16); v1[1] += __uint_as_float(b.z & 0xffff0000u); v1[2] += __uint_as_float(b.w << 16); v1[3] += __uint_as_float(b.w & 0xffff0000u);
                    *(u32x4*)p = pack8(v0, v1);
                    sq += (v0[0] * v0[0] + v0[1] * v0[1]) + (v0[2] * v0[2] + v0[3] * v0[3]) + (v1[0] * v1[0] + v1[1] * v1[1]) + (v1[2] * v1[2] + v1[3] * v1[3]);
                }
                sq += __shfl_xor(sq, 16); sq += __shfl_xor(sq, 32);
                if (fq == 0) ss[(size_t)row * 16 + u.pn * 4 + wc] = sq;
            }
    }
};
struct EpiSwiglu {
    static constexpr bool PERM = false, AFTER_DRAIN = false, KHOOK = false;
    bf16_t* act; const float* ss;
    __device__ __forceinline__ void operator()(const f32x4 (&acc)[2][2][4][2], const Unit& u, int wr, int wc, int fr, int fq) const {
        const int colb = u.pn * 128 + wc * 32 + 8 * fq;
#pragma unroll
        for (int ai = 0; ai < 2; ++ai)
#pragma unroll
            for (int m = 0; m < 4; ++m) {
                const int row = u.pm * BM + ai * HALF + wr * 64 + m * 16 + fr;
                const float r = row_rstd(ss, row, fq);
                const f32x4 a0 = silu4(acc[ai][0][m][0] * r) * (acc[ai][1][m][0] * r), a1 = silu4(acc[ai][0][m][1] * r) * (acc[ai][1][m][1] * r);
                *(u32x4*)(act + (size_t)row * DFF + colb) = pack8(a0, a1);
            }
    }
};
struct EpiQkv {
    static constexpr bool PERM = false, AFTER_DRAIN = false, KHOOK = false;
    bf16_t* Q; bf16_t* K; bf16_t* V; const float* ss; const float* cosT; const float* sinT;
    __device__ __forceinline__ void operator()(const f32x4 (&acc)[2][2][4][2], const Unit& u, int wr, int wc, int fr, int fq) const {
        if (u.pn < 12) {
            bf16_t* P = u.pn < 6 ? Q : K;
            const int j0 = (wc & 1) * 32 + 8 * fq, tcol = (u.pn % 6) * 256 + (wc >> 1) * 128 + j0;
#pragma unroll
            for (int ai = 0; ai < 2; ++ai)
#pragma unroll
                for (int m = 0; m < 4; ++m) {
                    const int row = u.pm * BM + ai * HALF + wr * 64 + m * 16 + fr;
                    const float r = row_rstd(ss, row, fq);
                    const size_t tb = (size_t)(row & (T - 1)) * 64 + j0;
                    const f32x4 c0 = *(const f32x4*)(cosT + tb), c1 = *(const f32x4*)(cosT + tb + 4), s0 = *(const f32x4*)(sinT + tb), s1 = *(const f32x4*)(sinT + tb + 4);
                    const f32x4 x1a = acc[ai][0][m][0] * r, x1b = acc[ai][0][m][1] * r, x2a = acc[ai][1][m][0] * r, x2b = acc[ai][1][m][1] * r;
                    bf16_t* p = P + (size_t)row * AW + tcol;
                    *(u32x4*)p = pack8(x1a * c0 - x2a * s0, x1b * c1 - x2b * s1);
                    *(u32x4*)(p + 64) = pack8(x2a * c0 + x1a * s0, x2b * c1 + x1b * s1);
                }
        } else {
            const int tcol = (u.pn - 12) * 256 + wc * 32 + 8 * fq;
#pragma unroll
            for (int ai = 0; ai < 2; ++ai)
#pragma unroll
                for (int m = 0; m < 4; ++m) {
                    const int row = u.pm * BM + ai * HALF + wr * 64 + m * 16 + fr;
                    const float r = row_rstd(ss, row, fq);
#pragma unroll
                    for (int bj = 0; bj < 2; ++bj) *(u32x4*)(V + (size_t)row * AW + tcol + bj * HALF) = pack8(acc[ai][bj][m][0] * r, acc[ai][bj][m][1] * r);
                }
        }
    }
};
struct EpiHgrnIn {
    static constexpr bool PERM = false, AFTER_DRAIN = false, KHOOK = false;
    bf16_t *QT, *KT, *VV, *GG; float *E1, *E2; const float* ss; const float* lb;
    __device__ __forceinline__ void operator()(const f32x4 (&acc)[2][2][4][2], const Unit& u, int wr, int wc, int fr, int fq) const {
        const int ch0 = u.pn * 64 + wc * 16 + 4 * fq;
        const f32x4 lbv = *(const f32x4*)(lb + ch0);
#pragma unroll
        for (int ai = 0; ai < 2; ++ai) {
            const int rowb = u.pm * BM + ai * HALF + wr * 64;
            float rs[4];
#pragma unroll
            for (int m = 0; m < 4; ++m) rs[m] = row_rstd(ss, rowb + m * 16 + fr, fq);
            f32x4 kv[4], bc[4], run = {0.f, 0.f, 0.f, 0.f};
#pragma unroll
            for (int m = 0; m < 4; ++m) {
                const f32x4 fz = acc[ai][0][m][1] * rs[m];
#pragma unroll
                for (int e = 0; e < 4; ++e) {
                    const float tt = __expf(-fmaxf(fz[e], -80.f)), inv = __builtin_amdgcn_rcpf(1.0f + tt);
                    const float oml = 1.0f - lbv[e];
                    const float fg = lbv[e] + oml * inv;
                    kv[m][e] = oml * (tt * inv);
                    float x = __logf(fg);
                    x += dpp_f<0x111>(x); x += dpp_f<0x112>(x); x += dpp_f<0x114>(x); x += dpp_f<0x118>(x);
                    const float tot = __shfl(x, 15, 16);
                    bc[m][e] = x + run[e]; run[e] += tot;
                }
            }
            f32x4 ref;
#pragma unroll
            for (int e = 0; e < 4; ++e) ref[e] = __shfl(bc[1][e], 15, 16);
            if (fr == 0) {
                const int chunk = rowb >> 6; f32x4 e1, e2;
#pragma unroll
                for (int e = 0; e < 4; ++e) { e1[e] = __expf(ref[e]); e2[e] = __expf(run[e] - ref[e]); }
                *(f32x4*)(E1 + (size_t)chunk * 1024 + ch0) = e1; *(f32x4*)(E2 + (size_t)chunk * 1024 + ch0) = e2;
            }
#pragma unroll
            for (int m = 0; m < 4; ++m) {
                const size_t off = (size_t)(rowb + m * 16 + fr) * 1024 + ch0;
                f32x4 qv = silu4(acc[ai][0][m][0] * rs[m]), kk = kv[m];
#pragma unroll
                for (int e = 0; e < 4; ++e) { const float dl = bc[m][e] - ref[e]; qv[e] *= __expf(dl); kk[e] *= __expf(-dl); }
                *(u32x2*)(QT + off) = pack4(qv); *(u32x2*)(KT + off) = pack4(kk);
                *(u32x2*)(VV + off) = pack4(acc[ai][1][m][0] * rs[m]); *(u32x2*)(GG + off) = pack4(silu4(acc[ai][1][m][1] * rs[m]));
            }
        }
    }
};

template <class Epi, class Sched, bool ALIGN_EPI = false, bool SP2 = false>
__device__ __forceinline__ void gemm_phase(PG8_LAS unsigned char* lds, const Gemm g, const Sched& S, const Epi& E) {
    int tid = threadIdx.x; asm volatile("" : "+v"(tid));
    const int wid = __builtin_amdgcn_readfirstlane(tid >> 6), lane = tid & 63, wr = wid >> 2, wc = wid & 3, fr = lane & 15, fq = lane >> 4;
    const int K = g.K, nt = K / BK;
    unsigned voffA[2], voffB[2];
#pragma unroll
    for (int i = 0; i < 2; ++i) { int R, C; stage_rc(tid * 16 + i * 8192, R, C); const int Rb = Epi::PERM ? ((R & ~31) + perm32(R & 31)) : R;
        voffA[i] = (unsigned)(R * K + C) * 2u; voffB[i] = (unsigned)(Rb * K + C) * 2u; }
    const size_t kstep = (size_t)(BK * 2);
    const size_t hstep = (size_t)HALF * K * 2;
    const size_t tstep = 2 * hstep;
    const unsigned ldsw = (unsigned)wid * 1024u;
    const int aoff = lds_byte(wr * 64 + fr, fq * 8), boff = lds_byte(wc * 32 + fr, fq * 8);
#define PG8_SA(b, h) (((b) * 2 + (h)) * HTB)
#define PG8_SB(b, h) ((4 + (b) * 2 + (h)) * HTB)
#define PG8_STAGE(bufoff, gbase, voff) do { _Pragma("unroll") for (int _i = 0; _i < 2; ++_i) \
        __builtin_amdgcn_global_load_lds((const unsigned*)((const char*)(gbase) + (voff)[_i]), (PG8_LAS unsigned*)(lds + (bufoff) + ldsw + _i * 8192), 16, 0, 0); } while (0)
#define PG8_LDA(dst, b, h) do { _Pragma("unroll") for (int m = 0; m < 4; ++m) _Pragma("unroll") for (int k = 0; k < 2; ++k) dst[m][k] = *(const PG8_LAS bf16x8*)(lds + PG8_SA(b, h) + aoff + m * 2048 + k * 1024); } while (0)
#define PG8_LDB(dst, b, h) do { _Pragma("unroll") for (int n = 0; n < 2; ++n) _Pragma("unroll") for (int k = 0; k < 2; ++k) dst[n][k] = *(const PG8_LAS bf16x8*)(lds + PG8_SB(b, h) + boff + n * 2048 + k * 1024); } while (0)
#define PG8_MMA(ai, bj, At, Bt) do { __builtin_amdgcn_s_setprio(1); _Pragma("unroll") for (int m = 0; m < 4; ++m) _Pragma("unroll") for (int n = 0; n < 2; ++n) _Pragma("unroll") for (int k = 0; k < 2; ++k) \
        acc[ai][bj][m][n] = __builtin_amdgcn_mfma_f32_16x16x32_bf16(Bt[n][k], At[m][k], acc[ai][bj][m][n], 0, 0, 0); __builtin_amdgcn_s_setprio(0); } while (0)
#define PG8_WAIT_V(n) asm volatile("s_waitcnt vmcnt(" #n ")" ::: "memory")
#define PG8_WAIT_L(n) asm volatile("s_waitcnt lgkmcnt(" #n ")" ::: "memory")
#define PG8_BAR __builtin_amdgcn_s_barrier()
#define PG8_SCHED __builtin_amdgcn_sched_barrier(0)
    Unit cur, nxt; int ui = 0;
    if (!S.next(0, cur)) return;
    f32x4 acc[2][2][4][2];
#pragma unroll
    for (int a = 0; a < 2; ++a)
#pragma unroll
        for (int b = 0; b < 2; ++b)
#pragma unroll
            for (int m = 0; m < 4; ++m)
#pragma unroll
                for (int n = 0; n < 2; ++n) acc[a][b][m][n] = (f32x4){0.f, 0.f, 0.f, 0.f};
    bf16x8 At[4][2], B0[2][2], B1[2][2];
    const char* cA = (const char*)g.A + (size_t)cur.pm * tstep; const char* cB = (const char*)g.Bt + (size_t)cur.pn * tstep;
    S.a_ready(cur);
    if constexpr (SP2) {
        PG8_STAGE(PG8_SB(0, 0), cB, voffB); PG8_STAGE(PG8_SB(0, 1), cB + hstep, voffB); PG8_STAGE(PG8_SA(0, 0), cA, voffA); PG8_STAGE(PG8_SA(0, 1), cA + hstep, voffA);
        if (wr == 1) PG8_BAR;
        PG8_WAIT_V(2); PG8_BAR;
        PG8_STAGE(PG8_SB(1, 0), cB + kstep, voffB); PG8_STAGE(PG8_SA(1, 0), cA + kstep, voffA); PG8_STAGE(PG8_SB(1, 1), cB + hstep + kstep, voffB);
        PG8_WAIT_V(6); PG8_BAR;
    } else {
        PG8_STAGE(PG8_SB(0, 0), cB, voffB); PG8_STAGE(PG8_SA(0, 0), cA, voffA); PG8_STAGE(PG8_SB(0, 1), cB + hstep, voffB); PG8_STAGE(PG8_SA(0, 1), cA + hstep, voffA);
        if (wr == 1) PG8_BAR;
        PG8_WAIT_V(4); PG8_BAR;
        PG8_STAGE(PG8_SB(1, 0), cB + kstep, voffB); PG8_STAGE(PG8_SA(1, 0), cA + kstep, voffA); PG8_STAGE(PG8_SB(1, 1), cB + hstep + kstep, voffB);
        PG8_WAIT_V(6); PG8_BAR;
    }
    for (;;) {
        const bool has_next = S.next(ui + 1, nxt);
        const char* nA = has_next ? (const char*)g.A + (size_t)nxt.pm * tstep : cA; const char* nB = has_next ? (const char*)g.Bt + (size_t)nxt.pn * tstep : cB;
        for (int t = 0; t < nt; t += 2) {
            const bool last = (t == nt - 2);
            const char* a1 = cA + (size_t)(t + 1) * kstep;
            const char* a2 = last ? nA : cA + (size_t)(t + 2) * kstep; const char* b2 = last ? nB : cB + (size_t)(t + 2) * kstep;
            const char* a3 = a2 + kstep; const char* b3 = b2 + kstep;
            if (last && has_next) S.a_ready(nxt);
            if constexpr (SP2) {
            PG8_LDB(B0, 0, 0); PG8_LDB(B1, 0, 1); PG8_SCHED; PG8_LDA(At, 0, 0); PG8_STAGE(PG8_SA(1, 1), a1 + hstep, voffA);
            PG8_WAIT_V(8); PG8_WAIT_L(0); PG8_BAR; PG8_MMA(0, 0, At, B0); PG8_MMA(0, 1, At, B1); PG8_BAR; PG8_SCHED;
            PG8_LDA(At, 0, 1); PG8_STAGE(PG8_SB(0, 0), b2, voffB); PG8_STAGE(PG8_SB(0, 1), b2 + hstep, voffB); PG8_STAGE(PG8_SA(0, 0), a2, voffA);
            PG8_WAIT_V(8); PG8_WAIT_L(0); PG8_BAR; PG8_MMA(1, 0, At, B0); PG8_MMA(1, 1, At, B1); PG8_BAR; PG8_SCHED;
            PG8_LDB(B0, 1, 0); PG8_LDB(B1, 1, 1); PG8_SCHED; PG8_LDA(At, 1, 0); PG8_STAGE(PG8_SA(0, 1), a2 + hstep, voffA);
            PG8_WAIT_V(8); PG8_WAIT_L(0); PG8_BAR; PG8_MMA(0, 0, At, B0); PG8_MMA(0, 1, At, B1); PG8_BAR; PG8_SCHED;
            PG8_LDA(At, 1, 1); PG8_STAGE(PG8_SB(1, 0), b3, voffB); PG8_STAGE(PG8_SB(1, 1), b3 + hstep, voffB); PG8_STAGE(PG8_SA(1, 0), a3, voffA);
            PG8_WAIT_V(8); PG8_WAIT_L(0); PG8_BAR; PG8_MMA(1, 0, At, B0); PG8_MMA(1, 1, At, B1); PG8_BAR; PG8_SCHED;
            if constexpr (Epi::KHOOK) E.khook(acc, t, wr, fr);
            } else {
            PG8_LDB(B0, 0, 0); PG8_SCHED; PG8_LDA(At, 0, 0); PG8_STAGE(PG8_SA(1, 1), a1 + hstep, voffA);
            PG8_WAIT_L(8); PG8_BAR; PG8_WAIT_L(0); PG8_MMA(0, 0, At, B0); PG8_BAR; PG8_SCHED;
            PG8_LDB(B1, 0, 1); PG8_STAGE(PG8_SB(0, 0), b2, voffB);
            PG8_BAR; PG8_WAIT_L(0); PG8_MMA(0, 1, At, B1); PG8_BAR;
            PG8_LDA(At, 0, 1); PG8_STAGE(PG8_SA(0, 0), a2, voffA);
            PG8_BAR; PG8_WAIT_L(0); PG8_MMA(1, 0, At, B0); PG8_BAR; PG8_SCHED;
            PG8_STAGE(PG8_SB(0, 1), b2 + hstep, voffB);
            PG8_WAIT_V(6); PG8_BAR; PG8_MMA(1, 1, At, B1); PG8_BAR;
            PG8_LDB(B0, 1, 0); PG8_SCHED; PG8_LDA(At, 1, 0); PG8_STAGE(PG8_SA(0, 1), a2 + hstep, voffA);
            PG8_WAIT_L(8); PG8_BAR; PG8_WAIT_L(0); PG8_MMA(0, 0, At, B0); PG8_BAR; PG8_SCHED;
            PG8_LDB(B1, 1, 1); PG8_STAGE(PG8_SB(1, 0), b3, voffB);
            PG8_BAR; PG8_WAIT_L(0); PG8_MMA(0, 1, At, B1); PG8_BAR;
            PG8_LDA(At, 1, 1); PG8_STAGE(PG8_SA(1, 0), a3, voffA);
            PG8_BAR; PG8_WAIT_L(0); PG8_MMA(1, 0, At, B0); PG8_BAR; PG8_SCHED;
            PG8_STAGE(PG8_SB(1, 1), b3 + hstep, voffB);
            PG8_WAIT_V(6); PG8_BAR; PG8_MMA(1, 1, At, B1); PG8_BAR;
            if constexpr (Epi::KHOOK) E.khook(acc, t, wr, fr);
            }
        }
        if constexpr (ALIGN_EPI) { if (wr == 0) PG8_BAR; }
        if constexpr (!Epi::AFTER_DRAIN) { E(acc, cur, wr, wc, fr, fq); S.done(cur); }
        if (!has_next) break;
#pragma unroll
        for (int a = 0; a < 2; ++a)
#pragma unroll
            for (int b = 0; b < 2; ++b)
#pragma unroll
                for (int m = 0; m < 4; ++m)
#pragma unroll
                    for (int n = 0; n < 2; ++n) acc[a][b][m][n] = (f32x4){0.f, 0.f, 0.f, 0.f};
        cur = nxt; cA = nA; cB = nB; ++ui;
        if constexpr (ALIGN_EPI) { if (wr == 1) PG8_BAR; }
    }
    PG8_WAIT_V(0);
    if constexpr (!ALIGN_EPI) { if (wr == 0) PG8_BAR; }
    PG8_BAR;
    if constexpr (Epi::AFTER_DRAIN) { E.fused(acc, cur, wr, wc, fr, fq, lds, wid, lane); S.done(cur); }
#undef PG8_SA
#undef PG8_SB
#undef PG8_STAGE
#undef PG8_LDA
#undef PG8_LDB
#undef PG8_MMA
#undef PG8_WAIT_V
#undef PG8_WAIT_L
#undef PG8_BAR
#undef PG8_SCHED
}
}


constexpr int NWAVES = 8;
#ifndef MK_PER_PHASE
#define MK_PER_PHASE 0
#endif
constexpr int NPH = 14;

constexpr size_t MiB = 1u << 20;
constexpr size_t WS_CTL = 0, CTL_ZERO_BYTES = 64 * 1024;
constexpr size_t WS_WHIN = 1 * MiB, WS_WHOUT = 9 * MiB, WS_WQKV = 11 * MiB, WS_WAO = 20 * MiB, WS_WF1 = 23 * MiB, WS_WF2 = 45 * MiB;
constexpr size_t WS_SS = 56 * MiB, WS_E1 = 57 * MiB, WS_E2 = 58 * MiB, WS_COS = 59 * MiB, WS_SIN = 61 * MiB, WS_LSE = 63 * MiB, WS_LB = 63 * MiB + 768 * 1024;
constexpr size_t WS_ST = 64 * MiB;
constexpr size_t WS_XB = 80 * MiB;
constexpr size_t WS_ACT = 112 * MiB;
constexpr size_t WS_QT = WS_ACT, WS_KT = WS_ACT + 32 * MiB, WS_VV = WS_ACT + 64 * MiB, WS_GG = WS_ACT + 96 * MiB;
constexpr size_t WS_FF = WS_ACT;
constexpr size_t WS_QP = WS_ACT, WS_KP = WS_ACT + 48 * MiB, WS_VP = WS_ACT + 96 * MiB;
constexpr size_t WS_END = 256 * MiB;
static_assert(WS_VP + (size_t)M * AW * 2 <= WS_END && WS_FF + (size_t)M * DFF * 2 <= WS_END && WS_GG + (size_t)M * D * 2 <= WS_END, "d_ws map");
static_assert(WS_WF2 + 2 * (size_t)D * DFF * 2 <= WS_SS && WS_WF1 + 2 * (size_t)FF2 * D * 2 <= WS_WF2 && WS_WAO + (size_t)D * AW * 2 <= WS_WF1 && WS_WQKV + (size_t)QKVW * D * 2 <= WS_WAO, "weights map");
constexpr int CW_TMO = 0, CW_BAR = 4096;

constexpr int RING_OFF = 0, RING_BYTES = 131072;
constexpr int LDSCTL_OFF = RING_BYTES, MISC_OFF = LDSCTL_OFF + 320;
constexpr int MERGE_OFF = RING_BYTES + 4096;
constexpr int LDS_BYTES = 147456;
namespace swa {
constexpr float SCALE = 0.08838834764831845f;
constexpr int D = 128; constexpr bool WSKIP = true; constexpr float THR = 8.f;
constexpr int PLANE_PITCH = AW, SEQ_T = T; constexpr size_t K_FROM_Q = (WS_KP - WS_QP) / 2, V_FROM_K = (WS_VP - WS_KP) / 2;
constexpr int NW = 8, QBLK = 32, KVBLK = 64, QB = NW * QBLK;
constexpr int SHM_V = KVBLK * D * 2, SHM_K = KVBLK * D * 2, ATT_LDS_BYTES = 2 * SHM_V + 2 * SHM_K + NW * 64 * 4;
typedef unsigned short bf16;
typedef short bf16x8 __attribute__((ext_vector_type(8)));
typedef short s16x4 __attribute__((ext_vector_type(4)));
typedef float f32x16 __attribute__((ext_vector_type(16)));
typedef float f32x4 __attribute__((ext_vector_type(4)));
typedef unsigned u32x4 __attribute__((ext_vector_type(4)));
template <class A, class Bt> struct same_t { static constexpr bool v = false; };
template <class A> struct same_t<A, A> { static constexpr bool v = true; };

#define KSWZ(row, colB) ((row) * 256 + ((colB) ^ (((row) & 7) << 4)))
#define SBAR() __builtin_amdgcn_sched_barrier(0)
__device__ __forceinline__ int v_st(int k, int c) { const int kk = (k & ~0xC) | ((k & 4) << 1) | ((k & 8) >> 1); return ((kk >> 3) * 4 + (c >> 5)) * 512 + ((kk & 7) * 32 + (c & 31)) * 2; }
__device__ __forceinline__ int v_rd_base(int lane) { return ((lane & 3) << 3) | (((lane >> 2) & 3) << 6) | (((lane >> 4) & 1) << 5) | (((lane >> 5) & 1) << 8); }
constexpr int v_rd_off(int d0, int ks, int half) { return d0 * 512 + ks * 4096 + half * 2048; }
__device__ __forceinline__ int crow(int r, int hi) { return (r & 3) + 8 * (r >> 2) + 4 * hi; }
__device__ __forceinline__ unsigned cvtpk(float lo, float hi) {
    unsigned r; asm volatile("v_cvt_pk_bf16_f32 %0, %1, %2" : "=v"(r) : "v"(lo), "v"(hi)); return r;
}
__device__ __forceinline__ bf16x8 pack8(f32x4 a, f32x4 b) {
    u32x4 w = {cvtpk(a[0], a[1]), cvtpk(a[2], a[3]), cvtpk(b[0], b[1]), cvtpk(b[2], b[3])};
    return *reinterpret_cast<bf16x8*>(&w);
}
template <class T> __device__ __forceinline__ bf16x8 load8(const T* p) {
    if constexpr (same_t<T, float>::v) { return pack8(*(const f32x4*)p, *(const f32x4*)(p + 4)); }
    else { return *reinterpret_cast<const bf16x8*>(p); }
}
__device__ __forceinline__ void mask_tile(f32x16& p0, f32x16& p1, int dq, unsigned W) {
    const float NEG = -__builtin_inff();
#pragma unroll
    for (int r = 0; r < 16; ++r) {
        const int c = (r & 3) + 8 * (r >> 2);
        if ((unsigned)(dq - c) >= W) p0[r] = NEG;
        if ((unsigned)(dq - c - 32) >= W) p1[r] = NEG;
    }
}
__device__ __forceinline__ void partialSM(f32x16& p0, f32x16& p1, float& m_reg, float& mn, float& alpha) {
    float pmax = p0[0]; for (int r = 1; r < 16; ++r) pmax = fmaxf(pmax, p0[r]); for (int r = 0; r < 16; ++r) pmax = fmaxf(pmax, p1[r]);
    { auto rr = __builtin_amdgcn_permlane32_swap(__float_as_uint(pmax), __float_as_uint(pmax), false, false);
      pmax = fmaxf(__uint_as_float(rr[0]), __uint_as_float(rr[1])); }
    constexpr float C2 = 1.4426950408889634f * SCALE;
    if (__builtin_expect(__all((pmax - m_reg) * SCALE <= THR), 1)) { mn = m_reg; alpha = 1.f; }
    else { mn = fmaxf(m_reg, pmax); alpha = __builtin_amdgcn_exp2f((m_reg - mn) * C2); m_reg = mn; }
    const float mnL = -mn * C2;
    for (int r = 0; r < 16; ++r) p0[r] = fmaf(p0[r], C2, mnL); for (int r = 0; r < 16; ++r) p1[r] = fmaf(p1[r], C2, mnL);
    for (int r = 0; r < 16; ++r) p0[r] = __builtin_amdgcn_exp2f(p0[r]);
}
__device__ __forceinline__ void finishSM(f32x16& p0, f32x16& p1, float alpha, float& l_reg, bf16x8& pa0, bf16x8& pa1, bf16x8& pa2, bf16x8& pa3) {
    for (int r = 0; r < 16; ++r) p1[r] = __builtin_amdgcn_exp2f(p1[r]);
    float ps = 0; for (int r = 0; r < 16; ++r) ps += p0[r]; for (int r = 0; r < 16; ++r) ps += p1[r];
    { auto rr = __builtin_amdgcn_permlane32_swap(__float_as_uint(ps), __float_as_uint(ps), false, false);
      ps = __uint_as_float(rr[0]) + __uint_as_float(rr[1]); }
    l_reg = l_reg * alpha + ps;
#define PK4(P, B_, OUT) do { unsigned a0 = cvtpk(P[B_+0], P[B_+1]), a1 = cvtpk(P[B_+2], P[B_+3]);                          \
        unsigned b0 = cvtpk(P[B_+4], P[B_+5]), b1 = cvtpk(P[B_+6], P[B_+7]);                                             \
        auto r0 = __builtin_amdgcn_permlane32_swap(a0, b0, false, false); auto r1 = __builtin_amdgcn_permlane32_swap(a1, b1, false, false); \
        u32x4 w = {r0[0], r1[0], r0[1], r1[1]}; OUT = *reinterpret_cast<bf16x8*>(&w); } while (0)
    PK4(p0, 0, pa0); PK4(p0, 8, pa1); PK4(p1, 0, pa2); PK4(p1, 8, pa3);
#undef PK4
}
template <int KB, bool SK>
__device__ __forceinline__ void qkt(f32x16& p0, f32x16& p1, const char* K_lds, int r32, int hi, const bf16x8* qr, bool act) {
    if (SK && !act) { const float NEG = -__builtin_inff();
#pragma unroll
        for (int r = 0; r < 16; ++r) { p0[r] = NEG; p1[r] = NEG; } return; }
    p0 = f32x16{}; p1 = f32x16{};
    const char* kb[4];
#pragma unroll
    for (int dd = 0; dd < 4; ++dd) kb[dd] = K_lds + KB * SHM_K + KSWZ(r32, (dd * 16 + hi * 8) * 2);
#pragma unroll
    for (int d0 = 0; d0 < 8; ++d0) { const char* a = kb[d0 & 3] + (d0 >> 2) * 128;
        bf16x8 b0 = *reinterpret_cast<const bf16x8*>(a);
        bf16x8 b1 = *reinterpret_cast<const bf16x8*>(a + 32 * 256);
        p0 = __builtin_amdgcn_mfma_f32_32x32x16_bf16(b0, qr[d0], p0, 0, 0, 0);
        p1 = __builtin_amdgcn_mfma_f32_32x32x16_bf16(b1, qr[d0], p1, 0, 0, 0); }
}
template <int VB, bool SK>
__device__ __forceinline__ void pv_tile(f32x16* o, int vb0, bf16x8 pa0, bf16x8 pa1, bf16x8 pa2, bf16x8 pa3, bool act) {
    if (SK && !act) return;
#define TRRD(dst, off) asm volatile("ds_read_b64_tr_b16 %0, %1 offset:%2" : "=&v"(dst) : "v"(vb0), "i"(off) : "memory")
#define PV_D0(d0) do { s16x4 l0, l1, l2, l3, h0, h1, h2, h3; constexpr int b_ = VB * SHM_V + v_rd_off(d0, 0, 0);     \
        TRRD(l0, b_); TRRD(h0, b_ + 2048); TRRD(l1, b_ + 4096); TRRD(h1, b_ + 6144); TRRD(l2, b_ + 8192); TRRD(h2, b_ + 10240); TRRD(l3, b_ + 12288); TRRD(h3, b_ + 14336); \
        asm volatile("s_waitcnt lgkmcnt(0)" ::: "memory"); SBAR();                 \
        o[d0] = __builtin_amdgcn_mfma_f32_32x32x16_bf16(pa0, (bf16x8){l0[0], l0[1], l0[2], l0[3], h0[0], h0[1], h0[2], h0[3]}, o[d0], 0, 0, 0);   \
        o[d0] = __builtin_amdgcn_mfma_f32_32x32x16_bf16(pa1, (bf16x8){l1[0], l1[1], l1[2], l1[3], h1[0], h1[1], h1[2], h1[3]}, o[d0], 0, 0, 0);   \
        o[d0] = __builtin_amdgcn_mfma_f32_32x32x16_bf16(pa2, (bf16x8){l2[0], l2[1], l2[2], l2[3], h2[0], h2[1], h2[2], h2[3]}, o[d0], 0, 0, 0);   \
        o[d0] = __builtin_amdgcn_mfma_f32_32x32x16_bf16(pa3, (bf16x8){l3[0], l3[1], l3[2], l3[3], h3[0], h3[1], h3[2], h3[3]}, o[d0], 0, 0, 0); } while (0)
    PV_D0(0); PV_D0(1); PV_D0(2); PV_D0(3);
#undef PV_D0
#undef TRRD
}

template <class TIn, class TOut> struct BlockRef { const TIn* Q; int P0, sh, lrow;
    __device__ __forceinline__ int pitch() const { return PLANE_PITCH << sh; }
    __device__ __forceinline__ const TIn* K() const { return Q + K_FROM_Q - (size_t)P0 * (size_t)pitch(); }
    __device__ __forceinline__ const TIn* V() const { return K() + V_FROM_K; }
    __device__ __forceinline__ int skv() const { return SEQ_T >> sh; }
    __device__ __forceinline__ int lp() const { return 12 << sh; } };
template <class TIn> struct Seam {
    bf16x8 qr[8];
    bf16x8 st_v0, st_v1, st_k0, st_k1; f32x4 sf0, sf1, sf2, sf3;
    f32x4 tq[16];
};
__device__ __forceinline__ int swa_jlo(int P0, int W) { const int lowk = P0 - W + 1; return lowk > 0 ? lowk / KVBLK : 0; }
#define ROW(p, k0, rr, kp_) ((p) + (size_t)((k0) + (rr)) * (kp_) + sc)
#define VMW() asm volatile("s_waitcnt vmcnt(0)" ::: "memory")
#define VMWN(n) asm volatile("s_waitcnt vmcnt(%0)" :: "i"(n) : "memory")
#define SLOAD_H(Kp, Vp, k0, kp_) do { S.st_v0 = load8<TIn>(ROW(Vp, k0, sr, kp_)); S.st_v1 = load8<TIn>(ROW(Vp, k0, 32 + sr, kp_));              \
                         S.st_k0 = load8<TIn>(ROW(Kp, k0, sr, kp_)); S.st_k1 = load8<TIn>(ROW(Kp, k0, 32 + sr, kp_)); } while (0)
#define SWRITE_HK(bf) do { *(bf16x8*)(K_lds + (bf) * SHM_K + kws) = S.st_k0; *(bf16x8*)(K_lds + (bf) * SHM_K + kws + 32 * 256) = S.st_k1; } while (0)
#define SWRITE_HV(bf) do { *(bf16x8*)(V_lds + (bf) * SHM_V + vst0) = S.st_v0; *(bf16x8*)(V_lds + (bf) * SHM_V + vst1) = S.st_v1; } while (0)
#define SWRITE_H(bf) do { SWRITE_HV(bf); SWRITE_HK(bf); } while (0)
#define SLOAD_F(p, k0) do { S.sf0 = *(const f32x4*)ROW(p, k0, sr, D); S.sf1 = *(const f32x4*)(ROW(p, k0, sr, D) + 4);                \
                            S.sf2 = *(const f32x4*)ROW(p, k0, 32 + sr, D); S.sf3 = *(const f32x4*)(ROW(p, k0, 32 + sr, D) + 4); } while (0)
#define SWRITE_KF(bf) do { *(bf16x8*)(K_lds + (bf) * SHM_K + kws) = pack8(S.sf0, S.sf1); *(bf16x8*)(K_lds + (bf) * SHM_K + kws + 32 * 256) = pack8(S.sf2, S.sf3); } while (0)
#define SWRITE_VF(bf) do { *(bf16x8*)(V_lds + (bf) * SHM_V + vst0) = pack8(S.sf0, S.sf1); *(bf16x8*)(V_lds + (bf) * SHM_V + vst1) = pack8(S.sf2, S.sf3); } while (0)
template <class TIn, class TOut>
__device__ __forceinline__ void causal_swa_prime(const BlockRef<TIn, TOut>& cur, int W, char* lds, Seam<TIn>& S) {
    constexpr bool F32 = same_t<TIn, float>::v;
    const int tid = threadIdx.x, wid = __builtin_amdgcn_readfirstlane(tid >> 6), lane = tid & 63, r32 = lane & 31, hi = lane >> 5;
    const int sr = tid >> 4, sc = (tid & 15) * 8, kws = KSWZ(sr, sc * 2); char* K_lds = lds + 2 * SHM_V;
    const int kb0 = swa_jlo(cur.P0, W) * KVBLK;
    for (int d0 = 0; d0 < 8; ++d0) S.qr[d0] = load8<TIn>(cur.Q + (size_t)(wid * QBLK + r32) * cur.pitch() + d0 * 16 + hi * 8);
    if constexpr (F32) { SLOAD_F((const float*)cur.K(), kb0); VMW(); SWRITE_KF(0); SBAR(); SLOAD_F((const float*)cur.V(), kb0); }
    else { SLOAD_H(cur.K(), cur.V(), kb0, cur.pitch()); VMW(); SWRITE_HK(0); }
    __syncthreads();
}
template <class TIn, class TOut>
__device__ __forceinline__ void causal_swa_block(const BlockRef<TIn, TOut>& cur, const BlockRef<TIn, TOut>& nxt, float* lse, int W, char* lds, Seam<TIn>& S) {
    const int skv = cur.skv();
    constexpr bool F32 = same_t<TIn, float>::v;
    const int tid = threadIdx.x, wid = __builtin_amdgcn_readfirstlane(tid >> 6), lane = tid & 63, r32 = lane & 31, hi = lane >> 5;
    const int j_lo = swa_jlo(cur.P0, W);
    int j_hi = (cur.P0 + QB - 1) / KVBLK + 1; if (j_hi > skv / KVBLK) j_hi = skv / KVBLK;
    const int NT = j_hi - j_lo;
    const int kbn = swa_jlo(nxt.P0, W) * KVBLK;
    const int qlo = cur.P0 + wid * QBLK, qm = qlo + r32 - 4 * hi;
    char* V_lds = lds; char* K_lds = lds + 2 * SHM_V;
    float* ws = (float*)(lds + 2 * SHM_V + 2 * SHM_K) + wid * 64; float* li_l = ws, * al_l = ws + 32;
    float m_reg = -1e30f, l_reg = 0; f32x16 o[4] = {};
    const int sr = tid >> 4, sc = (tid & 15) * 8, vst0 = v_st(sr, sc), vst1 = v_st(32 + sr, sc), kws = KSWZ(sr, sc * 2);
    const int vb0 = (int)(uintptr_t)V_lds + v_rd_base(lane);
    const TIn* Kh = cur.K(); const TIn* Vh = Kh + V_FROM_K; const int kpc = cur.pitch();
#define RESC(a) do { if (__any((a) < 1.f)) { if (hi == 0) al_l[r32] = (a); asm volatile("s_waitcnt lgkmcnt(0)" ::: "memory");              \
                     for (int d_ = 0; d_ < 4; ++d_) for (int r = 0; r < 16; ++r) o[d_][r] *= al_l[crow(r, hi)]; } } while (0)
#define KBASE(t) ((j_lo + (t)) * KVBLK)
#define ACT(t) (KBASE(t) <= qlo + QBLK - 1 && KBASE(t) + KVBLK - 1 >= qlo - W + 1)
#define MASKT(P0_, P1_, t) do { const int kb_ = KBASE(t); if ((!SK || ACT(t)) && (kb_ + KVBLK - 1 > qlo || kb_ <= qlo + QBLK - 1 - W)) mask_tile(P0_, P1_, qm - kb_, (unsigned)W); } while (0)
    constexpr int NQL = F32 ? 16 : 8;
    constexpr bool SK = WSKIP && !F32;
#define SEAM_K0() do { VMWN(NQL); if constexpr (F32) { SWRITE_KF(0); SBAR(); SLOAD_F((const float*)nxt.V(), kbn); } else { SWRITE_HK(0); } SBAR(); } while (0)
    f32x16 pA0, pA1, pB0, pB1; float mnA, mnB, alA, alB; bf16x8 pa0, pa1, pa2, pa3;
    if constexpr (F32) { VMW(); SWRITE_VF(0); SBAR(); } else { SWRITE_HV(0); SBAR(); }
    if (NT > 1) { if constexpr (F32) SLOAD_F((const float*)Kh, KBASE(1)); else SLOAD_H(Kh, Vh, KBASE(1), kpc); }
    SBAR(); qkt<0, SK>(pA0, pA1, K_lds, r32, hi, S.qr, ACT(0));
    if constexpr (F32) { if (NT > 1) { VMW(); SWRITE_KF(1); SBAR(); SLOAD_F((const float*)Vh, KBASE(1)); } }
    MASKT(pA0, pA1, 0); partialSM(pA0, pA1, m_reg, mnA, alA);
    if (NT > 1) { VMW(); if constexpr (F32) { SWRITE_VF(1); SBAR(); if (NT > 2) SLOAD_F((const float*)Kh, KBASE(2)); } else SWRITE_H(1); }
    __syncthreads();
#define HALF_STEP(PX0, PX1, mnX, alX, PY0, PY1, alY, t, KB, VB, SB) do {                                                      \
        SBAR(); qkt<KB, SK>(PX0, PX1, K_lds, r32, hi, S.qr, ACT(t));                                             \
        finishSM(PY0, PY1, alY, l_reg, pa0, pa1, pa2, pa3); SBAR();                                                           \
        if ((t) + 1 < NT) { if constexpr (F32) { VMW(); SWRITE_KF(SB); SBAR(); SLOAD_F((const float*)Vh, KBASE((t) + 1)); }  \
                            else { SLOAD_H(Kh, Vh, KBASE((t) + 1), kpc); } SBAR(); }                                               \
        pv_tile<VB, SK>(o, vb0, pa0, pa1, pa2, pa3, ACT((t) - 1)); MASKT(PX0, PX1, (t)); partialSM(PX0, PX1, m_reg, mnX, alX);                                        \
        __syncthreads();                                                                                                      \
        if ((t) + 1 < NT) { VMW(); if constexpr (F32) { SWRITE_VF(SB); SBAR(); if ((t) + 2 < NT) SLOAD_F((const float*)Kh, KBASE((t) + 2)); } \
                            else { SWRITE_H(SB); } }                                                                          \
        RESC(alX); __syncthreads(); } while (0)
    for (int t = 1; t + 1 < NT; t += 2) {
        HALF_STEP(pB0, pB1, mnB, alB, pA0, pA1, alA, t, 1, 0, 0);
        HALF_STEP(pA0, pA1, mnA, alA, pB0, pB1, alB, t + 1, 0, 1, 1);
    }
    const bool even = (NT & 1) == 0;
    if (even) { SBAR(); qkt<1, SK>(pB0, pB1, K_lds, r32, hi, S.qr, ACT(NT - 1)); SBAR(); }
#define QROW(e) (nxt.Q + (size_t)(wid * QBLK + r32) * nxt.pitch() + ((e) >> 1) * 16 + hi * 8 + ((e) & 1) * 4)
    if constexpr (F32) { SLOAD_F((const float*)nxt.K(), kbn); SBAR();
#pragma unroll
        for (int e = 0; e < 8; ++e) S.tq[e] = *(const f32x4*)QROW(e); }
    else { SLOAD_H(nxt.K(), nxt.V(), kbn, nxt.pitch()); SBAR();
#pragma unroll
        for (int d0 = 0; d0 < 8; ++d0) S.qr[d0] = load8<TIn>(nxt.Q + (size_t)(wid * QBLK + r32) * nxt.pitch() + d0 * 16 + hi * 8); }
    SBAR();
    finishSM(pA0, pA1, alA, l_reg, pa0, pa1, pa2, pa3); SBAR();
    if constexpr (F32) {
#pragma unroll
        for (int e = 8; e < 16; ++e) S.tq[e] = *(const f32x4*)QROW(e); SBAR(); }
#undef QROW
    pv_tile<0, SK>(o, vb0, pa0, pa1, pa2, pa3, ACT(even ? NT - 2 : NT - 1));
    if (even) { MASKT(pB0, pB1, NT - 1); partialSM(pB0, pB1, m_reg, mnB, alB); __syncthreads(); RESC(alB);
        finishSM(pB0, pB1, alB, l_reg, pa0, pa1, pa2, pa3); SBAR(); pv_tile<1, SK>(o, vb0, pa0, pa1, pa2, pa3, ACT(NT - 1)); }
    SBAR(); SEAM_K0();
    if (hi == 0) li_l[r32] = __expf(m_reg * SCALE); asm volatile("s_waitcnt lgkmcnt(0)" ::: "memory");
    float rli[16];
#pragma unroll
    for (int r = 0; r < 16; ++r) rli[r] = li_l[crow(r, hi)];
    TOut* Ow = (TOut*)cur.Q + (size_t)(wid * QBLK) * kpc;
    if (hi == 0) lse[(size_t)cur.lrow + (size_t)(wid * QBLK + r32) * cur.lp()] = m_reg * SCALE + __logf(l_reg);
#pragma unroll
    for (int r = 0; r < 16; ++r) { const int orow = crow(r, hi);
#pragma unroll
        for (int d0 = 0; d0 < 4; ++d0) { const float v = o[d0][r] * rli[r];
            if constexpr (same_t<TOut, float>::v) { Ow[(size_t)orow * kpc + d0 * 32 + r32] = v; }
            else { const float vn = __shfl_xor(v, 1);
                   if ((r32 & 1) == 0) *(unsigned*)(Ow + (size_t)orow * kpc + d0 * 32 + r32) = cvtpk(v, vn); } } }
    if constexpr (F32) {
#pragma unroll
        for (int d0 = 0; d0 < 8; ++d0) S.qr[d0] = pack8(S.tq[2 * d0], S.tq[2 * d0 + 1]); }
    __syncthreads();
#undef RESC
#undef KBASE
#undef ACT
#undef MASKT
#undef SEAM_K0
#undef HALF_STEP
}
#undef ROW
#undef VMW
#undef VMWN
#undef SLOAD_H
#undef SWRITE_HK
#undef SWRITE_HV
#undef SWRITE_H
#undef SLOAD_F
#undef SWRITE_KF
#undef SWRITE_VF


}

#define GAS __attribute__((address_space(1)))
#define LAS __attribute__((address_space(3)))
typedef unsigned short bf16;
typedef unsigned v4u __attribute__((ext_vector_type(4)));
typedef unsigned u32x2 __attribute__((ext_vector_type(2)));
typedef float f32x4 __attribute__((ext_vector_type(4)));
typedef short bf16x8 __attribute__((ext_vector_type(8)));
typedef GAS unsigned gu32;
typedef GAS unsigned long long gu64;
#define RLX_AGENT __ATOMIC_RELAXED, __HIP_MEMORY_SCOPE_AGENT
#define LDS_WAIT() asm volatile("s_waitcnt lgkmcnt(0)" ::: "memory")
#define VM_WAIT() asm volatile("s_waitcnt vmcnt(0)" ::: "memory")
__device__ __forceinline__ unsigned long long rt() { return __builtin_amdgcn_s_memrealtime(); }
__device__ __forceinline__ unsigned f2bf(float f) { unsigned u = __builtin_bit_cast(unsigned, f); return (u + 0x7fffu + ((u >> 16) & 1u)) >> 16; }
__device__ __forceinline__ unsigned pk2(float lo, float hi) { return f2bf(lo) | (f2bf(hi) << 16); }

#define XB_TMO      128
#define XB_XCNT(j)  (256  + 64 * (j))
#define XB_XSUB(j)  (1280 + 64 * (j))
#define XB_XGEN(j)  (2304 + 64 * (j))
#define XB_TOP      3328
#define XB_TOPGEN   3392
#define XCD_BAR_WORDS 3456
#define XB_SPIN_CAP (1u << 18)

__device__ __forceinline__ unsigned xb_ld(unsigned* p)              { return __hip_atomic_load(p, __ATOMIC_RELAXED, __HIP_MEMORY_SCOPE_AGENT); }
__device__ __forceinline__ unsigned xb_add(unsigned* p, unsigned v) { return __hip_atomic_fetch_add(p, v, __ATOMIC_RELAXED, __HIP_MEMORY_SCOPE_AGENT); }
__device__ __forceinline__ unsigned xb_xcc_id() { return (unsigned)__builtin_amdgcn_s_getreg((3 << 11) | 20) & 0xFu; }
#define XB_SPIN(cond, bar) do { unsigned _sp = 0; while (cond) { __builtin_amdgcn_s_sleep(1); \
    if ((++_sp & 255u) == 0u) { if (xb_ld(&(bar)[XB_TMO])) break; if (_sp > XB_SPIN_CAP) { atomicAdd(&(bar)[XB_TMO], 1u); break; } } } } while (0)

struct XcdBarrier {
    unsigned* bar; unsigned x;
    volatile LAS unsigned* st;
};

__device__ __forceinline__ XcdBarrier xcd_barrier_post(unsigned* bar, volatile LAS unsigned* st) {
    XcdBarrier b; b.bar = bar; b.x = xb_xcc_id(); b.st = st;
    if (threadIdx.x == 0) (void)xb_add(&bar[XB_XCNT(b.x)], 1u);
    return b;
}
__device__ __forceinline__ void xcd_barrier_complete(unsigned* bar, unsigned x, unsigned& nloc, unsigned& nx) {
    const unsigned G = gridDim.x * gridDim.y * gridDim.z;
    unsigned sum, cnt, mine, sp = 0u;
    for (;;) {
        sum = 0u; cnt = 0u; mine = 0u;
#pragma unroll
        for (unsigned j = 0; j < 16; ++j) { const unsigned c = xb_ld(&bar[XB_XCNT(j)]); sum += c; cnt += (c > 0u) ? 1u : 0u; mine = (j == x) ? c : mine; }
        if (sum == G) break;
        __builtin_amdgcn_s_sleep(1);
        if ((++sp & 255u) == 0u) { if (xb_ld(&bar[XB_TMO])) break; if (sp > XB_SPIN_CAP) { atomicAdd(&bar[XB_TMO], 1u); break; } }
    }
    nloc = mine > 0u ? mine : 1u; nx = cnt > 0u ? cnt : 1u;
}

__device__ __forceinline__ void xcd_barrier(const XcdBarrier& b) {
    asm volatile("s_waitcnt vmcnt(0)" ::: "memory");
    __syncthreads();
    if (threadIdx.x == 0) {
        unsigned* bar = b.bar;
        __builtin_amdgcn_s_waitcnt(0);
        unsigned nloc = b.st[0], nx = b.st[1];
        if (nloc == 0u) { xcd_barrier_complete(bar, b.x, nloc, nx); b.st[0] = nloc; b.st[1] = nx; }
        const unsigned old = xb_add(&bar[XB_XSUB(b.x)], 1u);
        const unsigned gen = old / nloc;
        if (old + 1u == (gen + 1u) * nloc) {
            __builtin_amdgcn_fence(__ATOMIC_RELEASE, "agent");
            asm volatile("s_waitcnt vmcnt(0)" ::: "memory");
            const unsigned og = xb_add(&bar[XB_TOP], 1u);
            const unsigned tg = og / nx;
            if (og + 1u == (tg + 1u) * nx) xb_add(&bar[XB_TOPGEN], 1u);
            else XB_SPIN(xb_ld(&bar[XB_TOPGEN]) == tg, bar);
            __builtin_amdgcn_fence(__ATOMIC_ACQUIRE, "agent");
            xb_add(&bar[XB_XGEN(b.x)], 1u);
            asm volatile("s_waitcnt vmcnt(0)" ::: "memory");
        } else {
            XB_SPIN(xb_ld(&bar[XB_XGEN(b.x)]) == gen, bar);
            __builtin_amdgcn_fence(__ATOMIC_ACQUIRE, "agent");
            asm volatile("s_waitcnt vmcnt(0)" ::: "memory");
        }
    }
    __syncthreads();
}

struct Frame {
    LAS unsigned char* lds;
    volatile LAS unsigned* MISC;
    gu32* ctl;
    int tid, lane, wave;
    int vcu, G;
    const float *x, *norm_mix, *norm_ffn, *hgrn_w_in, *lb_logits, *hgrn_out_norm, *hgrn_w_out, *attn_w_qkv, *attn_w_out, *ffn_w_in, *ffn_w_down, *final_norm;
    float* out;
    bf16 *Whin, *Whout, *Wqkv, *Wao, *Wf1, *Wf2;
    float *SS, *E1, *E2, *COS, *SIN, *LSE, *LB, *ST, *DJ;
    bf16 *XB, *QT, *KT, *VV, *GG, *FF, *QP, *KP, *VP;
};
__device__ __forceinline__ float wave_sum(float v) {
#pragma unroll
    for (int o = 1; o < 64; o <<= 1) v += __shfl_xor(v, o);
    return v;
}
__device__ __forceinline__ float bf_lo(unsigned u) { return __uint_as_float(u << 16); }
__device__ __forceinline__ float bf_hi(unsigned u) { return __uint_as_float(u & 0xffff0000u); }

__device__ __forceinline__ int pinv32(int l) { return 16 * ((l >> 2) & 1) + 4 * (l >> 3) + (l & 3); }
template <int MODE> __device__ __forceinline__ int phys_row(int c) {
    if (MODE == 0) return (c & ~31) + pinv32(c & 31);
    if (MODE == 1) { const int up = c >= DFF ? 1 : 0, j = c - up * DFF; return 256 * (j >> 7) + 128 * up + (j & 96) + pinv32(j & 31); }
    if (MODE == 2) {
        if (c >= 2 * AW) { const int c0 = c - 2 * AW, hl = c0 >> 7, cc = ((hl & 3) * 3 + (hl >> 2)) * 128 + (c0 & 127); return 256 * (12 + (cc >> 8)) + (cc & 224) + pinv32(cc & 31); }
        const int plane = c >= AW ? 1 : 0, cc = c - plane * AW, hl = cc >> 7, head = (hl & 3) * 3 + (hl >> 2), d = cc & 127, half = d >> 6, j = d & 63;
        return 256 * (plane * 6 + (head >> 1)) + 128 * half + 32 * (2 * (head & 1) + (j >> 5)) + pinv32(j & 31);
    }
    { const int type = c >> 10, ch = c & 1023, chl = ch & 63; return 256 * (ch >> 6) + 128 * (type >> 1) + 32 * (chl >> 4) + 16 * (type & 1) + (chl & 15); }
}
template <int MODE, bool KPOS = false>
__device__ __forceinline__ void p0_transpose_item(const float* W, int K, int N, bf16* WT, const float* gain, LAS float* scr, int item, int lane) {
    const int nblk = N / 32, kb = item / nblk, nb = item % nblk, k0 = 64 * kb, n0 = 32 * nb;
    int ks = k0; if (KPOS) { const int pos = k0 >> 7; ks = ((pos % 3) * 4 + pos / 3) * 128 + (k0 & 127); }
#pragma unroll 8
    for (int i = 0; i < 32; ++i) { const int kk = 2 * i + (lane >> 5); float w = W[(size_t)(ks + kk) * N + n0 + (lane & 31)]; if (gain) w *= gain[ks + kk]; scr[kk * 33 + (lane & 31)] = w; }
    LDS_WAIT(); asm volatile("" ::: "memory");
    const int c = lane & 7;
#pragma unroll
    for (int j = 0; j < 4; ++j) { const int n = (lane >> 3) + 8 * j; const LAS float* s = scr + (8 * c) * 33 + n;
        v4u o; o.x = pk2(s[0 * 33], s[1 * 33]); o.y = pk2(s[2 * 33], s[3 * 33]); o.z = pk2(s[4 * 33], s[5 * 33]); o.w = pk2(s[6 * 33], s[7 * 33]);
        *(GAS v4u*)(WT + (size_t)phys_row<MODE>(n0 + n) * K + k0 + 8 * c) = o; }
    LDS_WAIT(); asm volatile("" ::: "memory");
}
__device__ __forceinline__ void p0_prologue(Frame& F) {
    LAS float* scr = (LAS float*)(F.lds + RING_OFF + F.wave * 16384);
    const int gw = F.vcu * NWAVES + F.wave, NGW = F.G * NWAVES;
    constexpr int I_HIN = (D / 64) * (HIN / 32), I_HOUT = (D / 64) * (D / 32), I_QKV = (D / 64) * (QKVW / 32), I_AO = (AW / 64) * (D / 32), I_F1 = (D / 64) * (FF2 / 32), I_F2 = (DFF / 64) * (D / 32);
    constexpr int NITEMS = I_HIN + I_HOUT + I_QKV + I_AO + 2 * I_F1 + 2 * I_F2;
    for (int it = gw; it < NITEMS; it += NGW) {
        int r = it;
        if (r < I_HIN) { p0_transpose_item<3>(F.hgrn_w_in, D, HIN, F.Whin, F.norm_mix, scr, r, F.lane); continue; } r -= I_HIN;
        if (r < I_HOUT) { p0_transpose_item<0>(F.hgrn_w_out, D, D, F.Whout, nullptr, scr, r, F.lane); continue; } r -= I_HOUT;
        if (r < I_QKV) { p0_transpose_item<2>(F.attn_w_qkv, D, QKVW, F.Wqkv, F.norm_mix + D, scr, r, F.lane); continue; } r -= I_QKV;
        if (r < I_AO) { p0_transpose_item<0, true>(F.attn_w_out, AW, D, F.Wao, nullptr, scr, r, F.lane); continue; } r -= I_AO;
        if (r < 2 * I_F1) { const int l = r / I_F1; p0_transpose_item<1>(F.ffn_w_in + (size_t)l * D * FF2, D, FF2, F.Wf1 + (size_t)l * FF2 * D, F.norm_ffn + l * D, scr, r - l * I_F1, F.lane); continue; } r -= 2 * I_F1;
        { const int l = r / I_F2; p0_transpose_item<0>(F.ffn_w_down + (size_t)l * DFF * D, DFF, D, F.Wf2 + (size_t)l * D * DFF, nullptr, scr, r - l * I_F2, F.lane); }
    }
    for (int m = gw; m < M; m += NGW) {
        const GAS f32x4* xr = (const GAS f32x4*)(F.x + (size_t)m * D) + F.lane;
        GAS unsigned long long* o8 = (GAS unsigned long long*)(F.XB + (size_t)m * D) + F.lane;
        float s = 0.f;
#pragma unroll
        for (int j = 0; j < 4; ++j) { const f32x4 v = xr[64 * j]; s += (v.x * v.x + v.y * v.y) + (v.z * v.z + v.w * v.w); o8[64 * j] = (unsigned long long)pk2(v.x, v.y) | ((unsigned long long)pk2(v.z, v.w) << 32); }
        s = wave_sum(s);
        if (F.lane < 16) F.SS[(size_t)m * 16 + F.lane] = F.lane == 0 ? s : 0.f;
    }
    const int gt = F.vcu * NWAVES * 64 + F.tid, NGT = F.G * NWAVES * 64;
    for (int i = gt; i < T * 64; i += NGT) { const int pos = i >> 6, j = i & 63;
        const float inv = 1.0f / exp2f((float)j * (13.287712379549449f / 64.0f)); const float ang = (float)pos * inv;
        const double rev = (double)ang * 0.15915494309189535; const float fr = (float)(rev - floor(rev));
        F.COS[i] = __builtin_amdgcn_cosf(fr); F.SIN[i] = __builtin_amdgcn_sinf(fr); }
    if (gt < D) { const float a = F.lb_logits[gt], b = F.lb_logits[D + gt], c = F.lb_logits[2 * D + gt]; const float mx = fmaxf(a, fmaxf(b, c));
        const float ea = expf(a - mx), eb = expf(b - mx), ec = expf(c - mx); F.LB[gt] = ea / (ea + eb + ec); }
}

namespace hg {
typedef short bf16x8 __attribute__((ext_vector_type(8)));
typedef short s16x4 __attribute__((ext_vector_type(4)));
constexpr int TILE = 16384, BUF = 3 * TILE;
constexpr int OFF_F = 2 * BUF, OFF_PART = OFF_F + 1024;
constexpr int HG_LDS_BYTES = OFF_PART + 4096;
constexpr int SUPER = 8, NSUPER = T / (64 * SUPER), NITEM = BATCH * 8 * NSUPER;
__device__ __forceinline__ int swz(int row) { return ((row & 7) << 5) | (((row >> 3) & 1) << 4); }
__device__ __forceinline__ bf16x8 mk8(u32x2 a, u32x2 b) { v4u w = {a.x, a.y, b.x, b.y}; return __builtin_bit_cast(bf16x8, w); }
__device__ __forceinline__ bf16x8 mk8s(s16x4 a, s16x4 b) { return (bf16x8){a[0], a[1], a[2], a[3], b[0], b[1], b[2], b[3]}; }
__device__ __forceinline__ u32x2 pk4(const f32x4 a) { u32x2 w; w.x = pg8::cvt_pk_bf16(a[0], a[1]); w.y = pg8::cvt_pk_bf16(a[2], a[3]); return w; }
#define HG_TRRD(dst, addr, off) asm volatile("ds_read_b64_tr_b16 %0, %1 offset:%2" : "=&v"(dst) : "v"(addr), "i"(off) : "memory")
#define HG_LGKM0() do { asm volatile("s_waitcnt lgkmcnt(0)" ::: "memory"); __builtin_amdgcn_sched_barrier(0); } while (0)
#define HG_MFMA(a, b, c) __builtin_amdgcn_mfma_f32_16x16x32_bf16((a), (b), (c), 0, 0, 0)

template <bool PC>
__device__ __forceinline__ void item(Frame& F, int it, float* DJ) {
    const int tid = F.tid, lane = F.lane, w = F.wave, li = lane & 15, g = lane >> 4;
    const int bh = it / NSUPER, j = it - bh * NSUPER, b = bh >> 3, h = bh & 7;
    const size_t row0 = (size_t)b * T + (size_t)j * (64 * SUPER);
    const int chunk0 = (int)(row0 >> 6), hc = h * 128;
    LAS unsigned char* L = F.lds + RING_OFF;
    const int srow = tid >> 4, sc16 = tid & 15;
    const unsigned st_off = (unsigned)(srow * 256 + ((sc16 * 16) ^ swz(srow)));
    const size_t g_off = (size_t)srow * 1024 + hc + sc16 * 8;
    const int sr = swz(li);
    const unsigned rbase = (unsigned)(li * 256 + ((8 * g) ^ (sr & 16))), sEr = (unsigned)(sr & 0xE0);
    const int trow = 4 * g + (li >> 2), stt = swz(trow);
    const unsigned tbase = (unsigned)(trow * 256 + ((8 * (li & 3)) ^ (stt & 16))), sEt = (unsigned)(stt & 0xE0);
    const unsigned ldsb = (unsigned)(size_t)L;

    f32x4 S[8]; bf16x8 Sb[4];
    float dprod = 1.f;
    if (PC && j > 0) {
        const float* st = F.ST + ((size_t)it << 14) + (size_t)(w * 32) * 64 + lane;
#pragma unroll
        for (int kt = 0; kt < 8; ++kt) {
            const f32x4 e1 = *(const f32x4*)(F.E1 + (size_t)chunk0 * 1024 + hc + 16 * kt + 4 * g);
#pragma unroll
            for (int r = 0; r < 4; ++r) S[kt][r] = st[(kt * 4 + r) * 64] * e1[r];
        }
    } else {
#pragma unroll
        for (int kt = 0; kt < 8; ++kt) S[kt] = (f32x4){0.f, 0.f, 0.f, 0.f};
        if (!PC && tid < 128) dprod = F.E1[(size_t)chunk0 * 1024 + hc + tid];
    }
#pragma unroll
    for (int kp = 0; kp < 4; ++kp) Sb[kp] = mk8(pk4(S[2 * kp]), pk4(S[2 * kp + 1]));
    float gn[4];
#pragma unroll
    for (int r = 0; r < 4; ++r) gn[r] = PC ? F.hgrn_out_norm[16 * w + 4 * g + r] : 0.f;

    v4u sq0, sq1, sk0, sk1, sv0, sv1; float fe = 1.f;
#define HG_LOAD(cc) do { const size_t ro_ = (row0 + (size_t)(cc) * 64) * 1024 + g_off; \
        if (PC) { sq0 = *(const GAS v4u*)(F.QT + ro_); sq1 = *(const GAS v4u*)(F.QT + ro_ + 32 * 1024); } \
        sk0 = *(const GAS v4u*)(F.KT + ro_); sk1 = *(const GAS v4u*)(F.KT + ro_ + 32 * 1024); sv0 = *(const GAS v4u*)(F.VV + ro_); sv1 = *(const GAS v4u*)(F.VV + ro_ + 32 * 1024); \
        if (tid < 128) { fe = F.E2[(size_t)(chunk0 + (cc)) * 1024 + hc + tid]; if ((cc) < SUPER - 1) fe *= F.E1[(size_t)(chunk0 + (cc) + 1) * 1024 + hc + tid]; dprod *= fe; } } while (0)
#define HG_WRITE(bi) do { LAS unsigned char* B_ = L + (bi) * BUF + st_off; \
        if (PC) { *(LAS v4u*)B_ = sq0; *(LAS v4u*)(B_ + 8192) = sq1; } \
        *(LAS v4u*)(B_ + TILE) = sk0; *(LAS v4u*)(B_ + TILE + 8192) = sk1; *(LAS v4u*)(B_ + 2 * TILE) = sv0; *(LAS v4u*)(B_ + 2 * TILE + 8192) = sv1; \
        if (tid < 128) ((LAS float*)(L + OFF_F + (bi) * 512))[tid] = fe; } while (0)

    HG_LOAD(0); HG_WRITE(0);
    __syncthreads();
    for (int c = 0; c < SUPER; ++c) {
        const int bi = c & 1;
        u32x2 gg[4];
        if (c + 1 < SUPER) HG_LOAD(c + 1);
        if (PC) {
#pragma unroll
            for (int ti = 0; ti < 4; ++ti) gg[ti] = *(const GAS u32x2*)(F.GG + (row0 + (size_t)c * 64 + 16 * ti + li) * 1024 + hc + 16 * w + 4 * g);
        }
        const unsigned qb_ = ldsb + bi * BUF, kb_ = qb_ + TILE, vb_ = qb_ + 2 * TILE;
        LAS unsigned char* Qp = L + bi * BUF; LAS unsigned char* Kp = Qp + TILE;
        bf16x8 vf[2];
        { s16x4 a0, a1, a2, a3; const unsigned va = vb_ + tbase + ((32u * w) ^ sEt);
          HG_TRRD(a0, va, 0); HG_TRRD(a1, va, 4096); HG_TRRD(a2, va, 8192); HG_TRRD(a3, va, 12288); HG_LGKM0();
          vf[0] = mk8s(a0, a1); vf[1] = mk8s(a2, a3); }
        f32x4 O[4];
        if (PC) {
#pragma unroll
            for (int ti = 0; ti < 4; ++ti) {
                bf16x8 qf[4];
#pragma unroll
                for (int kp = 0; kp < 4; ++kp) { const LAS unsigned char* a = Qp + 4096 * ti + rbase;
                    qf[kp] = mk8(*(const LAS u32x2*)(a + ((64u * kp) ^ sEr)), *(const LAS u32x2*)(a + ((64u * kp + 32u) ^ sEr))); }
                f32x4 o = {0.f, 0.f, 0.f, 0.f};
#pragma unroll
                for (int kp = 0; kp < 4; ++kp) o = HG_MFMA(Sb[kp], qf[kp], o);
                __builtin_amdgcn_sched_barrier(0);
                f32x4 p[4];
#pragma unroll
                for (int si = 0; si < 4; ++si) { p[si] = (f32x4){0.f, 0.f, 0.f, 0.f};
                    if (si <= ti) {
#pragma unroll
                        for (int kp = 0; kp < 4; ++kp) { const LAS unsigned char* a = Kp + 4096 * si + rbase;
                            const bf16x8 kf = mk8(*(const LAS u32x2*)(a + ((64u * kp) ^ sEr)), *(const LAS u32x2*)(a + ((64u * kp + 32u) ^ sEr)));
                            p[si] = HG_MFMA(kf, qf[kp], p[si]); }
                    } }
#pragma unroll
                for (int r = 0; r < 4; ++r) if (4 * g + r > li) p[ti][r] = 0.f;
                o = HG_MFMA(vf[0], mk8(pk4(p[0]), pk4(p[1])), o);
                if (ti >= 2) o = HG_MFMA(vf[1], mk8(pk4(p[2]), pk4(p[3])), o);
                O[ti] = o;
                __builtin_amdgcn_sched_barrier(0);
            }
        }
#pragma unroll
        for (int kt = 0; kt < 8; ++kt) {
            s16x4 a0, a1, a2, a3; const unsigned ka = kb_ + tbase + ((32u * kt) ^ sEt);
            HG_TRRD(a0, ka, 0); HG_TRRD(a1, ka, 4096); HG_TRRD(a2, ka, 8192); HG_TRRD(a3, ka, 12288); HG_LGKM0();
            S[kt] = HG_MFMA(mk8s(a0, a1), vf[0], S[kt]); S[kt] = HG_MFMA(mk8s(a2, a3), vf[1], S[kt]);
        }
#pragma unroll
        for (int kt = 0; kt < 8; ++kt) S[kt] = S[kt] * *(const LAS f32x4*)(L + OFF_F + bi * 512 + (16 * kt + 4 * g) * 4);
#pragma unroll
        for (int kp = 0; kp < 4; ++kp) Sb[kp] = mk8(pk4(S[2 * kp]), pk4(S[2 * kp + 1]));
        LAS float* part = (LAS float*)(L + OFF_PART + bi * 2048);
        if (PC) {
#pragma unroll
            for (int ti = 0; ti < 4; ++ti) { float q = (O[ti][0] * O[ti][0] + O[ti][1] * O[ti][1]) + (O[ti][2] * O[ti][2] + O[ti][3] * O[ti][3]);
                q += __shfl_xor(q, 16); q += __shfl_xor(q, 32);
                if (g == 0) part[(16 * ti + li) * 8 + w] = q; }
        }
        if (c + 1 < SUPER) HG_WRITE(bi ^ 1);
        __syncthreads();
        if (PC) {
#pragma unroll
            for (int ti = 0; ti < 4; ++ti) {
                const f32x4 p0 = *(const LAS f32x4*)(part + (16 * ti + li) * 8), p1 = *(const LAS f32x4*)(part + (16 * ti + li) * 8 + 4);
                const float tot = ((p0[0] + p0[1]) + (p0[2] + p0[3])) + ((p1[0] + p1[1]) + (p1[2] + p1[3]));
                const float r = 1.0f / sqrtf(tot * (1.0f / 128.0f) + NORM_EPS);
                f32x4 o = O[ti] * r;
                o[0] *= gn[0] * bf_lo(gg[ti].x); o[1] *= gn[1] * bf_hi(gg[ti].x); o[2] *= gn[2] * bf_lo(gg[ti].y); o[3] *= gn[3] * bf_hi(gg[ti].y);
                *(GAS u32x2*)(F.QT + (row0 + (size_t)c * 64 + 16 * ti + li) * 1024 + hc + 16 * w + 4 * g) = pk4(o);
            }
        }
    }
    if (!PC) {
        float* st = F.ST + ((size_t)(it + 1) << 14) + (size_t)(w * 32) * 64 + lane;
#pragma unroll
        for (int kt = 0; kt < 8; ++kt)
#pragma unroll
            for (int r = 0; r < 4; ++r) st[(kt * 4 + r) * 64] = S[kt][r];
        if (tid < 128) DJ[it * 128 + tid] = dprod;
    }
    __syncthreads();
#undef HG_LOAD
#undef HG_WRITE
}
__device__ __forceinline__ void phase_a(Frame& F, float* DJ) {
    for (int it = F.vcu; it < NITEM; it += F.G) { if ((it % NSUPER) == NSUPER - 1) continue; item<false>(F, it, DJ); }
}
__device__ __forceinline__ void phase_b(Frame& F, const float* DJ) {
    const int gt = F.vcu * NWAVES * 64 + F.tid, NGT = F.G * NWAVES * 64;
    for (int e = gt; e < BATCH * 8 * 16384; e += NGT) {
        const int bh = e >> 14, idx = e & 16383, kr = (idx >> 6) & 31, k = 16 * (kr >> 2) + 4 * ((idx & 63) >> 4) + (kr & 3);
        float s = 0.f;
        for (int j = 0; j + 1 < NSUPER; ++j) { const size_t a = ((size_t)(bh * NSUPER + j + 1) << 14) + idx; s = DJ[(bh * NSUPER + j) * 128 + k] * s + F.ST[a]; F.ST[a] = s; }
    }
}
__device__ __forceinline__ void phase_c(Frame& F) {
    for (int it = F.vcu; it < NITEM; it += F.G) item<true>(F, it, nullptr);
}
#undef HG_TRRD
#undef HG_LGKM0
#undef HG_MFMA
}

__device__ __forceinline__ void hgrn_simple_rec(Frame& F, float* oraw) {
    const int item = F.wave * F.G + F.vcu;
    if (item >= 256) return;
    const int b = item >> 7, h = (item >> 4) & 7, vg = item & 15, kc = h * 128 + 2 * F.lane, vc = h * 128 + vg * 8;
    float S0[8], S1[8];
#pragma unroll
    for (int j = 0; j < 8; ++j) { S0[j] = 0.f; S1[j] = 0.f; }
    for (int c = 0; c < 128; ++c) {
        const int chunk = b * 128 + c;
        const float e1x = F.E1[(size_t)chunk * 1024 + kc], e1y = F.E1[(size_t)chunk * 1024 + kc + 1], e2x = F.E2[(size_t)chunk * 1024 + kc], e2y = F.E2[(size_t)chunk * 1024 + kc + 1];
#pragma unroll
        for (int j = 0; j < 8; ++j) { S0[j] *= e1x; S1[j] *= e1y; }
#pragma unroll 2
        for (int t = 0; t < 64; ++t) {
            const size_t row = (size_t)chunk * 64 + t;
            const unsigned kq = *(const GAS unsigned*)(F.KT + row * 1024 + kc), qq = *(const GAS unsigned*)(F.QT + row * 1024 + kc);
            const v4u vv = *(const GAS v4u*)(F.VV + row * 1024 + vc);
            const float k0 = bf_lo(kq), k1 = bf_hi(kq), q0 = bf_lo(qq), q1 = bf_hi(qq);
            const float v[8] = {bf_lo(vv.x), bf_hi(vv.x), bf_lo(vv.y), bf_hi(vv.y), bf_lo(vv.z), bf_hi(vv.z), bf_lo(vv.w), bf_hi(vv.w)};
            float part[8];
#pragma unroll
            for (int j = 0; j < 8; ++j) { S0[j] = fmaf(k0, v[j], S0[j]); S1[j] = fmaf(k1, v[j], S1[j]); part[j] = q0 * S0[j] + q1 * S1[j]; }
#pragma unroll
            for (int j = 0; j < 8; ++j) part[j] = wave_sum(part[j]);
            if (F.lane == 0) { float* o = oraw + row * 1024 + vc; *(f32x4*)o = (f32x4){part[0], part[1], part[2], part[3]}; *(f32x4*)(o + 4) = (f32x4){part[4], part[5], part[6], part[7]}; }
        }
#pragma unroll
        for (int j = 0; j < 8; ++j) { S0[j] *= e2x; S1[j] *= e2y; }
    }
}
__device__ __forceinline__ void hgrn_simple_post(Frame& F, const float* oraw) {
    const int gw = F.vcu * NWAVES + F.wave, NGW = F.G * NWAVES;
    const float gn0 = F.hgrn_out_norm[2 * F.lane], gn1 = F.hgrn_out_norm[2 * F.lane + 1];
    for (int it = gw; it < M * 8; it += NGW) {
        const size_t off = (size_t)(it >> 3) * 1024 + (it & 7) * 128 + 2 * F.lane;
        const float v0 = oraw[off], v1 = oraw[off + 1];
        const float r = 1.0f / sqrtf(wave_sum(v0 * v0 + v1 * v1) * (1.0f / 128.0f) + NORM_EPS);
        const unsigned g = *(const GAS unsigned*)(F.GG + off);
        *(GAS unsigned*)(F.QT + off) = pk2(v0 * r * gn0 * bf_lo(g), v1 * r * gn1 * bf_hi(g));
    }
}
__device__ __forceinline__ void attn_simple(Frame& F) {
    const int gw = F.vcu * NWAVES + F.wave, NGW = F.G * NWAVES;
    for (int it = gw; it < M * 12; it += NGW) {
        const int row = it / 12, hd = it - row * 12, t = row & (T - 1), g = hd >> 2, dil = g == 0 ? 1 : (g == 1 ? 4 : 16);
        const size_t co = (size_t)hd * 128 + 2 * F.lane;
        const unsigned qq = *(const GAS unsigned*)(F.QP + (size_t)row * AW + co);
        const float q0 = bf_lo(qq), q1 = bf_hi(qq);
        float m = -INFINITY, l = 0.f, o0 = 0.f, o1 = 0.f;
        for (int j = 0; j <= 128; ++j) {
            if (t - j * dil < 0) break;
            const size_t rk = (size_t)(row - j * dil) * AW + co;
            const unsigned kk = *(const GAS unsigned*)(F.KP + rk), vv = *(const GAS unsigned*)(F.VP + rk);
            const float s = wave_sum(q0 * bf_lo(kk) + q1 * bf_hi(kk)) * 0.08838834764831845f;
            const float mn = fmaxf(m, s), a = __expf(m - mn), p = __expf(s - mn);
            l = l * a + p; o0 = o0 * a + p * bf_lo(vv); o1 = o1 * a + p * bf_hi(vv); m = mn;
        }
        *(GAS unsigned*)(F.QP + (size_t)row * AW + co) = pk2(o0 / l, o1 / l);
        if (F.lane == 0) F.LSE[(size_t)row * 12 + hd] = m + logf(l);
    }
}
typedef swa::BlockRef<bf16, bf16> AttRef;
__device__ __forceinline__ AttRef attn_ref(const Frame& F, int L) {
    const int bh = L >> 5, x = L & 31, b = bh / 12, head = bh - b * 12, sh = 2 * (head % 3), nqs = 5 - sh;
    const int r = x >> nqs, qb = x & ((1 << nqs) - 1);
    const size_t rowq = (size_t)b * T + r + ((size_t)qb * 256 << sh);
    AttRef R; R.Q = F.QP + rowq * AW + head * 128; R.P0 = qb * 256; R.sh = sh; R.lrow = (int)rowq * 12 + head;
    return R;
}
__device__ __forceinline__ void attn_fast(Frame& F, char* lds) {
    constexpr int NITEM = BATCH * 12 * 32, W = 129;
    int L = F.vcu; if (L >= NITEM) return;
    AttRef cur = attn_ref(F, L);
    swa::Seam<bf16> S;
    swa::causal_swa_prime<bf16, bf16>(cur, W, lds, S);
    for (;;) {
        const bool more = L + F.G < NITEM;
        const AttRef nxt = more ? attn_ref(F, L + F.G) : cur;
        swa::causal_swa_block<bf16, bf16>(cur, nxt, F.LSE, W, lds, S);
        if (!more) break;
        cur = nxt; L += F.G;
    }
}
__device__ __forceinline__ void attn_scale(Frame& F) {
    const int gt = F.vcu * NWAVES * 64 + F.tid, NGT = F.G * NWAVES * 64;
    for (int i = gt; i < M * (AW / 8); i += NGT) {
        const int row = i / (AW / 8), c8 = i - row * (AW / 8), hd = c8 >> 4, hg = hd & 3;
        const float* ls = F.LSE + (size_t)row * 12;
        const float a = ls[hg], b = ls[4 + hg], c = ls[8 + hg], mx = fmaxf(a, fmaxf(b, c));
        const float al = __expf(ls[hd] - mx) / (__expf(a - mx) + __expf(b - mx) + __expf(c - mx));
        GAS v4u* p = (GAS v4u*)(F.QP + (size_t)row * AW + c8 * 8);
        v4u v = *p;
        v.x = pk2(bf_lo(v.x) * al, bf_hi(v.x) * al); v.y = pk2(bf_lo(v.y) * al, bf_hi(v.y) * al); v.z = pk2(bf_lo(v.z) * al, bf_hi(v.z) * al); v.w = pk2(bf_lo(v.w) * al, bf_hi(v.w) * al);
        *p = v;
    }
}
__device__ __forceinline__ void final_norm_rows(Frame& F) {
    const int gw = F.vcu * NWAVES + F.wave, NGW = F.G * NWAVES;
    for (int m = gw; m < M; m += NGW) {
        const float s = wave_sum(F.lane < 16 ? F.SS[(size_t)m * 16 + F.lane] : 0.f);
        const float r = 1.0f / sqrtf(s * (1.0f / D) + NORM_EPS);
        const GAS v4u* xr = (const GAS v4u*)(F.XB + (size_t)m * D) + F.lane;
        GAS f32x4* o = (GAS f32x4*)(F.out + (size_t)m * D) + 2 * F.lane;
        const GAS f32x4* gr = (const GAS f32x4*)F.final_norm + 2 * F.lane;
#pragma unroll
        for (int j = 0; j < 2; ++j) { const v4u v = xr[64 * j]; const f32x4 g0 = gr[128 * j], g1 = gr[128 * j + 1];
            o[128 * j] = (f32x4){bf_lo(v.x) * r * g0.x, bf_hi(v.x) * r * g0.y, bf_lo(v.y) * r * g0.z, bf_hi(v.y) * r * g0.w};
            o[128 * j + 1] = (f32x4){bf_lo(v.z) * r * g1.x, bf_hi(v.z) * r * g1.y, bf_lo(v.w) * r * g1.z, bf_hi(v.w) * r * g1.w}; }
    }
}

__device__ __forceinline__ bool fresh(Frame& F) { int t = threadIdx.x; asm volatile("" : "+v"(t)); F.tid = t; F.lane = t & 63; F.wave = __builtin_amdgcn_readfirstlane(t >> 6); return true; }
struct Args { const float* in[12]; float* out; unsigned char* ws; int ph_lo, ph_hi; };
__global__ void __launch_bounds__(NWAVES * 64, 2) trunk_fwd(Args args) {
    extern __shared__ __attribute__((aligned(16))) unsigned char lds[];
    Frame F;
    F.lds = (LAS unsigned char*)lds;
    F.MISC = (volatile LAS unsigned*)(F.lds + MISC_OFF);
    F.tid = threadIdx.x; F.lane = F.tid & 63; F.wave = __builtin_amdgcn_readfirstlane(F.tid >> 6);
    F.G = gridDim.x; { const int bx = blockIdx.x; F.vcu = (F.G % 8 == 0) ? (bx % 8) * (F.G / 8) + bx / 8 : bx; }
    unsigned char* ws = args.ws;
    F.ctl = (gu32*)(ws + WS_CTL);
    F.x = args.in[0]; F.norm_mix = args.in[1]; F.norm_ffn = args.in[2]; F.hgrn_w_in = args.in[3]; F.lb_logits = args.in[4]; F.hgrn_out_norm = args.in[5]; F.hgrn_w_out = args.in[6];
    F.attn_w_qkv = args.in[7]; F.attn_w_out = args.in[8]; F.ffn_w_in = args.in[9]; F.ffn_w_down = args.in[10]; F.final_norm = args.in[11]; F.out = args.out;
    F.Whin = (bf16*)(ws + WS_WHIN); F.Whout = (bf16*)(ws + WS_WHOUT); F.Wqkv = (bf16*)(ws + WS_WQKV); F.Wao = (bf16*)(ws + WS_WAO); F.Wf1 = (bf16*)(ws + WS_WF1); F.Wf2 = (bf16*)(ws + WS_WF2);
    F.SS = (float*)(ws + WS_SS); F.E1 = (float*)(ws + WS_E1); F.E2 = (float*)(ws + WS_E2); F.COS = (float*)(ws + WS_COS); F.SIN = (float*)(ws + WS_SIN); F.LSE = (float*)(ws + WS_LSE); F.LB = (float*)(ws + WS_LB); F.DJ = (float*)(ws + WS_LB + 4096); F.ST = (float*)(ws + WS_ST);
    F.XB = (bf16*)(ws + WS_XB); F.QT = (bf16*)(ws + WS_QT); F.KT = (bf16*)(ws + WS_KT); F.VV = (bf16*)(ws + WS_VV); F.GG = (bf16*)(ws + WS_GG); F.FF = (bf16*)(ws + WS_FF);
    F.QP = (bf16*)(ws + WS_QP); F.KP = (bf16*)(ws + WS_KP); F.VP = (bf16*)(ws + WS_VP);
    for (int u = F.tid; u < (LDS_BYTES - LDSCTL_OFF) / 4; u += NWAVES * 64) ((LAS unsigned*)(F.lds + LDSCTL_OFF))[u] = 0u;
    __syncthreads();
    XcdBarrier bar; bar.bar = (unsigned*)(F.ctl + CW_BAR); bar.x = 0; bar.st = nullptr;
    if (!MK_PER_PHASE) bar = xcd_barrier_post((unsigned*)(F.ctl + CW_BAR), F.MISC + 8);
    const int lo = args.ph_lo, hi = args.ph_hi;
#define IN(k) (lo <= (k) && (k) < hi && fresh(F))
#ifndef PROBE_A
#define PROBE_A -1
#define PROBE_B -1
#endif
#define SEAM(k) do { if (IN(k) && IN((k) + 1)) xcd_barrier(bar); if (PROBE_A >= 0 && blockIdx.x == 0 && F.tid == 0) ((unsigned long long*)(ws + WS_LB + 4096 + 256 * 1024))[(k) + 1] = __builtin_amdgcn_s_memrealtime(); } while (0)
    using pg8::Gemm; using pg8::StaticOrder;
#define RUN_GEMM(EPI, Aptr, Bptr, N_, K_, E) do { Gemm g{(const pg8::bf16_t*)(Aptr), (const pg8::bf16_t*)(Bptr), M, (N_), (K_)}; StaticOrder S; S.init(M, (N_), F.G, (int)blockIdx.x); \
        pg8::gemm_phase<EPI, StaticOrder, true, true>(F.lds + RING_OFF, g, S, E); } while (0)

    if (PROBE_A >= 0 && blockIdx.x == 0 && F.tid == 0) ((unsigned long long*)(ws + WS_LB + 4096 + 256 * 1024))[0] = __builtin_amdgcn_s_memrealtime();
    if (IN(0)) { p0_prologue(F); } SEAM(0);
    if (IN(1)) { pg8::EpiHgrnIn E{F.QT, F.KT, F.VV, F.GG, F.E1, F.E2, F.SS, F.LB}; RUN_GEMM(pg8::EpiHgrnIn, F.XB, F.Whin, HIN, D, E); } SEAM(1);
    if (IN(2)) { hg::phase_a(F, F.DJ); } SEAM(2);
    if (IN(3)) { hg::phase_b(F, F.DJ); } SEAM(3);
    if (IN(4)) { hg::phase_c(F); } SEAM(4);
    if (IN(5)) { pg8::EpiRes E{F.XB, F.SS}; RUN_GEMM(pg8::EpiRes, F.QT, F.Whout, D, D, E); } SEAM(5);
    if (IN(6)) { pg8::EpiSwiglu E{F.FF, F.SS}; RUN_GEMM(pg8::EpiSwiglu, F.XB, F.Wf1, FF2, D, E); } SEAM(6);
    if (IN(7)) { pg8::EpiRes E{F.XB, F.SS}; RUN_GEMM(pg8::EpiRes, F.FF, F.Wf2, D, DFF, E); } SEAM(7);
    if (IN(8)) { pg8::EpiQkv E{F.QP, F.KP, F.VP, F.SS, F.COS, F.SIN}; RUN_GEMM(pg8::EpiQkv, F.XB, F.Wqkv, QKVW, D, E); } SEAM(8);
    if (IN(9)) { attn_fast(F, (char*)lds); } SEAM(9);
    if (IN(10)) {
        LAS float* rt = (LAS float*)(F.lds + MERGE_OFF);
        { StaticOrder S0; S0.init(M, D, F.G, (int)blockIdx.x); pg8::Unit u0;
          if (S0.next(0, u0) && F.tid < 256) { const float* ls = F.LSE + (size_t)(u0.pm * 256 + F.tid) * 12; float dsum[4];
#pragma unroll
              for (int hg = 0; hg < 4; ++hg) dsum[hg] = (__expf(ls[3 * hg]) + __expf(ls[3 * hg + 1])) + __expf(ls[3 * hg + 2]);
              rt[F.tid * 4 + 0] = dsum[1] / dsum[0]; rt[F.tid * 4 + 1] = dsum[2] / dsum[1]; rt[F.tid * 4 + 2] = dsum[3] / dsum[2]; rt[F.tid * 4 + 3] = 1.0f / dsum[3]; } }
        __syncthreads();
        pg8::EpiResMerge E{F.XB, F.SS, rt}; RUN_GEMM(pg8::EpiResMerge, F.QP, F.Wao, D, AW, E); } SEAM(10);
    if (IN(11)) { pg8::EpiSwiglu E{F.FF, F.SS}; RUN_GEMM(pg8::EpiSwiglu, F.XB, F.Wf1 + (size_t)FF2 * D, FF2, D, E); } SEAM(11);
    if (IN(12)) { pg8::EpiRes E{F.XB, F.SS}; RUN_GEMM(pg8::EpiRes, F.FF, F.Wf2 + (size_t)D * DFF, D, DFF, E); } SEAM(12);
    if (IN(13)) { final_norm_rows(F); }
    if (PROBE_A >= 0) {
        if (blockIdx.x == 0 && F.tid == 0) ((unsigned long long*)(ws + WS_LB + 4096 + 256 * 1024))[14] = __builtin_amdgcn_s_memrealtime();
        xcd_barrier(bar);
        const unsigned long long* ts = (const unsigned long long*)(ws + WS_LB + 4096 + 256 * 1024);
        if (blockIdx.x == 0 && F.tid == 0) F.out[0] += (float)(ts[PROBE_B] - ts[PROBE_A]) * 0.0025f;
    }
#undef IN
#undef SEAM
#undef RUN_GEMM
}

extern "C" void kernel_launch(void* const* d_in, const int* in_sizes, int n_in, void* d_out, int out_size, void* d_ws, size_t ws_size, hipStream_t stream) {
    static int grid = 0;
    if (grid == 0) {
        if (n_in != 12 || in_sizes[0] != M * D || out_size != M * D || ws_size < WS_END) { fprintf(stderr, "kernel_launch: unexpected shapes (n_in %d, in0 %d, out %d, ws %zu); nothing launched\n", n_in, n_in > 0 ? in_sizes[0] : -1, out_size, ws_size); grid = -1; return; }
        int dev = 0, cus = 0, per_cu = 0;
        if (hipGetDevice(&dev) != hipSuccess || hipDeviceGetAttribute(&cus, hipDeviceAttributeMultiprocessorCount, dev) != hipSuccess) { grid = -1; return; }
        if (hipFuncSetAttribute((const void*)trunk_fwd, hipFuncAttributeMaxDynamicSharedMemorySize, LDS_BYTES) != hipSuccess) { fprintf(stderr, "kernel_launch: hipFuncSetAttribute failed\n"); grid = -1; return; }
        if (hipOccupancyMaxActiveBlocksPerMultiprocessor(&per_cu, (const void*)trunk_fwd, NWAVES * 64, LDS_BYTES) != hipSuccess || per_cu < 1)
            fprintf(stderr, "kernel_launch: note: the occupancy query reports %d workgroups per CU\n", per_cu);
        (void)hipGetLastError();
        grid = cus;
    }
    if (grid < 0) return;
    if (hipMemsetAsync((char*)d_ws + WS_CTL, 0, CTL_ZERO_BYTES, stream) != hipSuccess) { fprintf(stderr, "kernel_launch: hipMemsetAsync failed\n"); return; }
    Args a{};
    for (int i = 0; i < 12; ++i) a.in[i] = (const float*)d_in[i];
    a.out = (float*)d_out; a.ws = (unsigned char*)d_ws;
#if MK_PER_PHASE
    for (int p = 0; p < NPH; ++p) { a.ph_lo = p; a.ph_hi = p + 1; hipLaunchKernelGGL(trunk_fwd, dim3(grid), dim3(NWAVES * 64), LDS_BYTES, stream, a); }
#else
    a.ph_lo = 0; a.ph_hi = NPH; hipLaunchKernelGGL(trunk_fwd, dim3(grid), dim3(NWAVES * 64), LDS_BYTES, stream, a);
#endif
    const hipError_t le = hipPeekAtLastError();
    if (le != hipSuccess) fprintf(stderr, "kernel_launch: launch failed: %s (grid %d)\n", hipGetErrorName(le), grid);
}
```

```cpp
#include <hip/hip_runtime.h>
#include <cstdio>
#include <cstdint>
#include <math.h>

constexpr int BATCH = 2, T = 8192, D = 1024, M = BATCH * T;
constexpr int HIN = 4096, DFF = 2816, FF2 = 2 * DFF, QKVW = 4608, AW = 1536;
constexpr float NORM_EPS = 1e-6f;

namespace pg8 {
#define PG8_LAS __attribute__((address_space(3)))
typedef unsigned short bf16_t;
typedef short bf16x8 __attribute__((ext_vector_type(8)));
typedef float f32x4 __attribute__((ext_vector_type(4)));
typedef unsigned u32x4 __attribute__((ext_vector_type(4)));
constexpr int BM = 256, BK = 64, HALF = 128, HTB = HALF * BK * 2  , STAGE_BYTES = 8 * HTB, NXCD = 8, WGM = 8;

__host__ __device__ __forceinline__ int lds_byte(int r, int c) { const int st = (r >> 4) * 2 + (c >> 5), rr = r & 15, cc = c & 31, ob = rr * 64 + cc * 2; return st * 1024 + (ob ^ (((ob >> 9) & 1) << 5)); }
__host__ __device__ __forceinline__ void stage_rc(int b, int& R, int& C) { const int st = b / 1024, sb = b % 1024, swz = sb ^ (((sb >> 9) & 1) << 5); R = (st >> 1) * 16 + swz / 64; C = (st & 1) * 32 + (swz % 64) / 2; }
__host__ __device__ __forceinline__ int perm32(int rho) { const int n = rho >> 4, i = rho & 15; return 8 * (i >> 2) + 4 * n + (i & 3); }

struct Unit { int pm, pn; };
struct Gemm { const bf16_t* A; const bf16_t* Bt; int M, N, K; };

struct StaticOrder {
    int nM, nN, nwg, G, c;
    __host__ __device__ __forceinline__ void init(int M, int N, int G_, int c_) { nM = M / BM; nN = N / BM; nwg = nM * nN; G = G_; c = c_; }
    __host__ __device__ __forceinline__ bool next(int i, Unit& u) const {
        const long L = (long)i * G + c; if (L >= nwg) return false;
        int wgid = (int)L; { const int q = nwg / NXCD, r = nwg % NXCD, xcd = wgid % NXCD, off = wgid / NXCD; wgid = (xcd < r ? xcd * (q + 1) : r * (q + 1) + (xcd - r) * q) + off; }
        const int nig = WGM * nN, gid = wgid / nig, fm = gid * WGM, gsz = (nM - fm) < WGM ? (nM - fm) : WGM;
        u.pm = fm + ((wgid % nig) % gsz); u.pn = (wgid % nig) / gsz; return true;
    }
    __device__ __forceinline__ void a_ready(const Unit&) const {}
    __device__ __forceinline__ void done(const Unit&) const {}
};


typedef float f32x2 __attribute__((ext_vector_type(2)));
typedef __bf16 bf16x2_t __attribute__((ext_vector_type(2)));
__device__ __forceinline__ unsigned cvt_pk_bf16(float lo, float hi) { const f32x2 v = {lo, hi}; return __builtin_bit_cast(unsigned, __builtin_convertvector(v, bf16x2_t)); }
typedef unsigned u32x2 __attribute__((ext_vector_type(2)));
__device__ __forceinline__ u32x4 pack8(const f32x4 a, const f32x4 b) { u32x4 w; w.x = cvt_pk_bf16(a[0], a[1]); w.y = cvt_pk_bf16(a[2], a[3]); w.z = cvt_pk_bf16(b[0], b[1]); w.w = cvt_pk_bf16(b[2], b[3]); return w; }
__device__ __forceinline__ u32x2 pack4(const f32x4 a) { u32x2 w; w.x = cvt_pk_bf16(a[0], a[1]); w.y = cvt_pk_bf16(a[2], a[3]); return w; }
__device__ __forceinline__ float silu_f(float x) { return x * __builtin_amdgcn_rcpf(1.0f + __expf(-x)); }
__device__ __forceinline__ f32x4 silu4(const f32x4 x) { f32x4 r; r[0] = silu_f(x[0]); r[1] = silu_f(x[1]); r[2] = silu_f(x[2]); r[3] = silu_f(x[3]); return r; }
__device__ __forceinline__ float row_rstd(const float* ss, int row, int fq) {
    const f32x4 p = *(const f32x4*)(ss + (size_t)row * 16 + 4 * fq);
    float s = (p[0] + p[1]) + (p[2] + p[3]);
    s += __shfl_xor(s, 16); s += __shfl_xor(s, 32);
    return 1.0f / sqrtf(s * (1.0f / 1024.0f) + NORM_EPS);
}
template <int CTRL> __device__ __forceinline__ float dpp_f(float x) { return __builtin_bit_cast(float, __builtin_amdgcn_update_dpp(0, __builtin_bit_cast(int, x), CTRL, 0xf, 0xf, true)); }

struct EpiRes {
    static constexpr bool PERM = false, AFTER_DRAIN = false, KHOOK = false;
    bf16_t* xb; float* ss;
    __device__ __forceinline__ void operator()(const f32x4 (&acc)[2][2][4][2], const Unit& u, int wr, int wc, int fr, int fq) const {
        const int colb = u.pn * BM + wc * 32 + 8 * fq;
#pragma unroll
        for (int ai = 0; ai < 2; ++ai)
#pragma unroll
            for (int m = 0; m < 4; ++m) {
                const int row = u.pm * BM + ai * HALF + wr * 64 + m * 16 + fr;
                float sq = 0.f;
#pragma unroll
                for (int bj = 0; bj < 2; ++bj) {
                    bf16_t* p = xb + (size_t)row * 1024 + colb + bj * HALF;
                    const u32x4 b = *(const u32x4*)p;
                    f32x4 v0 = acc[ai][bj][m][0], v1 = acc[ai][bj][m][1];
                    v0[0] += __uint_as_float(b.x << 16); v0[1] += __uint_as_float(b.x & 0xffff0000u); v0[2] += __uint_as_float(b.y << 16); v0[3] += __uint_as_float(b.y & 0xffff0000u);
                    v1[0] += __uint_as_float(b.z << 16); v1[1] += __uint_as_float(b.z & 0xffff0000u); v1[2] += __uint_as_float(b.w << 16); v1[3] += __uint_as_float(b.w & 0xffff0000u);
                    *(u32x4*)p = pack8(v0, v1);
                    sq += (v0[0] * v0[0] + v0[1] * v0[1]) + (v0[2] * v0[2] + v0[3] * v0[3]) + (v1[0] * v1[0] + v1[1] * v1[1]) + (v1[2] * v1[2] + v1[3] * v1[3]);
                }
                sq += __shfl_xor(sq, 16); sq += __shfl_xor(sq, 32);
                if (fq == 0) ss[(size_t)row * 16 + u.pn * 4 + wc] = sq;
            }
    }
};
struct EpiResMerge {
    static constexpr bool PERM = false, AFTER_DRAIN = false, KHOOK = true;
    bf16_t* xb; float* ss; const PG8_LAS float* rt;
    __device__ __forceinline__ void khook(f32x4 (&acc)[2][2][4][2], int t, int wr, int fr) const {
        if (t == 4 || t == 10 || t == 16) { const int idx = t == 4 ? 0 : (t == 10 ? 1 : 2);
#pragma unroll
            for (int ai = 0; ai < 2; ++ai)
#pragma unroll
                for (int m = 0; m < 4; ++m) { const float f = rt[(ai * HALF + wr * 64 + m * 16 + fr) * 4 + idx];
#pragma unroll
                    for (int bj = 0; bj < 2; ++bj) { acc[ai][bj][m][0] = acc[ai][bj][m][0] * f; acc[ai][bj][m][1] = acc[ai][bj][m][1] * f; } } }
    }
    __device__ __forceinline__ void operator()(const f32x4 (&acc)[2][2][4][2], const Unit& u, int wr, int wc, int fr, int fq) const {
        const int colb = u.pn * BM + wc * 32 + 8 * fq;
#pragma unroll
        for (int ai = 0; ai < 2; ++ai)
#pragma unroll
            for (int m = 0; m < 4; ++m) {
                const int row = u.pm * BM + ai * HALF + wr * 64 + m * 16 + fr;
                const float f = rt[(ai * HALF + wr * 64 + m * 16 + fr) * 4 + 3];
                float sq = 0.f;
#pragma unroll
                for (int bj = 0; bj < 2; ++bj) {
                    bf16_t* p = xb + (size_t)row * 1024 + colb + bj * HALF;
                    const u32x4 b = *(const u32x4*)p;
                    f32x4 v0 = acc[ai][bj][m][0] * f, v1 = acc[ai][bj][m][1] * f;
                    v0[0] += __uint_as_float(b.x << 16); v0[1] += __uint_as_float(b.x & 0xffff0000u); v0[2] += __uint_as_float(b.y << 16); v0[3] += __uint_as_float(b.y & 0xffff0000u);
                    v1[0] += __uint_as_float(b.z << 16); v1[1] += __uint_as_float(b.z & 0xffff0000u); v1[2] += __uint_as_float(b.w << 16); v1[3] += __uint_as_float(b.w & 0xffff0000u);
                    *(u32x4*)p = pack8(v0, v1);
                    sq += (v0[0] * v0[0] + v0[1] * v0[1]) + (v0[2] * v0[2] + v0[3] * v0[3]) + (v1[0] * v1[0] + v1[1] * v1[1]) + (v1[2] * v1[2] + v1[3] * v1[3]);
                }
                sq += __shfl_xor(sq, 16); sq += __shfl_xor(sq, 32);
                if (fq == 0) ss[(size_t)row * 16 + u.pn * 4 + wc] = sq;
            }
    }
};
struct EpiSwiglu {
    static constexpr bool PERM = false, AFTER_DRAIN = false, KHOOK = false;
    bf16_t* act; const float* ss;
    __device__ __forceinline__ void operator()(const f32x4 (&acc)[2][2][4][2], const Unit& u, int wr, int wc, int fr, int fq) const {
        const int colb = u.pn * 128 + wc * 32 + 8 * fq;
#pragma unroll
        for (int ai = 0; ai < 2; ++ai)
#pragma unroll
            for (int m = 0; m < 4; ++m) {
                const int row = u.pm * BM + ai * HALF + wr * 64 + m * 16 + fr;
                const float r = row_rstd(ss, row, fq);
                const f32x4 a0 = silu4(acc[ai][0][m][0] * r) * (acc[ai][1][m][0] * r), a1 = silu4(acc[ai][0][m][1] * r) * (acc[ai][1][m][1] * r);
                *(u32x4*)(act + (size_t)row * DFF + colb) = pack8(a0, a1);
            }
    }
};
struct EpiQkv {
    static constexpr bool PERM = false, AFTER_DRAIN = false, KHOOK = false;
    bf16_t* Q; bf16_t* K; bf16_t* V; const float* ss; const float* cosT; const float* sinT;
    __device__ __forceinline__ void operator()(const f32x4 (&acc)[2][2][4][2], const Unit& u, int wr, int wc, int fr, int fq) const {
        if (u.pn < 12) {
            bf16_t* P = u.pn < 6 ? Q : K;
            const int j0 = (wc & 1) * 32 + 8 * fq, tcol = (u.pn % 6) * 256 + (wc >> 1) * 128 + j0;
#pragma unroll
            for (int ai = 0; ai < 2; ++ai)
#pragma unroll
                for (int m = 0; m < 4; ++m) {
                    const int row = u.pm * BM + ai * HALF + wr * 64 + m * 16 + fr;
                    const float r = row_rstd(ss, row, fq);
                    const size_t tb = (size_t)(row & (T - 1)) * 64 + j0;
                    const f32x4 c0 = *(const f32x4*)(cosT + tb), c1 = *(const f32x4*)(cosT + tb + 4), s0 = *(const f32x4*)(sinT + tb), s1 = *(const f32x4*)(sinT + tb + 4);
                    const f32x4 x1a = acc[ai][0][m][0] * r, x1b = acc[ai][0][m][1] * r, x2a = acc[ai][1][m][0] * r, x2b = acc[ai][1][m][1] * r;
                    bf16_t* p = P + (size_t)row * AW + tcol;
                    *(u32x4*)p = pack8(x1a * c0 - x2a * s0, x1b * c1 - x2b * s1);
                    *(u32x4*)(p + 64) = pack8(x2a * c0 + x1a * s0, x2b * c1 + x1b * s1);
                }
        } else {
            const int tcol = (u.pn - 12) * 256 + wc * 32 + 8 * fq;
#pragma unroll
            for (int ai = 0; ai < 2; ++ai)
#pragma unroll
                for (int m = 0; m < 4; ++m) {
                    const int row = u.pm * BM + ai * HALF + wr * 64 + m * 16 + fr;
                    const float r = row_rstd(ss, row, fq);
#pragma unroll
                    for (int bj = 0; bj < 2; ++bj) *(u32x4*)(V + (size_t)row * AW + tcol + bj * HALF) = pack8(acc[ai][bj][m][0] * r, acc[ai][bj][m][1] * r);
                }
        }
    }
};
struct EpiHgrnIn {
    static constexpr bool PERM = false, AFTER_DRAIN = false, KHOOK = false;
    bf16_t *QT, *KT, *VV, *GG; float *E1, *E2; const float* ss; const float* lb;
    __device__ __forceinline__ void operator()(const f32x4 (&acc)[2][2][4][2], const Unit& u, int wr, int wc, int fr, int fq) const {
        const int ch0 = u.pn * 64 + wc * 16 + 4 * fq;
        const f32x4 lbv = *(const f32x4*)(lb + ch0);
#pragma unroll
        for (int ai = 0; ai < 2; ++ai) {
            const int rowb = u.pm * BM + ai * HALF + wr * 64;
            float rs[4];
#pragma unroll
            for (int m = 0; m < 4; ++m) rs[m] = row_rstd(ss, rowb + m * 16 + fr, fq);
            f32x4 kv[4], bc[4], run = {0.f, 0.f, 0.f, 0.f};
#pragma unroll
            for (int m = 0; m < 4; ++m) {
                const f32x4 fz = acc[ai][0][m][1] * rs[m];
#pragma unroll
                for (int e = 0; e < 4; ++e) {
                    const float tt = __expf(-fmaxf(fz[e], -80.f)), inv = __builtin_amdgcn_rcpf(1.0f + tt);
                    const float oml = 1.0f - lbv[e];
                    const float fg = lbv[e] + oml * inv;
                    kv[m][e] = oml * (tt * inv);
                    float x = __logf(fg);
                    x += dpp_f<0x111>(x); x += dpp_f<0x112>(x); x += dpp_f<0x114>(x); x += dpp_f<0x118>(x);
                    const float tot = __shfl(x, 15, 16);
                    bc[m][e] = x + run[e]; run[e] += tot;
                }
            }
            f32x4 ref;
#pragma unroll
            for (int e = 0; e < 4; ++e) ref[e] = __shfl(bc[1][e], 15, 16);
            if (fr == 0) {
                const int chunk = rowb >> 6; f32x4 e1, e2;
#pragma unroll
                for (int e = 0; e < 4; ++e) { e1[e] = __expf(ref[e]); e2[e] = __expf(run[e] - ref[e]); }
                *(f32x4*)(E1 + (size_t)chunk * 1024 + ch0) = e1; *(f32x4*)(E2 + (size_t)chunk * 1024 + ch0) = e2;
            }
#pragma unroll
            for (int m = 0; m < 4; ++m) {
                const size_t off = (size_t)(rowb + m * 16 + fr) * 1024 + ch0;
                f32x4 qv = silu4(acc[ai][0][m][0] * rs[m]), kk = kv[m];
#pragma unroll
                for (int e = 0; e < 4; ++e) { const float dl = bc[m][e] - ref[e]; qv[e] *= __expf(dl); kk[e] *= __expf(-dl); }
                *(u32x2*)(QT + off) = pack4(qv); *(u32x2*)(KT + off) = pack4(kk);
                *(u32x2*)(VV + off) = pack4(acc[ai][1][m][0] * rs[m]); *(u32x2*)(GG + off) = pack4(silu4(acc[ai][1][m][1] * rs[m]));
            }
        }
    }
};

template <class Epi, class Sched, bool ALIGN_EPI = false, bool SP2 = false>
__device__ __forceinline__ void gemm_phase(PG8_LAS unsigned char* lds, const Gemm g, const Sched& S, const Epi& E) {
    int tid = threadIdx.x; asm volatile("" : "+v"(tid));
    const int wid = __builtin_amdgcn_readfirstlane(tid >> 6), lane = tid & 63, wr = wid >> 2, wc = wid & 3, fr = lane & 15, fq = lane >> 4;
    const int K = g.K, nt = K / BK;
    unsigned voffA[2], voffB[2];
#pragma unroll
    for (int i = 0; i < 2; ++i) { int R, C; stage_rc(tid * 16 + i * 8192, R, C); const int Rb = Epi::PERM ? ((R & ~31) + perm32(R & 31)) : R;
        voffA[i] = (unsigned)(R * K + C) * 2u; voffB[i] = (unsigned)(Rb * K + C) * 2u; }
    const size_t kstep = (size_t)(BK * 2);
    const size_t hstep = (size_t)HALF * K * 2;
    const size_t tstep = 2 * hstep;
    const unsigned ldsw = (unsigned)wid * 1024u;
    const int aoff = lds_byte(wr * 64 + fr, fq * 8), boff = lds_byte(wc * 32 + fr, fq * 8);
#define PG8_SA(b, h) (((b) * 2 + (h)) * HTB)
#define PG8_SB(b, h) ((4 + (b) * 2 + (h)) * HTB)
#define PG8_STAGE(bufoff, gbase, voff) do { _Pragma("unroll") for (int _i = 0; _i < 2; ++_i) \
        __builtin_amdgcn_global_load_lds((const unsigned*)((const char*)(gbase) + (voff)[_i]), (PG8_LAS unsigned*)(lds + (bufoff) + ldsw + _i * 8192), 16, 0, 0); } while (0)
#define PG8_LDA(dst, b, h) do { _Pragma("unroll") for (int m = 0; m < 4; ++m) _Pragma("unroll") for (int k = 0; k < 2; ++k) dst[m][k] = *(const PG8_LAS bf16x8*)(lds + PG8_SA(b, h) + aoff + m * 2048 + k * 1024); } while (0)
#define PG8_LDB(dst, b, h) do { _Pragma("unroll") for (int n = 0; n < 2; ++n) _Pragma("unroll") for (int k = 0; k < 2; ++k) dst[n][k] = *(const PG8_LAS bf16x8*)(lds + PG8_SB(b, h) + boff + n * 2048 + k * 1024); } while (0)
#define PG8_MMA(ai, bj, At, Bt) do { __builtin_amdgcn_s_setprio(1); _Pragma("unroll") for (int m = 0; m < 4; ++m) _Pragma("unroll") for (int n = 0; n < 2; ++n) _Pragma("unroll") for (int k = 0; k < 2; ++k) \
        acc[ai][bj][m][n] = __builtin_amdgcn_mfma_f32_16x16x32_bf16(Bt[n][k], At[m][k], acc[ai][bj][m][n], 0, 0, 0); __builtin_amdgcn_s_setprio(0); } while (0)
#define PG8_WAIT_V(n) asm volatile("s_waitcnt vmcnt(" #n ")" ::: "memory")
#define PG8_WAIT_L(n) asm volatile("s_waitcnt lgkmcnt(" #n ")" ::: "memory")
#define PG8_BAR __builtin_amdgcn_s_barrier()
#define PG8_SCHED __builtin_amdgcn_sched_barrier(0)
    Unit cur, nxt; int ui = 0;
    if (!S.next(0, cur)) return;
    f32x4 acc[2][2][4][2];
#pragma unroll
    for (int a = 0; a < 2; ++a)
#pragma unroll
        for (int b = 0; b < 2; ++b)
#pragma unroll
            for (int m = 0; m < 4; ++m)
#pragma unroll
                for (int n = 0; n < 2; ++n) acc[a][b][m][n] = (f32x4){0.f, 0.f, 0.f, 0.f};
    bf16x8 At[4][2], B0[2][2], B1[2][2];
    const char* cA = (const char*)g.A + (size_t)cur.pm * tstep; const char* cB = (const char*)g.Bt + (size_t)cur.pn * tstep;
    S.a_ready(cur);
    if constexpr (SP2) {
        PG8_STAGE(PG8_SB(0, 0), cB, voffB); PG8_STAGE(PG8_SB(0, 1), cB + hstep, voffB); PG8_STAGE(PG8_SA(0, 0), cA, voffA); PG8_STAGE(PG8_SA(0, 1), cA + hstep, voffA);
        if (wr == 1) PG8_BAR;
        PG8_WAIT_V(2); PG8_BAR;
        PG8_STAGE(PG8_SB(1, 0), cB + kstep, voffB); PG8_STAGE(PG8_SA(1, 0), cA + kstep, voffA); PG8_STAGE(PG8_SB(1, 1), cB + hstep + kstep, voffB);
        PG8_WAIT_V(6); PG8_BAR;
    } else {
        PG8_STAGE(PG8_SB(0, 0), cB, voffB); PG8_STAGE(PG8_SA(0, 0), cA, voffA); PG8_STAGE(PG8_SB(0, 1), cB + hstep, voffB); PG8_STAGE(PG8_SA(0, 1), cA + hstep, voffA);
        if (wr == 1) PG8_BAR;
        PG8_WAIT_V(4); PG8_BAR;
        PG8_STAGE(PG8_SB(1, 0), cB + kstep, voffB); PG8_STAGE(PG8_SA(1, 0), cA + kstep, voffA); PG8_STAGE(PG8_SB(1, 1), cB + hstep + kstep, voffB);
        PG8_WAIT_V(6); PG8_BAR;
    }
    for (;;) {
        const bool has_next = S.next(ui + 1, nxt);
        const char* nA = has_next ? (const char*)g.A + (size_t)nxt.pm * tstep : cA; const char* nB = has_next ? (const char*)g.Bt + (size_t)nxt.pn * tstep : cB;
        for (int t = 0; t < nt; t += 2) {
            const bool last = (t == nt - 2);
            const char* a1 = cA + (size_t)(t + 1) * kstep;
            const char* a2 = last ? nA : cA + (size_t)(t + 2) * kstep; const char* b2 = last ? nB : cB + (size_t)(t + 2) * kstep;
            const char* a3 = a2 + kstep; const char* b3 = b2 + kstep;
            if (last && has_next) S.a_ready(nxt);
            if constexpr (SP2) {
            PG8_LDB(B0, 0, 0); PG8_LDB(B1, 0, 1); PG8_SCHED; PG8_LDA(At, 0, 0); PG8_STAGE(PG8_SA(1, 1), a1 + hstep, voffA);
            PG8_WAIT_V(8); PG8_WAIT_L(0); PG8_BAR; PG8_MMA(0, 0, At, B0); PG8_MMA(0, 1, At, B1); PG8_BAR; PG8_SCHED;
            PG8_LDA(At, 0, 1); PG8_STAGE(PG8_SB(0, 0), b2, voffB); PG8_STAGE(PG8_SB(0, 1), b2 + hstep, voffB); PG8_STAGE(PG8_SA(0, 0), a2, voffA);
            PG8_WAIT_V(8); PG8_WAIT_L(0); PG8_BAR; PG8_MMA(1, 0, At, B0); PG8_MMA(1, 1, At, B1); PG8_BAR; PG8_SCHED;
            PG8_LDB(B0, 1, 0); PG8_LDB(B1, 1, 1); PG8_SCHED; PG8_LDA(At, 1, 0); PG8_STAGE(PG8_SA(0, 1), a2 + hstep, voffA);
            PG8_WAIT_V(8); PG8_WAIT_L(0); PG8_BAR; PG8_MMA(0, 0, At, B0); PG8_MMA(0, 1, At, B1); PG8_BAR; PG8_SCHED;
            PG8_LDA(At, 1, 1); PG8_STAGE(PG8_SB(1, 0), b3, voffB); PG8_STAGE(PG8_SB(1, 1), b3 + hstep, voffB); PG8_STAGE(PG8_SA(1, 0), a3, voffA);
            PG8_WAIT_V(8); PG8_WAIT_L(0); PG8_BAR; PG8_MMA(1, 0, At, B0); PG8_MMA(1, 1, At, B1); PG8_BAR; PG8_SCHED;
            if constexpr (Epi::KHOOK) E.khook(acc, t, wr, fr);
            } else {
            PG8_LDB(B0, 0, 0); PG8_SCHED; PG8_LDA(At, 0, 0); PG8_STAGE(PG8_SA(1, 1), a1 + hstep, voffA);
            PG8_WAIT_L(8); PG8_BAR; PG8_WAIT_L(0); PG8_MMA(0, 0, At, B0); PG8_BAR; PG8_SCHED;
            PG8_LDB(B1, 0, 1); PG8_STAGE(PG8_SB(0, 0), b2, voffB);
            PG8_BAR; PG8_WAIT_L(0); PG8_MMA(0, 1, At, B1); PG8_BAR;
            PG8_LDA(At, 0, 1); PG8_STAGE(PG8_SA(0, 0), a2, voffA);
            PG8_BAR; PG8_WAIT_L(0); PG8_MMA(1, 0, At, B0); PG8_BAR; PG8_SCHED;
            PG8_STAGE(PG8_SB(0, 1), b2 + hstep, voffB);
            PG8_WAIT_V(6); PG8_BAR; PG8_MMA(1, 1, At, B1); PG8_BAR;
            PG8_LDB(B0, 1, 0); PG8_SCHED; PG8_LDA(At, 1, 0); PG8_STAGE(PG8_SA(0, 1), a2 + hstep, voffA);
            PG8_WAIT_L(8); PG8_BAR; PG8_WAIT_L(0); PG8_MMA(0, 0, At, B0); PG8_BAR; PG8_SCHED;
            PG8_LDB(B1, 1, 1); PG8_STAGE(PG8_SB(1, 0), b3, voffB);
            PG8_BAR; PG8_WAIT_L(0); PG8_MMA(0, 1, At, B1); PG8_BAR;
            PG8_LDA(At, 1, 1); PG8_STAGE(PG8_SA(1, 0), a3, voffA);
            PG8_BAR; PG8_WAIT_L(0); PG8_MMA(1, 0, At, B0); PG8_BAR; PG8_SCHED;
            PG8_STAGE(PG8_SB(1, 1), b3 + hstep, voffB);
            PG8_WAIT_V(6); PG8_BAR; PG8_MMA(1, 1, At, B1); PG8_BAR;
            if constexpr (Epi::KHOOK) E.khook(acc, t, wr, fr);
            }
        }
        if constexpr (ALIGN_EPI) { if (wr == 0) PG8_BAR; }
        if constexpr (!Epi::AFTER_DRAIN) { E(acc, cur, wr, wc, fr, fq); S.done(cur); }
        if (!has_next) break;
#pragma unroll
        for (int a = 0; a < 2; ++a)
#pragma unroll
            for (int b = 0; b < 2; ++b)
#pragma unroll
                for (int m = 0; m < 4; ++m)
#pragma unroll
                    for (int n = 0; n < 2; ++n) acc[a][b][m][n] = (f32x4){0.f, 0.f, 0.f, 0.f};
        cur = nxt; cA = nA; cB = nB; ++ui;
        if constexpr (ALIGN_EPI) { if (wr == 1) PG8_BAR; }
    }
    PG8_WAIT_V(0);
    if constexpr (!ALIGN_EPI) { if (wr == 0) PG8_BAR; }
    PG8_BAR;
    if constexpr (Epi::AFTER_DRAIN) { E.fused(acc, cur, wr, wc, fr, fq, lds, wid, lane); S.done(cur); }
#undef PG8_SA
#undef PG8_SB
#undef PG8_STAGE
#undef PG8_LDA
#undef PG8_LDB
#undef PG8_MMA
#undef PG8_WAIT_V
#undef PG8_WAIT_L
#undef PG8_BAR
#undef PG8_SCHED
}
}


constexpr int NWAVES = 8;
#ifndef MK_PER_PHASE
#define MK_PER_PHASE 0
#endif
constexpr int NPH = 14;

constexpr size_t MiB = 1u << 20;
constexpr size_t WS_CTL = 0, CTL_ZERO_BYTES = 64 * 1024;
constexpr size_t WS_WHIN = 1 * MiB, WS_WHOUT = 9 * MiB, WS_WQKV = 11 * MiB, WS_WAO = 20 * MiB, WS_WF1 = 23 * MiB, WS_WF2 = 45 * MiB;
constexpr size_t WS_SS = 56 * MiB, WS_E1 = 57 * MiB, WS_E2 = 58 * MiB, WS_COS = 59 * MiB, WS_SIN = 61 * MiB, WS_LSE = 63 * MiB, WS_LB = 63 * MiB + 768 * 1024;
constexpr size_t WS_ST = 64 * MiB;
constexpr size_t WS_XB = 80 * MiB;
constexpr size_t WS_ACT = 112 * MiB;
constexpr size_t WS_QT = WS_ACT, WS_KT = WS_ACT + 32 * MiB, WS_VV = WS_ACT + 64 * MiB, WS_GG = WS_ACT + 96 * MiB;
constexpr size_t WS_FF = WS_ACT;
constexpr size_t WS_QP = WS_ACT, WS_KP = WS_ACT + 48 * MiB, WS_VP = WS_ACT + 96 * MiB;
constexpr size_t WS_END = 256 * MiB;
static_assert(WS_VP + (size_t)M * AW * 2 <= WS_END && WS_FF + (size_t)M * DFF * 2 <= WS_END && WS_GG + (size_t)M * D * 2 <= WS_END, "d_ws map");
static_assert(WS_WF2 + 2 * (size_t)D * DFF * 2 <= WS_SS && WS_WF1 + 2 * (size_t)FF2 * D * 2 <= WS_WF2 && WS_WAO + (size_t)D * AW * 2 <= WS_WF1 && WS_WQKV + (size_t)QKVW * D * 2 <= WS_WAO, "weights map");
constexpr int CW_TMO = 0, CW_BAR = 4096;

constexpr int RING_OFF = 0, RING_BYTES = 131072;
constexpr int LDSCTL_OFF = RING_BYTES, MISC_OFF = LDSCTL_OFF + 320;
constexpr int MERGE_OFF = RING_BYTES + 4096;
constexpr int LDS_BYTES = 147456;
namespace swa {
constexpr float SCALE = 0.08838834764831845f;
constexpr int D = 128; constexpr bool WSKIP = true; constexpr float THR = 8.f;
constexpr int PLANE_PITCH = AW, SEQ_T = T; constexpr size_t K_FROM_Q = (WS_KP - WS_QP) / 2, V_FROM_K = (WS_VP - WS_KP) / 2;
constexpr int NW = 8, QBLK = 32, KVBLK = 64, QB = NW * QBLK;
constexpr int SHM_V = KVBLK * D * 2, SHM_K = KVBLK * D * 2, ATT_LDS_BYTES = 2 * SHM_V + 2 * SHM_K + NW * 64 * 4;
typedef unsigned short bf16;
typedef short bf16x8 __attribute__((ext_vector_type(8)));
typedef short s16x4 __attribute__((ext_vector_type(4)));
typedef float f32x16 __attribute__((ext_vector_type(16)));
typedef float f32x4 __attribute__((ext_vector_type(4)));
typedef unsigned u32x4 __attribute__((ext_vector_type(4)));
template <class A, class Bt> struct same_t { static constexpr bool v = false; };
template <class A> struct same_t<A, A> { static constexpr bool v = true; };

#define KSWZ(row, colB) ((row) * 256 + ((colB) ^ (((row) & 7) << 4)))
#define SBAR() __builtin_amdgcn_sched_barrier(0)
__device__ __forceinline__ int v_st(int k, int c) { const int kk = (k & ~0xC) | ((k & 4) << 1) | ((k & 8) >> 1); return ((kk >> 3) * 4 + (c >> 5)) * 512 + ((kk & 7) * 32 + (c & 31)) * 2; }
__device__ __forceinline__ int v_rd_base(int lane) { return ((lane & 3) << 3) | (((lane >> 2) & 3) << 6) | (((lane >> 4) & 1) << 5) | (((lane >> 5) & 1) << 8); }
constexpr int v_rd_off(int d0, int ks, int half) { return d0 * 512 + ks * 4096 + half * 2048; }
__device__ __forceinline__ int crow(int r, int hi) { return (r & 3) + 8 * (r >> 2) + 4 * hi; }
__device__ __forceinline__ unsigned cvtpk(float lo, float hi) {
    unsigned r; asm volatile("v_cvt_pk_bf16_f32 %0, %1, %2" : "=v"(r) : "v"(lo), "v"(hi)); return r;
}
__device__ __forceinline__ bf16x8 pack8(f32x4 a, f32x4 b) {
    u32x4 w = {cvtpk(a[0], a[1]), cvtpk(a[2], a[3]), cvtpk(b[0], b[1]), cvtpk(b[2], b[3])};
    return *reinterpret_cast<bf16x8*>(&w);
}
template <class T> __device__ __forceinline__ bf16x8 load8(const T* p) {
    if constexpr (same_t<T, float>::v) { return pack8(*(const f32x4*)p, *(const f32x4*)(p + 4)); }
    else { return *reinterpret_cast<const bf16x8*>(p); }
}
__device__ __forceinline__ void mask_tile(f32x16& p0, f32x16& p1, int dq, unsigned W) {
    const float NEG = -__builtin_inff();
#pragma unroll
    for (int r = 0; r < 16; ++r) {
        const int c = (r & 3) + 8 * (r >> 2);
        if ((unsigned)(dq - c) >= W) p0[r] = NEG;
        if ((unsigned)(dq - c - 32) >= W) p1[r] = NEG;
    }
}
__device__ __forceinline__ void partialSM(f32x16& p0, f32x16& p1, float& m_reg, float& mn, float& alpha) {
    float pmax = p0[0]; for (int r = 1; r < 16; ++r) pmax = fmaxf(pmax, p0[r]); for (int r = 0; r < 16; ++r) pmax = fmaxf(pmax, p1[r]);
    { auto rr = __builtin_amdgcn_permlane32_swap(__float_as_uint(pmax), __float_as_uint(pmax), false, false);
      pmax = fmaxf(__uint_as_float(rr[0]), __uint_as_float(rr[1])); }
    constexpr float C2 = 1.4426950408889634f * SCALE;
    if (__builtin_expect(__all((pmax - m_reg) * SCALE <= THR), 1)) { mn = m_reg; alpha = 1.f; }
    else { mn = fmaxf(m_reg, pmax); alpha = __builtin_amdgcn_exp2f((m_reg - mn) * C2); m_reg = mn; }
    const float mnL = -mn * C2;
    for (int r = 0; r < 16; ++r) p0[r] = fmaf(p0[r], C2, mnL); for (int r = 0; r < 16; ++r) p1[r] = fmaf(p1[r], C2, mnL);
    for (int r = 0; r < 16; ++r) p0[r] = __builtin_amdgcn_exp2f(p0[r]);
}
__device__ __forceinline__ void finishSM(f32x16& p0, f32x16& p1, float alpha, float& l_reg, bf16x8& pa0, bf16x8& pa1, bf16x8& pa2, bf16x8& pa3) {
    for (int r = 0; r < 16; ++r) p1[r] = __builtin_amdgcn_exp2f(p1[r]);
    float ps = 0; for (int r = 0; r < 16; ++r) ps += p0[r]; for (int r = 0; r < 16; ++r) ps += p1[r];
    { auto rr = __builtin_amdgcn_permlane32_swap(__float_as_uint(ps), __float_as_uint(ps), false, false);
      ps = __uint_as_float(rr[0]) + __uint_as_float(rr[1]); }
    l_reg = l_reg * alpha + ps;
#define PK4(P, B_, OUT) do { unsigned a0 = cvtpk(P[B_+0], P[B_+1]), a1 = cvtpk(P[B_+2], P[B_+3]);                          \
        unsigned b0 = cvtpk(P[B_+4], P[B_+5]), b1 = cvtpk(P[B_+6], P[B_+7]);                                             \
        auto r0 = __builtin_amdgcn_permlane32_swap(a0, b0, false, false); auto r1 = __builtin_amdgcn_permlane32_swap(a1, b1, false, false); \
        u32x4 w = {r0[0], r1[0], r0[1], r1[1]}; OUT = *reinterpret_cast<bf16x8*>(&w); } while (0)
    PK4(p0, 0, pa0); PK4(p0, 8, pa1); PK4(p1, 0, pa2); PK4(p1, 8, pa3);
#undef PK4
}
template <int KB, bool SK>
__device__ __forceinline__ void qkt(f32x16& p0, f32x16& p1, const char* K_lds, int r32, int hi, const bf16x8* qr, bool act) {
    if (SK && !act) { const float NEG = -__builtin_inff();
#pragma unroll
        for (int r = 0; r < 16; ++r) { p0[r] = NEG; p1[r] = NEG; } return; }
    p0 = f32x16{}; p1 = f32x16{};
    const char* kb[4];
#pragma unroll
    for (int dd = 0; dd < 4; ++dd) kb[dd] = K_lds + KB * SHM_K + KSWZ(r32, (dd * 16 + hi * 8) * 2);
#pragma unroll
    for (int d0 = 0; d0 < 8; ++d0) { const char* a = kb[d0 & 3] + (d0 >> 2) * 128;
        bf16x8 b0 = *reinterpret_cast<const bf16x8*>(a);
        bf16x8 b1 = *reinterpret_cast<const bf16x8*>(a + 32 * 256);
        p0 = __builtin_amdgcn_mfma_f32_32x32x16_bf16(b0, qr[d0], p0, 0, 0, 0);
        p1 = __builtin_amdgcn_mfma_f32_32x32x16_bf16(b1, qr[d0], p1, 0, 0, 0); }
}
template <int VB, bool SK>
__device__ __forceinline__ void pv_tile(f32x16* o, int vb0, bf16x8 pa0, bf16x8 pa1, bf16x8 pa2, bf16x8 pa3, bool act) {
    if (SK && !act) return;
#define TRRD(dst, off) asm volatile("ds_read_b64_tr_b16 %0, %1 offset:%2" : "=&v"(dst) : "v"(vb0), "i"(off) : "memory")
#define PV_D0(d0) do { s16x4 l0, l1, l2, l3, h0, h1, h2, h3; constexpr int b_ = VB * SHM_V + v_rd_off(d0, 0, 0);     \
        TRRD(l0, b_); TRRD(h0, b_ + 2048); TRRD(l1, b_ + 4096); TRRD(h1, b_ + 6144); TRRD(l2, b_ + 8192); TRRD(h2, b_ + 10240); TRRD(l3, b_ + 12288); TRRD(h3, b_ + 14336); \
        asm volatile("s_waitcnt lgkmcnt(0)" ::: "memory"); SBAR();                 \
        o[d0] = __builtin_amdgcn_mfma_f32_32x32x16_bf16(pa0, (bf16x8){l0[0], l0[1], l0[2], l0[3], h0[0], h0[1], h0[2], h0[3]}, o[d0], 0, 0, 0);   \
        o[d0] = __builtin_amdgcn_mfma_f32_32x32x16_bf16(pa1, (bf16x8){l1[0], l1[1], l1[2], l1[3], h1[0], h1[1], h1[2], h1[3]}, o[d0], 0, 0, 0);   \
        o[d0] = __builtin_amdgcn_mfma_f32_32x32x16_bf16(pa2, (bf16x8){l2[0], l2[1], l2[2], l2[3], h2[0], h2[1], h2[2], h2[3]}, o[d0], 0, 0, 0);   \
        o[d0] = __builtin_amdgcn_mfma_f32_32x32x16_bf16(pa3, (bf16x8){l3[0], l3[1], l3[2], l3[3], h3[0], h3[1], h3[2], h3[3]}, o[d0], 0, 0, 0); } while (0)
    PV_D0(0); PV_D0(1); PV_D0(2); PV_D0(3);
#undef PV_D0
#undef TRRD
}

template <class TIn, class TOut> struct BlockRef { const TIn* Q; int P0, sh, lrow;
    __device__ __forceinline__ int pitch() const { return PLANE_PITCH << sh; }
    __device__ __forceinline__ const TIn* K() const { return Q + K_FROM_Q - (size_t)P0 * (size_t)pitch(); }
    __device__ __forceinline__ const TIn* V() const { return K() + V_FROM_K; }
    __device__ __forceinline__ int skv() const { return SEQ_T >> sh; }
    __device__ __forceinline__ int lp() const { return 12 << sh; } };
template <class TIn> struct Seam {
    bf16x8 qr[8];
    bf16x8 st_v0, st_v1, st_k0, st_k1; f32x4 sf0, sf1, sf2, sf3;
    f32x4 tq[16];
};
__device__ __forceinline__ int swa_jlo(int P0, int W) { const int lowk = P0 - W + 1; return lowk > 0 ? lowk / KVBLK : 0; }
#define ROW(p, k0, rr, kp_) ((p) + (size_t)((k0) + (rr)) * (kp_) + sc)
#define VMW() asm volatile("s_waitcnt vmcnt(0)" ::: "memory")
#define VMWN(n) asm volatile("s_waitcnt vmcnt(%0)" :: "i"(n) : "memory")
#define SLOAD_H(Kp, Vp, k0, kp_) do { S.st_v0 = load8<TIn>(ROW(Vp, k0, sr, kp_)); S.st_v1 = load8<TIn>(ROW(Vp, k0, 32 + sr, kp_));              \
                         S.st_k0 = load8<TIn>(ROW(Kp, k0, sr, kp_)); S.st_k1 = load8<TIn>(ROW(Kp, k0, 32 + sr, kp_)); } while (0)
#define SWRITE_HK(bf) do { *(bf16x8*)(K_lds + (bf) * SHM_K + kws) = S.st_k0; *(bf16x8*)(K_lds + (bf) * SHM_K + kws + 32 * 256) = S.st_k1; } while (0)
#define SWRITE_HV(bf) do { *(bf16x8*)(V_lds + (bf) * SHM_V + vst0) = S.st_v0; *(bf16x8*)(V_lds + (bf) * SHM_V + vst1) = S.st_v1; } while (0)
#define SWRITE_H(bf) do { SWRITE_HV(bf); SWRITE_HK(bf); } while (0)
#define SLOAD_F(p, k0) do { S.sf0 = *(const f32x4*)ROW(p, k0, sr, D); S.sf1 = *(const f32x4*)(ROW(p, k0, sr, D) + 4);                \
                            S.sf2 = *(const f32x4*)ROW(p, k0, 32 + sr, D); S.sf3 = *(const f32x4*)(ROW(p, k0, 32 + sr, D) + 4); } while (0)
#define SWRITE_KF(bf) do { *(bf16x8*)(K_lds + (bf) * SHM_K + kws) = pack8(S.sf0, S.sf1); *(bf16x8*)(K_lds + (bf) * SHM_K + kws + 32 * 256) = pack8(S.sf2, S.sf3); } while (0)
#define SWRITE_VF(bf) do { *(bf16x8*)(V_lds + (bf) * SHM_V + vst0) = pack8(S.sf0, S.sf1); *(bf16x8*)(V_lds + (bf) * SHM_V + vst1) = pack8(S.sf2, S.sf3); } while (0)
template <class TIn, class TOut>
__device__ __forceinline__ void causal_swa_prime(const BlockRef<TIn, TOut>& cur, int W, char* lds, Seam<TIn>& S) {
    constexpr bool F32 = same_t<TIn, float>::v;
    const int tid = threadIdx.x, wid = __builtin_amdgcn_readfirstlane(tid >> 6), lane = tid & 63, r32 = lane & 31, hi = lane >> 5;
    const int sr = tid >> 4, sc = (tid & 15) * 8, kws = KSWZ(sr, sc * 2); char* K_lds = lds + 2 * SHM_V;
    const int kb0 = swa_jlo(cur.P0, W) * KVBLK;
    for (int d0 = 0; d0 < 8; ++d0) S.qr[d0] = load8<TIn>(cur.Q + (size_t)(wid * QBLK + r32) * cur.pitch() + d0 * 16 + hi * 8);
    if constexpr (F32) { SLOAD_F((const float*)cur.K(), kb0); VMW(); SWRITE_KF(0); SBAR(); SLOAD_F((const float*)cur.V(), kb0); }
    else { SLOAD_H(cur.K(), cur.V(), kb0, cur.pitch()); VMW(); SWRITE_HK(0); }
    __syncthreads();
}
template <class TIn, class TOut>
__device__ __forceinline__ void causal_swa_block(const BlockRef<TIn, TOut>& cur, const BlockRef<TIn, TOut>& nxt, float* lse, int W, char* lds, Seam<TIn>& S) {
    const int skv = cur.skv();
    constexpr bool F32 = same_t<TIn, float>::v;
    const int tid = threadIdx.x, wid = __builtin_amdgcn_readfirstlane(tid >> 6), lane = tid & 63, r32 = lane & 31, hi = lane >> 5;
    const int j_lo = swa_jlo(cur.P0, W);
    int j_hi = (cur.P0 + QB - 1) / KVBLK + 1; if (j_hi > skv / KVBLK) j_hi = skv / KVBLK;
    const int NT = j_hi - j_lo;
    const int kbn = swa_jlo(nxt.P0, W) * KVBLK;
    const int qlo = cur.P0 + wid * QBLK, qm = qlo + r32 - 4 * hi;
    char* V_lds = lds; char* K_lds = lds + 2 * SHM_V;
    float* ws = (float*)(lds + 2 * SHM_V + 2 * SHM_K) + wid * 64; float* li_l = ws, * al_l = ws + 32;
    float m_reg = -1e30f, l_reg = 0; f32x16 o[4] = {};
    const int sr = tid >> 4, sc = (tid & 15) * 8, vst0 = v_st(sr, sc), vst1 = v_st(32 + sr, sc), kws = KSWZ(sr, sc * 2);
    const int vb0 = (int)(uintptr_t)V_lds + v_rd_base(lane);
    const TIn* Kh = cur.K(); const TIn* Vh = Kh + V_FROM_K; const int kpc = cur.pitch();
#define RESC(a) do { if (__any((a) < 1.f)) { if (hi == 0) al_l[r32] = (a); asm volatile("s_waitcnt lgkmcnt(0)" ::: "memory");              \
                     for (int d_ = 0; d_ < 4; ++d_) for (int r = 0; r < 16; ++r) o[d_][r] *= al_l[crow(r, hi)]; } } while (0)
#define KBASE(t) ((j_lo + (t)) * KVBLK)
#define ACT(t) (KBASE(t) <= qlo + QBLK - 1 && KBASE(t) + KVBLK - 1 >= qlo - W + 1)
#define MASKT(P0_, P1_, t) do { const int kb_ = KBASE(t); if ((!SK || ACT(t)) && (kb_ + KVBLK - 1 > qlo || kb_ <= qlo + QBLK - 1 - W)) mask_tile(P0_, P1_, qm - kb_, (unsigned)W); } while (0)
    constexpr int NQL = F32 ? 16 : 8;
    constexpr bool SK = WSKIP && !F32;
#define SEAM_K0() do { VMWN(NQL); if constexpr (F32) { SWRITE_KF(0); SBAR(); SLOAD_F((const float*)nxt.V(), kbn); } else { SWRITE_HK(0); } SBAR(); } while (0)
    f32x16 pA0, pA1, pB0, pB1; float mnA, mnB, alA, alB; bf16x8 pa0, pa1, pa2, pa3;
    if constexpr (F32) { VMW(); SWRITE_VF(0); SBAR(); } else { SWRITE_HV(0); SBAR(); }
    if (NT > 1) { if constexpr (F32) SLOAD_F((const float*)Kh, KBASE(1)); else SLOAD_H(Kh, Vh, KBASE(1), kpc); }
    SBAR(); qkt<0, SK>(pA0, pA1, K_lds, r32, hi, S.qr, ACT(0));
    if constexpr (F32) { if (NT > 1) { VMW(); SWRITE_KF(1); SBAR(); SLOAD_F((const float*)Vh, KBASE(1)); } }
    MASKT(pA0, pA1, 0); partialSM(pA0, pA1, m_reg, mnA, alA);
    if (NT > 1) { VMW(); if constexpr (F32) { SWRITE_VF(1); SBAR(); if (NT > 2) SLOAD_F((const float*)Kh, KBASE(2)); } else SWRITE_H(1); }
    __syncthreads();
#define HALF_STEP(PX0, PX1, mnX, alX, PY0, PY1, alY, t, KB, VB, SB) do {                                                      \
        SBAR(); qkt<KB, SK>(PX0, PX1, K_lds, r32, hi, S.qr, ACT(t));                                             \
        finishSM(PY0, PY1, alY, l_reg, pa0, pa1, pa2, pa3); SBAR();                                                           \
        if ((t) + 1 < NT) { if constexpr (F32) { VMW(); SWRITE_KF(SB); SBAR(); SLOAD_F((const float*)Vh, KBASE((t) + 1)); }  \
                            else { SLOAD_H(Kh, Vh, KBASE((t) + 1), kpc); } SBAR(); }                                               \
        pv_tile<VB, SK>(o, vb0, pa0, pa1, pa2, pa3, ACT((t) - 1)); MASKT(PX0, PX1, (t)); partialSM(PX0, PX1, m_reg, mnX, alX);                                        \
        __syncthreads();                                                                                                      \
        if ((t) + 1 < NT) { VMW(); if constexpr (F32) { SWRITE_VF(SB); SBAR(); if ((t) + 2 < NT) SLOAD_F((const float*)Kh, KBASE((t) + 2)); } \
                            else { SWRITE_H(SB); } }                                                                          \
        RESC(alX); __syncthreads(); } while (0)
    for (int t = 1; t + 1 < NT; t += 2) {
        HALF_STEP(pB0, pB1, mnB, alB, pA0, pA1, alA, t, 1, 0, 0);
        HALF_STEP(pA0, pA1, mnA, alA, pB0, pB1, alB, t + 1, 0, 1, 1);
    }
    const bool even = (NT & 1) == 0;
    if (even) { SBAR(); qkt<1, SK>(pB0, pB1, K_lds, r32, hi, S.qr, ACT(NT - 1)); SBAR(); }
#define QROW(e) (nxt.Q + (size_t)(wid * QBLK + r32) * nxt.pitch() + ((e) >> 1) * 16 + hi * 8 + ((e) & 1) * 4)
    if constexpr (F32) { SLOAD_F((const float*)nxt.K(), kbn); SBAR();
#pragma unroll
        for (int e = 0; e < 8; ++e) S.tq[e] = *(const f32x4*)QROW(e); }
    else { SLOAD_H(nxt.K(), nxt.V(), kbn, nxt.pitch()); SBAR();
#pragma unroll
        for (int d0 = 0; d0 < 8; ++d0) S.qr[d0] = load8<TIn>(nxt.Q + (size_t)(wid * QBLK + r32) * nxt.pitch() + d0 * 16 + hi * 8); }
    SBAR();
    finishSM(pA0, pA1, alA, l_reg, pa0, pa1, pa2, pa3); SBAR();
    if constexpr (F32) {
#pragma unroll
        for (int e = 8; e < 16; ++e) S.tq[e] = *(const f32x4*)QROW(e); SBAR(); }
#undef QROW
    pv_tile<0, SK>(o, vb0, pa0, pa1, pa2, pa3, ACT(even ? NT - 2 : NT - 1));
    if (even) { MASKT(pB0, pB1, NT - 1); partialSM(pB0, pB1, m_reg, mnB, alB); __syncthreads(); RESC(alB);
        finishSM(pB0, pB1, alB, l_reg, pa0, pa1, pa2, pa3); SBAR(); pv_tile<1, SK>(o, vb0, pa0, pa1, pa2, pa3, ACT(NT - 1)); }
    SBAR(); SEAM_K0();
    if (hi == 0) li_l[r32] = __expf(m_reg * SCALE); asm volatile("s_waitcnt lgkmcnt(0)" ::: "memory");
    float rli[16];
#pragma unroll
    for (int r = 0; r < 16; ++r) rli[r] = li_l[crow(r, hi)];
    TOut* Ow = (TOut*)cur.Q + (size_t)(wid * QBLK) * kpc;
    if (hi == 0) lse[(size_t)cur.lrow + (size_t)(wid * QBLK + r32) * cur.lp()] = m_reg * SCALE + __logf(l_reg);
#pragma unroll
    for (int r = 0; r < 16; ++r) { const int orow = crow(r, hi);
#pragma unroll
        for (int d0 = 0; d0 < 4; ++d0) { const float v = o[d0][r] * rli[r];
            if constexpr (same_t<TOut, float>::v) { Ow[(size_t)orow * kpc + d0 * 32 + r32] = v; }
            else { const float vn = __shfl_xor(v, 1);
                   if ((r32 & 1) == 0) *(unsigned*)(Ow + (size_t)orow * kpc + d0 * 32 + r32) = cvtpk(v, vn); } } }
    if constexpr (F32) {
#pragma unroll
        for (int d0 = 0; d0 < 8; ++d0) S.qr[d0] = pack8(S.tq[2 * d0], S.tq[2 * d0 + 1]); }
    __syncthreads();
#undef RESC
#undef KBASE
#undef ACT
#undef MASKT
#undef SEAM_K0
#undef HALF_STEP
}
#undef ROW
#undef VMW
#undef VMWN
#undef SLOAD_H
#undef SWRITE_HK
#undef SWRITE_HV
#undef SWRITE_H
#undef SLOAD_F
#undef SWRITE_KF
#undef SWRITE_VF


}

#define GAS __attribute__((address_space(1)))
#define LAS __attribute__((address_space(3)))
typedef unsigned short bf16;
typedef unsigned v4u __attribute__((ext_vector_type(4)));
typedef unsigned u32x2 __attribute__((ext_vector_type(2)));
typedef float f32x4 __attribute__((ext_vector_type(4)));
typedef short bf16x8 __attribute__((ext_vector_type(8)));
typedef GAS unsigned gu32;
typedef GAS unsigned long long gu64;
#define RLX_AGENT __ATOMIC_RELAXED, __HIP_MEMORY_SCOPE_AGENT
#define LDS_WAIT() asm volatile("s_waitcnt lgkmcnt(0)" ::: "memory")
#define VM_WAIT() asm volatile("s_waitcnt vmcnt(0)" ::: "memory")
__device__ __forceinline__ unsigned long long rt() { return __builtin_amdgcn_s_memrealtime(); }
__device__ __forceinline__ unsigned f2bf(float f) { unsigned u = __builtin_bit_cast(unsigned, f); return (u + 0x7fffu + ((u >> 16) & 1u)) >> 16; }
__device__ __forceinline__ unsigned pk2(float lo, float hi) { return f2bf(lo) | (f2bf(hi) << 16); }

#define XB_TMO      128
#define XB_XCNT(j)  (256  + 64 * (j))
#define XB_XSUB(j)  (1280 + 64 * (j))
#define XB_XGEN(j)  (2304 + 64 * (j))
#define XB_TOP      3328
#define XB_TOPGEN   3392
#define XCD_BAR_WORDS 3456
#define XB_SPIN_CAP (1u << 18)

__device__ __forceinline__ unsigned xb_ld(unsigned* p)              { return __hip_atomic_load(p, __ATOMIC_RELAXED, __HIP_MEMORY_SCOPE_AGENT); }
__device__ __forceinline__ unsigned xb_add(unsigned* p, unsigned v) { return __hip_atomic_fetch_add(p, v, __ATOMIC_RELAXED, __HIP_MEMORY_SCOPE_AGENT); }
__device__ __forceinline__ unsigned xb_xcc_id() { return (unsigned)__builtin_amdgcn_s_getreg((3 << 11) | 20) & 0xFu; }
#define XB_SPIN(cond, bar) do { unsigned _sp = 0; while (cond) { __builtin_amdgcn_s_sleep(1); \
    if ((++_sp & 255u) == 0u) { if (xb_ld(&(bar)[XB_TMO])) break; if (_sp > XB_SPIN_CAP) { atomicAdd(&(bar)[XB_TMO], 1u); break; } } } } while (0)

struct XcdBarrier {
    unsigned* bar; unsigned x;
    volatile LAS unsigned* st;
};

__device__ __forceinline__ XcdBarrier xcd_barrier_post(unsigned* bar, volatile LAS unsigned* st) {
    XcdBarrier b; b.bar = bar; b.x = xb_xcc_id(); b.st = st;
    if (threadIdx.x == 0) (void)xb_add(&bar[XB_XCNT(b.x)], 1u);
    return b;
}
__device__ __forceinline__ void xcd_barrier_complete(unsigned* bar, unsigned x, unsigned& nloc, unsigned& nx) {
    const unsigned G = gridDim.x * gridDim.y * gridDim.z;
    unsigned sum, cnt, mine, sp = 0u;
    for (;;) {
        sum = 0u; cnt = 0u; mine = 0u;
#pragma unroll
        for (unsigned j = 0; j < 16; ++j) { const unsigned c = xb_ld(&bar[XB_XCNT(j)]); sum += c; cnt += (c > 0u) ? 1u : 0u; mine = (j == x) ? c : mine; }
        if (sum == G) break;
        __builtin_amdgcn_s_sleep(1);
        if ((++sp & 255u) == 0u) { if (xb_ld(&bar[XB_TMO])) break; if (sp > XB_SPIN_CAP) { atomicAdd(&bar[XB_TMO], 1u); break; } }
    }
    nloc = mine > 0u ? mine : 1u; nx = cnt > 0u ? cnt : 1u;
}

__device__ __forceinline__ void xcd_barrier(const XcdBarrier& b) {
    asm volatile("s_waitcnt vmcnt(0)" ::: "memory");
    __syncthreads();
    if (threadIdx.x == 0) {
        unsigned* bar = b.bar;
        __builtin_amdgcn_s_waitcnt(0);
        unsigned nloc = b.st[0], nx = b.st[1];
        if (nloc == 0u) { xcd_barrier_complete(bar, b.x, nloc, nx); b.st[0] = nloc; b.st[1] = nx; }
        const unsigned old = xb_add(&bar[XB_XSUB(b.x)], 1u);
        const unsigned gen = old / nloc;
        if (old + 1u == (gen + 1u) * nloc) {
            __builtin_amdgcn_fence(__ATOMIC_RELEASE, "agent");
            asm volatile("s_waitcnt vmcnt(0)" ::: "memory");
            const unsigned og = xb_add(&bar[XB_TOP], 1u);
            const unsigned tg = og / nx;
            if (og + 1u == (tg + 1u) * nx) xb_add(&bar[XB_TOPGEN], 1u);
            else XB_SPIN(xb_ld(&bar[XB_TOPGEN]) == tg, bar);
            __builtin_amdgcn_fence(__ATOMIC_ACQUIRE, "agent");
            xb_add(&bar[XB_XGEN(b.x)], 1u);
            asm volatile("s_waitcnt vmcnt(0)" ::: "memory");
        } else {
            XB_SPIN(xb_ld(&bar[XB_XGEN(b.x)]) == gen, bar);
            __builtin_amdgcn_fence(__ATOMIC_ACQUIRE, "agent");
            asm volatile("s_waitcnt vmcnt(0)" ::: "memory");
        }
    }
    __syncthreads();
}

struct Frame {
    LAS unsigned char* lds;
    volatile LAS unsigned* MISC;
    gu32* ctl;
    int tid, lane, wave;
    int vcu, G;
    const float *x, *norm_mix, *norm_ffn, *hgrn_w_in, *lb_logits, *hgrn_out_norm, *hgrn_w_out, *attn_w_qkv, *attn_w_out, *ffn_w_in, *ffn_w_down, *final_norm;
    float* out;
    bf16 *Whin, *Whout, *Wqkv, *Wao, *Wf1, *Wf2;
    float *SS, *E1, *E2, *COS, *SIN, *LSE, *LB, *ST, *DJ;
    bf16 *XB, *QT, *KT, *VV, *GG, *FF, *QP, *KP, *VP;
};
__device__ __forceinline__ float wave_sum(float v) {
#pragma unroll
    for (int o = 1; o < 64; o <<= 1) v += __shfl_xor(v, o);
    return v;
}
__device__ __forceinline__ float bf_lo(unsigned u) { return __uint_as_float(u << 16); }
__device__ __forceinline__ float bf_hi(unsigned u) { return __uint_as_float(u & 0xffff0000u); }

__device__ __forceinline__ int pinv32(int l) { return 16 * ((l >> 2) & 1) + 4 * (l >> 3) + (l & 3); }
template <int MODE> __device__ __forceinline__ int phys_row(int c) {
    if (MODE == 0) return (c & ~31) + pinv32(c & 31);
    if (MODE == 1) { const int up = c >= DFF ? 1 : 0, j = c - up * DFF; return 256 * (j >> 7) + 128 * up + (j & 96) + pinv32(j & 31); }
    if (MODE == 2) {
        if (c >= 2 * AW) { const int c0 = c - 2 * AW, hl = c0 >> 7, cc = ((hl & 3) * 3 + (hl >> 2)) * 128 + (c0 & 127); return 256 * (12 + (cc >> 8)) + (cc & 224) + pinv32(cc & 31); }
        const int plane = c >= AW ? 1 : 0, cc = c - plane * AW, hl = cc >> 7, head = (hl & 3) * 3 + (hl >> 2), d = cc & 127, half = d >> 6, j = d & 63;
        return 256 * (plane * 6 + (head >> 1)) + 128 * half + 32 * (2 * (head & 1) + (j >> 5)) + pinv32(j & 31);
    }
    { const int type = c >> 10, ch = c & 1023, chl = ch & 63; return 256 * (ch >> 6) + 128 * (type >> 1) + 32 * (chl >> 4) + 16 * (type & 1) + (chl & 15); }
}
template <int MODE, bool KPOS = false>
__device__ __forceinline__ void p0_transpose_item(const float* W, int K, int N, bf16* WT, const float* gain, LAS float* scr, int item, int lane) {
    const int nblk = N / 32, kb = item / nblk, nb = item % nblk, k0 = 64 * kb, n0 = 32 * nb;
    int ks = k0; if (KPOS) { const int pos = k0 >> 7; ks = ((pos % 3) * 4 + pos / 3) * 128 + (k0 & 127); }
    float wv[32];
    const float* wp = W + (size_t)(ks + (lane >> 5)) * N + n0 + (lane & 31);
#pragma unroll
    for (int i = 0; i < 32; ++i) wv[i] = wp[(size_t)(2 * i) * N];
#pragma unroll
    for (int i = 0; i < 32; ++i) { const int kk = 2 * i + (lane >> 5); float w = wv[i]; if (gain) w *= gain[ks + kk]; scr[kk * 33 + (lane & 31)] = w; }
    LDS_WAIT(); asm volatile("" ::: "memory");
    const int c = lane & 7;
#pragma unroll
    for (int j = 0; j < 4; ++j) { const int n = (lane >> 3) + 8 * j; const LAS float* s = scr + (8 * c) * 33 + n;
        v4u o; o.x = pk2(s[0 * 33], s[1 * 33]); o.y = pk2(s[2 * 33], s[3 * 33]); o.z = pk2(s[4 * 33], s[5 * 33]); o.w = pk2(s[6 * 33], s[7 * 33]);
        *(GAS v4u*)(WT + (size_t)phys_row<MODE>(n0 + n) * K + k0 + 8 * c) = o; }
    LDS_WAIT(); asm volatile("" ::: "memory");
}
__device__ __forceinline__ void p0_prologue(Frame& F) {
    LAS float* scr = (LAS float*)(F.lds + RING_OFF + F.wave * 16384);
    const int gw = F.vcu * NWAVES + F.wave, NGW = F.G * NWAVES;
    constexpr int I_HIN = (D / 64) * (HIN / 32), I_HOUT = (D / 64) * (D / 32), I_QKV = (D / 64) * (QKVW / 32), I_AO = (AW / 64) * (D / 32), I_F1 = (D / 64) * (FF2 / 32), I_F2 = (DFF / 64) * (D / 32);
    constexpr int NITEMS = I_HIN + I_HOUT + I_QKV + I_AO + 2 * I_F1 + 2 * I_F2;
    for (int it = gw; it < NITEMS; it += NGW) {
        int r = it;
        if (r < I_HIN) { p0_transpose_item<3>(F.hgrn_w_in, D, HIN, F.Whin, F.norm_mix, scr, r, F.lane); continue; } r -= I_HIN;
        if (r < I_HOUT) { p0_transpose_item<0>(F.hgrn_w_out, D, D, F.Whout, nullptr, scr, r, F.lane); continue; } r -= I_HOUT;
        if (r < I_QKV) { p0_transpose_item<2>(F.attn_w_qkv, D, QKVW, F.Wqkv, F.norm_mix + D, scr, r, F.lane); continue; } r -= I_QKV;
        if (r < I_AO) { p0_transpose_item<0, true>(F.attn_w_out, AW, D, F.Wao, nullptr, scr, r, F.lane); continue; } r -= I_AO;
        if (r < 2 * I_F1) { const int l = r / I_F1; p0_transpose_item<1>(F.ffn_w_in + (size_t)l * D * FF2, D, FF2, F.Wf1 + (size_t)l * FF2 * D, F.norm_ffn + l * D, scr, r - l * I_F1, F.lane); continue; } r -= 2 * I_F1;
        { const int l = r / I_F2; p0_transpose_item<0>(F.ffn_w_down + (size_t)l * DFF * D, DFF, D, F.Wf2 + (size_t)l * D * DFF, nullptr, scr, r - l * I_F2, F.lane); }
    }
    for (int m = gw; m < M; m += NGW) {
        const GAS f32x4* xr = (const GAS f32x4*)(F.x + (size_t)m * D) + F.lane;
        GAS unsigned long long* o8 = (GAS unsigned long long*)(F.XB + (size_t)m * D) + F.lane;
        float s = 0.f;
#pragma unroll
        for (int j = 0; j < 4; ++j) { const f32x4 v = xr[64 * j]; s += (v.x * v.x + v.y * v.y) + (v.z * v.z + v.w * v.w); o8[64 * j] = (unsigned long long)pk2(v.x, v.y) | ((unsigned long long)pk2(v.z, v.w) << 32); }
        s = wave_sum(s);
        if (F.lane < 16) F.SS[(size_t)m * 16 + F.lane] = F.lane == 0 ? s : 0.f;
    }
    const int gt = F.vcu * NWAVES * 64 + F.tid, NGT = F.G * NWAVES * 64;
    for (int i = gt; i < T * 64; i += NGT) { const int pos = i >> 6, j = i & 63;
        const float inv = 1.0f / exp2f((float)j * (13.287712379549449f / 64.0f)); const float ang = (float)pos * inv;
        const double rev = (double)ang * 0.15915494309189535; const float fr = (float)(rev - floor(rev));
        F.COS[i] = __builtin_amdgcn_cosf(fr); F.SIN[i] = __builtin_amdgcn_sinf(fr); }
    if (gt < D) { const float a = F.lb_logits[gt], b = F.lb_logits[D + gt], c = F.lb_logits[2 * D + gt]; const float mx = fmaxf(a, fmaxf(b, c));
        const float ea = expf(a - mx), eb = expf(b - mx), ec = expf(c - mx); F.LB[gt] = ea / (ea + eb + ec); }
}

namespace hg {
typedef short bf16x8 __attribute__((ext_vector_type(8)));
typedef short s16x4 __attribute__((ext_vector_type(4)));
constexpr int TILE = 16384, BUF = 3 * TILE;
constexpr int OFF_F = 2 * BUF, OFF_PART = OFF_F + 1024;
constexpr int HG_LDS_BYTES = OFF_PART + 4096;
constexpr int SUPER = 8, NSUPER = T / (64 * SUPER), NITEM = BATCH * 8 * NSUPER;
__device__ __forceinline__ int swz(int row) { return ((row & 7) << 5) | (((row >> 3) & 1) << 4); }
__device__ __forceinline__ bf16x8 mk8(u32x2 a, u32x2 b) { v4u w = {a.x, a.y, b.x, b.y}; return __builtin_bit_cast(bf16x8, w); }
__device__ __forceinline__ bf16x8 mk8s(s16x4 a, s16x4 b) { return (bf16x8){a[0], a[1], a[2], a[3], b[0], b[1], b[2], b[3]}; }
__device__ __forceinline__ u32x2 pk4(const f32x4 a) { u32x2 w; w.x = pg8::cvt_pk_bf16(a[0], a[1]); w.y = pg8::cvt_pk_bf16(a[2], a[3]); return w; }
#define HG_TRRD(dst, addr, off) asm volatile("ds_read_b64_tr_b16 %0, %1 offset:%2" : "=&v"(dst) : "v"(addr), "i"(off) : "memory")
#define HG_LGKM0() do { asm volatile("s_waitcnt lgkmcnt(0)" ::: "memory"); __builtin_amdgcn_sched_barrier(0); } while (0)
#define HG_MFMA(a, b, c) __builtin_amdgcn_mfma_f32_16x16x32_bf16((a), (b), (c), 0, 0, 0)

template <bool PC>
__device__ __forceinline__ void item(Frame& F, int it, float* DJ) {
    const int tid = F.tid, lane = F.lane, w = F.wave, li = lane & 15, g = lane >> 4;
    const int bh = it / NSUPER, j = it - bh * NSUPER, b = bh >> 3, h = bh & 7;
    const size_t row0 = (size_t)b * T + (size_t)j * (64 * SUPER);
    const int chunk0 = (int)(row0 >> 6), hc = h * 128;
    LAS unsigned char* L = F.lds + RING_OFF;
    const int srow = tid >> 4, sc16 = tid & 15;
    const unsigned st_off = (unsigned)(srow * 256 + ((sc16 * 16) ^ swz(srow)));
    const size_t g_off = (size_t)srow * 1024 + hc + sc16 * 8;
    const int sr = swz(li);
    const unsigned rbase = (unsigned)(li * 256 + ((8 * g) ^ (sr & 16))), sEr = (unsigned)(sr & 0xE0);
    const int trow = 4 * g + (li >> 2), stt = swz(trow);
    const unsigned tbase = (unsigned)(trow * 256 + ((8 * (li & 3)) ^ (stt & 16))), sEt = (unsigned)(stt & 0xE0);
    const unsigned ldsb = (unsigned)(size_t)L;

    f32x4 S[8]; bf16x8 Sb[4];
    float dprod = 1.f;
    if (PC && j > 0) {
        const float* st = F.ST + ((size_t)it << 14) + (size_t)(w * 32) * 64 + lane;
#pragma unroll
        for (int kt = 0; kt < 8; ++kt) {
            const f32x4 e1 = *(const f32x4*)(F.E1 + (size_t)chunk0 * 1024 + hc + 16 * kt + 4 * g);
#pragma unroll
            for (int r = 0; r < 4; ++r) S[kt][r] = st[(kt * 4 + r) * 64] * e1[r];
        }
    } else {
#pragma unroll
        for (int kt = 0; kt < 8; ++kt) S[kt] = (f32x4){0.f, 0.f, 0.f, 0.f};
        if (!PC && tid < 128) dprod = F.E1[(size_t)chunk0 * 1024 + hc + tid];
    }
#pragma unroll
    for (int kp = 0; kp < 4; ++kp) Sb[kp] = mk8(pk4(S[2 * kp]), pk4(S[2 * kp + 1]));
    float gn[4];
#pragma unroll
    for (int r = 0; r < 4; ++r) gn[r] = PC ? F.hgrn_out_norm[16 * w + 4 * g + r] : 0.f;

    v4u sq0, sq1, sk0, sk1, sv0, sv1; float fe = 1.f;
#define HG_LOAD(cc) do { const size_t ro_ = (row0 + (size_t)(cc) * 64) * 1024 + g_off; \
        if (PC) { sq0 = *(const GAS v4u*)(F.QT + ro_); sq1 = *(const GAS v4u*)(F.QT + ro_ + 32 * 1024); } \
        sk0 = *(const GAS v4u*)(F.KT + ro_); sk1 = *(const GAS v4u*)(F.KT + ro_ + 32 * 1024); sv0 = *(const GAS v4u*)(F.VV + ro_); sv1 = *(const GAS v4u*)(F.VV + ro_ + 32 * 1024); \
        if (tid < 128) { fe = F.E2[(size_t)(chunk0 + (cc)) * 1024 + hc + tid]; if ((cc) < SUPER - 1) fe *= F.E1[(size_t)(chunk0 + (cc) + 1) * 1024 + hc + tid]; dprod *= fe; } } while (0)
#define HG_WRITE(bi) do { LAS unsigned char* B_ = L + (bi) * BUF + st_off; \
        if (PC) { *(LAS v4u*)B_ = sq0; *(LAS v4u*)(B_ + 8192) = sq1; } \
        *(LAS v4u*)(B_ + TILE) = sk0; *(LAS v4u*)(B_ + TILE + 8192) = sk1; *(LAS v4u*)(B_ + 2 * TILE) = sv0; *(LAS v4u*)(B_ + 2 * TILE + 8192) = sv1; \
        if (tid < 128) ((LAS float*)(L + OFF_F + (bi) * 512))[tid] = fe; } while (0)

    HG_LOAD(0); HG_WRITE(0);
    __syncthreads();
    for (int c = 0; c < SUPER; ++c) {
        const int bi = c & 1;
        u32x2 gg[4];
        if (c + 1 < SUPER) HG_LOAD(c + 1);
        if (PC) {
#pragma unroll
            for (int ti = 0; ti < 4; ++ti) gg[ti] = *(const GAS u32x2*)(F.GG + (row0 + (size_t)c * 64 + 16 * ti + li) * 1024 + hc + 16 * w + 4 * g);
        }
        const unsigned qb_ = ldsb + bi * BUF, kb_ = qb_ + TILE, vb_ = qb_ + 2 * TILE;
        LAS unsigned char* Qp = L + bi * BUF; LAS unsigned char* Kp = Qp + TILE;
        bf16x8 vf[2];
        { s16x4 a0, a1, a2, a3; const unsigned va = vb_ + tbase + ((32u * w) ^ sEt);
          HG_TRRD(a0, va, 0); HG_TRRD(a1, va, 4096); HG_TRRD(a2, va, 8192); HG_TRRD(a3, va, 12288); HG_LGKM0();
          vf[0] = mk8s(a0, a1); vf[1] = mk8s(a2, a3); }
        f32x4 O[4];
        if (PC) {
#pragma unroll
            for (int ti = 0; ti < 4; ++ti) {
                bf16x8 qf[4];
#pragma unroll
                for (int kp = 0; kp < 4; ++kp) { const LAS unsigned char* a = Qp + 4096 * ti + rbase;
                    qf[kp] = mk8(*(const LAS u32x2*)(a + ((64u * kp) ^ sEr)), *(const LAS u32x2*)(a + ((64u * kp + 32u) ^ sEr))); }
                f32x4 o = {0.f, 0.f, 0.f, 0.f};
#pragma unroll
                for (int kp = 0; kp < 4; ++kp) o = HG_MFMA(Sb[kp], qf[kp], o);
                __builtin_amdgcn_sched_barrier(0);
                f32x4 p[4];
#pragma unroll
                for (int si = 0; si < 4; ++si) { p[si] = (f32x4){0.f, 0.f, 0.f, 0.f};
                    if (si <= ti) {
#pragma unroll
                        for (int kp = 0; kp < 4; ++kp) { const LAS unsigned char* a = Kp + 4096 * si + rbase;
                            const bf16x8 kf = mk8(*(const LAS u32x2*)(a + ((64u * kp) ^ sEr)), *(const LAS u32x2*)(a + ((64u * kp + 32u) ^ sEr)));
                            p[si] = HG_MFMA(kf, qf[kp], p[si]); }
                    } }
#pragma unroll
                for (int r = 0; r < 4; ++r) if (4 * g + r > li) p[ti][r] = 0.f;
                o = HG_MFMA(vf[0], mk8(pk4(p[0]), pk4(p[1])), o);
                if (ti >= 2) o = HG_MFMA(vf[1], mk8(pk4(p[2]), pk4(p[3])), o);
                O[ti] = o;
                __builtin_amdgcn_sched_barrier(0);
            }
        }
#pragma unroll
        for (int kt = 0; kt < 8; ++kt) {
            s16x4 a0, a1, a2, a3; const unsigned ka = kb_ + tbase + ((32u * kt) ^ sEt);
            HG_TRRD(a0, ka, 0); HG_TRRD(a1, ka, 4096); HG_TRRD(a2, ka, 8192); HG_TRRD(a3, ka, 12288); HG_LGKM0();
            S[kt] = HG_MFMA(mk8s(a0, a1), vf[0], S[kt]); S[kt] = HG_MFMA(mk8s(a2, a3), vf[1], S[kt]);
        }
#pragma unroll
        for (int kt = 0; kt < 8; ++kt) S[kt] = S[kt] * *(const LAS f32x4*)(L + OFF_F + bi * 512 + (16 * kt + 4 * g) * 4);
#pragma unroll
        for (int kp = 0; kp < 4; ++kp) Sb[kp] = mk8(pk4(S[2 * kp]), pk4(S[2 * kp + 1]));
        LAS float* part = (LAS float*)(L + OFF_PART + bi * 2048);
        if (PC) {
#pragma unroll
            for (int ti = 0; ti < 4; ++ti) { float q = (O[ti][0] * O[ti][0] + O[ti][1] * O[ti][1]) + (O[ti][2] * O[ti][2] + O[ti][3] * O[ti][3]);
                q += __shfl_xor(q, 16); q += __shfl_xor(q, 32);
                if (g == 0) part[(16 * ti + li) * 8 + w] = q; }
        }
        if (c + 1 < SUPER) HG_WRITE(bi ^ 1);
        __syncthreads();
        if (PC) {
#pragma unroll
            for (int ti = 0; ti < 4; ++ti) {
                const f32x4 p0 = *(const LAS f32x4*)(part + (16 * ti + li) * 8), p1 = *(const LAS f32x4*)(part + (16 * ti + li) * 8 + 4);
                const float tot = ((p0[0] + p0[1]) + (p0[2] + p0[3])) + ((p1[0] + p1[1]) + (p1[2] + p1[3]));
                const float r = 1.0f / sqrtf(tot * (1.0f / 128.0f) + NORM_EPS);
                f32x4 o = O[ti] * r;
                o[0] *= gn[0] * bf_lo(gg[ti].x); o[1] *= gn[1] * bf_hi(gg[ti].x); o[2] *= gn[2] * bf_lo(gg[ti].y); o[3] *= gn[3] * bf_hi(gg[ti].y);
                *(GAS u32x2*)(F.QT + (row0 + (size_t)c * 64 + 16 * ti + li) * 1024 + hc + 16 * w + 4 * g) = pk4(o);
            }
        }
    }
    if (!PC) {
        float* st = F.ST + ((size_t)(it + 1) << 14) + (size_t)(w * 32) * 64 + lane;
#pragma unroll
        for (int kt = 0; kt < 8; ++kt)
#pragma unroll
            for (int r = 0; r < 4; ++r) st[(kt * 4 + r) * 64] = S[kt][r];
        if (tid < 128) DJ[it * 128 + tid] = dprod;
    }
    __syncthreads();
#undef HG_LOAD
#undef HG_WRITE
}
__device__ __forceinline__ void phase_a(Frame& F, float* DJ) {
    for (int it = F.vcu; it < NITEM; it += F.G) { if ((it % NSUPER) == NSUPER - 1) continue; item<false>(F, it, DJ); }
}
__device__ __forceinline__ void phase_b(Frame& F, const float* DJ) {
    const int gt = F.vcu * NWAVES * 64 + F.tid, NGT = F.G * NWAVES * 64;
    for (int e = gt; e < BATCH * 8 * 16384; e += NGT) {
        const int bh = e >> 14, idx = e & 16383, kr = (idx >> 6) & 31, k = 16 * (kr >> 2) + 4 * ((idx & 63) >> 4) + (kr & 3);
        float s = 0.f;
        for (int j = 0; j + 1 < NSUPER; ++j) { const size_t a = ((size_t)(bh * NSUPER + j + 1) << 14) + idx; s = DJ[(bh * NSUPER + j) * 128 + k] * s + F.ST[a]; F.ST[a] = s; }
    }
}
__device__ __forceinline__ void phase_c(Frame& F) {
    for (int it = F.vcu; it < NITEM; it += F.G) item<true>(F, it, nullptr);
}
#undef HG_TRRD
#undef HG_LGKM0
#undef HG_MFMA
}

__device__ __forceinline__ void hgrn_simple_rec(Frame& F, float* oraw) {
    const int item = F.wave * F.G + F.vcu;
    if (item >= 256) return;
    const int b = item >> 7, h = (item >> 4) & 7, vg = item & 15, kc = h * 128 + 2 * F.lane, vc = h * 128 + vg * 8;
    float S0[8], S1[8];
#pragma unroll
    for (int j = 0; j < 8; ++j) { S0[j] = 0.f; S1[j] = 0.f; }
    for (int c = 0; c < 128; ++c) {
        const int chunk = b * 128 + c;
        const float e1x = F.E1[(size_t)chunk * 1024 + kc], e1y = F.E1[(size_t)chunk * 1024 + kc + 1], e2x = F.E2[(size_t)chunk * 1024 + kc], e2y = F.E2[(size_t)chunk * 1024 + kc + 1];
#pragma unroll
        for (int j = 0; j < 8; ++j) { S0[j] *= e1x; S1[j] *= e1y; }
#pragma unroll 2
        for (int t = 0; t < 64; ++t) {
            const size_t row = (size_t)chunk * 64 + t;
            const unsigned kq = *(const GAS unsigned*)(F.KT + row * 1024 + kc), qq = *(const GAS unsigned*)(F.QT + row * 1024 + kc);
            const v4u vv = *(const GAS v4u*)(F.VV + row * 1024 + vc);
            const float k0 = bf_lo(kq), k1 = bf_hi(kq), q0 = bf_lo(qq), q1 = bf_hi(qq);
            const float v[8] = {bf_lo(vv.x), bf_hi(vv.x), bf_lo(vv.y), bf_hi(vv.y), bf_lo(vv.z), bf_hi(vv.z), bf_lo(vv.w), bf_hi(vv.w)};
            float part[8];
#pragma unroll
            for (int j = 0; j < 8; ++j) { S0[j] = fmaf(k0, v[j], S0[j]); S1[j] = fmaf(k1, v[j], S1[j]); part[j] = q0 * S0[j] + q1 * S1[j]; }
#pragma unroll
            for (int j = 0; j < 8; ++j) part[j] = wave_sum(part[j]);
            if (F.lane == 0) { float* o = oraw + row * 1024 + vc; *(f32x4*)o = (f32x4){part[0], part[1], part[2], part[3]}; *(f32x4*)(o + 4) = (f32x4){part[4], part[5], part[6], part[7]}; }
        }
#pragma unroll
        for (int j = 0; j < 8; ++j) { S0[j] *= e2x; S1[j] *= e2y; }
    }
}
__device__ __forceinline__ void hgrn_simple_post(Frame& F, const float* oraw) {
    const int gw = F.vcu * NWAVES + F.wave, NGW = F.G * NWAVES;
    const float gn0 = F.hgrn_out_norm[2 * F.lane], gn1 = F.hgrn_out_norm[2 * F.lane + 1];
    for (int it = gw; it < M * 8; it += NGW) {
        const size_t off = (size_t)(it >> 3) * 1024 + (it & 7) * 128 + 2 * F.lane;
        const float v0 = oraw[off], v1 = oraw[off + 1];
        const float r = 1.0f / sqrtf(wave_sum(v0 * v0 + v1 * v1) * (1.0f / 128.0f) + NORM_EPS);
        const unsigned g = *(const GAS unsigned*)(F.GG + off);
        *(GAS unsigned*)(F.QT + off) = pk2(v0 * r * gn0 * bf_lo(g), v1 * r * gn1 * bf_hi(g));
    }
}
__device__ __forceinline__ void attn_simple(Frame& F) {
    const int gw = F.vcu * NWAVES + F.wave, NGW = F.G * NWAVES;
    for (int it = gw; it < M * 12; it += NGW) {
        const int row = it / 12, hd = it - row * 12, t = row & (T - 1), g = hd >> 2, dil = g == 0 ? 1 : (g == 1 ? 4 : 16);
        const size_t co = (size_t)hd * 128 + 2 * F.lane;
        const unsigned qq = *(const GAS unsigned*)(F.QP + (size_t)row * AW + co);
        const float q0 = bf_lo(qq), q1 = bf_hi(qq);
        float m = -INFINITY, l = 0.f, o0 = 0.f, o1 = 0.f;
        for (int j = 0; j <= 128; ++j) {
            if (t - j * dil < 0) break;
            const size_t rk = (size_t)(row - j * dil) * AW + co;
            const unsigned kk = *(const GAS unsigned*)(F.KP + rk), vv = *(const GAS unsigned*)(F.VP + rk);
            const float s = wave_sum(q0 * bf_lo(kk) + q1 * bf_hi(kk)) * 0.08838834764831845f;
            const float mn = fmaxf(m, s), a = __expf(m - mn), p = __expf(s - mn);
            l = l * a + p; o0 = o0 * a + p * bf_lo(vv); o1 = o1 * a + p * bf_hi(vv); m = mn;
        }
        *(GAS unsigned*)(F.QP + (size_t)row * AW + co) = pk2(o0 / l, o1 / l);
        if (F.lane == 0) F.LSE[(size_t)row * 12 + hd] = m + logf(l);
    }
}
typedef swa::BlockRef<bf16, bf16> AttRef;
__device__ __forceinline__ AttRef attn_ref(const Frame& F, int L) {
    const int bh = L >> 5, x = L & 31, b = bh / 12, head = bh - b * 12, sh = 2 * (head % 3), nqs = 5 - sh;
    const int r = x >> nqs, qb = x & ((1 << nqs) - 1);
    const size_t rowq = (size_t)b * T + r + ((size_t)qb * 256 << sh);
    AttRef R; R.Q = F.QP + rowq * AW + head * 128; R.P0 = qb * 256; R.sh = sh; R.lrow = (int)rowq * 12 + head;
    return R;
}
__device__ __forceinline__ void attn_fast(Frame& F, char* lds) {
    constexpr int NITEM = BATCH * 12 * 32, W = 129;
    int L = F.vcu; if (L >= NITEM) return;
    AttRef cur = attn_ref(F, L);
    swa::Seam<bf16> S;
    swa::causal_swa_prime<bf16, bf16>(cur, W, lds, S);
    for (;;) {
        const bool more = L + F.G < NITEM;
        const AttRef nxt = more ? attn_ref(F, L + F.G) : cur;
        swa::causal_swa_block<bf16, bf16>(cur, nxt, F.LSE, W, lds, S);
        if (!more) break;
        cur = nxt; L += F.G;
    }
}
__device__ __forceinline__ void attn_scale(Frame& F) {
    const int gt = F.vcu * NWAVES * 64 + F.tid, NGT = F.G * NWAVES * 64;
    for (int i = gt; i < M * (AW / 8); i += NGT) {
        const int row = i / (AW / 8), c8 = i - row * (AW / 8), hd = c8 >> 4, hg = hd & 3;
        const float* ls = F.LSE + (size_t)row * 12;
        const float a = ls[hg], b = ls[4 + hg], c = ls[8 + hg], mx = fmaxf(a, fmaxf(b, c));
        const float al = __expf(ls[hd] - mx) / (__expf(a - mx) + __expf(b - mx) + __expf(c - mx));
        GAS v4u* p = (GAS v4u*)(F.QP + (size_t)row * AW + c8 * 8);
        v4u v = *p;
        v.x = pk2(bf_lo(v.x) * al, bf_hi(v.x) * al); v.y = pk2(bf_lo(v.y) * al, bf_hi(v.y) * al); v.z = pk2(bf_lo(v.z) * al, bf_hi(v.z) * al); v.w = pk2(bf_lo(v.w) * al, bf_hi(v.w) * al);
        *p = v;
    }
}
__device__ __forceinline__ void final_norm_rows(Frame& F) {
    const int gw = F.vcu * NWAVES + F.wave, NGW = F.G * NWAVES;
    for (int m = gw; m < M; m += NGW) {
        const float s = wave_sum(F.lane < 16 ? F.SS[(size_t)m * 16 + F.lane] : 0.f);
        const float r = 1.0f / sqrtf(s * (1.0f / D) + NORM_EPS);
        const GAS v4u* xr = (const GAS v4u*)(F.XB + (size_t)m * D) + F.lane;
        GAS f32x4* o = (GAS f32x4*)(F.out + (size_t)m * D) + 2 * F.lane;
        const GAS f32x4* gr = (const GAS f32x4*)F.final_norm + 2 * F.lane;
#pragma unroll
        for (int j = 0; j < 2; ++j) { const v4u v = xr[64 * j]; const f32x4 g0 = gr[128 * j], g1 = gr[128 * j + 1];
            o[128 * j] = (f32x4){bf_lo(v.x) * r * g0.x, bf_hi(v.x) * r * g0.y, bf_lo(v.y) * r * g0.z, bf_hi(v.y) * r * g0.w};
            o[128 * j + 1] = (f32x4){bf_lo(v.z) * r * g1.x, bf_hi(v.z) * r * g1.y, bf_lo(v.w) * r * g1.z, bf_hi(v.w) * r * g1.w}; }
    }
}

__device__ __forceinline__ bool fresh(Frame& F) { int t = threadIdx.x; asm volatile("" : "+v"(t)); F.tid = t; F.lane = t & 63; F.wave = __builtin_amdgcn_readfirstlane(t >> 6); return true; }
struct Args { const float* in[12]; float* out; unsigned char* ws; int ph_lo, ph_hi; };
__global__ void __launch_bounds__(NWAVES * 64, 2) trunk_fwd(Args args) {
    extern __shared__ __attribute__((aligned(16))) unsigned char lds[];
    Frame F;
    F.lds = (LAS unsigned char*)lds;
    F.MISC = (volatile LAS unsigned*)(F.lds + MISC_OFF);
    F.tid = threadIdx.x; F.lane = F.tid & 63; F.wave = __builtin_amdgcn_readfirstlane(F.tid >> 6);
    F.G = gridDim.x; { const int bx = blockIdx.x; F.vcu = (F.G % 8 == 0) ? (bx % 8) * (F.G / 8) + bx / 8 : bx; }
    unsigned char* ws = args.ws;
    F.ctl = (gu32*)(ws + WS_CTL);
    F.x = args.in[0]; F.norm_mix = args.in[1]; F.norm_ffn = args.in[2]; F.hgrn_w_in = args.in[3]; F.lb_logits = args.in[4]; F.hgrn_out_norm = args.in[5]; F.hgrn_w_out = args.in[6];
    F.attn_w_qkv = args.in[7]; F.attn_w_out = args.in[8]; F.ffn_w_in = args.in[9]; F.ffn_w_down = args.in[10]; F.final_norm = args.in[11]; F.out = args.out;
    F.Whin = (bf16*)(ws + WS_WHIN); F.Whout = (bf16*)(ws + WS_WHOUT); F.Wqkv = (bf16*)(ws + WS_WQKV); F.Wao = (bf16*)(ws + WS_WAO); F.Wf1 = (bf16*)(ws + WS_WF1); F.Wf2 = (bf16*)(ws + WS_WF2);
    F.SS = (float*)(ws + WS_SS); F.E1 = (float*)(ws + WS_E1); F.E2 = (float*)(ws + WS_E2); F.COS = (float*)(ws + WS_COS); F.SIN = (float*)(ws + WS_SIN); F.LSE = (float*)(ws + WS_LSE); F.LB = (float*)(ws + WS_LB); F.DJ = (float*)(ws + WS_LB + 4096); F.ST = (float*)(ws + WS_ST);
    F.XB = (bf16*)(ws + WS_XB); F.QT = (bf16*)(ws + WS_QT); F.KT = (bf16*)(ws + WS_KT); F.VV = (bf16*)(ws + WS_VV); F.GG = (bf16*)(ws + WS_GG); F.FF = (bf16*)(ws + WS_FF);
    F.QP = (bf16*)(ws + WS_QP); F.KP = (bf16*)(ws + WS_KP); F.VP = (bf16*)(ws + WS_VP);
    for (int u = F.tid; u < (LDS_BYTES - LDSCTL_OFF) / 4; u += NWAVES * 64) ((LAS unsigned*)(F.lds + LDSCTL_OFF))[u] = 0u;
    __syncthreads();
    XcdBarrier bar; bar.bar = (unsigned*)(F.ctl + CW_BAR); bar.x = 0; bar.st = nullptr;
    if (!MK_PER_PHASE) bar = xcd_barrier_post((unsigned*)(F.ctl + CW_BAR), F.MISC + 8);
    const int lo = args.ph_lo, hi = args.ph_hi;
#define IN(k) (lo <= (k) && (k) < hi && fresh(F))
#ifndef PROBE_A
#define PROBE_A -1
#define PROBE_B -1
#endif
#define SEAM(k) do { if (IN(k) && IN((k) + 1)) xcd_barrier(bar); if (PROBE_A >= 0 && blockIdx.x == 0 && F.tid == 0) ((unsigned long long*)(ws + WS_LB + 4096 + 256 * 1024))[(k) + 1] = __builtin_amdgcn_s_memrealtime(); } while (0)
    using pg8::Gemm; using pg8::StaticOrder;
#define RUN_GEMM(EPI, Aptr, Bptr, N_, K_, E) do { Gemm g{(const pg8::bf16_t*)(Aptr), (const pg8::bf16_t*)(Bptr), M, (N_), (K_)}; StaticOrder S; S.init(M, (N_), F.G, (int)blockIdx.x); \
        pg8::gemm_phase<EPI, StaticOrder, true, true>(F.lds + RING_OFF, g, S, E); } while (0)

    if (PROBE_A >= 0 && blockIdx.x == 0 && F.tid == 0) ((unsigned long long*)(ws + WS_LB + 4096 + 256 * 1024))[0] = __builtin_amdgcn_s_memrealtime();
    if (IN(0)) { p0_prologue(F); } SEAM(0);
    if (IN(1)) { pg8::EpiHgrnIn E{F.QT, F.KT, F.VV, F.GG, F.E1, F.E2, F.SS, F.LB}; RUN_GEMM(pg8::EpiHgrnIn, F.XB, F.Whin, HIN, D, E); } SEAM(1);
    if (IN(2)) { hg::phase_a(F, F.DJ); } SEAM(2);
    if (IN(3)) { hg::phase_b(F, F.DJ); } SEAM(3);
    if (IN(4)) { hg::phase_c(F); } SEAM(4);
    if (IN(5)) { pg8::EpiRes E{F.XB, F.SS}; RUN_GEMM(pg8::EpiRes, F.QT, F.Whout, D, D, E); } SEAM(5);
    if (IN(6)) { pg8::EpiSwiglu E{F.FF, F.SS}; RUN_GEMM(pg8::EpiSwiglu, F.XB, F.Wf1, FF2, D, E); } SEAM(6);
    if (IN(7)) { pg8::EpiRes E{F.XB, F.SS}; RUN_GEMM(pg8::EpiRes, F.FF, F.Wf2, D, DFF, E); } SEAM(7);
    if (IN(8)) { pg8::EpiQkv E{F.QP, F.KP, F.VP, F.SS, F.COS, F.SIN}; RUN_GEMM(pg8::EpiQkv, F.XB, F.Wqkv, QKVW, D, E); } SEAM(8);
    if (IN(9)) { attn_fast(F, (char*)lds); } SEAM(9);
    if (IN(10)) {
        LAS float* rt = (LAS float*)(F.lds + MERGE_OFF);
        { StaticOrder S0; S0.init(M, D, F.G, (int)blockIdx.x); pg8::Unit u0;
          if (S0.next(0, u0) && F.tid < 256) { const float* ls = F.LSE + (size_t)(u0.pm * 256 + F.tid) * 12; float dsum[4];
#pragma unroll
              for (int hg = 0; hg < 4; ++hg) dsum[hg] = (__expf(ls[3 * hg]) + __expf(ls[3 * hg + 1])) + __expf(ls[3 * hg + 2]);
              rt[F.tid * 4 + 0] = dsum[1] / dsum[0]; rt[F.tid * 4 + 1] = dsum[2] / dsum[1]; rt[F.tid * 4 + 2] = dsum[3] / dsum[2]; rt[F.tid * 4 + 3] = 1.0f / dsum[3]; } }
        __syncthreads();
        pg8::EpiResMerge E{F.XB, F.SS, rt}; RUN_GEMM(pg8::EpiResMerge, F.QP, F.Wao, D, AW, E); } SEAM(10);
    if (IN(11)) { pg8::EpiSwiglu E{F.FF, F.SS}; RUN_GEMM(pg8::EpiSwiglu, F.XB, F.Wf1 + (size_t)FF2 * D, FF2, D, E); } SEAM(11);
    if (IN(12)) { pg8::EpiRes E{F.XB, F.SS}; RUN_GEMM(pg8::EpiRes, F.FF, F.Wf2 + (size_t)D * DFF, D, DFF, E); } SEAM(12);
    if (IN(13)) { final_norm_rows(F); }
    if (PROBE_A >= 0) {
        if (blockIdx.x == 0 && F.tid == 0) ((unsigned long long*)(ws + WS_LB + 4096 + 256 * 1024))[14] = __builtin_amdgcn_s_memrealtime();
        xcd_barrier(bar);
        const unsigned long long* ts = (const unsigned long long*)(ws + WS_LB + 4096 + 256 * 1024);
        if (blockIdx.x == 0 && F.tid == 0) F.out[0] += (float)(ts[PROBE_B] - ts[PROBE_A]) * 0.0025f;
    }
#undef IN
#undef SEAM
#undef RUN_GEMM
}

extern "C" void kernel_launch(void* const* d_in, const int* in_sizes, int n_in, void* d_out, int out_size, void* d_ws, size_t ws_size, hipStream_t stream) {
    static int grid = 0;
    if (grid == 0) {
        if (n_in != 12 || in_sizes[0] != M * D || out_size != M * D || ws_size < WS_END) { fprintf(stderr, "kernel_launch: unexpected shapes (n_in %d, in0 %d, out %d, ws %zu); nothing launched\n", n_in, n_in > 0 ? in_sizes[0] : -1, out_size, ws_size); grid = -1; return; }
        int dev = 0, cus = 0, per_cu = 0;
        if (hipGetDevice(&dev) != hipSuccess || hipDeviceGetAttribute(&cus, hipDeviceAttributeMultiprocessorCount, dev) != hipSuccess) { grid = -1; return; }
        if (hipFuncSetAttribute((const void*)trunk_fwd, hipFuncAttributeMaxDynamicSharedMemorySize, LDS_BYTES) != hipSuccess) { fprintf(stderr, "kernel_launch: hipFuncSetAttribute failed\n"); grid = -1; return; }
        if (hipOccupancyMaxActiveBlocksPerMultiprocessor(&per_cu, (const void*)trunk_fwd, NWAVES * 64, LDS_BYTES) != hipSuccess || per_cu < 1)
            fprintf(stderr, "kernel_launch: note: the occupancy query reports %d workgroups per CU\n", per_cu);
        (void)hipGetLastError();
        grid = cus;
    }
    if (grid < 0) return;
    if (hipMemsetAsync((char*)d_ws + WS_CTL, 0, CTL_ZERO_BYTES, stream) != hipSuccess) { fprintf(stderr, "kernel_launch: hipMemsetAsync failed\n"); return; }
    Args a{};
    for (int i = 0; i < 12; ++i) a.in[i] = (const float*)d_in[i];
    a.out = (float*)d_out; a.ws = (unsigned char*)d_ws;
#if MK_PER_PHASE
    for (int p = 0; p < NPH; ++p) { a.ph_lo = p; a.ph_hi = p + 1; hipLaunchKernelGGL(trunk_fwd, dim3(grid), dim3(NWAVES * 64), LDS_BYTES, stream, a); }
#else
    a.ph_lo = 0; a.ph_hi = NPH; hipLaunchKernelGGL(trunk_fwd, dim3(grid), dim3(NWAVES * 64), LDS_BYTES, stream, a);
#endif
    const hipError_t le = hipPeekAtLastError();
    if (le != hipSuccess) fprintf(stderr, "kernel_launch: launch failed: %s (grid %d)\n", hipGetErrorName(le), grid);
}
```

```cpp
#include <hip/hip_runtime.h>
#include <cstdio>
#include <cstdint>
#include <math.h>

constexpr int BATCH = 2, T = 8192, D = 1024, M = BATCH * T;
constexpr int HIN = 4096, DFF = 2816, FF2 = 2 * DFF, QKVW = 4608, AW = 1536;
constexpr float NORM_EPS = 1e-6f;
__device__ __forceinline__ int lane_id() { return (int)__builtin_amdgcn_mbcnt_hi(~0u, __builtin_amdgcn_mbcnt_lo(~0u, 0u)); }

namespace pg8 {
#define PG8_LAS __attribute__((address_space(3)))
typedef unsigned short bf16_t;
typedef short bf16x8 __attribute__((ext_vector_type(8)));
typedef float f32x4 __attribute__((ext_vector_type(4)));
typedef unsigned u32x4 __attribute__((ext_vector_type(4)));
constexpr int BM = 256, BK = 64, HALF = 128, HTB = HALF * BK * 2  , STAGE_BYTES = 8 * HTB, NXCD = 8, WGM = 8;

__host__ __device__ __forceinline__ int lds_byte(int r, int c) { const int st = (r >> 4) * 2 + (c >> 5), rr = r & 15, cc = c & 31, ob = rr * 64 + cc * 2; return st * 1024 + (ob ^ (((ob >> 9) & 1) << 5)); }
__host__ __device__ __forceinline__ void stage_rc(int b, int& R, int& C) { const int st = b / 1024, sb = b % 1024, swz = sb ^ (((sb >> 9) & 1) << 5); R = (st >> 1) * 16 + swz / 64; C = (st & 1) * 32 + (swz % 64) / 2; }
__host__ __device__ __forceinline__ int perm32(int rho) { const int n = rho >> 4, i = rho & 15; return 8 * (i >> 2) + 4 * n + (i & 3); }

struct Unit { int pm, pn; };
struct Gemm { const bf16_t* A; const bf16_t* Bt; int M, N, K; };

struct StaticOrder {
    int nM, nN, nwg, G, c;
    __host__ __device__ __forceinline__ void init(int M, int N, int G_, int c_) { nM = M / BM; nN = N / BM; nwg = nM * nN; G = G_; c = c_; }
    __host__ __device__ __forceinline__ bool next(int i, Unit& u) const {
        const long L = (long)i * G + c; if (L >= nwg) return false;
        int wgid = (int)L; { const int q = nwg / NXCD, r = nwg % NXCD, xcd = wgid % NXCD, off = wgid / NXCD; wgid = (xcd < r ? xcd * (q + 1) : r * (q + 1) + (xcd - r) * q) + off; }
        const int nig = WGM * nN, gid = wgid / nig, fm = gid * WGM, gsz = (nM - fm) < WGM ? (nM - fm) : WGM;
        u.pm = fm + ((wgid % nig) % gsz); u.pn = (wgid % nig) / gsz; return true;
    }
    __device__ __forceinline__ void a_ready(const Unit&) const {}
    __device__ __forceinline__ void done(const Unit&) const {}
};


typedef float f32x2 __attribute__((ext_vector_type(2)));
typedef __bf16 bf16x2_t __attribute__((ext_vector_type(2)));
__device__ __forceinline__ unsigned cvt_pk_bf16(float lo, float hi) { const f32x2 v = {lo, hi}; return __builtin_bit_cast(unsigned, __builtin_convertvector(v, bf16x2_t)); }
typedef unsigned u32x2 __attribute__((ext_vector_type(2)));
__device__ __forceinline__ u32x4 pack8(const f32x4 a, const f32x4 b) { u32x4 w; w.x = cvt_pk_bf16(a[0], a[1]); w.y = cvt_pk_bf16(a[2], a[3]); w.z = cvt_pk_bf16(b[0], b[1]); w.w = cvt_pk_bf16(b[2], b[3]); return w; }
__device__ __forceinline__ u32x2 pack4(const f32x4 a) { u32x2 w; w.x = cvt_pk_bf16(a[0], a[1]); w.y = cvt_pk_bf16(a[2], a[3]); return w; }
__device__ __forceinline__ float silu_f(float x) { return x * __builtin_amdgcn_rcpf(1.0f + __builtin_amdgcn_exp2f(x * -1.4426950408889634f)); }
__device__ __forceinline__ f32x4 silu4(const f32x4 x) { f32x4 r; r[0] = silu_f(x[0]); r[1] = silu_f(x[1]); r[2] = silu_f(x[2]); r[3] = silu_f(x[3]); return r; }
__device__ __forceinline__ float sum_fq(float v) {
    v += __builtin_bit_cast(float, __builtin_amdgcn_ds_swizzle(__builtin_bit_cast(int, v), 0x401F));
    const auto r = __builtin_amdgcn_permlane32_swap(__float_as_uint(v), __float_as_uint(v), false, false);
    return __uint_as_float(r[0]) + __uint_as_float(r[1]);
}
__device__ __forceinline__ float bcast15(float v) { return __builtin_bit_cast(float, __builtin_amdgcn_ds_swizzle(__builtin_bit_cast(int, v), 0x01F0)); }
__device__ __forceinline__ float row_rstd(const float* ss, int row, int fq) {
    const f32x4 p = *(const f32x4*)(ss + (size_t)row * 16 + 4 * fq);
    const float s = sum_fq((p[0] + p[1]) + (p[2] + p[3]));
    return __builtin_amdgcn_rsqf(s * (1.0f / 1024.0f) + NORM_EPS);
}
template <int CTRL> __device__ __forceinline__ float dpp_f(float x) { return __builtin_bit_cast(float, __builtin_amdgcn_update_dpp(0, __builtin_bit_cast(int, x), CTRL, 0xf, 0xf, true)); }

struct EpiRes {
    static constexpr bool PERM = false, AFTER_DRAIN = false, KHOOK = false; static constexpr int NVM = 24;
    bf16_t* xb; float* ss;
    __device__ __forceinline__ void operator()(const f32x4 (&acc)[2][2][4][2], const Unit& u, int wr, int wc, int fr, int fq) const {
        { int l_ = lane_id(); asm volatile("" : "+v"(l_)); fr = l_ & 15; fq = l_ >> 4; }
        const int colb = u.pn * BM + wc * 32 + 8 * fq;
#pragma unroll
        for (int ai = 0; ai < 2; ++ai)
#pragma unroll
            for (int m = 0; m < 4; ++m) {
                const int row = u.pm * BM + ai * HALF + wr * 64 + m * 16 + fr;
                float sq = 0.f;
#pragma unroll
                for (int bj = 0; bj < 2; ++bj) {
                    bf16_t* p = xb + (size_t)row * 1024 + colb + bj * HALF;
                    const u32x4 b = *(const u32x4*)p;
                    f32x4 v0 = acc[ai][bj][m][0], v1 = acc[ai][bj][m][1];
                    v0[0] += __uint_as_float(b.x << 16); v0[1] += __uint_as_float(b.x & 0xffff0000u); v0[2] += __uint_as_float(b.y << 16); v0[3] += __uint_as_float(b.y & 0xffff0000u);
                    v1[0] += __uint_as_float(b.z << 16); v1[1] += __uint_as_float(b.z & 0xffff0000u); v1[2] += __uint_as_float(b.w << 16); v1[3] += __uint_as_float(b.w & 0xffff0000u);
                    *(u32x4*)p = pack8(v0, v1);
                    sq += (v0[0] * v0[0] + v0[1] * v0[1]) + (v0[2] * v0[2] + v0[3] * v0[3]) + (v1[0] * v1[0] + v1[1] * v1[1]) + (v1[2] * v1[2] + v1[3] * v1[3]);
                }
                sq = sum_fq(sq);
                if (fq == 0) ss[(size_t)row * 16 + u.pn * 4 + wc] = sq;
            }
    }
};
struct EpiResMerge {
    static constexpr bool PERM = false, AFTER_DRAIN = false, KHOOK = true; static constexpr int NVM = 24;
    bf16_t* xb; float* ss; const PG8_LAS float* rt;
    __device__ __forceinline__ void khook(f32x4 (&acc)[2][2][4][2], int t, int wr, int fr) const {
        if (t == 4 || t == 10 || t == 16) { const int idx = t == 4 ? 0 : (t == 10 ? 1 : 2);
#pragma unroll
            for (int ai = 0; ai < 2; ++ai)
#pragma unroll
                for (int m = 0; m < 4; ++m) { const float f = rt[(ai * HALF + wr * 64 + m * 16 + fr) * 4 + idx];
#pragma unroll
                    for (int bj = 0; bj < 2; ++bj) { acc[ai][bj][m][0] = acc[ai][bj][m][0] * f; acc[ai][bj][m][1] = acc[ai][bj][m][1] * f; } } }
    }
    __device__ __forceinline__ void operator()(const f32x4 (&acc)[2][2][4][2], const Unit& u, int wr, int wc, int fr, int fq) const {
        { int l_ = lane_id(); asm volatile("" : "+v"(l_)); fr = l_ & 15; fq = l_ >> 4; }
        const int colb = u.pn * BM + wc * 32 + 8 * fq;
#pragma unroll
        for (int ai = 0; ai < 2; ++ai)
#pragma unroll
            for (int m = 0; m < 4; ++m) {
                const int row = u.pm * BM + ai * HALF + wr * 64 + m * 16 + fr;
                const float f = rt[(ai * HALF + wr * 64 + m * 16 + fr) * 4 + 3];
                float sq = 0.f;
#pragma unroll
                for (int bj = 0; bj < 2; ++bj) {
                    bf16_t* p = xb + (size_t)row * 1024 + colb + bj * HALF;
                    const u32x4 b = *(const u32x4*)p;
                    f32x4 v0 = acc[ai][bj][m][0] * f, v1 = acc[ai][bj][m][1] * f;
                    v0[0] += __uint_as_float(b.x << 16); v0[1] += __uint_as_float(b.x & 0xffff0000u); v0[2] += __uint_as_float(b.y << 16); v0[3] += __uint_as_float(b.y & 0xffff0000u);
                    v1[0] += __uint_as_float(b.z << 16); v1[1] += __uint_as_float(b.z & 0xffff0000u); v1[2] += __uint_as_float(b.w << 16); v1[3] += __uint_as_float(b.w & 0xffff0000u);
                    *(u32x4*)p = pack8(v0, v1);
                    sq += (v0[0] * v0[0] + v0[1] * v0[1]) + (v0[2] * v0[2] + v0[3] * v0[3]) + (v1[0] * v1[0] + v1[1] * v1[1]) + (v1[2] * v1[2] + v1[3] * v1[3]);
                }
                sq = sum_fq(sq);
                if (fq == 0) ss[(size_t)row * 16 + u.pn * 4 + wc] = sq;
            }
    }
};
struct EpiNull {
    static constexpr bool PERM = false, AFTER_DRAIN = false, KHOOK = false; static constexpr int NVM = 0;
    float* sink;
    __device__ __forceinline__ void operator()(const f32x4 (&acc)[2][2][4][2], const Unit& u, int wr, int wc, int fr, int fq) const {
        { int l_ = lane_id(); asm volatile("" : "+v"(l_)); fr = l_ & 15; fq = l_ >> 4; }
        float s = 0.f;
#pragma unroll
        for (int ai = 0; ai < 2; ++ai)
#pragma unroll
            for (int bj = 0; bj < 2; ++bj)
#pragma unroll
                for (int m = 0; m < 4; ++m) s += acc[ai][bj][m][0][0] + acc[ai][bj][m][1][3];
        if (s == 123456.789f) sink[0] = s;
    }
};
struct EpiSwiglu {
    static constexpr bool PERM = false, AFTER_DRAIN = false, KHOOK = false; static constexpr int NVM = 8;
    bf16_t* act; const float* ss;
    __device__ __forceinline__ void operator()(const f32x4 (&acc)[2][2][4][2], const Unit& u, int wr, int wc, int fr, int fq) const {
        { int l_ = lane_id(); asm volatile("" : "+v"(l_)); fr = l_ & 15; fq = l_ >> 4; }
        const int colb = u.pn * 128 + wc * 32 + 8 * fq;
#pragma unroll
        for (int ai = 0; ai < 2; ++ai)
#pragma unroll
            for (int m = 0; m < 4; ++m) {
                const int row = u.pm * BM + ai * HALF + wr * 64 + m * 16 + fr;
                const float r = row_rstd(ss, row, fq);
                const f32x4 a0 = silu4(acc[ai][0][m][0] * r) * (acc[ai][1][m][0] * r), a1 = silu4(acc[ai][0][m][1] * r) * (acc[ai][1][m][1] * r);
                *(u32x4*)(act + (size_t)row * DFF + colb) = pack8(a0, a1);
            }
    }
};
struct EpiQkv {
    static constexpr bool PERM = false, AFTER_DRAIN = false, KHOOK = false; static constexpr int NVM = 16;
    bf16_t* Q; bf16_t* K; bf16_t* V; const float* ss; const float* cosT; const float* sinT;
    __device__ __forceinline__ void operator()(const f32x4 (&acc)[2][2][4][2], const Unit& u, int wr, int wc, int fr, int fq) const {
        { int l_ = lane_id(); asm volatile("" : "+v"(l_)); fr = l_ & 15; fq = l_ >> 4; }
        if (u.pn < 12) {
            bf16_t* P = u.pn < 6 ? Q : K;
            const int j0 = (wc & 1) * 32 + 8 * fq, tcol = (u.pn % 6) * 256 + (wc >> 1) * 128 + j0;
#pragma unroll
            for (int ai = 0; ai < 2; ++ai)
#pragma unroll
                for (int m = 0; m < 4; ++m) {
                    const int row = u.pm * BM + ai * HALF + wr * 64 + m * 16 + fr;
                    const float r = row_rstd(ss, row, fq);
                    const size_t tb = (size_t)(row & (T - 1)) * 64 + j0;
                    const f32x4 c0 = *(const f32x4*)(cosT + tb), c1 = *(const f32x4*)(cosT + tb + 4), s0 = *(const f32x4*)(sinT + tb), s1 = *(const f32x4*)(sinT + tb + 4);
                    const f32x4 x1a = acc[ai][0][m][0] * r, x1b = acc[ai][0][m][1] * r, x2a = acc[ai][1][m][0] * r, x2b = acc[ai][1][m][1] * r;
                    bf16_t* p = P + (size_t)row * AW + tcol;
                    *(u32x4*)p = pack8(x1a * c0 - x2a * s0, x1b * c1 - x2b * s1);
                    *(u32x4*)(p + 64) = pack8(x2a * c0 + x1a * s0, x2b * c1 + x1b * s1);
                }
        } else {
            const int tcol = (u.pn - 12) * 256 + wc * 32 + 8 * fq;
#pragma unroll
            for (int ai = 0; ai < 2; ++ai)
#pragma unroll
                for (int m = 0; m < 4; ++m) {
                    const int row = u.pm * BM + ai * HALF + wr * 64 + m * 16 + fr;
                    const float r = row_rstd(ss, row, fq);
#pragma unroll
                    for (int bj = 0; bj < 2; ++bj) *(u32x4*)(V + (size_t)row * AW + tcol + bj * HALF) = pack8(acc[ai][bj][m][0] * r, acc[ai][bj][m][1] * r);
                }
        }
    }
};
struct EpiHgrnIn {
    static constexpr bool PERM = false, AFTER_DRAIN = false, KHOOK = false; static constexpr int NVM = 36;
    bf16_t *QT, *KT, *VV, *GG; float *E1, *E2; const float* ss; const float* lb;
    __device__ __forceinline__ void operator()(const f32x4 (&acc)[2][2][4][2], const Unit& u, int wr, int wc, int fr, int fq) const {
        { int l_ = lane_id(); asm volatile("" : "+v"(l_)); fr = l_ & 15; fq = l_ >> 4; }
        const int ch0 = u.pn * 64 + wc * 16 + 4 * fq;
        const f32x4 lbv = *(const f32x4*)(lb + ch0);
#pragma unroll
        for (int ai = 0; ai < 2; ++ai) {
            const int rowb = u.pm * BM + ai * HALF + wr * 64;
            float rs[4];
#pragma unroll
            for (int m = 0; m < 4; ++m) rs[m] = row_rstd(ss, rowb + m * 16 + fr, fq);
            f32x4 kv[4], bc[4], run = {0.f, 0.f, 0.f, 0.f};
#pragma unroll
            for (int m = 0; m < 4; ++m) {
                const f32x4 fz = acc[ai][0][m][1] * rs[m];
#pragma unroll
                for (int e = 0; e < 4; ++e) {
                    const float tt = __builtin_amdgcn_exp2f(fmaxf(fz[e], -80.f) * -1.4426950408889634f), inv = __builtin_amdgcn_rcpf(1.0f + tt);
                    const float oml = 1.0f - lbv[e];
                    const float fg = lbv[e] + oml * inv;
                    kv[m][e] = oml * (tt * inv);
                    float x = __builtin_amdgcn_logf(fg);
                    x += dpp_f<0x111>(x); x += dpp_f<0x112>(x); x += dpp_f<0x114>(x); x += dpp_f<0x118>(x);
                    const float tot = bcast15(x);
                    bc[m][e] = x + run[e]; run[e] += tot;
                }
            }
            f32x4 ref;
#pragma unroll
            for (int e = 0; e < 4; ++e) ref[e] = bcast15(bc[1][e]);
            if (fr == 0) {
                const int chunk = rowb >> 6; f32x4 e1, e2;
#pragma unroll
                for (int e = 0; e < 4; ++e) { e1[e] = __builtin_amdgcn_exp2f(ref[e]); e2[e] = __builtin_amdgcn_exp2f(run[e] - ref[e]); }
                *(f32x4*)(E1 + (size_t)chunk * 1024 + ch0) = e1; *(f32x4*)(E2 + (size_t)chunk * 1024 + ch0) = e2;
            }
#pragma unroll
            for (int m = 0; m < 4; ++m) {
                const size_t off = (size_t)(rowb + m * 16 + fr) * 1024 + ch0;
                f32x4 qv = silu4(acc[ai][0][m][0] * rs[m]), kk = kv[m];
#pragma unroll
                for (int e = 0; e < 4; ++e) { const float dl = bc[m][e] - ref[e]; qv[e] *= __builtin_amdgcn_exp2f(dl); kk[e] *= __builtin_amdgcn_exp2f(-dl); }
                *(u32x2*)(QT + off) = pack4(qv); *(u32x2*)(KT + off) = pack4(kk);
                *(u32x2*)(VV + off) = pack4(acc[ai][1][m][0] * rs[m]); *(u32x2*)(GG + off) = pack4(silu4(acc[ai][1][m][1] * rs[m]));
            }
            __builtin_amdgcn_sched_barrier(0);
        }
    }
};

template <class Epi, class Sched, bool ALIGN_EPI = false, bool SP2 = false>
__device__ __forceinline__ void gemm_phase(PG8_LAS unsigned char* lds, const Gemm g, const Sched& S, const Epi& E, const int wid) {
    int lane = lane_id(); asm volatile("" : "+v"(lane));
    const int tid = wid * 64 + lane, wr = wid >> 2, wc = wid & 3, fr = lane & 15, fq = lane >> 4;
    const int K = g.K, nt = K / BK;
    unsigned voffA[2], voffB[2];
#pragma unroll
    for (int i = 0; i < 2; ++i) { int R, C; stage_rc(tid * 16 + i * 8192, R, C); const int Rb = Epi::PERM ? ((R & ~31) + perm32(R & 31)) : R;
        voffA[i] = (unsigned)(R * K + C) * 2u; voffB[i] = (unsigned)(Rb * K + C) * 2u; }
    const size_t kstep = (size_t)(BK * 2);
    const size_t hstep = (size_t)HALF * K * 2;
    const size_t tstep = 2 * hstep;
    const unsigned ldsw = (unsigned)wid * 1024u;
    const int aoff = lds_byte(wr * 64 + fr, fq * 8), boff = lds_byte(wc * 32 + fr, fq * 8);
#define PG8_SA(b, h) (((b) * 2 + (h)) * HTB)
#define PG8_SB(b, h) ((4 + (b) * 2 + (h)) * HTB)
#define PG8_STAGE(bufoff, gbase, voff) do { _Pragma("unroll") for (int _i = 0; _i < 2; ++_i) \
        __builtin_amdgcn_global_load_lds((const unsigned*)((const char*)(gbase) + (voff)[_i]), (PG8_LAS unsigned*)(lds + (bufoff) + ldsw + _i * 8192), 16, 0, 0); } while (0)
#define PG8_LDA(dst, b, h) do { _Pragma("unroll") for (int m = 0; m < 4; ++m) _Pragma("unroll") for (int k = 0; k < 2; ++k) dst[m][k] = *(const PG8_LAS bf16x8*)(lds + PG8_SA(b, h) + aoff + m * 2048 + k * 1024); } while (0)
#define PG8_LDB(dst, b, h) do { _Pragma("unroll") for (int n = 0; n < 2; ++n) _Pragma("unroll") for (int k = 0; k < 2; ++k) dst[n][k] = *(const PG8_LAS bf16x8*)(lds + PG8_SB(b, h) + boff + n * 2048 + k * 1024); } while (0)
#define PG8_MMA(ai, bj, At, Bt) do { __builtin_amdgcn_s_setprio(1); _Pragma("unroll") for (int m = 0; m < 4; ++m) _Pragma("unroll") for (int n = 0; n < 2; ++n) _Pragma("unroll") for (int k = 0; k < 2; ++k) \
        acc[ai][bj][m][n] = __builtin_amdgcn_mfma_f32_16x16x32_bf16(Bt[n][k], At[m][k], acc[ai][bj][m][n], 0, 0, 0); __builtin_amdgcn_s_setprio(0); } while (0)
#define PG8_WAIT_V(n) asm volatile("s_waitcnt vmcnt(" #n ")" ::: "memory")
#define PG8_WAIT_L(n) asm volatile("s_waitcnt lgkmcnt(" #n ")" ::: "memory")
#define PG8_BAR __builtin_amdgcn_s_barrier()
#define PG8_SCHED __builtin_amdgcn_sched_barrier(0)
    Unit cur, nxt; int ui = 0;
    if (!S.next(0, cur)) return;
    f32x4 acc[2][2][4][2];
#pragma unroll
    for (int a = 0; a < 2; ++a)
#pragma unroll
        for (int b = 0; b < 2; ++b)
#pragma unroll
            for (int m = 0; m < 4; ++m)
#pragma unroll
                for (int n = 0; n < 2; ++n) acc[a][b][m][n] = (f32x4){0.f, 0.f, 0.f, 0.f};
    bf16x8 At[4][2], B0[2][2], B1[2][2];
    const char* cA = (const char*)g.A + (size_t)cur.pm * tstep; const char* cB = (const char*)g.Bt + (size_t)cur.pn * tstep;
    S.a_ready(cur);
    static_assert(SP2, "this copy of the body keeps only the SP2 schedule");
    PG8_STAGE(PG8_SB(0, 0), cB, voffB); PG8_STAGE(PG8_SB(0, 1), cB + hstep, voffB); PG8_STAGE(PG8_SA(0, 0), cA, voffA); PG8_STAGE(PG8_SA(0, 1), cA + hstep, voffA);
    if (wr == 1) PG8_BAR;
    PG8_WAIT_V(2); PG8_BAR;
    PG8_STAGE(PG8_SB(1, 0), cB + kstep, voffB); PG8_STAGE(PG8_SA(1, 0), cA + kstep, voffA); PG8_STAGE(PG8_SB(1, 1), cB + hstep + kstep, voffB);
    PG8_WAIT_V(0); PG8_BAR;
#define PG8_WAIT_VR asm volatile("s_waitcnt vmcnt(%0)" :: "i"(8 + Epi::NVM) : "memory")
#define PG8_KITER(WV) { \
            const bool last = (t == nt - 2); \
            const char* a1 = cA + (size_t)(t + 1) * kstep; \
            const char* a2 = last ? nA : cA + (size_t)(t + 2) * kstep; const char* b2 = last ? nB : cB + (size_t)(t + 2) * kstep; \
            const char* a3 = a2 + kstep; const char* b3 = b2 + kstep; \
            if (last && has_next) S.a_ready(nxt); \
              \
            PG8_LDB(B0, 0, 0); PG8_LDB(B1, 0, 1); PG8_SCHED; PG8_LDA(At, 0, 0); PG8_STAGE(PG8_SA(1, 1), a1 + hstep, voffA); \
            WV; PG8_WAIT_L(0); PG8_BAR; PG8_MMA(0, 0, At, B0); PG8_MMA(0, 1, At, B1); PG8_BAR; PG8_SCHED; \
              \
            PG8_LDA(At, 0, 1); PG8_STAGE(PG8_SB(0, 0), b2, voffB); PG8_STAGE(PG8_SB(0, 1), b2 + hstep, voffB); PG8_STAGE(PG8_SA(0, 0), a2, voffA); \
            WV; PG8_WAIT_L(0); PG8_BAR; PG8_MMA(1, 0, At, B0); PG8_MMA(1, 1, At, B1); PG8_BAR; PG8_SCHED; \
              \
            PG8_LDB(B0, 1, 0); PG8_LDB(B1, 1, 1); PG8_SCHED; PG8_LDA(At, 1, 0); PG8_STAGE(PG8_SA(0, 1), a2 + hstep, voffA); \
            PG8_WAIT_V(8); PG8_WAIT_L(0); PG8_BAR; PG8_MMA(0, 0, At, B0); PG8_MMA(0, 1, At, B1); PG8_BAR; PG8_SCHED; \
              \
            PG8_LDA(At, 1, 1); PG8_STAGE(PG8_SB(1, 0), b3, voffB); PG8_STAGE(PG8_SB(1, 1), b3 + hstep, voffB); PG8_STAGE(PG8_SA(1, 0), a3, voffA); \
            PG8_WAIT_V(8); PG8_WAIT_L(0); PG8_BAR; PG8_MMA(1, 0, At, B0); PG8_MMA(1, 1, At, B1); PG8_BAR; PG8_SCHED; \
            if constexpr (Epi::KHOOK) E.khook(acc, t, wr, fr); }
    for (;;) {
        const bool has_next = S.next(ui + 1, nxt);
        const char* nA = has_next ? (const char*)g.A + (size_t)nxt.pm * tstep : cA; const char* nB = has_next ? (const char*)g.Bt + (size_t)nxt.pn * tstep : cB;
        int t = 0;
        PG8_KITER(PG8_WAIT_VR)
        for (t = 2; t < nt; t += 2) PG8_KITER(PG8_WAIT_V(8))
        if constexpr (ALIGN_EPI) { if (wr == 0) PG8_BAR; }
        if constexpr (!Epi::AFTER_DRAIN) { E(acc, cur, wr, wc, fr, fq); S.done(cur); }
        if (!has_next) break;
#pragma unroll
        for (int a = 0; a < 2; ++a)
#pragma unroll
            for (int b = 0; b < 2; ++b)
#pragma unroll
                for (int m = 0; m < 4; ++m)
#pragma unroll
                    for (int n = 0; n < 2; ++n) acc[a][b][m][n] = (f32x4){0.f, 0.f, 0.f, 0.f};
        cur = nxt; cA = nA; cB = nB; ++ui;
        if constexpr (ALIGN_EPI) { if (wr == 1) PG8_BAR; }
    }
    PG8_WAIT_V(0);
    if constexpr (!ALIGN_EPI) { if (wr == 0) PG8_BAR; }
    PG8_BAR;
    if constexpr (Epi::AFTER_DRAIN) { E.fused(acc, cur, wr, wc, fr, fq, lds, wid, lane); S.done(cur); }
#undef PG8_KITER
#undef PG8_WAIT_VR
#undef PG8_SA
#undef PG8_SB
#undef PG8_STAGE
#undef PG8_LDA
#undef PG8_LDB
#undef PG8_MMA
#undef PG8_WAIT_V
#undef PG8_WAIT_L
#undef PG8_BAR
#undef PG8_SCHED
}
}


constexpr int NWAVES = 8;
#ifndef MK_PER_PHASE
#define MK_PER_PHASE 0
#endif
constexpr int NPH = 14;

constexpr size_t MiB = 1u << 20;
constexpr size_t WS_CTL = 0, CTL_ZERO_BYTES = 64 * 1024;
constexpr size_t WS_WHIN = 1 * MiB, WS_WHOUT = 9 * MiB, WS_WQKV = 11 * MiB, WS_WAO = 20 * MiB, WS_WF1 = 23 * MiB, WS_WF2 = 45 * MiB;
constexpr size_t WS_SS = 56 * MiB, WS_E1 = 57 * MiB, WS_E2 = 58 * MiB, WS_COS = 59 * MiB, WS_SIN = 61 * MiB, WS_LSE = 63 * MiB, WS_LB = 63 * MiB + 768 * 1024;
constexpr size_t WS_ST = 64 * MiB;
constexpr size_t WS_XB = 80 * MiB;
constexpr size_t WS_ACT = 112 * MiB;
constexpr size_t WS_QT = WS_ACT, WS_KT = WS_ACT + 32 * MiB, WS_VV = WS_ACT + 64 * MiB, WS_GG = WS_ACT + 96 * MiB;
constexpr size_t WS_FF = WS_ACT;
constexpr size_t WS_QP = WS_ACT, WS_KP = WS_ACT + 48 * MiB, WS_VP = WS_ACT + 96 * MiB;
constexpr size_t WS_END = 256 * MiB;
static_assert(WS_VP + (size_t)M * AW * 2 <= WS_END && WS_FF + (size_t)M * DFF * 2 <= WS_END && WS_GG + (size_t)M * D * 2 <= WS_END, "d_ws map");
static_assert(WS_WF2 + 2 * (size_t)D * DFF * 2 <= WS_SS && WS_WF1 + 2 * (size_t)FF2 * D * 2 <= WS_WF2 && WS_WAO + (size_t)D * AW * 2 <= WS_WF1 && WS_WQKV + (size_t)QKVW * D * 2 <= WS_WAO, "weights map");
constexpr int CW_TMO = 0, CW_BAR = 4096;

constexpr int RING_OFF = 0, RING_BYTES = 131072;
constexpr int LDSCTL_OFF = RING_BYTES, MISC_OFF = LDSCTL_OFF + 320;
constexpr int MERGE_OFF = RING_BYTES + 4096;
constexpr int LDS_BYTES = 147456;
namespace swa {
constexpr float SCALE = 0.08838834764831845f;
constexpr int D = 128; constexpr bool WSKIP = true; constexpr float THR = 8.f;
constexpr int PLANE_PITCH = AW, SEQ_T = T; constexpr size_t K_FROM_Q = (WS_KP - WS_QP) / 2, V_FROM_K = (WS_VP - WS_KP) / 2;
constexpr int NW = 8, QBLK = 32, KVBLK = 64, QB = NW * QBLK;
constexpr int SHM_V = KVBLK * D * 2, SHM_K = KVBLK * D * 2, ATT_LDS_BYTES = 2 * SHM_V + 2 * SHM_K + NW * 64 * 4;
typedef unsigned short bf16;
typedef short bf16x8 __attribute__((ext_vector_type(8)));
typedef short s16x4 __attribute__((ext_vector_type(4)));
typedef float f32x16 __attribute__((ext_vector_type(16)));
typedef float f32x4 __attribute__((ext_vector_type(4)));
typedef unsigned u32x4 __attribute__((ext_vector_type(4)));
template <class A, class Bt> struct same_t { static constexpr bool v = false; };
template <class A> struct same_t<A, A> { static constexpr bool v = true; };

#define KSWZ(row, colB) ((row) * 256 + ((colB) ^ (((row) & 7) << 4)))
#define SBAR() __builtin_amdgcn_sched_barrier(0)
__device__ __forceinline__ int v_st(int k, int c) { const int kk = (k & ~0xC) | ((k & 4) << 1) | ((k & 8) >> 1); return ((kk >> 3) * 4 + (c >> 5)) * 512 + ((kk & 7) * 32 + (c & 31)) * 2; }
__device__ __forceinline__ int v_rd_base(int lane) { return ((lane & 3) << 3) | (((lane >> 2) & 3) << 6) | (((lane >> 4) & 1) << 5) | (((lane >> 5) & 1) << 8); }
constexpr int v_rd_off(int d0, int ks, int half) { return d0 * 512 + ks * 4096 + half * 2048; }
__device__ __forceinline__ int crow(int r, int hi) { return (r & 3) + 8 * (r >> 2) + 4 * hi; }
__device__ __forceinline__ unsigned cvtpk(float lo, float hi) {
    unsigned r; asm volatile("v_cvt_pk_bf16_f32 %0, %1, %2" : "=v"(r) : "v"(lo), "v"(hi)); return r;
}
__device__ __forceinline__ bf16x8 pack8(f32x4 a, f32x4 b) {
    u32x4 w = {cvtpk(a[0], a[1]), cvtpk(a[2], a[3]), cvtpk(b[0], b[1]), cvtpk(b[2], b[3])};
    return *reinterpret_cast<bf16x8*>(&w);
}
template <class T> __device__ __forceinline__ bf16x8 load8(const T* p) {
    if constexpr (same_t<T, float>::v) { return pack8(*(const f32x4*)p, *(const f32x4*)(p + 4)); }
    else { return *reinterpret_cast<const bf16x8*>(p); }
}
__device__ __forceinline__ void mask_tile(f32x16& p0, f32x16& p1, int dq, unsigned W) {
    const float NEG = -__builtin_inff();
#pragma unroll
    for (int r = 0; r < 16; ++r) {
        const int c = (r & 3) + 8 * (r >> 2);
        if ((unsigned)(dq - c) >= W) p0[r] = NEG;
        if ((unsigned)(dq - c - 32) >= W) p1[r] = NEG;
    }
}
__device__ __forceinline__ void partialSM(f32x16& p0, f32x16& p1, float& m_reg, float& mn, float& alpha) {
    float pmax = p0[0]; for (int r = 1; r < 16; ++r) pmax = fmaxf(pmax, p0[r]); for (int r = 0; r < 16; ++r) pmax = fmaxf(pmax, p1[r]);
    { auto rr = __builtin_amdgcn_permlane32_swap(__float_as_uint(pmax), __float_as_uint(pmax), false, false);
      pmax = fmaxf(__uint_as_float(rr[0]), __uint_as_float(rr[1])); }
    constexpr float C2 = 1.4426950408889634f * SCALE;
    if (__builtin_expect(__all((pmax - m_reg) * SCALE <= THR), 1)) { mn = m_reg; alpha = 1.f; }
    else { mn = fmaxf(m_reg, pmax); alpha = __builtin_amdgcn_exp2f((m_reg - mn) * C2); m_reg = mn; }
    const float mnL = -mn * C2;
    for (int r = 0; r < 16; ++r) p0[r] = fmaf(p0[r], C2, mnL); for (int r = 0; r < 16; ++r) p1[r] = fmaf(p1[r], C2, mnL);
    for (int r = 0; r < 16; ++r) p0[r] = __builtin_amdgcn_exp2f(p0[r]);
}
__device__ __forceinline__ void finishSM(f32x16& p0, f32x16& p1, float alpha, float& l_reg, bf16x8& pa0, bf16x8& pa1, bf16x8& pa2, bf16x8& pa3) {
    for (int r = 0; r < 16; ++r) p1[r] = __builtin_amdgcn_exp2f(p1[r]);
    float ps = 0; for (int r = 0; r < 16; ++r) ps += p0[r]; for (int r = 0; r < 16; ++r) ps += p1[r];
    { auto rr = __builtin_amdgcn_permlane32_swap(__float_as_uint(ps), __float_as_uint(ps), false, false);
      ps = __uint_as_float(rr[0]) + __uint_as_float(rr[1]); }
    l_reg = l_reg * alpha + ps;
#define PK4(P, B_, OUT) do { unsigned a0 = cvtpk(P[B_+0], P[B_+1]), a1 = cvtpk(P[B_+2], P[B_+3]);                          \
        unsigned b0 = cvtpk(P[B_+4], P[B_+5]), b1 = cvtpk(P[B_+6], P[B_+7]);                                             \
        auto r0 = __builtin_amdgcn_permlane32_swap(a0, b0, false, false); auto r1 = __builtin_amdgcn_permlane32_swap(a1, b1, false, false); \
        u32x4 w = {r0[0], r1[0], r0[1], r1[1]}; OUT = *reinterpret_cast<bf16x8*>(&w); } while (0)
    PK4(p0, 0, pa0); PK4(p0, 8, pa1); PK4(p1, 0, pa2); PK4(p1, 8, pa3);
#undef PK4
}
template <int KB, bool SK>
__device__ __forceinline__ void qkt(f32x16& p0, f32x16& p1, const char* K_lds, int r32, int hi, const bf16x8* qr, bool act) {
    if (SK && !act) { const float NEG = -__builtin_inff();
#pragma unroll
        for (int r = 0; r < 16; ++r) { p0[r] = NEG; p1[r] = NEG; } return; }
    p0 = f32x16{}; p1 = f32x16{};
    const char* kb[4];
#pragma unroll
    for (int dd = 0; dd < 4; ++dd) kb[dd] = K_lds + KB * SHM_K + KSWZ(r32, (dd * 16 + hi * 8) * 2);
#pragma unroll
    for (int d0 = 0; d0 < 8; ++d0) { const char* a = kb[d0 & 3] + (d0 >> 2) * 128;
        bf16x8 b0 = *reinterpret_cast<const bf16x8*>(a);
        bf16x8 b1 = *reinterpret_cast<const bf16x8*>(a + 32 * 256);
        p0 = __builtin_amdgcn_mfma_f32_32x32x16_bf16(b0, qr[d0], p0, 0, 0, 0);
        p1 = __builtin_amdgcn_mfma_f32_32x32x16_bf16(b1, qr[d0], p1, 0, 0, 0); }
}
template <int VB, bool SK>
__device__ __forceinline__ void pv_tile(f32x16* o, int vb0, bf16x8 pa0, bf16x8 pa1, bf16x8 pa2, bf16x8 pa3, bool act) {
    if (SK && !act) return;
#define TRRD(dst, off) asm volatile("ds_read_b64_tr_b16 %0, %1 offset:%2" : "=&v"(dst) : "v"(vb0), "i"(off) : "memory")
#define PV_D0(d0) do { s16x4 l0, l1, l2, l3, h0, h1, h2, h3; constexpr int b_ = VB * SHM_V + v_rd_off(d0, 0, 0);     \
        TRRD(l0, b_); TRRD(h0, b_ + 2048); TRRD(l1, b_ + 4096); TRRD(h1, b_ + 6144); TRRD(l2, b_ + 8192); TRRD(h2, b_ + 10240); TRRD(l3, b_ + 12288); TRRD(h3, b_ + 14336); \
        asm volatile("s_waitcnt lgkmcnt(0)" ::: "memory"); SBAR();                 \
        o[d0] = __builtin_amdgcn_mfma_f32_32x32x16_bf16(pa0, (bf16x8){l0[0], l0[1], l0[2], l0[3], h0[0], h0[1], h0[2], h0[3]}, o[d0], 0, 0, 0);   \
        o[d0] = __builtin_amdgcn_mfma_f32_32x32x16_bf16(pa1, (bf16x8){l1[0], l1[1], l1[2], l1[3], h1[0], h1[1], h1[2], h1[3]}, o[d0], 0, 0, 0);   \
        o[d0] = __builtin_amdgcn_mfma_f32_32x32x16_bf16(pa2, (bf16x8){l2[0], l2[1], l2[2], l2[3], h2[0], h2[1], h2[2], h2[3]}, o[d0], 0, 0, 0);   \
        o[d0] = __builtin_amdgcn_mfma_f32_32x32x16_bf16(pa3, (bf16x8){l3[0], l3[1], l3[2], l3[3], h3[0], h3[1], h3[2], h3[3]}, o[d0], 0, 0, 0); } while (0)
    PV_D0(0); PV_D0(1); PV_D0(2); PV_D0(3);
#undef PV_D0
#undef TRRD
}

template <class TIn, class TOut> struct BlockRef { const TIn* Q; int P0, sh, lrow;
    __device__ __forceinline__ int pitch() const { return PLANE_PITCH << sh; }
    __device__ __forceinline__ const TIn* K() const { return Q + K_FROM_Q - (size_t)P0 * (size_t)pitch(); }
    __device__ __forceinline__ const TIn* V() const { return K() + V_FROM_K; }
    __device__ __forceinline__ int skv() const { return SEQ_T >> sh; }
    __device__ __forceinline__ int lp() const { return 12 << sh; } };
template <class TIn> struct Seam {
    bf16x8 qr[8];
    bf16x8 st_v0, st_v1, st_k0, st_k1; f32x4 sf0, sf1, sf2, sf3;
    f32x4 tq[16];
};
__device__ __forceinline__ int swa_jlo(int P0, int W) { const int lowk = P0 - W + 1; return lowk > 0 ? lowk / KVBLK : 0; }
#define ROW(p, k0, rr, kp_) ((p) + (unsigned)(((k0) + (rr)) * (kp_) + sc))
#define VMW() asm volatile("s_waitcnt vmcnt(0)" ::: "memory")
#define VMWN(n) asm volatile("s_waitcnt vmcnt(%0)" :: "i"(n) : "memory")
#define SLOAD_H(Kp, Vp, k0, kp_) do { S.st_v0 = load8<TIn>(ROW(Vp, k0, sr, kp_)); S.st_v1 = load8<TIn>(ROW(Vp, k0, 32 + sr, kp_));              \
                         S.st_k0 = load8<TIn>(ROW(Kp, k0, sr, kp_)); S.st_k1 = load8<TIn>(ROW(Kp, k0, 32 + sr, kp_)); } while (0)
#define SWRITE_HK(bf) do { *(bf16x8*)(K_lds + (bf) * SHM_K + kws) = S.st_k0; *(bf16x8*)(K_lds + (bf) * SHM_K + kws + 32 * 256) = S.st_k1; } while (0)
#define SWRITE_HV(bf) do { *(bf16x8*)(V_lds + (bf) * SHM_V + vst0) = S.st_v0; *(bf16x8*)(V_lds + (bf) * SHM_V + vst1) = S.st_v1; } while (0)
#define SWRITE_H(bf) do { SWRITE_HV(bf); SWRITE_HK(bf); } while (0)
#define SLOAD_F(p, k0) do { S.sf0 = *(const f32x4*)ROW(p, k0, sr, D); S.sf1 = *(const f32x4*)(ROW(p, k0, sr, D) + 4);                \
                            S.sf2 = *(const f32x4*)ROW(p, k0, 32 + sr, D); S.sf3 = *(const f32x4*)(ROW(p, k0, 32 + sr, D) + 4); } while (0)
#define SWRITE_KF(bf) do { *(bf16x8*)(K_lds + (bf) * SHM_K + kws) = pack8(S.sf0, S.sf1); *(bf16x8*)(K_lds + (bf) * SHM_K + kws + 32 * 256) = pack8(S.sf2, S.sf3); } while (0)
#define SWRITE_VF(bf) do { *(bf16x8*)(V_lds + (bf) * SHM_V + vst0) = pack8(S.sf0, S.sf1); *(bf16x8*)(V_lds + (bf) * SHM_V + vst1) = pack8(S.sf2, S.sf3); } while (0)
template <class TIn, class TOut>
__device__ __forceinline__ void causal_swa_prime(const BlockRef<TIn, TOut>& cur, int W, char* lds, Seam<TIn>& S, const int wid) {
    constexpr bool F32 = same_t<TIn, float>::v;
    const int lane = lane_id(), tid = wid * 64 + lane, r32 = lane & 31, hi = lane >> 5;
    const int sr = tid >> 4, sc = (tid & 15) * 8, kws = KSWZ(sr, sc * 2); char* K_lds = lds + 2 * SHM_V;
    const int kb0 = swa_jlo(cur.P0, W) * KVBLK;
    for (int d0 = 0; d0 < 8; ++d0) S.qr[d0] = load8<TIn>(cur.Q + (unsigned)((wid * QBLK + r32) * cur.pitch() + d0 * 16 + hi * 8));
    if constexpr (F32) { SLOAD_F((const float*)cur.K(), kb0); VMW(); SWRITE_KF(0); SBAR(); SLOAD_F((const float*)cur.V(), kb0); }
    else { SLOAD_H(cur.K(), cur.V(), kb0, cur.pitch()); VMW(); SWRITE_HK(0); }
    __syncthreads();
}
template <class TIn, class TOut>
__device__ __forceinline__ void causal_swa_block(const BlockRef<TIn, TOut>& cur, const BlockRef<TIn, TOut>& nxt, float* lse, int W, char* lds, Seam<TIn>& S, const int wid) {
    const int skv = cur.skv();
    constexpr bool F32 = same_t<TIn, float>::v;
    const int lane = lane_id(), tid = wid * 64 + lane, r32 = lane & 31, hi = lane >> 5;
    const int j_lo = swa_jlo(cur.P0, W);
    int j_hi = (cur.P0 + QB - 1) / KVBLK + 1; if (j_hi > skv / KVBLK) j_hi = skv / KVBLK;
    const int NT = j_hi - j_lo;
    const int kbn = swa_jlo(nxt.P0, W) * KVBLK;
    const int qlo = cur.P0 + wid * QBLK, qm = qlo + r32 - 4 * hi;
    char* V_lds = lds; char* K_lds = lds + 2 * SHM_V;
    float* ws = (float*)(lds + 2 * SHM_V + 2 * SHM_K) + wid * 64; float* li_l = ws, * al_l = ws + 32;
    float m_reg = -1e30f, l_reg = 0; f32x16 o[4] = {};
    const int sr = tid >> 4, sc = (tid & 15) * 8, vst0 = v_st(sr, sc), vst1 = v_st(32 + sr, sc), kws = KSWZ(sr, sc * 2);
    const int vb0 = (int)(uintptr_t)V_lds + v_rd_base(lane);
    const TIn* Kh = cur.K(); const TIn* Vh = Kh + V_FROM_K; const int kpc = cur.pitch();
#define RESC(a) do { if (__any((a) < 1.f)) { if (hi == 0) al_l[r32] = (a); asm volatile("s_waitcnt lgkmcnt(0)" ::: "memory");              \
                     for (int d_ = 0; d_ < 4; ++d_) for (int r = 0; r < 16; ++r) o[d_][r] *= al_l[crow(r, hi)]; } } while (0)
#define KBASE(t) ((j_lo + (t)) * KVBLK)
#define ACT(t) (KBASE(t) <= qlo + QBLK - 1 && KBASE(t) + KVBLK - 1 >= qlo - W + 1)
#define MASKT(P0_, P1_, t) do { const int kb_ = KBASE(t); if ((!SK || ACT(t)) && (kb_ + KVBLK - 1 > qlo || kb_ <= qlo + QBLK - 1 - W)) mask_tile(P0_, P1_, qm - kb_, (unsigned)W); } while (0)
    constexpr int NQL = F32 ? 16 : 8;
    constexpr bool SK = WSKIP && !F32;
#define SEAM_K0() do { VMWN(NQL); if constexpr (F32) { SWRITE_KF(0); SBAR(); SLOAD_F((const float*)nxt.V(), kbn); } else { SWRITE_HK(0); } SBAR(); } while (0)
    f32x16 pA0, pA1, pB0, pB1; float mnA, mnB, alA, alB; bf16x8 pa0, pa1, pa2, pa3;
    if constexpr (F32) { VMW(); SWRITE_VF(0); SBAR(); } else { SWRITE_HV(0); SBAR(); }
    if (NT > 1) { if constexpr (F32) SLOAD_F((const float*)Kh, KBASE(1)); else SLOAD_H(Kh, Vh, KBASE(1), kpc); }
    SBAR(); qkt<0, SK>(pA0, pA1, K_lds, r32, hi, S.qr, ACT(0));
    if constexpr (F32) { if (NT > 1) { VMW(); SWRITE_KF(1); SBAR(); SLOAD_F((const float*)Vh, KBASE(1)); } }
    MASKT(pA0, pA1, 0); partialSM(pA0, pA1, m_reg, mnA, alA);
    if (NT > 1) { VMW(); if constexpr (F32) { SWRITE_VF(1); SBAR(); if (NT > 2) SLOAD_F((const float*)Kh, KBASE(2)); } else SWRITE_H(1); }
    __syncthreads();
#define HALF_STEP(PX0, PX1, mnX, alX, PY0, PY1, alY, t, KB, VB, SB) do {                                                      \
        SBAR(); qkt<KB, SK>(PX0, PX1, K_lds, r32, hi, S.qr, ACT(t));                                             \
        finishSM(PY0, PY1, alY, l_reg, pa0, pa1, pa2, pa3); SBAR();                                                           \
        if ((t) + 1 < NT) { if constexpr (F32) { VMW(); SWRITE_KF(SB); SBAR(); SLOAD_F((const float*)Vh, KBASE((t) + 1)); }  \
                            else { SLOAD_H(Kh, Vh, KBASE((t) + 1), kpc); } SBAR(); }                                               \
        pv_tile<VB, SK>(o, vb0, pa0, pa1, pa2, pa3, ACT((t) - 1)); MASKT(PX0, PX1, (t)); partialSM(PX0, PX1, m_reg, mnX, alX);                                        \
        __syncthreads();                                                                                                      \
        if ((t) + 1 < NT) { VMW(); if constexpr (F32) { SWRITE_VF(SB); SBAR(); if ((t) + 2 < NT) SLOAD_F((const float*)Kh, KBASE((t) + 2)); } \
                            else { SWRITE_H(SB); } }                                                                          \
        RESC(alX); __syncthreads(); } while (0)
    for (int t = 1; t + 1 < NT; t += 2) {
        HALF_STEP(pB0, pB1, mnB, alB, pA0, pA1, alA, t, 1, 0, 0);
        HALF_STEP(pA0, pA1, mnA, alA, pB0, pB1, alB, t + 1, 0, 1, 1);
    }
    const bool even = (NT & 1) == 0;
    if (even) { SBAR(); qkt<1, SK>(pB0, pB1, K_lds, r32, hi, S.qr, ACT(NT - 1)); SBAR(); }
#define QROW(e) (nxt.Q + (size_t)(wid * QBLK + r32) * nxt.pitch() + ((e) >> 1) * 16 + hi * 8 + ((e) & 1) * 4)
    if constexpr (F32) { SLOAD_F((const float*)nxt.K(), kbn); SBAR();
#pragma unroll
        for (int e = 0; e < 8; ++e) S.tq[e] = *(const f32x4*)QROW(e); }
    else { SLOAD_H(nxt.K(), nxt.V(), kbn, nxt.pitch()); SBAR();
#pragma unroll
        for (int d0 = 0; d0 < 8; ++d0) S.qr[d0] = load8<TIn>(nxt.Q + (unsigned)((wid * QBLK + r32) * nxt.pitch() + d0 * 16 + hi * 8)); }
    SBAR();
    finishSM(pA0, pA1, alA, l_reg, pa0, pa1, pa2, pa3); SBAR();
    if constexpr (F32) {
#pragma unroll
        for (int e = 8; e < 16; ++e) S.tq[e] = *(const f32x4*)QROW(e); SBAR(); }
#undef QROW
    pv_tile<0, SK>(o, vb0, pa0, pa1, pa2, pa3, ACT(even ? NT - 2 : NT - 1));
    if (even) { MASKT(pB0, pB1, NT - 1); partialSM(pB0, pB1, m_reg, mnB, alB); __syncthreads(); RESC(alB);
        finishSM(pB0, pB1, alB, l_reg, pa0, pa1, pa2, pa3); SBAR(); pv_tile<1, SK>(o, vb0, pa0, pa1, pa2, pa3, ACT(NT - 1)); }
    SBAR(); SEAM_K0();
    if (hi == 0) li_l[r32] = __expf(m_reg * SCALE); asm volatile("s_waitcnt lgkmcnt(0)" ::: "memory");
    float rli[16];
#pragma unroll
    for (int r = 0; r < 16; ++r) rli[r] = li_l[crow(r, hi)];
    TOut* Ow = (TOut*)cur.Q;
    if (hi == 0) lse[(size_t)cur.lrow + (size_t)(wid * QBLK + r32) * cur.lp()] = m_reg * SCALE + __logf(l_reg);
#pragma unroll
    for (int r = 0; r < 16; ++r) { const int orow = crow(r, hi);
#pragma unroll
        for (int d0 = 0; d0 < 4; ++d0) { const float v = o[d0][r] * rli[r];
            if constexpr (same_t<TOut, float>::v) { Ow[(unsigned)((wid * QBLK + orow) * kpc + d0 * 32 + r32)] = v; }
            else { const float vn = __shfl_xor(v, 1);
                   if ((r32 & 1) == 0) *(unsigned*)(Ow + (unsigned)((wid * QBLK + orow) * kpc + d0 * 32 + r32)) = cvtpk(v, vn); } } }
    if constexpr (F32) {
#pragma unroll
        for (int d0 = 0; d0 < 8; ++d0) S.qr[d0] = pack8(S.tq[2 * d0], S.tq[2 * d0 + 1]); }
    __syncthreads();
#undef RESC
#undef KBASE
#undef ACT
#undef MASKT
#undef SEAM_K0
#undef HALF_STEP
}
#undef ROW
#undef VMW
#undef VMWN
#undef SLOAD_H
#undef SWRITE_HK
#undef SWRITE_HV
#undef SWRITE_H
#undef SLOAD_F
#undef SWRITE_KF
#undef SWRITE_VF


}

#define GAS __attribute__((address_space(1)))
#define LAS __attribute__((address_space(3)))
typedef unsigned short bf16;
typedef unsigned v4u __attribute__((ext_vector_type(4)));
typedef unsigned u32x2 __attribute__((ext_vector_type(2)));
typedef float f32x4 __attribute__((ext_vector_type(4)));
typedef short bf16x8 __attribute__((ext_vector_type(8)));
typedef GAS unsigned gu32;
typedef GAS unsigned long long gu64;
#define RLX_AGENT __ATOMIC_RELAXED, __HIP_MEMORY_SCOPE_AGENT
#define LDS_WAIT() asm volatile("s_waitcnt lgkmcnt(0)" ::: "memory")
#define VM_WAIT() asm volatile("s_waitcnt vmcnt(0)" ::: "memory")
__device__ __forceinline__ unsigned long long rt() { return __builtin_amdgcn_s_memrealtime(); }
__device__ __forceinline__ unsigned f2bf(float f) { unsigned u = __builtin_bit_cast(unsigned, f); return (u + 0x7fffu + ((u >> 16) & 1u)) >> 16; }
__device__ __forceinline__ unsigned pk2(float lo, float hi) { return f2bf(lo) | (f2bf(hi) << 16); }

#define XB_TMO      128
#define XB_XCNT(j)  (256  + 64 * (j))
#define XB_XSUB(j)  (1280 + 64 * (j))
#define XB_XGEN(j)  (2304 + 64 * (j))
#define XB_TOP      3328
#define XB_TOPGEN   3392
#define XCD_BAR_WORDS 3456
#define XB_SPIN_CAP (1u << 18)

__device__ __forceinline__ unsigned xb_ld(unsigned* p)              { return __hip_atomic_load(p, __ATOMIC_RELAXED, __HIP_MEMORY_SCOPE_AGENT); }
__device__ __forceinline__ unsigned xb_add(unsigned* p, unsigned v) { return __hip_atomic_fetch_add(p, v, __ATOMIC_RELAXED, __HIP_MEMORY_SCOPE_AGENT); }
__device__ __forceinline__ unsigned xb_xcc_id() { return (unsigned)__builtin_amdgcn_s_getreg((3 << 11) | 20) & 0xFu; }
#define XB_SPIN(cond, bar) do { unsigned _sp = 0; while (cond) { __builtin_amdgcn_s_sleep(1); \
    if ((++_sp & 255u) == 0u) { if (xb_ld(&(bar)[XB_TMO])) break; if (_sp > XB_SPIN_CAP) { atomicAdd(&(bar)[XB_TMO], 1u); break; } } } } while (0)

struct XcdBarrier {
    unsigned* bar; unsigned x; int w;
    volatile LAS unsigned* st;
};

__device__ __forceinline__ XcdBarrier xcd_barrier_post(unsigned* bar, volatile LAS unsigned* st, int wave) {
    XcdBarrier b; b.bar = bar; b.x = xb_xcc_id(); b.st = st; b.w = wave;
    if (wave == 0 && lane_id() == 0) (void)xb_add(&bar[XB_XCNT(b.x)], 1u);
    return b;
}
__device__ __forceinline__ void xcd_barrier_complete(unsigned* bar, unsigned x, unsigned& nloc, unsigned& nx) {
    const unsigned G = gridDim.x * gridDim.y * gridDim.z;
    unsigned sum, cnt, mine, sp = 0u;
    for (;;) {
        sum = 0u; cnt = 0u; mine = 0u;
#pragma unroll
        for (unsigned j = 0; j < 16; ++j) { const unsigned c = xb_ld(&bar[XB_XCNT(j)]); sum += c; cnt += (c > 0u) ? 1u : 0u; mine = (j == x) ? c : mine; }
        if (sum == G) break;
        __builtin_amdgcn_s_sleep(1);
        if ((++sp & 255u) == 0u) { if (xb_ld(&bar[XB_TMO])) break; if (sp > XB_SPIN_CAP) { atomicAdd(&bar[XB_TMO], 1u); break; } }
    }
    nloc = mine > 0u ? mine : 1u; nx = cnt > 0u ? cnt : 1u;
}

__device__ __forceinline__ void xcd_barrier(const XcdBarrier& b) {
    asm volatile("s_waitcnt vmcnt(0)" ::: "memory");
    __syncthreads();
    if (b.w == 0 && lane_id() == 0) {
        unsigned* bar = b.bar;
        __builtin_amdgcn_s_waitcnt(0);
        unsigned nloc = b.st[0], nx = b.st[1];
        if (nloc == 0u) { xcd_barrier_complete(bar, b.x, nloc, nx); b.st[0] = nloc; b.st[1] = nx; }
        const unsigned old = xb_add(&bar[XB_XSUB(b.x)], 1u);
        const unsigned gen = old / nloc;
        if (old + 1u == (gen + 1u) * nloc) {
            __builtin_amdgcn_fence(__ATOMIC_RELEASE, "agent");
            asm volatile("s_waitcnt vmcnt(0)" ::: "memory");
            const unsigned og = xb_add(&bar[XB_TOP], 1u);
            const unsigned tg = og / nx;
            if (og + 1u == (tg + 1u) * nx) xb_add(&bar[XB_TOPGEN], 1u);
            else XB_SPIN(xb_ld(&bar[XB_TOPGEN]) == tg, bar);
            __builtin_amdgcn_fence(__ATOMIC_ACQUIRE, "agent");
            xb_add(&bar[XB_XGEN(b.x)], 1u);
            asm volatile("s_waitcnt vmcnt(0)" ::: "memory");
        } else {
            XB_SPIN(xb_ld(&bar[XB_XGEN(b.x)]) == gen, bar);
            __builtin_amdgcn_fence(__ATOMIC_ACQUIRE, "agent");
            asm volatile("s_waitcnt vmcnt(0)" ::: "memory");
        }
    }
    __syncthreads();
}

typedef __attribute__((address_space(4))) const unsigned char KARG;
struct Frame {
    LAS unsigned char* lds;
    volatile LAS unsigned* MISC;
    int tid, lane, wave;
    int vcu, G;
    unsigned char* ws; KARG* kp;
    __device__ __forceinline__ const float* in(int i) const { return *(const float* const __attribute__((address_space(4)))*)(kp + 8 * i); }
    __device__ __forceinline__ const float* x() const { return in(0); }
    __device__ __forceinline__ const float* norm_mix() const { return in(1); }
    __device__ __forceinline__ const float* norm_ffn() const { return in(2); }
    __device__ __forceinline__ const float* hgrn_w_in() const { return in(3); }
    __device__ __forceinline__ const float* lb_logits() const { return in(4); }
    __device__ __forceinline__ const float* hgrn_out_norm() const { return in(5); }
    __device__ __forceinline__ const float* hgrn_w_out() const { return in(6); }
    __device__ __forceinline__ const float* attn_w_qkv() const { return in(7); }
    __device__ __forceinline__ const float* attn_w_out() const { return in(8); }
    __device__ __forceinline__ const float* ffn_w_in() const { return in(9); }
    __device__ __forceinline__ const float* ffn_w_down() const { return in(10); }
    __device__ __forceinline__ const float* final_norm() const { return in(11); }
    __device__ __forceinline__ float* out() const { return *(float* const __attribute__((address_space(4)))*)(kp + 96); }
    __device__ __forceinline__ gu32* ctl() const { return (gu32*)(ws + WS_CTL); }
#define FRAME_WS(NAME, TYPE, OFF) __device__ __forceinline__ TYPE* NAME() const { return (TYPE*)(ws + (OFF)); }
    FRAME_WS(Whin, bf16, WS_WHIN) FRAME_WS(Whout, bf16, WS_WHOUT) FRAME_WS(Wqkv, bf16, WS_WQKV) FRAME_WS(Wao, bf16, WS_WAO) FRAME_WS(Wf1, bf16, WS_WF1) FRAME_WS(Wf2, bf16, WS_WF2)
    FRAME_WS(SS, float, WS_SS) FRAME_WS(E1, float, WS_E1) FRAME_WS(E2, float, WS_E2) FRAME_WS(COS, float, WS_COS) FRAME_WS(SIN, float, WS_SIN) FRAME_WS(LSE, float, WS_LSE) FRAME_WS(LB, float, WS_LB)
    FRAME_WS(DJ, float, WS_LB + 4096) FRAME_WS(ST, float, WS_ST)
    FRAME_WS(XB, bf16, WS_XB) FRAME_WS(QT, bf16, WS_QT) FRAME_WS(KT, bf16, WS_KT) FRAME_WS(VV, bf16, WS_VV) FRAME_WS(GG, bf16, WS_GG) FRAME_WS(FF, bf16, WS_FF) FRAME_WS(QP, bf16, WS_QP) FRAME_WS(KP, bf16, WS_KP) FRAME_WS(VP, bf16, WS_VP)
#undef FRAME_WS
};
__device__ __forceinline__ float wave_sum(float v) {
#pragma unroll
    for (int o = 1; o < 64; o <<= 1) v += __shfl_xor(v, o);
    return v;
}
__device__ __forceinline__ float bf_lo(unsigned u) { return __uint_as_float(u << 16); }
__device__ __forceinline__ float bf_hi(unsigned u) { return __uint_as_float(u & 0xffff0000u); }

__device__ __forceinline__ int pinv32(int l) { return 16 * ((l >> 2) & 1) + 4 * (l >> 3) + (l & 3); }
template <int MODE> __device__ __forceinline__ int phys_row(int c) {
    if (MODE == 0) return (c & ~31) + pinv32(c & 31);
    if (MODE == 1) { const int up = c >= DFF ? 1 : 0, j = c - up * DFF; return 256 * (j >> 7) + 128 * up + (j & 96) + pinv32(j & 31); }
    if (MODE == 2) {
        if (c >= 2 * AW) { const int c0 = c - 2 * AW, hl = c0 >> 7, cc = ((hl & 3) * 3 + (hl >> 2)) * 128 + (c0 & 127); return 256 * (12 + (cc >> 8)) + (cc & 224) + pinv32(cc & 31); }
        const int plane = c >= AW ? 1 : 0, cc = c - plane * AW, hl = cc >> 7, head = (hl & 3) * 3 + (hl >> 2), d = cc & 127, half = d >> 6, j = d & 63;
        return 256 * (plane * 6 + (head >> 1)) + 128 * half + 32 * (2 * (head & 1) + (j >> 5)) + pinv32(j & 31);
    }
    { const int type = c >> 10, ch = c & 1023, chl = ch & 63; return 256 * (ch >> 6) + 128 * (type >> 1) + 32 * (chl >> 4) + 16 * (type & 1) + (chl & 15); }
}
template <int MODE, bool KPOS = false>
__device__ __forceinline__ void p0_transpose_item(const float* W, int K, int N, bf16* WT, const float* gain, LAS float* scr, int item, int lane) {
    const int nblk = N / 32, kb = item / nblk, nb = item % nblk, k0 = 64 * kb, n0 = 32 * nb;
    int ks = k0; if (KPOS) { const int pos = k0 >> 7; ks = ((pos % 3) * 4 + pos / 3) * 128 + (k0 & 127); }
    float wv[32];
    const float* wp = W + (size_t)(ks + (lane >> 5)) * N + n0 + (lane & 31);
#pragma unroll
    for (int i = 0; i < 32; ++i) wv[i] = wp[(size_t)(2 * i) * N];
#pragma unroll
    for (int i = 0; i < 32; ++i) { const int kk = 2 * i + (lane >> 5); float w = wv[i]; if (gain) w *= gain[ks + kk]; scr[kk * 33 + (lane & 31)] = w; }
    LDS_WAIT(); asm volatile("" ::: "memory");
    const int c = lane & 7;
#pragma unroll
    for (int j = 0; j < 4; ++j) { const int n = (lane >> 3) + 8 * j; const LAS float* s = scr + (8 * c) * 33 + n;
        v4u o; o.x = pk2(s[0 * 33], s[1 * 33]); o.y = pk2(s[2 * 33], s[3 * 33]); o.z = pk2(s[4 * 33], s[5 * 33]); o.w = pk2(s[6 * 33], s[7 * 33]);
        *(GAS v4u*)(WT + (size_t)phys_row<MODE>(n0 + n) * K + k0 + 8 * c) = o; }
    LDS_WAIT(); asm volatile("" ::: "memory");
}
__device__ __forceinline__ void p0_prologue(Frame& F) {
    LAS float* scr = (LAS float*)(F.lds + RING_OFF + F.wave * 16384);
    const int gw = F.vcu * NWAVES + F.wave, NGW = F.G * NWAVES;
    constexpr int I_HIN = (D / 64) * (HIN / 32), I_HOUT = (D / 64) * (D / 32), I_QKV = (D / 64) * (QKVW / 32), I_AO = (AW / 64) * (D / 32), I_F1 = (D / 64) * (FF2 / 32), I_F2 = (DFF / 64) * (D / 32);
    constexpr int NITEMS = I_HIN + I_HOUT + I_QKV + I_AO + 2 * I_F1 + 2 * I_F2;
    for (int it = gw; it < NITEMS; it += NGW) {
        int r = it;
        if (r < I_HIN) { p0_transpose_item<3>(F.hgrn_w_in(), D, HIN, F.Whin(), F.norm_mix(), scr, r, F.lane); continue; } r -= I_HIN;
        if (r < I_HOUT) { p0_transpose_item<0>(F.hgrn_w_out(), D, D, F.Whout(), nullptr, scr, r, F.lane); continue; } r -= I_HOUT;
        if (r < I_QKV) { p0_transpose_item<2>(F.attn_w_qkv(), D, QKVW, F.Wqkv(), F.norm_mix() + D, scr, r, F.lane); continue; } r -= I_QKV;
        if (r < I_AO) { p0_transpose_item<0, true>(F.attn_w_out(), AW, D, F.Wao(), nullptr, scr, r, F.lane); continue; } r -= I_AO;
        if (r < 2 * I_F1) { const int l = r / I_F1; p0_transpose_item<1>(F.ffn_w_in() + (size_t)l * D * FF2, D, FF2, F.Wf1() + (size_t)l * FF2 * D, F.norm_ffn() + l * D, scr, r - l * I_F1, F.lane); continue; } r -= 2 * I_F1;
        { const int l = r / I_F2; p0_transpose_item<0>(F.ffn_w_down() + (size_t)l * DFF * D, DFF, D, F.Wf2() + (size_t)l * D * DFF, nullptr, scr, r - l * I_F2, F.lane); }
    }
    for (int m = gw; m < M; m += NGW) {
        const GAS f32x4* xr = (const GAS f32x4*)(F.x() + (size_t)m * D) + F.lane;
        GAS unsigned long long* o8 = (GAS unsigned long long*)(F.XB() + (size_t)m * D) + F.lane;
        float s = 0.f;
#pragma unroll
        for (int j = 0; j < 4; ++j) { const f32x4 v = xr[64 * j]; s += (v.x * v.x + v.y * v.y) + (v.z * v.z + v.w * v.w); o8[64 * j] = (unsigned long long)pk2(v.x, v.y) | ((unsigned long long)pk2(v.z, v.w) << 32); }
        s = wave_sum(s);
        if (F.lane < 16) F.SS()[(size_t)m * 16 + F.lane] = F.lane == 0 ? s : 0.f;
    }
    const int gt = F.vcu * NWAVES * 64 + F.tid, NGT = F.G * NWAVES * 64;
    for (int i = gt; i < T * 64; i += NGT) { const int pos = i >> 6, j = i & 63;
        const float inv = 1.0f / exp2f((float)j * (13.287712379549449f / 64.0f)); const float ang = (float)pos * inv;
        const double rev = (double)ang * 0.15915494309189535; const float fr = (float)(rev - floor(rev));
        F.COS()[i] = __builtin_amdgcn_cosf(fr); F.SIN()[i] = __builtin_amdgcn_sinf(fr); }
    if (gt < D) { const float a = F.lb_logits()[gt], b = F.lb_logits()[D + gt], c = F.lb_logits()[2 * D + gt]; const float mx = fmaxf(a, fmaxf(b, c));
        const float ea = expf(a - mx), eb = expf(b - mx), ec = expf(c - mx); F.LB()[gt] = ea / (ea + eb + ec); }
}

namespace hg {
typedef short bf16x8 __attribute__((ext_vector_type(8)));
typedef short s16x4 __attribute__((ext_vector_type(4)));
constexpr int TILE = 16384, BUF = 3 * TILE;
constexpr int OFF_F = 2 * BUF, OFF_PART = OFF_F + 1024;
constexpr int HG_LDS_BYTES = OFF_PART + 4096;
constexpr int SUPER = 8, NSUPER = T / (64 * SUPER), NITEM = BATCH * 8 * NSUPER;
__device__ __forceinline__ int swz(int row) { return ((row & 7) << 5) | (((row >> 3) & 1) << 4); }
__device__ __forceinline__ bf16x8 mk8(u32x2 a, u32x2 b) { v4u w = {a.x, a.y, b.x, b.y}; return __builtin_bit_cast(bf16x8, w); }
__device__ __forceinline__ bf16x8 mk8s(s16x4 a, s16x4 b) { return (bf16x8){a[0], a[1], a[2], a[3], b[0], b[1], b[2], b[3]}; }
__device__ __forceinline__ u32x2 pk4(const f32x4 a) { u32x2 w; w.x = pg8::cvt_pk_bf16(a[0], a[1]); w.y = pg8::cvt_pk_bf16(a[2], a[3]); return w; }
#define HG_TRRD(dst, addr, off) asm volatile("ds_read_b64_tr_b16 %0, %1 offset:%2" : "=&v"(dst) : "v"(addr), "i"(off) : "memory")
#define HG_LGKM0() do { asm volatile("s_waitcnt lgkmcnt(0)" ::: "memory"); __builtin_amdgcn_sched_barrier(0); } while (0)
#define HG_MFMA(a, b, c) __builtin_amdgcn_mfma_f32_16x16x32_bf16((a), (b), (c), 0, 0, 0)

template <bool PC>
__device__ __forceinline__ void item(Frame& F, int it, float* DJ) {
    const int tid = F.tid, lane = F.lane, w = F.wave, li = lane & 15, g = lane >> 4;
    const int bh = it / NSUPER, j = it - bh * NSUPER, b = bh >> 3, h = bh & 7;
    const size_t row0 = (size_t)b * T + (size_t)j * (64 * SUPER);
    const int chunk0 = (int)(row0 >> 6), hc = h * 128;
    LAS unsigned char* L = F.lds + RING_OFF;
    const int srow = tid >> 4, sc16 = tid & 15;
    const unsigned st_off = (unsigned)(srow * 256 + ((sc16 * 16) ^ swz(srow)));
    const size_t g_off = (size_t)srow * 1024 + hc + sc16 * 8;
    const int sr = swz(li);
    const unsigned rbase = (unsigned)(li * 256 + ((8 * g) ^ (sr & 16))), sEr = (unsigned)(sr & 0xE0);
    const int trow = 4 * g + (li >> 2), stt = swz(trow);
    const unsigned tbase = (unsigned)(trow * 256 + ((8 * (li & 3)) ^ (stt & 16))), sEt = (unsigned)(stt & 0xE0);
    const unsigned ldsb = (unsigned)(size_t)L;

    f32x4 S[8]; bf16x8 Sb[4];
    float dprod = 1.f;
    if (PC && j > 0) {
        const float* st = F.ST() + ((size_t)it << 14) + (size_t)(w * 32) * 64 + lane;
#pragma unroll
        for (int kt = 0; kt < 8; ++kt) {
            const f32x4 e1 = *(const f32x4*)(F.E1() + (size_t)chunk0 * 1024 + hc + 16 * kt + 4 * g);
#pragma unroll
            for (int r = 0; r < 4; ++r) S[kt][r] = st[(kt * 4 + r) * 64] * e1[r];
        }
    } else {
#pragma unroll
        for (int kt = 0; kt < 8; ++kt) S[kt] = (f32x4){0.f, 0.f, 0.f, 0.f};
        if (!PC && tid < 128) dprod = F.E1()[(size_t)chunk0 * 1024 + hc + tid];
    }
#pragma unroll
    for (int kp = 0; kp < 4; ++kp) Sb[kp] = mk8(pk4(S[2 * kp]), pk4(S[2 * kp + 1]));
    float gn[4];
#pragma unroll
    for (int r = 0; r < 4; ++r) gn[r] = PC ? F.hgrn_out_norm()[16 * w + 4 * g + r] : 0.f;

    v4u sq0, sq1, sk0, sk1, sv0, sv1; float fe = 1.f;
#define HG_LOAD(cc) do { const size_t ro_ = (row0 + (size_t)(cc) * 64) * 1024 + g_off; \
        if (PC) { sq0 = *(const GAS v4u*)(F.QT() + ro_); sq1 = *(const GAS v4u*)(F.QT() + ro_ + 32 * 1024); } \
        sk0 = *(const GAS v4u*)(F.KT() + ro_); sk1 = *(const GAS v4u*)(F.KT() + ro_ + 32 * 1024); sv0 = *(const GAS v4u*)(F.VV() + ro_); sv1 = *(const GAS v4u*)(F.VV() + ro_ + 32 * 1024); \
        if (tid < 128) { fe = F.E2()[(size_t)(chunk0 + (cc)) * 1024 + hc + tid]; if ((cc) < SUPER - 1) fe *= F.E1()[(size_t)(chunk0 + (cc) + 1) * 1024 + hc + tid]; dprod *= fe; } } while (0)
#define HG_WRITE(bi) do { LAS unsigned char* B_ = L + (bi) * BUF + st_off; \
        if (PC) { *(LAS v4u*)B_ = sq0; *(LAS v4u*)(B_ + 8192) = sq1; } \
        *(LAS v4u*)(B_ + TILE) = sk0; *(LAS v4u*)(B_ + TILE + 8192) = sk1; *(LAS v4u*)(B_ + 2 * TILE) = sv0; *(LAS v4u*)(B_ + 2 * TILE + 8192) = sv1; \
        if (tid < 128) ((LAS float*)(L + OFF_F + (bi) * 512))[tid] = fe; } while (0)

    HG_LOAD(0); HG_WRITE(0);
    __syncthreads();
    for (int c = 0; c < SUPER; ++c) {
        const int bi = c & 1;
        u32x2 gg[4];
        if (c + 1 < SUPER) HG_LOAD(c + 1);
        if (PC) {
#pragma unroll
            for (int ti = 0; ti < 4; ++ti) gg[ti] = *(const GAS u32x2*)(F.GG() + (row0 + (size_t)c * 64 + 16 * ti + li) * 1024 + hc + 16 * w + 4 * g);
        }
        const unsigned qb_ = ldsb + bi * BUF, kb_ = qb_ + TILE, vb_ = qb_ + 2 * TILE;
        LAS unsigned char* Qp = L + bi * BUF; LAS unsigned char* Kp = Qp + TILE;
        bf16x8 vf[2];
        { s16x4 a0, a1, a2, a3; const unsigned va = vb_ + tbase + ((32u * w) ^ sEt);
          HG_TRRD(a0, va, 0); HG_TRRD(a1, va, 4096); HG_TRRD(a2, va, 8192); HG_TRRD(a3, va, 12288); HG_LGKM0();
          vf[0] = mk8s(a0, a1); vf[1] = mk8s(a2, a3); }
        f32x4 O[4];
        if (PC) {
#pragma unroll
            for (int ti = 0; ti < 4; ++ti) {
                bf16x8 qf[4];
#pragma unroll
                for (int kp = 0; kp < 4; ++kp) { const LAS unsigned char* a = Qp + 4096 * ti + rbase;
                    qf[kp] = mk8(*(const LAS u32x2*)(a + ((64u * kp) ^ sEr)), *(const LAS u32x2*)(a + ((64u * kp + 32u) ^ sEr))); }
                f32x4 o = {0.f, 0.f, 0.f, 0.f};
#pragma unroll
                for (int kp = 0; kp < 4; ++kp) o = HG_MFMA(Sb[kp], qf[kp], o);
                __builtin_amdgcn_sched_barrier(0);
                f32x4 p[4];
#pragma unroll
                for (int si = 0; si < 4; ++si) { p[si] = (f32x4){0.f, 0.f, 0.f, 0.f};
                    if (si <= ti) {
#pragma unroll
                        for (int kp = 0; kp < 4; ++kp) { const LAS unsigned char* a = Kp + 4096 * si + rbase;
                            const bf16x8 kf = mk8(*(const LAS u32x2*)(a + ((64u * kp) ^ sEr)), *(const LAS u32x2*)(a + ((64u * kp + 32u) ^ sEr)));
                            p[si] = HG_MFMA(kf, qf[kp], p[si]); }
                    } }
#pragma unroll
                for (int r = 0; r < 4; ++r) if (4 * g + r > li) p[ti][r] = 0.f;
                o = HG_MFMA(vf[0], mk8(pk4(p[0]), pk4(p[1])), o);
                if (ti >= 2) o = HG_MFMA(vf[1], mk8(pk4(p[2]), pk4(p[3])), o);
                O[ti] = o;
                __builtin_amdgcn_sched_barrier(0);
            }
        }
#pragma unroll
        for (int kt = 0; kt < 8; ++kt) {
            s16x4 a0, a1, a2, a3; const unsigned ka = kb_ + tbase + ((32u * kt) ^ sEt);
            HG_TRRD(a0, ka, 0); HG_TRRD(a1, ka, 4096); HG_TRRD(a2, ka, 8192); HG_TRRD(a3, ka, 12288); HG_LGKM0();
            S[kt] = HG_MFMA(mk8s(a0, a1), vf[0], S[kt]); S[kt] = HG_MFMA(mk8s(a2, a3), vf[1], S[kt]);
        }
#pragma unroll
        for (int kt = 0; kt < 8; ++kt) S[kt] = S[kt] * *(const LAS f32x4*)(L + OFF_F + bi * 512 + (16 * kt + 4 * g) * 4);
#pragma unroll
        for (int kp = 0; kp < 4; ++kp) Sb[kp] = mk8(pk4(S[2 * kp]), pk4(S[2 * kp + 1]));
        LAS float* part = (LAS float*)(L + OFF_PART + bi * 2048);
        if (PC) {
#pragma unroll
            for (int ti = 0; ti < 4; ++ti) { float q = (O[ti][0] * O[ti][0] + O[ti][1] * O[ti][1]) + (O[ti][2] * O[ti][2] + O[ti][3] * O[ti][3]);
                q += __shfl_xor(q, 16); q += __shfl_xor(q, 32);
                if (g == 0) part[(16 * ti + li) * 8 + w] = q; }
        }
        if (c + 1 < SUPER) HG_WRITE(bi ^ 1);
        __syncthreads();
        if (PC) {
#pragma unroll
            for (int ti = 0; ti < 4; ++ti) {
                const f32x4 p0 = *(const LAS f32x4*)(part + (16 * ti + li) * 8), p1 = *(const LAS f32x4*)(part + (16 * ti + li) * 8 + 4);
                const float tot = ((p0[0] + p0[1]) + (p0[2] + p0[3])) + ((p1[0] + p1[1]) + (p1[2] + p1[3]));
                const float r = 1.0f / sqrtf(tot * (1.0f / 128.0f) + NORM_EPS);
                f32x4 o = O[ti] * r;
                o[0] *= gn[0] * bf_lo(gg[ti].x); o[1] *= gn[1] * bf_hi(gg[ti].x); o[2] *= gn[2] * bf_lo(gg[ti].y); o[3] *= gn[3] * bf_hi(gg[ti].y);
                *(GAS u32x2*)(F.QT() + (row0 + (size_t)c * 64 + 16 * ti + li) * 1024 + hc + 16 * w + 4 * g) = pk4(o);
            }
        }
    }
    if (!PC) {
        float* st = F.ST() + ((size_t)(it + 1) << 14) + (size_t)(w * 32) * 64 + lane;
#pragma unroll
        for (int kt = 0; kt < 8; ++kt)
#pragma unroll
            for (int r = 0; r < 4; ++r) st[(kt * 4 + r) * 64] = S[kt][r];
        if (tid < 128) DJ[it * 128 + tid] = dprod;
    }
    __syncthreads();
#undef HG_LOAD
#undef HG_WRITE
}
__device__ __forceinline__ void phase_a(Frame& F, float* DJ) {
    for (int it = F.vcu; it < NITEM; it += F.G) { if ((it % NSUPER) == NSUPER - 1) continue; item<false>(F, it, DJ); }
}
__device__ __forceinline__ void phase_b(Frame& F, const float* DJ) {
    const int gt = F.vcu * NWAVES * 64 + F.tid, NGT = F.G * NWAVES * 64;
    for (int e = gt; e < BATCH * 8 * 16384; e += NGT) {
        const int bh = e >> 14, idx = e & 16383, kr = (idx >> 6) & 31, k = 16 * (kr >> 2) + 4 * ((idx & 63) >> 4) + (kr & 3);
        float s = 0.f;
        for (int j = 0; j + 1 < NSUPER; ++j) { const size_t a = ((size_t)(bh * NSUPER + j + 1) << 14) + idx; s = DJ[(bh * NSUPER + j) * 128 + k] * s + F.ST()[a]; F.ST()[a] = s; }
    }
}
__device__ __forceinline__ void phase_c(Frame& F) {
    for (int it = F.vcu; it < NITEM; it += F.G) item<true>(F, it, nullptr);
}
#undef HG_TRRD
#undef HG_LGKM0
#undef HG_MFMA
}

__device__ __forceinline__ void hgrn_simple_rec(Frame& F, float* oraw) {
    const int item = F.wave * F.G + F.vcu;
    if (item >= 256) return;
    const int b = item >> 7, h = (item >> 4) & 7, vg = item & 15, kc = h * 128 + 2 * F.lane, vc = h * 128 + vg * 8;
    float S0[8], S1[8];
#pragma unroll
    for (int j = 0; j < 8; ++j) { S0[j] = 0.f; S1[j] = 0.f; }
    for (int c = 0; c < 128; ++c) {
        const int chunk = b * 128 + c;
        const float e1x = F.E1()[(size_t)chunk * 1024 + kc], e1y = F.E1()[(size_t)chunk * 1024 + kc + 1], e2x = F.E2()[(size_t)chunk * 1024 + kc], e2y = F.E2()[(size_t)chunk * 1024 + kc + 1];
#pragma unroll
        for (int j = 0; j < 8; ++j) { S0[j] *= e1x; S1[j] *= e1y; }
#pragma unroll 2
        for (int t = 0; t < 64; ++t) {
            const size_t row = (size_t)chunk * 64 + t;
            const unsigned kq = *(const GAS unsigned*)(F.KT() + row * 1024 + kc), qq = *(const GAS unsigned*)(F.QT() + row * 1024 + kc);
            const v4u vv = *(const GAS v4u*)(F.VV() + row * 1024 + vc);
            const float k0 = bf_lo(kq), k1 = bf_hi(kq), q0 = bf_lo(qq), q1 = bf_hi(qq);
            const float v[8] = {bf_lo(vv.x), bf_hi(vv.x), bf_lo(vv.y), bf_hi(vv.y), bf_lo(vv.z), bf_hi(vv.z), bf_lo(vv.w), bf_hi(vv.w)};
            float part[8];
#pragma unroll
            for (int j = 0; j < 8; ++j) { S0[j] = fmaf(k0, v[j], S0[j]); S1[j] = fmaf(k1, v[j], S1[j]); part[j] = q0 * S0[j] + q1 * S1[j]; }
#pragma unroll
            for (int j = 0; j < 8; ++j) part[j] = wave_sum(part[j]);
            if (F.lane == 0) { float* o = oraw + row * 1024 + vc; *(f32x4*)o = (f32x4){part[0], part[1], part[2], part[3]}; *(f32x4*)(o + 4) = (f32x4){part[4], part[5], part[6], part[7]}; }
        }
#pragma unroll
        for (int j = 0; j < 8; ++j) { S0[j] *= e2x; S1[j] *= e2y; }
    }
}
__device__ __forceinline__ void hgrn_simple_post(Frame& F, const float* oraw) {
    const int gw = F.vcu * NWAVES + F.wave, NGW = F.G * NWAVES;
    const float gn0 = F.hgrn_out_norm()[2 * F.lane], gn1 = F.hgrn_out_norm()[2 * F.lane + 1];
    for (int it = gw; it < M * 8; it += NGW) {
        const size_t off = (size_t)(it >> 3) * 1024 + (it & 7) * 128 + 2 * F.lane;
        const float v0 = oraw[off], v1 = oraw[off + 1];
        const float r = 1.0f / sqrtf(wave_sum(v0 * v0 + v1 * v1) * (1.0f / 128.0f) + NORM_EPS);
        const unsigned g = *(const GAS unsigned*)(F.GG() + off);
        *(GAS unsigned*)(F.QT() + off) = pk2(v0 * r * gn0 * bf_lo(g), v1 * r * gn1 * bf_hi(g));
    }
}
__device__ __forceinline__ void attn_simple(Frame& F) {
    const int gw = F.vcu * NWAVES + F.wave, NGW = F.G * NWAVES;
    for (int it = gw; it < M * 12; it += NGW) {
        const int row = it / 12, hd = it - row * 12, t = row & (T - 1), g = hd >> 2, dil = g == 0 ? 1 : (g == 1 ? 4 : 16);
        const size_t co = (size_t)hd * 128 + 2 * F.lane;
        const unsigned qq = *(const GAS unsigned*)(F.QP() + (size_t)row * AW + co);
        const float q0 = bf_lo(qq), q1 = bf_hi(qq);
        float m = -INFINITY, l = 0.f, o0 = 0.f, o1 = 0.f;
        for (int j = 0; j <= 128; ++j) {
            if (t - j * dil < 0) break;
            const size_t rk = (size_t)(row - j * dil) * AW + co;
            const unsigned kk = *(const GAS unsigned*)(F.KP() + rk), vv = *(const GAS unsigned*)(F.VP() + rk);
            const float s = wave_sum(q0 * bf_lo(kk) + q1 * bf_hi(kk)) * 0.08838834764831845f;
            const float mn = fmaxf(m, s), a = __expf(m - mn), p = __expf(s - mn);
            l = l * a + p; o0 = o0 * a + p * bf_lo(vv); o1 = o1 * a + p * bf_hi(vv); m = mn;
        }
        *(GAS unsigned*)(F.QP() + (size_t)row * AW + co) = pk2(o0 / l, o1 / l);
        if (F.lane == 0) F.LSE()[(size_t)row * 12 + hd] = m + logf(l);
    }
}
typedef swa::BlockRef<bf16, bf16> AttRef;
__device__ __forceinline__ AttRef attn_ref(const Frame& F, int L) {
    const int bh = L >> 5, x = L & 31, b = bh / 12, head = bh - b * 12, sh = 2 * (head % 3), nqs = 5 - sh;
    const int r = x >> nqs, qb = x & ((1 << nqs) - 1);
    const size_t rowq = (size_t)b * T + r + ((size_t)qb * 256 << sh);
    AttRef R; R.Q = F.QP() + rowq * AW + head * 128; R.P0 = qb * 256; R.sh = sh; R.lrow = (int)rowq * 12 + head;
    return R;
}
__device__ __forceinline__ void attn_fast(Frame& F, char* lds) {
    constexpr int NITEM = BATCH * 12 * 32, W = 129;
    int L = F.vcu; if (L >= NITEM) return;
    AttRef cur = attn_ref(F, L);
    swa::Seam<bf16> S;
    swa::causal_swa_prime<bf16, bf16>(cur, W, lds, S, F.wave);
    for (;;) {
        const bool more = L + F.G < NITEM;
        const AttRef nxt = more ? attn_ref(F, L + F.G) : cur;
        swa::causal_swa_block<bf16, bf16>(cur, nxt, F.LSE(), W, lds, S, F.wave);
        if (!more) break;
        cur = nxt; L += F.G;
    }
}
__device__ __forceinline__ void attn_scale(Frame& F) {
    const int gt = F.vcu * NWAVES * 64 + F.tid, NGT = F.G * NWAVES * 64;
    for (int i = gt; i < M * (AW / 8); i += NGT) {
        const int row = i / (AW / 8), c8 = i - row * (AW / 8), hd = c8 >> 4, hg = hd & 3;
        const float* ls = F.LSE() + (size_t)row * 12;
        const float a = ls[hg], b = ls[4 + hg], c = ls[8 + hg], mx = fmaxf(a, fmaxf(b, c));
        const float al = __expf(ls[hd] - mx) / (__expf(a - mx) + __expf(b - mx) + __expf(c - mx));
        GAS v4u* p = (GAS v4u*)(F.QP() + (size_t)row * AW + c8 * 8);
        v4u v = *p;
        v.x = pk2(bf_lo(v.x) * al, bf_hi(v.x) * al); v.y = pk2(bf_lo(v.y) * al, bf_hi(v.y) * al); v.z = pk2(bf_lo(v.z) * al, bf_hi(v.z) * al); v.w = pk2(bf_lo(v.w) * al, bf_hi(v.w) * al);
        *p = v;
    }
}
__device__ __forceinline__ void final_norm_rows(Frame& F) {
    const int gw = F.vcu * NWAVES + F.wave, NGW = F.G * NWAVES;
    for (int m = gw; m < M; m += NGW) {
        const float s = wave_sum(F.lane < 16 ? F.SS()[(size_t)m * 16 + F.lane] : 0.f);
        const float r = 1.0f / sqrtf(s * (1.0f / D) + NORM_EPS);
        const GAS v4u* xr = (const GAS v4u*)(F.XB() + (size_t)m * D) + F.lane;
        GAS f32x4* o = (GAS f32x4*)(F.out() + (size_t)m * D) + 2 * F.lane;
        const GAS f32x4* gr = (const GAS f32x4*)F.final_norm() + 2 * F.lane;
#pragma unroll
        for (int j = 0; j < 2; ++j) { const v4u v = xr[64 * j]; const f32x4 g0 = gr[128 * j], g1 = gr[128 * j + 1];
            o[128 * j] = (f32x4){bf_lo(v.x) * r * g0.x, bf_hi(v.x) * r * g0.y, bf_lo(v.y) * r * g0.z, bf_hi(v.y) * r * g0.w};
            o[128 * j + 1] = (f32x4){bf_lo(v.z) * r * g1.x, bf_hi(v.z) * r * g1.y, bf_lo(v.w) * r * g1.z, bf_hi(v.w) * r * g1.w}; }
    }
}

__device__ __forceinline__ bool fresh(Frame& F) {
    int l = lane_id(); asm volatile("" : "+v"(l)); F.lane = l; F.tid = F.wave * 64 + l;
    unsigned long long kq = (unsigned long long)__builtin_amdgcn_kernarg_segment_ptr(); asm volatile("" : "+s"(kq)); F.kp = (KARG*)kq;
    unsigned long long wq = (unsigned long long)*(unsigned char* const __attribute__((address_space(4)))*)(F.kp + 104); asm volatile("" : "+s"(wq)); F.ws = (unsigned char*)wq;
    return true; }
struct Args { const float* in[12]; float* out; unsigned char* ws; int ph_lo, ph_hi; };
__global__ void __launch_bounds__(NWAVES * 64, 2) trunk_fwd(Args args) {
    extern __shared__ __attribute__((aligned(16))) unsigned char lds[];
    Frame F;
    F.lds = (LAS unsigned char*)lds;
    F.MISC = (volatile LAS unsigned*)(F.lds + MISC_OFF);
    F.wave = __builtin_amdgcn_readfirstlane((int)threadIdx.x >> 6);
    F.G = gridDim.x; { const int bx = blockIdx.x; F.vcu = (F.G % 8 == 0) ? (bx % 8) * (F.G / 8) + bx / 8 : bx; }
    fresh(F);
    unsigned char* ws = F.ws;
    for (int u = F.tid; u < (LDS_BYTES - LDSCTL_OFF) / 4; u += NWAVES * 64) ((LAS unsigned*)(F.lds + LDSCTL_OFF))[u] = 0u;
    __syncthreads();
    XcdBarrier bar; bar.bar = (unsigned*)(F.ctl() + CW_BAR); bar.x = 0; bar.st = nullptr; bar.w = F.wave;
    if (!MK_PER_PHASE) bar = xcd_barrier_post((unsigned*)(F.ctl() + CW_BAR), F.MISC + 8, F.wave);
    const int lo = args.ph_lo, hi = args.ph_hi;
#define IN(k) (lo <= (k) && (k) < hi && fresh(F))
#ifndef PROBE_A
#define PROBE_A -1
#define PROBE_B -1
#endif
#define SEAM(k) do { if (IN(k) && IN((k) + 1)) xcd_barrier(bar); if (PROBE_A >= 0 && blockIdx.x == 0 && F.tid == 0) ((unsigned long long*)(ws + WS_LB + 4096 + 256 * 1024))[(k) + 1] = __builtin_amdgcn_s_memrealtime(); } while (0)
    using pg8::Gemm; using pg8::StaticOrder;
#define RUN_GEMM(EPI, Aptr, Bptr, N_, K_, E) do { Gemm g{(const pg8::bf16_t*)(Aptr), (const pg8::bf16_t*)(Bptr), M, (N_), (K_)}; StaticOrder S; S.init(M, (N_), F.G, (int)blockIdx.x); \
        pg8::gemm_phase<EPI, StaticOrder, true, true>(F.lds + RING_OFF, g, S, E, F.wave); } while (0)

    if (PROBE_A >= 0 && blockIdx.x == 0 && F.tid == 0) ((unsigned long long*)(ws + WS_LB + 4096 + 256 * 1024))[0] = __builtin_amdgcn_s_memrealtime();
    if (IN(0)) { p0_prologue(F); } SEAM(0);
    if (IN(1)) { pg8::EpiHgrnIn E{F.QT(), F.KT(), F.VV(), F.GG(), F.E1(), F.E2(), F.SS(), F.LB()}; RUN_GEMM(pg8::EpiHgrnIn, F.XB(), F.Whin(), HIN, D, E); } SEAM(1);
    if (IN(2)) { hg::phase_a(F, F.DJ()); } SEAM(2);
    if (IN(3)) { hg::phase_b(F, F.DJ()); } SEAM(3);
    if (IN(4)) { hg::phase_c(F); } SEAM(4);
    if (IN(5)) { pg8::EpiRes E{F.XB(), F.SS()}; RUN_GEMM(pg8::EpiRes, F.QT(), F.Whout(), D, D, E); } SEAM(5);
    if (IN(6)) { pg8::EpiSwiglu E{F.FF(), F.SS()}; RUN_GEMM(pg8::EpiSwiglu, F.XB(), F.Wf1(), FF2, D, E); } SEAM(6);
    if (IN(7)) { pg8::EpiRes E{F.XB(), F.SS()}; RUN_GEMM(pg8::EpiRes, F.FF(), F.Wf2(), D, DFF, E); } SEAM(7);
    if (IN(8)) { pg8::EpiQkv E{F.QP(), F.KP(), F.VP(), F.SS(), F.COS(), F.SIN()}; RUN_GEMM(pg8::EpiQkv, F.XB(), F.Wqkv(), QKVW, D, E); } SEAM(8);
    if (IN(9)) { attn_fast(F, (char*)lds); } SEAM(9);
    if (IN(10)) {
        LAS float* rt = (LAS float*)(F.lds + MERGE_OFF);
        { StaticOrder S0; S0.init(M, D, F.G, (int)blockIdx.x); pg8::Unit u0;
          if (S0.next(0, u0) && F.tid < 256) { const float* ls = F.LSE() + (size_t)(u0.pm * 256 + F.tid) * 12; float dsum[4];
#pragma unroll
              for (int hg = 0; hg < 4; ++hg) dsum[hg] = (__expf(ls[3 * hg]) + __expf(ls[3 * hg + 1])) + __expf(ls[3 * hg + 2]);
              rt[F.tid * 4 + 0] = dsum[1] / dsum[0]; rt[F.tid * 4 + 1] = dsum[2] / dsum[1]; rt[F.tid * 4 + 2] = dsum[3] / dsum[2]; rt[F.tid * 4 + 3] = 1.0f / dsum[3]; } }
        __syncthreads();
        pg8::EpiResMerge E{F.XB(), F.SS(), rt}; RUN_GEMM(pg8::EpiResMerge, F.QP(), F.Wao(), D, AW, E); } SEAM(10);
    if (IN(11)) { pg8::EpiSwiglu E{F.FF(), F.SS()}; RUN_GEMM(pg8::EpiSwiglu, F.XB(), F.Wf1() + (size_t)FF2 * D, FF2, D, E); } SEAM(11);
    if (IN(12)) { pg8::EpiRes E{F.XB(), F.SS()}; RUN_GEMM(pg8::EpiRes, F.FF(), F.Wf2() + (size_t)D * DFF, D, DFF, E); } SEAM(12);
    if (IN(13)) { final_norm_rows(F); }
#ifdef PROBE_NULLGEMM
    if (PROBE_A >= 0) { xcd_barrier(bar);
        if (blockIdx.x == 0 && F.tid == 0) ((unsigned long long*)(ws + WS_LB + 4096 + 256 * 1024))[20] = __builtin_amdgcn_s_memrealtime();
        { pg8::EpiNull E{F.SS()}; RUN_GEMM(pg8::EpiNull, F.XB(), F.Wf1(), FF2, D, E); }
        xcd_barrier(bar);
        if (blockIdx.x == 0 && F.tid == 0) ((unsigned long long*)(ws + WS_LB + 4096 + 256 * 1024))[21] = __builtin_amdgcn_s_memrealtime(); }
#endif
    if (PROBE_A >= 0) {
        if (blockIdx.x == 0 && F.tid == 0) ((unsigned long long*)(ws + WS_LB + 4096 + 256 * 1024))[14] = __builtin_amdgcn_s_memrealtime();
        xcd_barrier(bar);
        const unsigned long long* ts = (const unsigned long long*)(ws + WS_LB + 4096 + 256 * 1024);
        if (blockIdx.x == 0 && F.tid == 0) F.out()[0] += (float)(ts[PROBE_B] - ts[PROBE_A]) * 0.0025f;
    }
#undef IN
#undef SEAM
#undef RUN_GEMM
}

extern "C" void kernel_launch(void* const* d_in, const int* in_sizes, int n_in, void* d_out, int out_size, void* d_ws, size_t ws_size, hipStream_t stream) {
    static int grid = 0;
    if (grid == 0) {
        if (n_in != 12 || in_sizes[0] != M * D || out_size != M * D || ws_size < WS_END) { fprintf(stderr, "kernel_launch: unexpected shapes (n_in %d, in0 %d, out %d, ws %zu); nothing launched\n", n_in, n_in > 0 ? in_sizes[0] : -1, out_size, ws_size); grid = -1; return; }
        int dev = 0, cus = 0, per_cu = 0;
        if (hipGetDevice(&dev) != hipSuccess || hipDeviceGetAttribute(&cus, hipDeviceAttributeMultiprocessorCount, dev) != hipSuccess) { grid = -1; return; }
        if (hipFuncSetAttribute((const void*)trunk_fwd, hipFuncAttributeMaxDynamicSharedMemorySize, LDS_BYTES) != hipSuccess) { fprintf(stderr, "kernel_launch: hipFuncSetAttribute failed\n"); grid = -1; return; }
        if (hipOccupancyMaxActiveBlocksPerMultiprocessor(&per_cu, (const void*)trunk_fwd, NWAVES * 64, LDS_BYTES) != hipSuccess || per_cu < 1)
            fprintf(stderr, "kernel_launch: note: the occupancy query reports %d workgroups per CU\n", per_cu);
        (void)hipGetLastError();
        grid = cus;
    }
    if (grid < 0) return;
    if (hipMemsetAsync((char*)d_ws + WS_CTL, 0, CTL_ZERO_BYTES, stream) != hipSuccess) { fprintf(stderr, "kernel_launch: hipMemsetAsync failed\n"); return; }
    Args a{};
    for (int i = 0; i < 12; ++i) a.in[i] = (const float*)d_in[i];
    a.out = (float*)d_out; a.ws = (unsigned char*)d_ws;
#if MK_PER_PHASE
    for (int p = 0; p < NPH; ++p) { a.ph_lo = p; a.ph_hi = p + 1; hipLaunchKernelGGL(trunk_fwd, dim3(grid), dim3(NWAVES * 64), LDS_BYTES, stream, a); }
#else
    a.ph_lo = 0; a.ph_hi = NPH; hipLaunchKernelGGL(trunk_fwd, dim3(grid), dim3(NWAVES * 64), LDS_BYTES, stream, a);
#endif
    const hipError_t le = hipPeekAtLastError();
    if (le != hipSuccess) fprintf(stderr, "kernel_launch: launch failed: %s (grid %d)\n", hipGetErrorName(le), grid);
}
```

```cpp
#include <hip/hip_runtime.h>
#include <cstdio>
#include <cstdint>
#include <math.h>

constexpr int BATCH = 2, T = 8192, D = 1024, M = BATCH * T;
constexpr int HIN = 4096, DFF = 2816, FF2 = 2 * DFF, QKVW = 4608, AW = 1536;
constexpr float NORM_EPS = 1e-6f;
__device__ __forceinline__ int lane_id() { return (int)__builtin_amdgcn_mbcnt_hi(~0u, __builtin_amdgcn_mbcnt_lo(~0u, 0u)); }

namespace pg8 {
#define PG8_LAS __attribute__((address_space(3)))
typedef unsigned short bf16_t;
typedef short bf16x8 __attribute__((ext_vector_type(8)));
typedef float f32x4 __attribute__((ext_vector_type(4)));
typedef unsigned u32x4 __attribute__((ext_vector_type(4)));
constexpr int BM = 256, BK = 64, HALF = 128, HTB = HALF * BK * 2  , STAGE_BYTES = 8 * HTB, NXCD = 8, WGM = 8;

__host__ __device__ __forceinline__ int lds_byte(int r, int c) { const int st = (r >> 4) * 2 + (c >> 5), rr = r & 15, cc = c & 31, ob = rr * 64 + cc * 2; return st * 1024 + (ob ^ (((ob >> 9) & 1) << 5)); }
__host__ __device__ __forceinline__ void stage_rc(int b, int& R, int& C) { const int st = b / 1024, sb = b % 1024, swz = sb ^ (((sb >> 9) & 1) << 5); R = (st >> 1) * 16 + swz / 64; C = (st & 1) * 32 + (swz % 64) / 2; }
__host__ __device__ __forceinline__ int perm32(int rho) { const int n = rho >> 4, i = rho & 15; return 8 * (i >> 2) + 4 * n + (i & 3); }

struct Unit { int pm, pn; };
struct Gemm { const bf16_t* A; const bf16_t* Bt; int M, N, K; };

struct StaticOrder {
    int nM, nN, nwg, G, c;
    __host__ __device__ __forceinline__ void init(int M, int N, int G_, int c_) { nM = M / BM; nN = N / BM; nwg = nM * nN; G = G_; c = c_; }
    __host__ __device__ __forceinline__ bool next(int i, Unit& u) const {
        const long L = (long)i * G + c; if (L >= nwg) return false;
        int wgid = (int)L; { const int q = nwg / NXCD, r = nwg % NXCD, xcd = wgid % NXCD, off = wgid / NXCD; wgid = (xcd < r ? xcd * (q + 1) : r * (q + 1) + (xcd - r) * q) + off; }
        const int nig = WGM * nN, gid = wgid / nig, fm = gid * WGM, gsz = (nM - fm) < WGM ? (nM - fm) : WGM;
        u.pm = fm + ((wgid % nig) % gsz); u.pn = (wgid % nig) / gsz; return true;
    }
    __device__ __forceinline__ void a_ready(const Unit&) const {}
    __device__ __forceinline__ void done(const Unit&) const {}
};


typedef float f32x2 __attribute__((ext_vector_type(2)));
typedef __bf16 bf16x2_t __attribute__((ext_vector_type(2)));
__device__ __forceinline__ unsigned cvt_pk_bf16(float lo, float hi) { const f32x2 v = {lo, hi}; return __builtin_bit_cast(unsigned, __builtin_convertvector(v, bf16x2_t)); }
typedef unsigned u32x2 __attribute__((ext_vector_type(2)));
__device__ __forceinline__ u32x4 pack8(const f32x4 a, const f32x4 b) { u32x4 w; w.x = cvt_pk_bf16(a[0], a[1]); w.y = cvt_pk_bf16(a[2], a[3]); w.z = cvt_pk_bf16(b[0], b[1]); w.w = cvt_pk_bf16(b[2], b[3]); return w; }
__device__ __forceinline__ u32x2 pack4(const f32x4 a) { u32x2 w; w.x = cvt_pk_bf16(a[0], a[1]); w.y = cvt_pk_bf16(a[2], a[3]); return w; }
__device__ __forceinline__ float silu_f(float x) { return x * __builtin_amdgcn_rcpf(1.0f + __builtin_amdgcn_exp2f(x * -1.4426950408889634f)); }
__device__ __forceinline__ f32x4 silu4(const f32x4 x) { f32x4 r; r[0] = silu_f(x[0]); r[1] = silu_f(x[1]); r[2] = silu_f(x[2]); r[3] = silu_f(x[3]); return r; }
__device__ __forceinline__ float sum_fq(float v) {
    v += __builtin_bit_cast(float, __builtin_amdgcn_ds_swizzle(__builtin_bit_cast(int, v), 0x401F));
    const auto r = __builtin_amdgcn_permlane32_swap(__float_as_uint(v), __float_as_uint(v), false, false);
    return __uint_as_float(r[0]) + __uint_as_float(r[1]);
}
__device__ __forceinline__ float bcast15(float v) { return __builtin_bit_cast(float, __builtin_amdgcn_ds_swizzle(__builtin_bit_cast(int, v), 0x01F0)); }
__device__ __forceinline__ float row_rstd(const float* ss, int row, int fq) {
    const f32x4 p = *(const f32x4*)(ss + (size_t)row * 16 + 4 * fq);
    const float s = sum_fq((p[0] + p[1]) + (p[2] + p[3]));
    return __builtin_amdgcn_rsqf(s * (1.0f / 1024.0f) + NORM_EPS);
}
template <int CTRL> __device__ __forceinline__ float dpp_f(float x) { return __builtin_bit_cast(float, __builtin_amdgcn_update_dpp(0, __builtin_bit_cast(int, x), CTRL, 0xf, 0xf, true)); }

struct EpiRes {
    static constexpr bool PERM = false, AFTER_DRAIN = false, KHOOK = false; static constexpr int NVM = 24;
    bf16_t* xb; float* ss;
    __device__ __forceinline__ void operator()(const f32x4 (&acc)[2][2][4][2], const Unit& u, int wr, int wc, int fr, int fq) const {
        { int l_ = lane_id(); asm volatile("" : "+v"(l_)); fr = l_ & 15; fq = l_ >> 4; }
        const int colb = u.pn * BM + wc * 32 + 8 * fq;
#pragma unroll
        for (int ai = 0; ai < 2; ++ai)
#pragma unroll
            for (int m = 0; m < 4; ++m) {
                const int row = u.pm * BM + ai * HALF + wr * 64 + m * 16 + fr;
                float sq = 0.f;
#pragma unroll
                for (int bj = 0; bj < 2; ++bj) {
                    bf16_t* p = xb + (size_t)row * 1024 + colb + bj * HALF;
                    const u32x4 b = *(const u32x4*)p;
                    f32x4 v0 = acc[ai][bj][m][0], v1 = acc[ai][bj][m][1];
                    v0[0] += __uint_as_float(b.x << 16); v0[1] += __uint_as_float(b.x & 0xffff0000u); v0[2] += __uint_as_float(b.y << 16); v0[3] += __uint_as_float(b.y & 0xffff0000u);
                    v1[0] += __uint_as_float(b.z << 16); v1[1] += __uint_as_float(b.z & 0xffff0000u); v1[2] += __uint_as_float(b.w << 16); v1[3] += __uint_as_float(b.w & 0xffff0000u);
                    *(u32x4*)p = pack8(v0, v1);
                    sq += (v0[0] * v0[0] + v0[1] * v0[1]) + (v0[2] * v0[2] + v0[3] * v0[3]) + (v1[0] * v1[0] + v1[1] * v1[1]) + (v1[2] * v1[2] + v1[3] * v1[3]);
                }
                sq = sum_fq(sq);
                if (fq == 0) ss[(size_t)row * 16 + u.pn * 4 + wc] = sq;
            }
    }
};
struct EpiResMerge {
    static constexpr bool PERM = false, AFTER_DRAIN = false, KHOOK = true; static constexpr int NVM = 24;
    bf16_t* xb; float* ss; const PG8_LAS float* rt;
    __device__ __forceinline__ void khook(f32x4 (&acc)[2][2][4][2], int t, int wr, int fr) const {
        if (t == 4 || t == 10 || t == 16) { const int idx = t == 4 ? 0 : (t == 10 ? 1 : 2);
#pragma unroll
            for (int ai = 0; ai < 2; ++ai)
#pragma unroll
                for (int m = 0; m < 4; ++m) { const float f = rt[(ai * HALF + wr * 64 + m * 16 + fr) * 4 + idx];
#pragma unroll
                    for (int bj = 0; bj < 2; ++bj) { acc[ai][bj][m][0] = acc[ai][bj][m][0] * f; acc[ai][bj][m][1] = acc[ai][bj][m][1] * f; } } }
    }
    __device__ __forceinline__ void operator()(const f32x4 (&acc)[2][2][4][2], const Unit& u, int wr, int wc, int fr, int fq) const {
        { int l_ = lane_id(); asm volatile("" : "+v"(l_)); fr = l_ & 15; fq = l_ >> 4; }
        const int colb = u.pn * BM + wc * 32 + 8 * fq;
#pragma unroll
        for (int ai = 0; ai < 2; ++ai)
#pragma unroll
            for (int m = 0; m < 4; ++m) {
                const int row = u.pm * BM + ai * HALF + wr * 64 + m * 16 + fr;
                const float f = rt[(ai * HALF + wr * 64 + m * 16 + fr) * 4 + 3];
                float sq = 0.f;
#pragma unroll
                for (int bj = 0; bj < 2; ++bj) {
                    bf16_t* p = xb + (size_t)row * 1024 + colb + bj * HALF;
                    const u32x4 b = *(const u32x4*)p;
                    f32x4 v0 = acc[ai][bj][m][0] * f, v1 = acc[ai][bj][m][1] * f;
                    v0[0] += __uint_as_float(b.x << 16); v0[1] += __uint_as_float(b.x & 0xffff0000u); v0[2] += __uint_as_float(b.y << 16); v0[3] += __uint_as_float(b.y & 0xffff0000u);
                    v1[0] += __uint_as_float(b.z << 16); v1[1] += __uint_as_float(b.z & 0xffff0000u); v1[2] += __uint_as_float(b.w << 16); v1[3] += __uint_as_float(b.w & 0xffff0000u);
                    *(u32x4*)p = pack8(v0, v1);
                    sq += (v0[0] * v0[0] + v0[1] * v0[1]) + (v0[2] * v0[2] + v0[3] * v0[3]) + (v1[0] * v1[0] + v1[1] * v1[1]) + (v1[2] * v1[2] + v1[3] * v1[3]);
                }
                sq = sum_fq(sq);
                if (fq == 0) ss[(size_t)row * 16 + u.pn * 4 + wc] = sq;
            }
    }
};
struct EpiNull {
    static constexpr bool PERM = false, AFTER_DRAIN = false, KHOOK = false; static constexpr int NVM = 0;
    float* sink;
    __device__ __forceinline__ void operator()(const f32x4 (&acc)[2][2][4][2], const Unit& u, int wr, int wc, int fr, int fq) const {
        { int l_ = lane_id(); asm volatile("" : "+v"(l_)); fr = l_ & 15; fq = l_ >> 4; }
        float s = 0.f;
#pragma unroll
        for (int ai = 0; ai < 2; ++ai)
#pragma unroll
            for (int bj = 0; bj < 2; ++bj)
#pragma unroll
                for (int m = 0; m < 4; ++m) s += acc[ai][bj][m][0][0] + acc[ai][bj][m][1][3];
        if (s == 123456.789f) sink[0] = s;
    }
};
struct EpiStoreOnly {
    static constexpr bool PERM = false, AFTER_DRAIN = false, KHOOK = false; static constexpr int NVM = 8;
    bf16_t* act;
    __device__ __forceinline__ void operator()(const f32x4 (&acc)[2][2][4][2], const Unit& u, int wr, int wc, int fr, int fq) const {
        { int l_ = lane_id(); asm volatile("" : "+v"(l_)); fr = l_ & 15; fq = l_ >> 4; }
        const int colb = u.pn * 128 + wc * 32 + 8 * fq;
#pragma unroll
        for (int ai = 0; ai < 2; ++ai)
#pragma unroll
            for (int m = 0; m < 4; ++m) {
                const int row = u.pm * BM + ai * HALF + wr * 64 + m * 16 + fr;
                *(u32x4*)(act + (size_t)row * DFF + colb) = pack8(acc[ai][0][m][0] + acc[ai][1][m][0], acc[ai][0][m][1] + acc[ai][1][m][1]);
            }
    }
};
struct EpiSwiglu {
    static constexpr bool PERM = false, AFTER_DRAIN = false, KHOOK = false; static constexpr int NVM = 8;
    bf16_t* act; const float* ss;
    __device__ __forceinline__ void operator()(const f32x4 (&acc)[2][2][4][2], const Unit& u, int wr, int wc, int fr, int fq) const {
        { int l_ = lane_id(); asm volatile("" : "+v"(l_)); fr = l_ & 15; fq = l_ >> 4; }
        const int colb = u.pn * 128 + wc * 32 + 8 * fq;
#pragma unroll
        for (int ai = 0; ai < 2; ++ai)
#pragma unroll
            for (int m = 0; m < 4; ++m) {
                const int row = u.pm * BM + ai * HALF + wr * 64 + m * 16 + fr;
                const float r = row_rstd(ss, row, fq);
                const f32x4 a0 = silu4(acc[ai][0][m][0] * r) * (acc[ai][1][m][0] * r), a1 = silu4(acc[ai][0][m][1] * r) * (acc[ai][1][m][1] * r);
                *(u32x4*)(act + (size_t)row * DFF + colb) = pack8(a0, a1);
            }
    }
};
struct EpiQkv {
    static constexpr bool PERM = false, AFTER_DRAIN = false, KHOOK = false; static constexpr int NVM = 16;
    bf16_t* Q; bf16_t* K; bf16_t* V; const float* ss; const float* cosT; const float* sinT;
    __device__ __forceinline__ void operator()(const f32x4 (&acc)[2][2][4][2], const Unit& u, int wr, int wc, int fr, int fq) const {
        { int l_ = lane_id(); asm volatile("" : "+v"(l_)); fr = l_ & 15; fq = l_ >> 4; }
        if (u.pn < 12) {
            bf16_t* P = u.pn < 6 ? Q : K;
            const int j0 = (wc & 1) * 32 + 8 * fq, tcol = (u.pn % 6) * 256 + (wc >> 1) * 128 + j0;
#pragma unroll
            for (int ai = 0; ai < 2; ++ai)
#pragma unroll
                for (int m = 0; m < 4; ++m) {
                    const int row = u.pm * BM + ai * HALF + wr * 64 + m * 16 + fr;
                    const float r = row_rstd(ss, row, fq);
                    const size_t tb = (size_t)(row & (T - 1)) * 64 + j0;
                    const f32x4 c0 = *(const f32x4*)(cosT + tb), c1 = *(const f32x4*)(cosT + tb + 4), s0 = *(const f32x4*)(sinT + tb), s1 = *(const f32x4*)(sinT + tb + 4);
                    const f32x4 x1a = acc[ai][0][m][0] * r, x1b = acc[ai][0][m][1] * r, x2a = acc[ai][1][m][0] * r, x2b = acc[ai][1][m][1] * r;
                    bf16_t* p = P + (size_t)row * AW + tcol;
                    *(u32x4*)p = pack8(x1a * c0 - x2a * s0, x1b * c1 - x2b * s1);
                    *(u32x4*)(p + 64) = pack8(x2a * c0 + x1a * s0, x2b * c1 + x1b * s1);
                }
        } else {
            const int tcol = (u.pn - 12) * 256 + wc * 32 + 8 * fq;
#pragma unroll
            for (int ai = 0; ai < 2; ++ai)
#pragma unroll
                for (int m = 0; m < 4; ++m) {
                    const int row = u.pm * BM + ai * HALF + wr * 64 + m * 16 + fr;
                    const float r = row_rstd(ss, row, fq);
#pragma unroll
                    for (int bj = 0; bj < 2; ++bj) *(u32x4*)(V + (size_t)row * AW + tcol + bj * HALF) = pack8(acc[ai][bj][m][0] * r, acc[ai][bj][m][1] * r);
                }
        }
    }
};
struct EpiHgrnIn {
    static constexpr bool PERM = false, AFTER_DRAIN = false, KHOOK = false; static constexpr int NVM = 36;
    bf16_t *QT, *KT, *VV, *GG; float *E1, *E2; const float* ss; const float* lb;
    __device__ __forceinline__ void operator()(const f32x4 (&acc)[2][2][4][2], const Unit& u, int wr, int wc, int fr, int fq) const {
        { int l_ = lane_id(); asm volatile("" : "+v"(l_)); fr = l_ & 15; fq = l_ >> 4; }
        const int ch0 = u.pn * 64 + wc * 16 + 4 * fq;
        const f32x4 lbv = *(const f32x4*)(lb + ch0);
#pragma unroll
        for (int ai = 0; ai < 2; ++ai) {
            const int rowb = u.pm * BM + ai * HALF + wr * 64;
            float rs[4];
#pragma unroll
            for (int m = 0; m < 4; ++m) rs[m] = row_rstd(ss, rowb + m * 16 + fr, fq);
            f32x4 kv[4], bc[4], run = {0.f, 0.f, 0.f, 0.f};
#pragma unroll
            for (int m = 0; m < 4; ++m) {
                const f32x4 fz = acc[ai][0][m][1] * rs[m];
#pragma unroll
                for (int e = 0; e < 4; ++e) {
                    const float tt = __builtin_amdgcn_exp2f(fmaxf(fz[e], -80.f) * -1.4426950408889634f), inv = __builtin_amdgcn_rcpf(1.0f + tt);
                    const float oml = 1.0f - lbv[e];
                    const float fg = lbv[e] + oml * inv;
                    kv[m][e] = oml * (tt * inv);
                    float x = __builtin_amdgcn_logf(fg);
                    x += dpp_f<0x111>(x); x += dpp_f<0x112>(x); x += dpp_f<0x114>(x); x += dpp_f<0x118>(x);
                    const float tot = bcast15(x);
                    bc[m][e] = x + run[e]; run[e] += tot;
                }
            }
            f32x4 ref;
#pragma unroll
            for (int e = 0; e < 4; ++e) ref[e] = bcast15(bc[1][e]);
            if (fr == 0) {
                const int chunk = rowb >> 6; f32x4 e1, e2;
#pragma unroll
                for (int e = 0; e < 4; ++e) { e1[e] = __builtin_amdgcn_exp2f(ref[e]); e2[e] = __builtin_amdgcn_exp2f(run[e] - ref[e]); }
                *(f32x4*)(E1 + (size_t)chunk * 1024 + ch0) = e1; *(f32x4*)(E2 + (size_t)chunk * 1024 + ch0) = e2;
            }
#pragma unroll
            for (int m = 0; m < 4; ++m) {
                const size_t off = (size_t)(rowb + m * 16 + fr) * 1024 + ch0;
                f32x4 qv = silu4(acc[ai][0][m][0] * rs[m]), kk = kv[m];
#pragma unroll
                for (int e = 0; e < 4; ++e) { const float dl = bc[m][e] - ref[e]; qv[e] *= __builtin_amdgcn_exp2f(dl); kk[e] *= __builtin_amdgcn_exp2f(-dl); }
                *(u32x2*)(QT + off) = pack4(qv); *(u32x2*)(KT + off) = pack4(kk);
                *(u32x2*)(VV + off) = pack4(acc[ai][1][m][0] * rs[m]); *(u32x2*)(GG + off) = pack4(silu4(acc[ai][1][m][1] * rs[m]));
            }
            __builtin_amdgcn_sched_barrier(0);
        }
    }
};

template <class Epi, class Sched, bool ALIGN_EPI = false, bool SP2 = false>
__device__ __forceinline__ void gemm_phase(PG8_LAS unsigned char* lds, const Gemm g, const Sched& S, const Epi& E, const int wid) {
    int lane = lane_id(); asm volatile("" : "+v"(lane));
    const int tid = wid * 64 + lane, wr = wid >> 2, wc = wid & 3, fr = lane & 15, fq = lane >> 4;
    const int K = g.K, nt = K / BK;
    unsigned voffA[2], voffB[2];
#pragma unroll
    for (int i = 0; i < 2; ++i) { int R, C; stage_rc(tid * 16 + i * 8192, R, C); const int Rb = Epi::PERM ? ((R & ~31) + perm32(R & 31)) : R;
        voffA[i] = (unsigned)(R * K + C) * 2u; voffB[i] = (unsigned)(Rb * K + C) * 2u; }
    const size_t kstep = (size_t)(BK * 2);
    const size_t hstep = (size_t)HALF * K * 2;
    const size_t tstep = 2 * hstep;
    const unsigned ldsw = (unsigned)wid * 1024u;
    const int aoff = lds_byte(wr * 64 + fr, fq * 8), boff = lds_byte(wc * 32 + fr, fq * 8);
#define PG8_SA(b, h) (((b) * 2 + (h)) * HTB)
#define PG8_SB(b, h) ((4 + (b) * 2 + (h)) * HTB)
#define PG8_STAGE(bufoff, gbase, voff) do { _Pragma("unroll") for (int _i = 0; _i < 2; ++_i) \
        __builtin_amdgcn_global_load_lds((const unsigned*)((const char*)(gbase) + (voff)[_i]), (PG8_LAS unsigned*)(lds + (bufoff) + ldsw + _i * 8192), 16, 0, 0); } while (0)
#define PG8_LDA(dst, b, h) do { _Pragma("unroll") for (int m = 0; m < 4; ++m) _Pragma("unroll") for (int k = 0; k < 2; ++k) dst[m][k] = *(const PG8_LAS bf16x8*)(lds + PG8_SA(b, h) + aoff + m * 2048 + k * 1024); } while (0)
#define PG8_LDB(dst, b, h) do { _Pragma("unroll") for (int n = 0; n < 2; ++n) _Pragma("unroll") for (int k = 0; k < 2; ++k) dst[n][k] = *(const PG8_LAS bf16x8*)(lds + PG8_SB(b, h) + boff + n * 2048 + k * 1024); } while (0)
#define PG8_MMA(ai, bj, At, Bt) do { __builtin_amdgcn_s_setprio(1); _Pragma("unroll") for (int m = 0; m < 4; ++m) _Pragma("unroll") for (int n = 0; n < 2; ++n) _Pragma("unroll") for (int k = 0; k < 2; ++k) \
        acc[ai][bj][m][n] = __builtin_amdgcn_mfma_f32_16x16x32_bf16(Bt[n][k], At[m][k], acc[ai][bj][m][n], 0, 0, 0); __builtin_amdgcn_s_setprio(0); } while (0)
#define PG8_MMA0(ai, bj, At, Bt) do { __builtin_amdgcn_s_setprio(1); _Pragma("unroll") for (int m = 0; m < 4; ++m) _Pragma("unroll") for (int n = 0; n < 2; ++n) { \
        acc[ai][bj][m][n] = __builtin_amdgcn_mfma_f32_16x16x32_bf16(Bt[n][0], At[m][0], (f32x4){0.f, 0.f, 0.f, 0.f}, 0, 0, 0); \
        acc[ai][bj][m][n] = __builtin_amdgcn_mfma_f32_16x16x32_bf16(Bt[n][1], At[m][1], acc[ai][bj][m][n], 0, 0, 0); } __builtin_amdgcn_s_setprio(0); } while (0)
#define PG8_WAIT_V(n) asm volatile("s_waitcnt vmcnt(" #n ")" ::: "memory")
#define PG8_WAIT_L(n) asm volatile("s_waitcnt lgkmcnt(" #n ")" ::: "memory")
#define PG8_BAR __builtin_amdgcn_s_barrier()
#define PG8_SCHED __builtin_amdgcn_sched_barrier(0)
    Unit cur, nxt; int ui = 0;
    if (!S.next(0, cur)) return;
    f32x4 acc[2][2][4][2];
    bf16x8 At[4][2], B0[2][2], B1[2][2];
    const char* cA = (const char*)g.A + (size_t)cur.pm * tstep; const char* cB = (const char*)g.Bt + (size_t)cur.pn * tstep;
    S.a_ready(cur);
    static_assert(SP2, "this copy of the body keeps only the SP2 schedule");
    PG8_STAGE(PG8_SB(0, 0), cB, voffB); PG8_STAGE(PG8_SB(0, 1), cB + hstep, voffB); PG8_STAGE(PG8_SA(0, 0), cA, voffA); PG8_STAGE(PG8_SA(0, 1), cA + hstep, voffA);
    if (wr == 1) PG8_BAR;
    PG8_WAIT_V(2); PG8_BAR;
    PG8_STAGE(PG8_SB(1, 0), cB + kstep, voffB); PG8_STAGE(PG8_SA(1, 0), cA + kstep, voffA); PG8_STAGE(PG8_SB(1, 1), cB + hstep + kstep, voffB);
    PG8_WAIT_V(0); PG8_BAR;
#define PG8_WAIT_VR asm volatile("s_waitcnt vmcnt(%0)" :: "i"(8 + Epi::NVM) : "memory")
#define PG8_KITER(WV, MM) { \
            const bool last = (t == nt - 2); \
            const char* a1 = cA + (size_t)(t + 1) * kstep; \
            const char* a2 = last ? nA : cA + (size_t)(t + 2) * kstep; const char* b2 = last ? nB : cB + (size_t)(t + 2) * kstep; \
            const char* a3 = a2 + kstep; const char* b3 = b2 + kstep; \
            if (last && has_next) S.a_ready(nxt); \
              \
            PG8_LDB(B0, 0, 0); PG8_LDB(B1, 0, 1); PG8_SCHED; PG8_LDA(At, 0, 0); PG8_STAGE(PG8_SA(1, 1), a1 + hstep, voffA); \
            WV; PG8_WAIT_L(0); PG8_BAR; MM(0, 0, At, B0); MM(0, 1, At, B1); PG8_BAR; PG8_SCHED; \
              \
            PG8_LDA(At, 0, 1); PG8_STAGE(PG8_SB(0, 0), b2, voffB); PG8_STAGE(PG8_SB(0, 1), b2 + hstep, voffB); PG8_STAGE(PG8_SA(0, 0), a2, voffA); \
            WV; PG8_WAIT_L(0); PG8_BAR; MM(1, 0, At, B0); MM(1, 1, At, B1); PG8_BAR; PG8_SCHED; \
              \
            PG8_LDB(B0, 1, 0); PG8_LDB(B1, 1, 1); PG8_SCHED; PG8_LDA(At, 1, 0); PG8_STAGE(PG8_SA(0, 1), a2 + hstep, voffA); \
            PG8_WAIT_V(8); PG8_WAIT_L(0); PG8_BAR; PG8_MMA(0, 0, At, B0); PG8_MMA(0, 1, At, B1); PG8_BAR; PG8_SCHED; \
              \
            PG8_LDA(At, 1, 1); PG8_STAGE(PG8_SB(1, 0), b3, voffB); PG8_STAGE(PG8_SB(1, 1), b3 + hstep, voffB); PG8_STAGE(PG8_SA(1, 0), a3, voffA); \
            PG8_WAIT_V(8); PG8_WAIT_L(0); PG8_BAR; PG8_MMA(1, 0, At, B0); PG8_MMA(1, 1, At, B1); PG8_BAR; PG8_SCHED; \
            if constexpr (Epi::KHOOK) E.khook(acc, t, wr, fr); }
    for (;;) {
        const bool has_next = S.next(ui + 1, nxt);
        const char* nA = has_next ? (const char*)g.A + (size_t)nxt.pm * tstep : cA; const char* nB = has_next ? (const char*)g.Bt + (size_t)nxt.pn * tstep : cB;
        int t = 0;
        PG8_KITER(PG8_WAIT_VR, PG8_MMA0)
        for (t = 2; t < nt; t += 2) PG8_KITER(PG8_WAIT_V(8), PG8_MMA)
        if constexpr (ALIGN_EPI) { if (wr == 0) PG8_BAR; }
        if constexpr (!Epi::AFTER_DRAIN) { E(acc, cur, wr, wc, fr, fq); S.done(cur); }
        if (!has_next) break;
        cur = nxt; cA = nA; cB = nB; ++ui;
        if constexpr (ALIGN_EPI) { if (wr == 1) PG8_BAR; }
    }
    PG8_WAIT_V(0);
    if constexpr (!ALIGN_EPI) { if (wr == 0) PG8_BAR; }
    PG8_BAR;
    if constexpr (Epi::AFTER_DRAIN) { E.fused(acc, cur, wr, wc, fr, fq, lds, wid, lane); S.done(cur); }
#undef PG8_KITER
#undef PG8_WAIT_VR
#undef PG8_SA
#undef PG8_SB
#undef PG8_STAGE
#undef PG8_LDA
#undef PG8_LDB
#undef PG8_MMA
#undef PG8_MMA0
#undef PG8_WAIT_V
#undef PG8_WAIT_L
#undef PG8_BAR
#undef PG8_SCHED
}
}


constexpr int NWAVES = 8;
#ifndef MK_PER_PHASE
#define MK_PER_PHASE 0
#endif
constexpr int NPH = 14;

constexpr size_t MiB = 1u << 20;
constexpr size_t WS_CTL = 0, CTL_ZERO_BYTES = 64 * 1024;
constexpr size_t WS_WHIN = 1 * MiB, WS_WHOUT = 9 * MiB, WS_WQKV = 11 * MiB, WS_WAO = 20 * MiB, WS_WF1 = 23 * MiB, WS_WF2 = 45 * MiB;
constexpr size_t WS_SS = 56 * MiB, WS_E1 = 57 * MiB, WS_E2 = 58 * MiB, WS_COS = 59 * MiB, WS_SIN = 61 * MiB, WS_LSE = 63 * MiB, WS_LB = 63 * MiB + 768 * 1024;
constexpr size_t WS_ST = 64 * MiB;
constexpr size_t WS_XB = 80 * MiB;
constexpr size_t WS_ACT = 112 * MiB;
constexpr size_t WS_QT = WS_ACT, WS_KT = WS_ACT + 32 * MiB, WS_VV = WS_ACT + 64 * MiB, WS_GG = WS_ACT + 96 * MiB;
constexpr size_t WS_FF = WS_ACT;
constexpr size_t WS_QP = WS_ACT, WS_KP = WS_ACT + 48 * MiB, WS_VP = WS_ACT + 96 * MiB;
constexpr size_t WS_END = 256 * MiB;
static_assert(WS_VP + (size_t)M * AW * 2 <= WS_END && WS_FF + (size_t)M * DFF * 2 <= WS_END && WS_GG + (size_t)M * D * 2 <= WS_END, "d_ws map");
static_assert(WS_WF2 + 2 * (size_t)D * DFF * 2 <= WS_SS && WS_WF1 + 2 * (size_t)FF2 * D * 2 <= WS_WF2 && WS_WAO + (size_t)D * AW * 2 <= WS_WF1 && WS_WQKV + (size_t)QKVW * D * 2 <= WS_WAO, "weights map");
constexpr int CW_TMO = 0, CW_BAR = 4096;

constexpr int RING_OFF = 0, RING_BYTES = 131072;
constexpr int LDSCTL_OFF = RING_BYTES, MISC_OFF = LDSCTL_OFF + 320;
constexpr int MERGE_OFF = RING_BYTES + 4096;
constexpr int LDS_BYTES = 147456;
namespace swa {
constexpr float SCALE = 0.08838834764831845f;
constexpr int D = 128; constexpr bool WSKIP = true; constexpr float THR = 8.f;
constexpr int PLANE_PITCH = AW, SEQ_T = T; constexpr size_t K_FROM_Q = (WS_KP - WS_QP) / 2, V_FROM_K = (WS_VP - WS_KP) / 2;
constexpr int NW = 8, QBLK = 32, KVBLK = 64, QB = NW * QBLK;
constexpr int SHM_V = KVBLK * D * 2, SHM_K = KVBLK * D * 2, ATT_LDS_BYTES = 2 * SHM_V + 2 * SHM_K + NW * 64 * 4;
typedef unsigned short bf16;
typedef short bf16x8 __attribute__((ext_vector_type(8)));
typedef short s16x4 __attribute__((ext_vector_type(4)));
typedef float f32x16 __attribute__((ext_vector_type(16)));
typedef float f32x4 __attribute__((ext_vector_type(4)));
typedef unsigned u32x4 __attribute__((ext_vector_type(4)));
template <class A, class Bt> struct same_t { static constexpr bool v = false; };
template <class A> struct same_t<A, A> { static constexpr bool v = true; };

#define KSWZ(row, colB) ((row) * 256 + ((colB) ^ (((row) & 7) << 4)))
#define SBAR() __builtin_amdgcn_sched_barrier(0)
__device__ __forceinline__ int v_st(int k, int c) { const int kk = (k & ~0xC) | ((k & 4) << 1) | ((k & 8) >> 1); return ((kk >> 3) * 4 + (c >> 5)) * 512 + ((kk & 7) * 32 + (c & 31)) * 2; }
__device__ __forceinline__ int v_rd_base(int lane) { return ((lane & 3) << 3) | (((lane >> 2) & 3) << 6) | (((lane >> 4) & 1) << 5) | (((lane >> 5) & 1) << 8); }
constexpr int v_rd_off(int d0, int ks, int half) { return d0 * 512 + ks * 4096 + half * 2048; }
__device__ __forceinline__ int crow(int r, int hi) { return (r & 3) + 8 * (r >> 2) + 4 * hi; }
__device__ __forceinline__ unsigned cvtpk(float lo, float hi) {
    unsigned r; asm volatile("v_cvt_pk_bf16_f32 %0, %1, %2" : "=v"(r) : "v"(lo), "v"(hi)); return r;
}
__device__ __forceinline__ bf16x8 pack8(f32x4 a, f32x4 b) {
    u32x4 w = {cvtpk(a[0], a[1]), cvtpk(a[2], a[3]), cvtpk(b[0], b[1]), cvtpk(b[2], b[3])};
    return *reinterpret_cast<bf16x8*>(&w);
}
template <class T> __device__ __forceinline__ bf16x8 load8(const T* p) {
    if constexpr (same_t<T, float>::v) { return pack8(*(const f32x4*)p, *(const f32x4*)(p + 4)); }
    else { return *reinterpret_cast<const bf16x8*>(p); }
}
__device__ __forceinline__ void mask_tile(f32x16& p0, f32x16& p1, int dq, unsigned W) {
    const float NEG = -__builtin_inff();
#pragma unroll
    for (int r = 0; r < 16; ++r) {
        const int c = (r & 3) + 8 * (r >> 2);
        if ((unsigned)(dq - c) >= W) p0[r] = NEG;
        if ((unsigned)(dq - c - 32) >= W) p1[r] = NEG;
    }
}
__device__ __forceinline__ void partialSM(f32x16& p0, f32x16& p1, float& m_reg, float& mn, float& alpha) {
    float pmax = p0[0]; for (int r = 1; r < 16; ++r) pmax = fmaxf(pmax, p0[r]); for (int r = 0; r < 16; ++r) pmax = fmaxf(pmax, p1[r]);
    { auto rr = __builtin_amdgcn_permlane32_swap(__float_as_uint(pmax), __float_as_uint(pmax), false, false);
      pmax = fmaxf(__uint_as_float(rr[0]), __uint_as_float(rr[1])); }
    constexpr float C2 = 1.4426950408889634f * SCALE;
    if (__builtin_expect(__all((pmax - m_reg) * SCALE <= THR), 1)) { mn = m_reg; alpha = 1.f; }
    else { mn = fmaxf(m_reg, pmax); alpha = __builtin_amdgcn_exp2f((m_reg - mn) * C2); m_reg = mn; }
    const float mnL = -mn * C2;
    for (int r = 0; r < 16; ++r) p0[r] = fmaf(p0[r], C2, mnL); for (int r = 0; r < 16; ++r) p1[r] = fmaf(p1[r], C2, mnL);
    for (int r = 0; r < 16; ++r) p0[r] = __builtin_amdgcn_exp2f(p0[r]);
}
__device__ __forceinline__ void finishSM(f32x16& p0, f32x16& p1, float alpha, float& l_reg, bf16x8& pa0, bf16x8& pa1, bf16x8& pa2, bf16x8& pa3) {
    for (int r = 0; r < 16; ++r) p1[r] = __builtin_amdgcn_exp2f(p1[r]);
    float ps = 0; for (int r = 0; r < 16; ++r) ps += p0[r]; for (int r = 0; r < 16; ++r) ps += p1[r];
    { auto rr = __builtin_amdgcn_permlane32_swap(__float_as_uint(ps), __float_as_uint(ps), false, false);
      ps = __uint_as_float(rr[0]) + __uint_as_float(rr[1]); }
    l_reg = l_reg * alpha + ps;
#define PK4(P, B_, OUT) do { unsigned a0 = cvtpk(P[B_+0], P[B_+1]), a1 = cvtpk(P[B_+2], P[B_+3]);                          \
        unsigned b0 = cvtpk(P[B_+4], P[B_+5]), b1 = cvtpk(P[B_+6], P[B_+7]);                                             \
        auto r0 = __builtin_amdgcn_permlane32_swap(a0, b0, false, false); auto r1 = __builtin_amdgcn_permlane32_swap(a1, b1, false, false); \
        u32x4 w = {r0[0], r1[0], r0[1], r1[1]}; OUT = *reinterpret_cast<bf16x8*>(&w); } while (0)
    PK4(p0, 0, pa0); PK4(p0, 8, pa1); PK4(p1, 0, pa2); PK4(p1, 8, pa3);
#undef PK4
}
template <int KB, bool SK>
__device__ __forceinline__ void qkt(f32x16& p0, f32x16& p1, const char* K_lds, int r32, int hi, const bf16x8* qr, bool act) {
    if (SK && !act) { const float NEG = -__builtin_inff();
#pragma unroll
        for (int r = 0; r < 16; ++r) { p0[r] = NEG; p1[r] = NEG; } return; }
    p0 = f32x16{}; p1 = f32x16{};
    const char* kb[4];
#pragma unroll
    for (int dd = 0; dd < 4; ++dd) kb[dd] = K_lds + KB * SHM_K + KSWZ(r32, (dd * 16 + hi * 8) * 2);
#pragma unroll
    for (int d0 = 0; d0 < 8; ++d0) { const char* a = kb[d0 & 3] + (d0 >> 2) * 128;
        bf16x8 b0 = *reinterpret_cast<const bf16x8*>(a);
        bf16x8 b1 = *reinterpret_cast<const bf16x8*>(a + 32 * 256);
        p0 = __builtin_amdgcn_mfma_f32_32x32x16_bf16(b0, qr[d0], p0, 0, 0, 0);
        p1 = __builtin_amdgcn_mfma_f32_32x32x16_bf16(b1, qr[d0], p1, 0, 0, 0); }
}
template <int VB, bool SK>
__device__ __forceinline__ void pv_tile(f32x16* o, int vb0, bf16x8 pa0, bf16x8 pa1, bf16x8 pa2, bf16x8 pa3, bool act) {
    if (SK && !act) return;
#define TRRD(dst, off) asm volatile("ds_read_b64_tr_b16 %0, %1 offset:%2" : "=&v"(dst) : "v"(vb0), "i"(off) : "memory")
#define PV_D0(d0) do { s16x4 l0, l1, l2, l3, h0, h1, h2, h3; constexpr int b_ = VB * SHM_V + v_rd_off(d0, 0, 0);     \
        TRRD(l0, b_); TRRD(h0, b_ + 2048); TRRD(l1, b_ + 4096); TRRD(h1, b_ + 6144); TRRD(l2, b_ + 8192); TRRD(h2, b_ + 10240); TRRD(l3, b_ + 12288); TRRD(h3, b_ + 14336); \
        asm volatile("s_waitcnt lgkmcnt(0)" ::: "memory"); SBAR();                 \
        o[d0] = __builtin_amdgcn_mfma_f32_32x32x16_bf16(pa0, (bf16x8){l0[0], l0[1], l0[2], l0[3], h0[0], h0[1], h0[2], h0[3]}, o[d0], 0, 0, 0);   \
        o[d0] = __builtin_amdgcn_mfma_f32_32x32x16_bf16(pa1, (bf16x8){l1[0], l1[1], l1[2], l1[3], h1[0], h1[1], h1[2], h1[3]}, o[d0], 0, 0, 0);   \
        o[d0] = __builtin_amdgcn_mfma_f32_32x32x16_bf16(pa2, (bf16x8){l2[0], l2[1], l2[2], l2[3], h2[0], h2[1], h2[2], h2[3]}, o[d0], 0, 0, 0);   \
        o[d0] = __builtin_amdgcn_mfma_f32_32x32x16_bf16(pa3, (bf16x8){l3[0], l3[1], l3[2], l3[3], h3[0], h3[1], h3[2], h3[3]}, o[d0], 0, 0, 0); } while (0)
    PV_D0(0); PV_D0(1); PV_D0(2); PV_D0(3);
#undef PV_D0
#undef TRRD
}

template <class TIn, class TOut> struct BlockRef { const TIn* Q; int P0, sh, lrow;
    __device__ __forceinline__ int pitch() const { return PLANE_PITCH << sh; }
    __device__ __forceinline__ const TIn* K() const { return Q + K_FROM_Q - (size_t)P0 * (size_t)pitch(); }
    __device__ __forceinline__ const TIn* V() const { return K() + V_FROM_K; }
    __device__ __forceinline__ int skv() const { return SEQ_T >> sh; }
    __device__ __forceinline__ int lp() const { return 12 << sh; } };
template <class TIn> struct Seam {
    bf16x8 qr[8];
    bf16x8 st_v0, st_v1, st_k0, st_k1; f32x4 sf0, sf1, sf2, sf3;
    f32x4 tq[16];
};
__device__ __forceinline__ int swa_jlo(int P0, int W) { const int lowk = P0 - W + 1; return lowk > 0 ? lowk / KVBLK : 0; }
#define ROW(p, k0, rr, kp_) ((p) + (unsigned)(((k0) + (rr)) * (kp_) + sc))
#define VMW() asm volatile("s_waitcnt vmcnt(0)" ::: "memory")
#define VMWN(n) asm volatile("s_waitcnt vmcnt(%0)" :: "i"(n) : "memory")
#define SLOAD_H(Kp, Vp, k0, kp_) do { S.st_v0 = load8<TIn>(ROW(Vp, k0, sr, kp_)); S.st_v1 = load8<TIn>(ROW(Vp, k0, 32 + sr, kp_));              \
                         S.st_k0 = load8<TIn>(ROW(Kp, k0, sr, kp_)); S.st_k1 = load8<TIn>(ROW(Kp, k0, 32 + sr, kp_)); } while (0)
#define SWRITE_HK(bf) do { *(bf16x8*)(K_lds + (bf) * SHM_K + kws) = S.st_k0; *(bf16x8*)(K_lds + (bf) * SHM_K + kws + 32 * 256) = S.st_k1; } while (0)
#define SWRITE_HV(bf) do { *(bf16x8*)(V_lds + (bf) * SHM_V + vst0) = S.st_v0; *(bf16x8*)(V_lds + (bf) * SHM_V + vst1) = S.st_v1; } while (0)
#define SWRITE_H(bf) do { SWRITE_HV(bf); SWRITE_HK(bf); } while (0)
#define SLOAD_F(p, k0) do { S.sf0 = *(const f32x4*)ROW(p, k0, sr, D); S.sf1 = *(const f32x4*)(ROW(p, k0, sr, D) + 4);                \
                            S.sf2 = *(const f32x4*)ROW(p, k0, 32 + sr, D); S.sf3 = *(const f32x4*)(ROW(p, k0, 32 + sr, D) + 4); } while (0)
#define SWRITE_KF(bf) do { *(bf16x8*)(K_lds + (bf) * SHM_K + kws) = pack8(S.sf0, S.sf1); *(bf16x8*)(K_lds + (bf) * SHM_K + kws + 32 * 256) = pack8(S.sf2, S.sf3); } while (0)
#define SWRITE_VF(bf) do { *(bf16x8*)(V_lds + (bf) * SHM_V + vst0) = pack8(S.sf0, S.sf1); *(bf16x8*)(V_lds + (bf) * SHM_V + vst1) = pack8(S.sf2, S.sf3); } while (0)
template <class TIn, class TOut>
__device__ __forceinline__ void causal_swa_prime(const BlockRef<TIn, TOut>& cur, int W, char* lds, Seam<TIn>& S, const int wid) {
    constexpr bool F32 = same_t<TIn, float>::v;
    const int lane = lane_id(), tid = wid * 64 + lane, r32 = lane & 31, hi = lane >> 5;
    const int sr = tid >> 4, sc = (tid & 15) * 8, kws = KSWZ(sr, sc * 2); char* K_lds = lds + 2 * SHM_V;
    const int kb0 = swa_jlo(cur.P0, W) * KVBLK;
    for (int d0 = 0; d0 < 8; ++d0) S.qr[d0] = load8<TIn>(cur.Q + (unsigned)((wid * QBLK + r32) * cur.pitch() + d0 * 16 + hi * 8));
    if constexpr (F32) { SLOAD_F((const float*)cur.K(), kb0); VMW(); SWRITE_KF(0); SBAR(); SLOAD_F((const float*)cur.V(), kb0); }
    else { SLOAD_H(cur.K(), cur.V(), kb0, cur.pitch()); VMW(); SWRITE_HK(0); }
    __syncthreads();
}
template <class TIn, class TOut>
__device__ __forceinline__ void causal_swa_block(const BlockRef<TIn, TOut>& cur, const BlockRef<TIn, TOut>& nxt, float* lse, int W, char* lds, Seam<TIn>& S, const int wid) {
    const int skv = cur.skv();
    constexpr bool F32 = same_t<TIn, float>::v;
    const int lane = lane_id(), tid = wid * 64 + lane, r32 = lane & 31, hi = lane >> 5;
    const int j_lo = swa_jlo(cur.P0, W);
    int j_hi = (cur.P0 + QB - 1) / KVBLK + 1; if (j_hi > skv / KVBLK) j_hi = skv / KVBLK;
    const int NT = j_hi - j_lo;
    const int kbn = swa_jlo(nxt.P0, W) * KVBLK;
    const int qlo = cur.P0 + wid * QBLK, qm = qlo + r32 - 4 * hi;
    char* V_lds = lds; char* K_lds = lds + 2 * SHM_V;
    float* ws = (float*)(lds + 2 * SHM_V + 2 * SHM_K) + wid * 64; float* li_l = ws, * al_l = ws + 32;
    float m_reg = -1e30f, l_reg = 0; f32x16 o[4] = {};
    const int sr = tid >> 4, sc = (tid & 15) * 8, vst0 = v_st(sr, sc), vst1 = v_st(32 + sr, sc), kws = KSWZ(sr, sc * 2);
    const int vb0 = (int)(uintptr_t)V_lds + v_rd_base(lane);
    const TIn* Kh = cur.K(); const TIn* Vh = Kh + V_FROM_K; const int kpc = cur.pitch();
#define RESC(a) do { if (__any((a) < 1.f)) { if (hi == 0) al_l[r32] = (a); asm volatile("s_waitcnt lgkmcnt(0)" ::: "memory");              \
                     for (int d_ = 0; d_ < 4; ++d_) for (int r = 0; r < 16; ++r) o[d_][r] *= al_l[crow(r, hi)]; } } while (0)
#define KBASE(t) ((j_lo + (t)) * KVBLK)
#define ACT(t) (KBASE(t) <= qlo + QBLK - 1 && KBASE(t) + KVBLK - 1 >= qlo - W + 1)
#define MASKT(P0_, P1_, t) do { const int kb_ = KBASE(t); if ((!SK || ACT(t)) && (kb_ + KVBLK - 1 > qlo || kb_ <= qlo + QBLK - 1 - W)) mask_tile(P0_, P1_, qm - kb_, (unsigned)W); } while (0)
    constexpr int NQL = F32 ? 16 : 8;
    constexpr bool SK = WSKIP && !F32;
#define SEAM_K0() do { VMWN(NQL); if constexpr (F32) { SWRITE_KF(0); SBAR(); SLOAD_F((const float*)nxt.V(), kbn); } else { SWRITE_HK(0); } SBAR(); } while (0)
    f32x16 pA0, pA1, pB0, pB1; float mnA, mnB, alA, alB; bf16x8 pa0, pa1, pa2, pa3;
    if constexpr (F32) { VMW(); SWRITE_VF(0); SBAR(); } else { SWRITE_HV(0); SBAR(); }
    if (NT > 1) { if constexpr (F32) SLOAD_F((const float*)Kh, KBASE(1)); else SLOAD_H(Kh, Vh, KBASE(1), kpc); }
    SBAR(); qkt<0, SK>(pA0, pA1, K_lds, r32, hi, S.qr, ACT(0));
    if constexpr (F32) { if (NT > 1) { VMW(); SWRITE_KF(1); SBAR(); SLOAD_F((const float*)Vh, KBASE(1)); } }
    MASKT(pA0, pA1, 0); partialSM(pA0, pA1, m_reg, mnA, alA);
    if (NT > 1) { VMW(); if constexpr (F32) { SWRITE_VF(1); SBAR(); if (NT > 2) SLOAD_F((const float*)Kh, KBASE(2)); } else SWRITE_H(1); }
    __syncthreads();
#define HALF_STEP(PX0, PX1, mnX, alX, PY0, PY1, alY, t, KB, VB, SB) do {                                                      \
        SBAR(); qkt<KB, SK>(PX0, PX1, K_lds, r32, hi, S.qr, ACT(t));                                             \
        finishSM(PY0, PY1, alY, l_reg, pa0, pa1, pa2, pa3); SBAR();                                                           \
        if ((t) + 1 < NT) { if constexpr (F32) { VMW(); SWRITE_KF(SB); SBAR(); SLOAD_F((const float*)Vh, KBASE((t) + 1)); }  \
                            else { SLOAD_H(Kh, Vh, KBASE((t) + 1), kpc); } SBAR(); }                                               \
        pv_tile<VB, SK>(o, vb0, pa0, pa1, pa2, pa3, ACT((t) - 1)); MASKT(PX0, PX1, (t)); partialSM(PX0, PX1, m_reg, mnX, alX);                                        \
        __syncthreads();                                                                                                      \
        if ((t) + 1 < NT) { VMW(); if constexpr (F32) { SWRITE_VF(SB); SBAR(); if ((t) + 2 < NT) SLOAD_F((const float*)Kh, KBASE((t) + 2)); } \
                            else { SWRITE_H(SB); } }                                                                          \
        RESC(alX); __syncthreads(); } while (0)
    for (int t = 1; t + 1 < NT; t += 2) {
        HALF_STEP(pB0, pB1, mnB, alB, pA0, pA1, alA, t, 1, 0, 0);
        HALF_STEP(pA0, pA1, mnA, alA, pB0, pB1, alB, t + 1, 0, 1, 1);
    }
    const bool even = (NT & 1) == 0;
    if (even) { SBAR(); qkt<1, SK>(pB0, pB1, K_lds, r32, hi, S.qr, ACT(NT - 1)); SBAR(); }
#define QROW(e) (nxt.Q + (size_t)(wid * QBLK + r32) * nxt.pitch() + ((e) >> 1) * 16 + hi * 8 + ((e) & 1) * 4)
    if constexpr (F32) { SLOAD_F((const float*)nxt.K(), kbn); SBAR();
#pragma unroll
        for (int e = 0; e < 8; ++e) S.tq[e] = *(const f32x4*)QROW(e); }
    else { SLOAD_H(nxt.K(), nxt.V(), kbn, nxt.pitch()); SBAR();
#pragma unroll
        for (int d0 = 0; d0 < 8; ++d0) S.qr[d0] = load8<TIn>(nxt.Q + (unsigned)((wid * QBLK + r32) * nxt.pitch() + d0 * 16 + hi * 8)); }
    SBAR();
    finishSM(pA0, pA1, alA, l_reg, pa0, pa1, pa2, pa3); SBAR();
    if constexpr (F32) {
#pragma unroll
        for (int e = 8; e < 16; ++e) S.tq[e] = *(const f32x4*)QROW(e); SBAR(); }
#undef QROW
    pv_tile<0, SK>(o, vb0, pa0, pa1, pa2, pa3, ACT(even ? NT - 2 : NT - 1));
    if (even) { MASKT(pB0, pB1, NT - 1); partialSM(pB0, pB1, m_reg, mnB, alB); __syncthreads(); RESC(alB);
        finishSM(pB0, pB1, alB, l_reg, pa0, pa1, pa2, pa3); SBAR(); pv_tile<1, SK>(o, vb0, pa0, pa1, pa2, pa3, ACT(NT - 1)); }
    SBAR(); SEAM_K0();
    if (hi == 0) li_l[r32] = __expf(m_reg * SCALE); asm volatile("s_waitcnt lgkmcnt(0)" ::: "memory");
    float rli[16];
#pragma unroll
    for (int r = 0; r < 16; ++r) rli[r] = li_l[crow(r, hi)];
    TOut* Ow = (TOut*)cur.Q;
    if (hi == 0) lse[(size_t)cur.lrow + (size_t)(wid * QBLK + r32) * cur.lp()] = m_reg * SCALE + __logf(l_reg);
#pragma unroll
    for (int r = 0; r < 16; ++r) { const int orow = crow(r, hi);
#pragma unroll
        for (int d0 = 0; d0 < 4; ++d0) { const float v = o[d0][r] * rli[r];
            if constexpr (same_t<TOut, float>::v) { Ow[(unsigned)((wid * QBLK + orow) * kpc + d0 * 32 + r32)] = v; }
            else { const float vn = __shfl_xor(v, 1);
                   if ((r32 & 1) == 0) *(unsigned*)(Ow + (unsigned)((wid * QBLK + orow) * kpc + d0 * 32 + r32)) = cvtpk(v, vn); } } }
    if constexpr (F32) {
#pragma unroll
        for (int d0 = 0; d0 < 8; ++d0) S.qr[d0] = pack8(S.tq[2 * d0], S.tq[2 * d0 + 1]); }
    __syncthreads();
#undef RESC
#undef KBASE
#undef ACT
#undef MASKT
#undef SEAM_K0
#undef HALF_STEP
}
#undef ROW
#undef VMW
#undef VMWN
#undef SLOAD_H
#undef SWRITE_HK
#undef SWRITE_HV
#undef SWRITE_H
#undef SLOAD_F
#undef SWRITE_KF
#undef SWRITE_VF


}

#define GAS __attribute__((address_space(1)))
#define LAS __attribute__((address_space(3)))
typedef unsigned short bf16;
typedef unsigned v4u __attribute__((ext_vector_type(4)));
typedef unsigned u32x2 __attribute__((ext_vector_type(2)));
typedef float f32x4 __attribute__((ext_vector_type(4)));
typedef short bf16x8 __attribute__((ext_vector_type(8)));
typedef GAS unsigned gu32;
typedef GAS unsigned long long gu64;
#define RLX_AGENT __ATOMIC_RELAXED, __HIP_MEMORY_SCOPE_AGENT
#define LDS_WAIT() asm volatile("s_waitcnt lgkmcnt(0)" ::: "memory")
#define VM_WAIT() asm volatile("s_waitcnt vmcnt(0)" ::: "memory")
__device__ __forceinline__ unsigned long long rt() { return __builtin_amdgcn_s_memrealtime(); }
__device__ __forceinline__ unsigned f2bf(float f) { unsigned u = __builtin_bit_cast(unsigned, f); return (u + 0x7fffu + ((u >> 16) & 1u)) >> 16; }
__device__ __forceinline__ unsigned pk2(float lo, float hi) { return f2bf(lo) | (f2bf(hi) << 16); }

#define XB_TMO      128
#define XB_XCNT(j)  (256  + 64 * (j))
#define XB_XSUB(j)  (1280 + 64 * (j))
#define XB_XGEN(j)  (2304 + 64 * (j))
#define XB_TOP      3328
#define XB_TOPGEN   3392
#define XCD_BAR_WORDS 3456
#define XB_SPIN_CAP (1u << 18)

__device__ __forceinline__ unsigned xb_ld(unsigned* p)              { return __hip_atomic_load(p, __ATOMIC_RELAXED, __HIP_MEMORY_SCOPE_AGENT); }
__device__ __forceinline__ unsigned xb_add(unsigned* p, unsigned v) { return __hip_atomic_fetch_add(p, v, __ATOMIC_RELAXED, __HIP_MEMORY_SCOPE_AGENT); }
__device__ __forceinline__ unsigned xb_xcc_id() { return (unsigned)__builtin_amdgcn_s_getreg((3 << 11) | 20) & 0xFu; }
#define XB_SPIN(cond, bar) do { unsigned _sp = 0; while (cond) { __builtin_amdgcn_s_sleep(1); \
    if ((++_sp & 255u) == 0u) { if (xb_ld(&(bar)[XB_TMO])) break; if (_sp > XB_SPIN_CAP) { atomicAdd(&(bar)[XB_TMO], 1u); break; } } } } while (0)

struct XcdBarrier {
    unsigned* bar; unsigned x; int w;
    volatile LAS unsigned* st;
};

__device__ __forceinline__ XcdBarrier xcd_barrier_post(unsigned* bar, volatile LAS unsigned* st, int wave) {
    XcdBarrier b; b.bar = bar; b.x = xb_xcc_id(); b.st = st; b.w = wave;
    if (wave == 0 && lane_id() == 0) (void)xb_add(&bar[XB_XCNT(b.x)], 1u);
    return b;
}
__device__ __forceinline__ void xcd_barrier_complete(unsigned* bar, unsigned x, unsigned& nloc, unsigned& nx) {
    const unsigned G = gridDim.x * gridDim.y * gridDim.z;
    unsigned sum, cnt, mine, sp = 0u;
    for (;;) {
        sum = 0u; cnt = 0u; mine = 0u;
#pragma unroll
        for (unsigned j = 0; j < 16; ++j) { const unsigned c = xb_ld(&bar[XB_XCNT(j)]); sum += c; cnt += (c > 0u) ? 1u : 0u; mine = (j == x) ? c : mine; }
        if (sum == G) break;
        __builtin_amdgcn_s_sleep(1);
        if ((++sp & 255u) == 0u) { if (xb_ld(&bar[XB_TMO])) break; if (sp > XB_SPIN_CAP) { atomicAdd(&bar[XB_TMO], 1u); break; } }
    }
    nloc = mine > 0u ? mine : 1u; nx = cnt > 0u ? cnt : 1u;
}

__device__ __forceinline__ void xcd_barrier(const XcdBarrier& b) {
    asm volatile("s_waitcnt vmcnt(0)" ::: "memory");
    __syncthreads();
    if (b.w == 0 && lane_id() == 0) {
        unsigned* bar = b.bar;
        __builtin_amdgcn_s_waitcnt(0);
        unsigned nloc = b.st[0], nx = b.st[1];
        if (nloc == 0u) { xcd_barrier_complete(bar, b.x, nloc, nx); b.st[0] = nloc; b.st[1] = nx; }
        const unsigned old = xb_add(&bar[XB_XSUB(b.x)], 1u);
        const unsigned gen = old / nloc;
        if (old + 1u == (gen + 1u) * nloc) {
            __builtin_amdgcn_fence(__ATOMIC_RELEASE, "agent");
            asm volatile("s_waitcnt vmcnt(0)" ::: "memory");
            const unsigned og = xb_add(&bar[XB_TOP], 1u);
            const unsigned tg = og / nx;
            if (og + 1u == (tg + 1u) * nx) xb_add(&bar[XB_TOPGEN], 1u);
            else XB_SPIN(xb_ld(&bar[XB_TOPGEN]) == tg, bar);
            __builtin_amdgcn_fence(__ATOMIC_ACQUIRE, "agent");
            xb_add(&bar[XB_XGEN(b.x)], 1u);
            asm volatile("s_waitcnt vmcnt(0)" ::: "memory");
        } else {
            XB_SPIN(xb_ld(&bar[XB_XGEN(b.x)]) == gen, bar);
            __builtin_amdgcn_fence(__ATOMIC_ACQUIRE, "agent");
            asm volatile("s_waitcnt vmcnt(0)" ::: "memory");
        }
    }
    __syncthreads();
}

typedef __attribute__((address_space(4))) const unsigned char KARG;
struct Frame {
    LAS unsigned char* lds;
    volatile LAS unsigned* MISC;
    int tid, lane, wave;
    int vcu, G;
    unsigned char* ws; KARG* kp;
    __device__ __forceinline__ const float* in(int i) const { return *(const float* const __attribute__((address_space(4)))*)(kp + 8 * i); }
    __device__ __forceinline__ const float* x() const { return in(0); }
    __device__ __forceinline__ const float* norm_mix() const { return in(1); }
    __device__ __forceinline__ const float* norm_ffn() const { return in(2); }
    __device__ __forceinline__ const float* hgrn_w_in() const { return in(3); }
    __device__ __forceinline__ const float* lb_logits() const { return in(4); }
    __device__ __forceinline__ const float* hgrn_out_norm() const { return in(5); }
    __device__ __forceinline__ const float* hgrn_w_out() const { return in(6); }
    __device__ __forceinline__ const float* attn_w_qkv() const { return in(7); }
    __device__ __forceinline__ const float* attn_w_out() const { return in(8); }
    __device__ __forceinline__ const float* ffn_w_in() const { return in(9); }
    __device__ __forceinline__ const float* ffn_w_down() const { return in(10); }
    __device__ __forceinline__ const float* final_norm() const { return in(11); }
    __device__ __forceinline__ float* out() const { return *(float* const __attribute__((address_space(4)))*)(kp + 96); }
    __device__ __forceinline__ gu32* ctl() const { return (gu32*)(ws + WS_CTL); }
#define FRAME_WS(NAME, TYPE, OFF) __device__ __forceinline__ TYPE* NAME() const { return (TYPE*)(ws + (OFF)); }
    FRAME_WS(Whin, bf16, WS_WHIN) FRAME_WS(Whout, bf16, WS_WHOUT) FRAME_WS(Wqkv, bf16, WS_WQKV) FRAME_WS(Wao, bf16, WS_WAO) FRAME_WS(Wf1, bf16, WS_WF1) FRAME_WS(Wf2, bf16, WS_WF2)
    FRAME_WS(SS, float, WS_SS) FRAME_WS(E1, float, WS_E1) FRAME_WS(E2, float, WS_E2) FRAME_WS(COS, float, WS_COS) FRAME_WS(SIN, float, WS_SIN) FRAME_WS(LSE, float, WS_LSE) FRAME_WS(LB, float, WS_LB)
    FRAME_WS(DJ, float, WS_LB + 4096) FRAME_WS(ST, float, WS_ST)
    FRAME_WS(XB, bf16, WS_XB) FRAME_WS(QT, bf16, WS_QT) FRAME_WS(KT, bf16, WS_KT) FRAME_WS(VV, bf16, WS_VV) FRAME_WS(GG, bf16, WS_GG) FRAME_WS(FF, bf16, WS_FF) FRAME_WS(QP, bf16, WS_QP) FRAME_WS(KP, bf16, WS_KP) FRAME_WS(VP, bf16, WS_VP)
#undef FRAME_WS
};
__device__ __forceinline__ float wave_sum(float v) {
#pragma unroll
    for (int o = 1; o < 64; o <<= 1) v += __shfl_xor(v, o);
    return v;
}
__device__ __forceinline__ float bf_lo(unsigned u) { return __uint_as_float(u << 16); }
__device__ __forceinline__ float bf_hi(unsigned u) { return __uint_as_float(u & 0xffff0000u); }

__device__ __forceinline__ int pinv32(int l) { return 16 * ((l >> 2) & 1) + 4 * (l >> 3) + (l & 3); }
template <int MODE> __device__ __forceinline__ int phys_row(int c) {
    if (MODE == 0) return (c & ~31) + pinv32(c & 31);
    if (MODE == 1) { const int up = c >= DFF ? 1 : 0, j = c - up * DFF; return 256 * (j >> 7) + 128 * up + (j & 96) + pinv32(j & 31); }
    if (MODE == 2) {
        if (c >= 2 * AW) { const int c0 = c - 2 * AW, hl = c0 >> 7, cc = ((hl & 3) * 3 + (hl >> 2)) * 128 + (c0 & 127); return 256 * (12 + (cc >> 8)) + (cc & 224) + pinv32(cc & 31); }
        const int plane = c >= AW ? 1 : 0, cc = c - plane * AW, hl = cc >> 7, head = (hl & 3) * 3 + (hl >> 2), d = cc & 127, half = d >> 6, j = d & 63;
        return 256 * (plane * 6 + (head >> 1)) + 128 * half + 32 * (2 * (head & 1) + (j >> 5)) + pinv32(j & 31);
    }
    { const int type = c >> 10, ch = c & 1023, chl = ch & 63; return 256 * (ch >> 6) + 128 * (type >> 1) + 32 * (chl >> 4) + 16 * (type & 1) + (chl & 15); }
}
template <int MODE, bool KPOS = false>
__device__ __forceinline__ void p0_transpose_item(const float* W, int K, int N, bf16* WT, const float* gain, LAS float* scr, int item, int lane) {
    const int nblk = N / 32, kb = item / nblk, nb = item % nblk, k0 = 64 * kb, n0 = 32 * nb;
    int ks = k0; if (KPOS) { const int pos = k0 >> 7; ks = ((pos % 3) * 4 + pos / 3) * 128 + (k0 & 127); }
    float wv[32];
    const float* wp = W + (size_t)(ks + (lane >> 5)) * N + n0 + (lane & 31);
#pragma unroll
    for (int i = 0; i < 32; ++i) wv[i] = wp[(size_t)(2 * i) * N];
#pragma unroll
    for (int i = 0; i < 32; ++i) { const int kk = 2 * i + (lane >> 5); float w = wv[i]; if (gain) w *= gain[ks + kk]; scr[kk * 33 + (lane & 31)] = w; }
    LDS_WAIT(); asm volatile("" ::: "memory");
    const int c = lane & 7;
#pragma unroll
    for (int j = 0; j < 4; ++j) { const int n = (lane >> 3) + 8 * j; const LAS float* s = scr + (8 * c) * 33 + n;
        v4u o; o.x = pk2(s[0 * 33], s[1 * 33]); o.y = pk2(s[2 * 33], s[3 * 33]); o.z = pk2(s[4 * 33], s[5 * 33]); o.w = pk2(s[6 * 33], s[7 * 33]);
        *(GAS v4u*)(WT + (size_t)phys_row<MODE>(n0 + n) * K + k0 + 8 * c) = o; }
    LDS_WAIT(); asm volatile("" ::: "memory");
}
__device__ __forceinline__ void p0_prologue(Frame& F) {
    LAS float* scr = (LAS float*)(F.lds + RING_OFF + F.wave * 16384);
    const int gw = F.vcu * NWAVES + F.wave, NGW = F.G * NWAVES;
    constexpr int I_HIN = (D / 64) * (HIN / 32), I_HOUT = (D / 64) * (D / 32), I_QKV = (D / 64) * (QKVW / 32), I_AO = (AW / 64) * (D / 32), I_F1 = (D / 64) * (FF2 / 32), I_F2 = (DFF / 64) * (D / 32);
    constexpr int NITEMS = I_HIN + I_HOUT + I_QKV + I_AO + I_F1 + I_F2;
    for (int it = gw; it < NITEMS; it += NGW) {
        int r = it;
        if (r < I_HIN) { p0_transpose_item<3>(F.hgrn_w_in(), D, HIN, F.Whin(), F.norm_mix(), scr, r, F.lane); continue; } r -= I_HIN;
        if (r < I_HOUT) { p0_transpose_item<0>(F.hgrn_w_out(), D, D, F.Whout(), nullptr, scr, r, F.lane); continue; } r -= I_HOUT;
        if (r < I_QKV) { p0_transpose_item<2>(F.attn_w_qkv(), D, QKVW, F.Wqkv(), F.norm_mix() + D, scr, r, F.lane); continue; } r -= I_QKV;
        if (r < I_AO) { p0_transpose_item<0, true>(F.attn_w_out(), AW, D, F.Wao(), nullptr, scr, r, F.lane); continue; } r -= I_AO;
        if (r < I_F1) { p0_transpose_item<1>(F.ffn_w_in(), D, FF2, F.Wf1(), F.norm_ffn(), scr, r, F.lane); continue; } r -= I_F1;
        p0_transpose_item<0>(F.ffn_w_down(), DFF, D, F.Wf2(), nullptr, scr, r, F.lane);
    }
    for (int m = gw; m < M; m += NGW) {
        const GAS f32x4* xr = (const GAS f32x4*)(F.x() + (size_t)m * D) + F.lane;
        GAS unsigned long long* o8 = (GAS unsigned long long*)(F.XB() + (size_t)m * D) + F.lane;
        float s = 0.f;
#pragma unroll
        for (int j = 0; j < 4; ++j) { const f32x4 v = xr[64 * j]; s += (v.x * v.x + v.y * v.y) + (v.z * v.z + v.w * v.w); o8[64 * j] = (unsigned long long)pk2(v.x, v.y) | ((unsigned long long)pk2(v.z, v.w) << 32); }
        s = wave_sum(s);
        if (F.lane < 16) F.SS()[(size_t)m * 16 + F.lane] = F.lane == 0 ? s : 0.f;
    }
    const int gt = F.vcu * NWAVES * 64 + F.tid, NGT = F.G * NWAVES * 64;
    for (int i = gt; i < T * 64; i += NGT) { const int pos = i >> 6, j = i & 63;
        const float inv = 1.0f / exp2f((float)j * (13.287712379549449f / 64.0f)); const float ang = (float)pos * inv;
        const double rev = (double)ang * 0.15915494309189535; const float fr = (float)(rev - floor(rev));
        F.COS()[i] = __builtin_amdgcn_cosf(fr); F.SIN()[i] = __builtin_amdgcn_sinf(fr); }
    if (gt < D) { const float a = F.lb_logits()[gt], b = F.lb_logits()[D + gt], c = F.lb_logits()[2 * D + gt]; const float mx = fmaxf(a, fmaxf(b, c));
        const float ea = expf(a - mx), eb = expf(b - mx), ec = expf(c - mx); F.LB()[gt] = ea / (ea + eb + ec); }
}

__device__ __forceinline__ void p0_late_weights(Frame& F, int iw, int nidle) {
    LAS float* scr = (LAS float*)(F.lds + RING_OFF + F.wave * 16384);
    constexpr int I_F1 = (D / 64) * (FF2 / 32), I_F2 = (DFF / 64) * (D / 32);
    for (int it = iw * NWAVES + F.wave; it < I_F1 + I_F2; it += nidle * NWAVES) {
        if (it < I_F1) p0_transpose_item<1>(F.ffn_w_in() + (size_t)D * FF2, D, FF2, F.Wf1() + (size_t)FF2 * D, F.norm_ffn() + D, scr, it, F.lane);
        else p0_transpose_item<0>(F.ffn_w_down() + (size_t)DFF * D, DFF, D, F.Wf2() + (size_t)D * DFF, nullptr, scr, it - I_F1, F.lane);
    }
}
namespace hg {
typedef short bf16x8 __attribute__((ext_vector_type(8)));
typedef short s16x4 __attribute__((ext_vector_type(4)));
constexpr int TILE = 16384, BUF = 3 * TILE;
constexpr int OFF_F = 2 * BUF, OFF_PART = OFF_F + 1024;
constexpr int HG_LDS_BYTES = OFF_PART + 4096;
constexpr int SUPER = 8, NSUPER = T / (64 * SUPER), NITEM = BATCH * 8 * NSUPER;
__device__ __forceinline__ int swz(int row) { return ((row & 7) << 5) | (((row >> 3) & 1) << 4); }
__device__ __forceinline__ bf16x8 mk8(u32x2 a, u32x2 b) { v4u w = {a.x, a.y, b.x, b.y}; return __builtin_bit_cast(bf16x8, w); }
__device__ __forceinline__ bf16x8 mk8s(s16x4 a, s16x4 b) { return (bf16x8){a[0], a[1], a[2], a[3], b[0], b[1], b[2], b[3]}; }
__device__ __forceinline__ u32x2 pk4(const f32x4 a) { u32x2 w; w.x = pg8::cvt_pk_bf16(a[0], a[1]); w.y = pg8::cvt_pk_bf16(a[2], a[3]); return w; }
#define HG_TRRD(dst, addr, off) asm volatile("ds_read_b64_tr_b16 %0, %1 offset:%2" : "=&v"(dst) : "v"(addr), "i"(off) : "memory")
#define HG_LGKM0() do { asm volatile("s_waitcnt lgkmcnt(0)" ::: "memory"); __builtin_amdgcn_sched_barrier(0); } while (0)
#define HG_MFMA(a, b, c) __builtin_amdgcn_mfma_f32_16x16x32_bf16((a), (b), (c), 0, 0, 0)

template <bool PC>
__device__ __forceinline__ void item(Frame& F, int it, float* DJ) {
    const int tid = F.tid, lane = F.lane, w = F.wave, li = lane & 15, g = lane >> 4;
    const int bh = it / NSUPER, j = it - bh * NSUPER, b = bh >> 3, h = bh & 7;
    const size_t row0 = (size_t)b * T + (size_t)j * (64 * SUPER);
    const int chunk0 = (int)(row0 >> 6), hc = h * 128;
    LAS unsigned char* L = F.lds + RING_OFF;
    const int srow = tid >> 4, sc16 = tid & 15;
    const unsigned st_off = (unsigned)(srow * 256 + ((sc16 * 16) ^ swz(srow)));
    const size_t g_off = (size_t)srow * 1024 + hc + sc16 * 8;
    const int sr = swz(li);
    const unsigned rbase = (unsigned)(li * 256 + ((8 * g) ^ (sr & 16))), sEr = (unsigned)(sr & 0xE0);
    const int trow = 4 * g + (li >> 2), stt = swz(trow);
    const unsigned tbase = (unsigned)(trow * 256 + ((8 * (li & 3)) ^ (stt & 16))), sEt = (unsigned)(stt & 0xE0);
    const unsigned ldsb = (unsigned)(size_t)L;

    f32x4 S[8]; bf16x8 Sb[4];
    float dprod = 1.f;
    if (PC && j > 0) {
        const float* st = F.ST() + ((size_t)it << 14) + (size_t)(w * 32) * 64 + lane;
#pragma unroll
        for (int kt = 0; kt < 8; ++kt) {
            const f32x4 e1 = *(const f32x4*)(F.E1() + (size_t)chunk0 * 1024 + hc + 16 * kt + 4 * g);
#pragma unroll
            for (int r = 0; r < 4; ++r) S[kt][r] = st[(kt * 4 + r) * 64] * e1[r];
        }
    } else {
#pragma unroll
        for (int kt = 0; kt < 8; ++kt) S[kt] = (f32x4){0.f, 0.f, 0.f, 0.f};
        if (!PC && tid < 128) dprod = F.E1()[(size_t)chunk0 * 1024 + hc + tid];
    }
#pragma unroll
    for (int kp = 0; kp < 4; ++kp) Sb[kp] = mk8(pk4(S[2 * kp]), pk4(S[2 * kp + 1]));
    float gn[4];
#pragma unroll
    for (int r = 0; r < 4; ++r) gn[r] = PC ? F.hgrn_out_norm()[16 * w + 4 * g + r] : 0.f;

    v4u sq0, sq1, sk0, sk1, sv0, sv1; float fe = 1.f, fe1 = 1.f;
#define HG_LOAD(cc) do { const size_t ro_ = (row0 + (size_t)(cc) * 64) * 1024 + g_off; \
        if (PC) { sq0 = *(const GAS v4u*)(F.QT() + ro_); sq1 = *(const GAS v4u*)(F.QT() + ro_ + 32 * 1024); } \
        sk0 = *(const GAS v4u*)(F.KT() + ro_); sk1 = *(const GAS v4u*)(F.KT() + ro_ + 32 * 1024); sv0 = *(const GAS v4u*)(F.VV() + ro_); sv1 = *(const GAS v4u*)(F.VV() + ro_ + 32 * 1024); \
        if (tid < 128) { fe = F.E2()[(size_t)(chunk0 + (cc)) * 1024 + hc + tid]; fe1 = (cc) < SUPER - 1 ? F.E1()[(size_t)(chunk0 + (cc) + 1) * 1024 + hc + tid] : 1.f; } } while (0)
#define HG_WRITE(bi) do { LAS unsigned char* B_ = L + (bi) * BUF + st_off; \
        if (PC) { *(LAS v4u*)B_ = sq0; *(LAS v4u*)(B_ + 8192) = sq1; } \
        *(LAS v4u*)(B_ + TILE) = sk0; *(LAS v4u*)(B_ + TILE + 8192) = sk1; *(LAS v4u*)(B_ + 2 * TILE) = sv0; *(LAS v4u*)(B_ + 2 * TILE + 8192) = sv1; \
        if (tid < 128) { const float f_ = fe * fe1; dprod *= f_; ((LAS float*)(L + OFF_F + (bi) * 512))[tid] = f_; } } while (0)

    HG_LOAD(0); HG_WRITE(0);
    __syncthreads();
    for (int c = 0; c < SUPER; ++c) {
        const int bi = c & 1;
        u32x2 gg[4];
        if (c + 1 < SUPER) HG_LOAD(c + 1);
        if (PC) {
#pragma unroll
            for (int ti = 0; ti < 4; ++ti) gg[ti] = *(const GAS u32x2*)(F.GG() + (row0 + (size_t)c * 64 + 16 * ti + li) * 1024 + hc + 16 * w + 4 * g);
        }
        const unsigned qb_ = ldsb + bi * BUF, kb_ = qb_ + TILE, vb_ = qb_ + 2 * TILE;
        LAS unsigned char* Qp = L + bi * BUF; LAS unsigned char* Kp = Qp + TILE;
        bf16x8 vf[2];
        { s16x4 a0, a1, a2, a3; const unsigned va = vb_ + tbase + ((32u * w) ^ sEt);
          HG_TRRD(a0, va, 0); HG_TRRD(a1, va, 4096); HG_TRRD(a2, va, 8192); HG_TRRD(a3, va, 12288); HG_LGKM0();
          vf[0] = mk8s(a0, a1); vf[1] = mk8s(a2, a3); }
        f32x4 O[4];
        if (PC) {
#pragma unroll
            for (int ti = 0; ti < 4; ++ti) {
                bf16x8 qf[4];
#pragma unroll
                for (int kp = 0; kp < 4; ++kp) { const LAS unsigned char* a = Qp + 4096 * ti + rbase;
                    qf[kp] = mk8(*(const LAS u32x2*)(a + ((64u * kp) ^ sEr)), *(const LAS u32x2*)(a + ((64u * kp + 32u) ^ sEr))); }
                f32x4 o = {0.f, 0.f, 0.f, 0.f};
#pragma unroll
                for (int kp = 0; kp < 4; ++kp) o = HG_MFMA(Sb[kp], qf[kp], o);
                __builtin_amdgcn_sched_barrier(0);
                f32x4 p[4];
#pragma unroll
                for (int si = 0; si < 4; ++si) { p[si] = (f32x4){0.f, 0.f, 0.f, 0.f};
                    if (si <= ti) {
#pragma unroll
                        for (int kp = 0; kp < 4; ++kp) { const LAS unsigned char* a = Kp + 4096 * si + rbase;
                            const bf16x8 kf = mk8(*(const LAS u32x2*)(a + ((64u * kp) ^ sEr)), *(const LAS u32x2*)(a + ((64u * kp + 32u) ^ sEr)));
                            p[si] = HG_MFMA(kf, qf[kp], p[si]); }
                    } }
#pragma unroll
                for (int r = 0; r < 4; ++r) if (4 * g + r > li) p[ti][r] = 0.f;
                o = HG_MFMA(vf[0], mk8(pk4(p[0]), pk4(p[1])), o);
                if (ti >= 2) o = HG_MFMA(vf[1], mk8(pk4(p[2]), pk4(p[3])), o);
                O[ti] = o;
                __builtin_amdgcn_sched_barrier(0);
            }
        }
#pragma unroll
        for (int kt = 0; kt < 8; ++kt) {
            s16x4 a0, a1, a2, a3; const unsigned ka = kb_ + tbase + ((32u * kt) ^ sEt);
            HG_TRRD(a0, ka, 0); HG_TRRD(a1, ka, 4096); HG_TRRD(a2, ka, 8192); HG_TRRD(a3, ka, 12288); HG_LGKM0();
            S[kt] = HG_MFMA(mk8s(a0, a1), vf[0], S[kt]); S[kt] = HG_MFMA(mk8s(a2, a3), vf[1], S[kt]);
        }
#pragma unroll
        for (int kt = 0; kt < 8; ++kt) S[kt] = S[kt] * *(const LAS f32x4*)(L + OFF_F + bi * 512 + (16 * kt + 4 * g) * 4);
#pragma unroll
        for (int kp = 0; kp < 4; ++kp) Sb[kp] = mk8(pk4(S[2 * kp]), pk4(S[2 * kp + 1]));
        LAS float* part = (LAS float*)(L + OFF_PART + bi * 2048);
        if (PC) {
#pragma unroll
            for (int ti = 0; ti < 4; ++ti) { float q = (O[ti][0] * O[ti][0] + O[ti][1] * O[ti][1]) + (O[ti][2] * O[ti][2] + O[ti][3] * O[ti][3]);
                q += __shfl_xor(q, 16); q += __shfl_xor(q, 32);
                if (g == 0) part[(16 * ti + li) * 8 + w] = q; }
        }
        if (c + 1 < SUPER) HG_WRITE(bi ^ 1);
        __syncthreads();
        if (PC) {
#pragma unroll
            for (int ti = 0; ti < 4; ++ti) {
                const f32x4 p0 = *(const LAS f32x4*)(part + (16 * ti + li) * 8), p1 = *(const LAS f32x4*)(part + (16 * ti + li) * 8 + 4);
                const float tot = ((p0[0] + p0[1]) + (p0[2] + p0[3])) + ((p1[0] + p1[1]) + (p1[2] + p1[3]));
                const float r = 1.0f / sqrtf(tot * (1.0f / 128.0f) + NORM_EPS);
                f32x4 o = O[ti] * r;
                o[0] *= gn[0] * bf_lo(gg[ti].x); o[1] *= gn[1] * bf_hi(gg[ti].x); o[2] *= gn[2] * bf_lo(gg[ti].y); o[3] *= gn[3] * bf_hi(gg[ti].y);
                *(GAS u32x2*)(F.QT() + (row0 + (size_t)c * 64 + 16 * ti + li) * 1024 + hc + 16 * w + 4 * g) = pk4(o);
            }
        }
    }
    if (!PC) {
        float* st = F.ST() + ((size_t)(it + 1) << 14) + (size_t)(w * 32) * 64 + lane;
#pragma unroll
        for (int kt = 0; kt < 8; ++kt)
#pragma unroll
            for (int r = 0; r < 4; ++r) st[(kt * 4 + r) * 64] = S[kt][r];
        if (tid < 128) DJ[it * 128 + tid] = dprod;
    }
    __syncthreads();
#undef HG_LOAD
#undef HG_WRITE
}
__device__ __forceinline__ void phase_a(Frame& F, float* DJ) {
    for (int it = F.vcu; it < NITEM; it += F.G) { if ((it % NSUPER) == NSUPER - 1) continue; item<false>(F, it, DJ); }
}
__device__ __forceinline__ void phase_b(Frame& F, const float* DJ) {
    const int gt = F.vcu * NWAVES * 64 + F.tid, NGT = F.G * NWAVES * 64;
    for (int e = gt; e < BATCH * 8 * 16384; e += NGT) {
        const int bh = e >> 14, idx = e & 16383, kr = (idx >> 6) & 31, k = 16 * (kr >> 2) + 4 * ((idx & 63) >> 4) + (kr & 3);
        float s = 0.f, lv[NSUPER - 1], dv[NSUPER - 1];
        float* st = F.ST() + ((size_t)(bh * NSUPER + 1) << 14) + idx;
#pragma unroll
        for (int j = 0; j + 1 < NSUPER; ++j) { lv[j] = st[(size_t)j << 14]; dv[j] = DJ[(bh * NSUPER + j) * 128 + k]; }
#pragma unroll
        for (int j = 0; j + 1 < NSUPER; ++j) { s = dv[j] * s + lv[j]; st[(size_t)j << 14] = s; }
    }
}
__device__ __forceinline__ void phase_c(Frame& F) {
    for (int it = F.vcu; it < NITEM; it += F.G) item<true>(F, it, nullptr);
}
#undef HG_TRRD
#undef HG_LGKM0
#undef HG_MFMA
}

__device__ __forceinline__ void hgrn_simple_rec(Frame& F, float* oraw) {
    const int item = F.wave * F.G + F.vcu;
    if (item >= 256) return;
    const int b = item >> 7, h = (item >> 4) & 7, vg = item & 15, kc = h * 128 + 2 * F.lane, vc = h * 128 + vg * 8;
    float S0[8], S1[8];
#pragma unroll
    for (int j = 0; j < 8; ++j) { S0[j] = 0.f; S1[j] = 0.f; }
    for (int c = 0; c < 128; ++c) {
        const int chunk = b * 128 + c;
        const float e1x = F.E1()[(size_t)chunk * 1024 + kc], e1y = F.E1()[(size_t)chunk * 1024 + kc + 1], e2x = F.E2()[(size_t)chunk * 1024 + kc], e2y = F.E2()[(size_t)chunk * 1024 + kc + 1];
#pragma unroll
        for (int j = 0; j < 8; ++j) { S0[j] *= e1x; S1[j] *= e1y; }
#pragma unroll 2
        for (int t = 0; t < 64; ++t) {
            const size_t row = (size_t)chunk * 64 + t;
            const unsigned kq = *(const GAS unsigned*)(F.KT() + row * 1024 + kc), qq = *(const GAS unsigned*)(F.QT() + row * 1024 + kc);
            const v4u vv = *(const GAS v4u*)(F.VV() + row * 1024 + vc);
            const float k0 = bf_lo(kq), k1 = bf_hi(kq), q0 = bf_lo(qq), q1 = bf_hi(qq);
            const float v[8] = {bf_lo(vv.x), bf_hi(vv.x), bf_lo(vv.y), bf_hi(vv.y), bf_lo(vv.z), bf_hi(vv.z), bf_lo(vv.w), bf_hi(vv.w)};
            float part[8];
#pragma unroll
            for (int j = 0; j < 8; ++j) { S0[j] = fmaf(k0, v[j], S0[j]); S1[j] = fmaf(k1, v[j], S1[j]); part[j] = q0 * S0[j] + q1 * S1[j]; }
#pragma unroll
            for (int j = 0; j < 8; ++j) part[j] = wave_sum(part[j]);
            if (F.lane == 0) { float* o = oraw + row * 1024 + vc; *(f32x4*)o = (f32x4){part[0], part[1], part[2], part[3]}; *(f32x4*)(o + 4) = (f32x4){part[4], part[5], part[6], part[7]}; }
        }
#pragma unroll
        for (int j = 0; j < 8; ++j) { S0[j] *= e2x; S1[j] *= e2y; }
    }
}
__device__ __forceinline__ void hgrn_simple_post(Frame& F, const float* oraw) {
    const int gw = F.vcu * NWAVES + F.wave, NGW = F.G * NWAVES;
    const float gn0 = F.hgrn_out_norm()[2 * F.lane], gn1 = F.hgrn_out_norm()[2 * F.lane + 1];
    for (int it = gw; it < M * 8; it += NGW) {
        const size_t off = (size_t)(it >> 3) * 1024 + (it & 7) * 128 + 2 * F.lane;
        const float v0 = oraw[off], v1 = oraw[off + 1];
        const float r = 1.0f / sqrtf(wave_sum(v0 * v0 + v1 * v1) * (1.0f / 128.0f) + NORM_EPS);
        const unsigned g = *(const GAS unsigned*)(F.GG() + off);
        *(GAS unsigned*)(F.QT() + off) = pk2(v0 * r * gn0 * bf_lo(g), v1 * r * gn1 * bf_hi(g));
    }
}
__device__ __forceinline__ void attn_simple(Frame& F) {
    const int gw = F.vcu * NWAVES + F.wave, NGW = F.G * NWAVES;
    for (int it = gw; it < M * 12; it += NGW) {
        const int row = it / 12, hd = it - row * 12, t = row & (T - 1), g = hd >> 2, dil = g == 0 ? 1 : (g == 1 ? 4 : 16);
        const size_t co = (size_t)hd * 128 + 2 * F.lane;
        const unsigned qq = *(const GAS unsigned*)(F.QP() + (size_t)row * AW + co);
        const float q0 = bf_lo(qq), q1 = bf_hi(qq);
        float m = -INFINITY, l = 0.f, o0 = 0.f, o1 = 0.f;
        for (int j = 0; j <= 128; ++j) {
            if (t - j * dil < 0) break;
            const size_t rk = (size_t)(row - j * dil) * AW + co;
            const unsigned kk = *(const GAS unsigned*)(F.KP() + rk), vv = *(const GAS unsigned*)(F.VP() + rk);
            const float s = wave_sum(q0 * bf_lo(kk) + q1 * bf_hi(kk)) * 0.08838834764831845f;
            const float mn = fmaxf(m, s), a = __expf(m - mn), p = __expf(s - mn);
            l = l * a + p; o0 = o0 * a + p * bf_lo(vv); o1 = o1 * a + p * bf_hi(vv); m = mn;
        }
        *(GAS unsigned*)(F.QP() + (size_t)row * AW + co) = pk2(o0 / l, o1 / l);
        if (F.lane == 0) F.LSE()[(size_t)row * 12 + hd] = m + logf(l);
    }
}
typedef swa::BlockRef<bf16, bf16> AttRef;
__device__ __forceinline__ AttRef attn_ref(const Frame& F, int L) {
    const int bh = L >> 5, x = L & 31, b = bh / 12, head = bh - b * 12, sh = 2 * (head % 3), nqs = 5 - sh;
    const int r = x >> nqs, qb = x & ((1 << nqs) - 1);
    const size_t rowq = (size_t)b * T + r + ((size_t)qb * 256 << sh);
    AttRef R; R.Q = F.QP() + rowq * AW + head * 128; R.P0 = qb * 256; R.sh = sh; R.lrow = (int)rowq * 12 + head;
    return R;
}
__device__ __forceinline__ void attn_fast(Frame& F, char* lds) {
    constexpr int NITEM = BATCH * 12 * 32, W = 129;
    int L = F.vcu; if (L >= NITEM) return;
    AttRef cur = attn_ref(F, L);
    swa::Seam<bf16> S;
    swa::causal_swa_prime<bf16, bf16>(cur, W, lds, S, F.wave);
    for (;;) {
        const bool more = L + F.G < NITEM;
        const AttRef nxt = more ? attn_ref(F, L + F.G) : cur;
        swa::causal_swa_block<bf16, bf16>(cur, nxt, F.LSE(), W, lds, S, F.wave);
        if (!more) break;
        cur = nxt; L += F.G;
    }
}
__device__ __forceinline__ void attn_scale(Frame& F) {
    const int gt = F.vcu * NWAVES * 64 + F.tid, NGT = F.G * NWAVES * 64;
    for (int i = gt; i < M * (AW / 8); i += NGT) {
        const int row = i / (AW / 8), c8 = i - row * (AW / 8), hd = c8 >> 4, hg = hd & 3;
        const float* ls = F.LSE() + (size_t)row * 12;
        const float a = ls[hg], b = ls[4 + hg], c = ls[8 + hg], mx = fmaxf(a, fmaxf(b, c));
        const float al = __expf(ls[hd] - mx) / (__expf(a - mx) + __expf(b - mx) + __expf(c - mx));
        GAS v4u* p = (GAS v4u*)(F.QP() + (size_t)row * AW + c8 * 8);
        v4u v = *p;
        v.x = pk2(bf_lo(v.x) * al, bf_hi(v.x) * al); v.y = pk2(bf_lo(v.y) * al, bf_hi(v.y) * al); v.z = pk2(bf_lo(v.z) * al, bf_hi(v.z) * al); v.w = pk2(bf_lo(v.w) * al, bf_hi(v.w) * al);
        *p = v;
    }
}
__device__ __forceinline__ void final_norm_rows(Frame& F) {
    const int gw = F.vcu * NWAVES + F.wave, NGW = F.G * NWAVES;
    for (int m = gw; m < M; m += NGW) {
        const float s = wave_sum(F.lane < 16 ? F.SS()[(size_t)m * 16 + F.lane] : 0.f);
        const float r = 1.0f / sqrtf(s * (1.0f / D) + NORM_EPS);
        const GAS v4u* xr = (const GAS v4u*)(F.XB() + (size_t)m * D) + F.lane;
        GAS f32x4* o = (GAS f32x4*)(F.out() + (size_t)m * D) + 2 * F.lane;
        const GAS f32x4* gr = (const GAS f32x4*)F.final_norm() + 2 * F.lane;
#pragma unroll
        for (int j = 0; j < 2; ++j) { const v4u v = xr[64 * j]; const f32x4 g0 = gr[128 * j], g1 = gr[128 * j + 1];
            o[128 * j] = (f32x4){bf_lo(v.x) * r * g0.x, bf_hi(v.x) * r * g0.y, bf_lo(v.y) * r * g0.z, bf_hi(v.y) * r * g0.w};
            o[128 * j + 1] = (f32x4){bf_lo(v.z) * r * g1.x, bf_hi(v.z) * r * g1.y, bf_lo(v.w) * r * g1.z, bf_hi(v.w) * r * g1.w}; }
    }
}

__device__ __forceinline__ bool fresh(Frame& F) {
    int l = lane_id(); asm volatile("" : "+v"(l)); F.lane = l; F.tid = F.wave * 64 + l;
    unsigned long long kq = (unsigned long long)__builtin_amdgcn_kernarg_segment_ptr(); asm volatile("" : "+s"(kq)); F.kp = (KARG*)kq;
    unsigned long long wq = (unsigned long long)*(unsigned char* const __attribute__((address_space(4)))*)(F.kp + 104); asm volatile("" : "+s"(wq)); F.ws = (unsigned char*)wq;
    return true; }
struct Args { const float* in[12]; float* out; unsigned char* ws; int ph_lo, ph_hi; };
__global__ void __launch_bounds__(NWAVES * 64, 2) trunk_fwd(Args args) {
    extern __shared__ __attribute__((aligned(16))) unsigned char lds[];
    Frame F;
    F.lds = (LAS unsigned char*)lds;
    F.MISC = (volatile LAS unsigned*)(F.lds + MISC_OFF);
    F.wave = __builtin_amdgcn_readfirstlane((int)threadIdx.x >> 6);
    F.G = gridDim.x; { const int bx = blockIdx.x; F.vcu = (F.G % 8 == 0) ? (bx % 8) * (F.G / 8) + bx / 8 : bx; }
    fresh(F);
    unsigned char* ws = F.ws;
    for (int u = F.tid; u < (LDS_BYTES - LDSCTL_OFF) / 4; u += NWAVES * 64) ((LAS unsigned*)(F.lds + LDSCTL_OFF))[u] = 0u;
    __syncthreads();
    XcdBarrier bar; bar.bar = (unsigned*)(F.ctl() + CW_BAR); bar.x = 0; bar.st = nullptr; bar.w = F.wave;
    if (!MK_PER_PHASE) bar = xcd_barrier_post((unsigned*)(F.ctl() + CW_BAR), F.MISC + 8, F.wave);
    const int lo = args.ph_lo, hi = args.ph_hi;
#define IN(k) (lo <= (k) && (k) < hi && fresh(F))
#ifndef PROBE_A
#define PROBE_A -1
#define PROBE_B -1
#endif
#define SEAM(k) do { if (IN(k) && IN((k) + 1)) xcd_barrier(bar); if (PROBE_A >= 0 && blockIdx.x == 0 && F.tid == 0) ((unsigned long long*)(ws + WS_LB + 4096 + 256 * 1024))[(k) + 1] = __builtin_amdgcn_s_memrealtime(); } while (0)
    using pg8::Gemm; using pg8::StaticOrder;
#define RUN_GEMM(EPI, Aptr, Bptr, N_, K_, E) do { Gemm g{(const pg8::bf16_t*)(Aptr), (const pg8::bf16_t*)(Bptr), M, (N_), (K_)}; StaticOrder S; S.init(M, (N_), F.G, (int)blockIdx.x); \
        pg8::gemm_phase<EPI, StaticOrder, true, true>(F.lds + RING_OFF, g, S, E, F.wave); } while (0)

    if (PROBE_A >= 0 && blockIdx.x == 0 && F.tid == 0) ((unsigned long long*)(ws + WS_LB + 4096 + 256 * 1024))[0] = __builtin_amdgcn_s_memrealtime();
    if (IN(0)) { p0_prologue(F); } SEAM(0);
    if (IN(1)) { pg8::EpiHgrnIn E{F.QT(), F.KT(), F.VV(), F.GG(), F.E1(), F.E2(), F.SS(), F.LB()}; RUN_GEMM(pg8::EpiHgrnIn, F.XB(), F.Whin(), HIN, D, E); } SEAM(1);
    if (IN(2)) { hg::phase_a(F, F.DJ()); } SEAM(2);
    if (IN(3)) { hg::phase_b(F, F.DJ()); } SEAM(3);
    if (IN(4)) { hg::phase_c(F); } SEAM(4);
    if (IN(5)) { pg8::EpiRes E{F.XB(), F.SS()}; RUN_GEMM(pg8::EpiRes, F.QT(), F.Whout(), D, D, E); } SEAM(5);
    if (IN(6)) { pg8::EpiSwiglu E{F.FF(), F.SS()}; RUN_GEMM(pg8::EpiSwiglu, F.XB(), F.Wf1(), FF2, D, E);
        { constexpr int NU = (M / 256) * (FF2 / 256); const int full = NU / F.G, rem = NU - full * F.G;
          if (rem > 0 && (int)blockIdx.x >= rem) { fresh(F); p0_late_weights(F, (int)blockIdx.x - rem, F.G - rem); } } } SEAM(6);
    if (IN(7)) { pg8::EpiRes E{F.XB(), F.SS()}; RUN_GEMM(pg8::EpiRes, F.FF(), F.Wf2(), D, DFF, E); } SEAM(7);
    if (IN(8)) { pg8::EpiQkv E{F.QP(), F.KP(), F.VP(), F.SS(), F.COS(), F.SIN()}; RUN_GEMM(pg8::EpiQkv, F.XB(), F.Wqkv(), QKVW, D, E); } SEAM(8);
    if (IN(9)) { attn_fast(F, (char*)lds); } SEAM(9);
    if (IN(10)) {
        LAS float* rt = (LAS float*)(F.lds + MERGE_OFF);
        { StaticOrder S0; S0.init(M, D, F.G, (int)blockIdx.x); pg8::Unit u0;
          if (S0.next(0, u0) && F.tid < 256) { const float* ls = F.LSE() + (size_t)(u0.pm * 256 + F.tid) * 12; float dsum[4];
#pragma unroll
              for (int hg = 0; hg < 4; ++hg) dsum[hg] = (__expf(ls[3 * hg]) + __expf(ls[3 * hg + 1])) + __expf(ls[3 * hg + 2]);
              rt[F.tid * 4 + 0] = dsum[1] / dsum[0]; rt[F.tid * 4 + 1] = dsum[2] / dsum[1]; rt[F.tid * 4 + 2] = dsum[3] / dsum[2]; rt[F.tid * 4 + 3] = 1.0f / dsum[3]; } }
        __syncthreads();
        pg8::EpiResMerge E{F.XB(), F.SS(), rt}; RUN_GEMM(pg8::EpiResMerge, F.QP(), F.Wao(), D, AW, E); } SEAM(10);
    if (IN(11)) { pg8::EpiSwiglu E{F.FF(), F.SS()}; RUN_GEMM(pg8::EpiSwiglu, F.XB(), F.Wf1() + (size_t)FF2 * D, FF2, D, E); } SEAM(11);
    if (IN(12)) { pg8::EpiRes E{F.XB(), F.SS()}; RUN_GEMM(pg8::EpiRes, F.FF(), F.Wf2() + (size_t)D * DFF, D, DFF, E); } SEAM(12);
    if (IN(13)) { final_norm_rows(F); }
#ifdef PROBE_NULLGEMM
    if (PROBE_A >= 0) { xcd_barrier(bar);
        if (blockIdx.x == 0 && F.tid == 0) ((unsigned long long*)(ws + WS_LB + 4096 + 256 * 1024))[20] = __builtin_amdgcn_s_memrealtime();
        { pg8::EpiStoreOnly E{F.FF()}; RUN_GEMM(pg8::EpiStoreOnly, F.XB(), F.Wf1(), FF2, D, E); }
        xcd_barrier(bar);
        if (blockIdx.x == 0 && F.tid == 0) ((unsigned long long*)(ws + WS_LB + 4096 + 256 * 1024))[21] = __builtin_amdgcn_s_memrealtime(); }
#endif
    if (PROBE_A >= 0) {
        if (blockIdx.x == 0 && F.tid == 0) ((unsigned long long*)(ws + WS_LB + 4096 + 256 * 1024))[14] = __builtin_amdgcn_s_memrealtime();
        xcd_barrier(bar);
        const unsigned long long* ts = (const unsigned long long*)(ws + WS_LB + 4096 + 256 * 1024);
        if (blockIdx.x == 0 && F.tid == 0) F.out()[0] += (float)(ts[PROBE_B] - ts[PROBE_A]) * 0.0025f;
    }
#undef IN
#undef SEAM
#undef RUN_GEMM
}

extern "C" void kernel_launch(void* const* d_in, const int* in_sizes, int n_in, void* d_out, int out_size, void* d_ws, size_t ws_size, hipStream_t stream) {
    static int grid = 0;
    if (grid == 0) {
        if (n_in != 12 || in_sizes[0] != M * D || out_size != M * D || ws_size < WS_END) { fprintf(stderr, "kernel_launch: unexpected shapes (n_in %d, in0 %d, out %d, ws %zu); nothing launched\n", n_in, n_in > 0 ? in_sizes[0] : -1, out_size, ws_size); grid = -1; return; }
        int dev = 0, cus = 0, per_cu = 0;
        if (hipGetDevice(&dev) != hipSuccess || hipDeviceGetAttribute(&cus, hipDeviceAttributeMultiprocessorCount, dev) != hipSuccess) { grid = -1; return; }
        if (hipFuncSetAttribute((const void*)trunk_fwd, hipFuncAttributeMaxDynamicSharedMemorySize, LDS_BYTES) != hipSuccess) { fprintf(stderr, "kernel_launch: hipFuncSetAttribute failed\n"); grid = -1; return; }
        if (hipOccupancyMaxActiveBlocksPerMultiprocessor(&per_cu, (const void*)trunk_fwd, NWAVES * 64, LDS_BYTES) != hipSuccess || per_cu < 1)
            fprintf(stderr, "kernel_launch: note: the occupancy query reports %d workgroups per CU\n", per_cu);
        (void)hipGetLastError();
        grid = cus;
    }
    if (grid < 0) return;
    if (hipMemsetAsync((char*)d_ws + WS_CTL, 0, CTL_ZERO_BYTES, stream) != hipSuccess) { fprintf(stderr, "kernel_launch: hipMemsetAsync failed\n"); return; }
    Args a{};
    for (int i = 0; i < 12; ++i) a.in[i] = (const float*)d_in[i];
    a.out = (float*)d_out; a.ws = (unsigned char*)d_ws;
#if MK_PER_PHASE
    for (int p = 0; p < NPH; ++p) { a.ph_lo = p; a.ph_hi = p + 1; hipLaunchKernelGGL(trunk_fwd, dim3(grid), dim3(NWAVES * 64), LDS_BYTES, stream, a); }
#else
    a.ph_lo = 0; a.ph_hi = NPH; hipLaunchKernelGGL(trunk_fwd, dim3(grid), dim3(NWAVES * 64), LDS_BYTES, stream, a);
#endif
    const hipError_t le = hipPeekAtLastError();
    if (le != hipSuccess) fprintf(stderr, "kernel_launch: launch failed: %s (grid %d)\n", hipGetErrorName(le), grid);
}
```
